# Optimizing an MI355X kernel written in HIP

```python
import math
import jax, jax.numpy as jnp
from jax import lax
import numpy as np

D_MODEL = 2048
BATCH = 2
SEQ = 16384
DEPTH = 2

HEAD_DIM = 128
A_GROUPS = ((128, 1), (512, 4), (2048, 16))
A_HEADS_PER_GROUP = 4
A_HEADS = A_HEADS_PER_GROUP * len(A_GROUPS)
A_BLOCK = 64
A_QKV_W = A_HEADS * HEAD_DIM
A_OUT_W = A_HEADS_PER_GROUP * HEAD_DIM
B_Q_HEADS = 8
B_KV_HEADS = 2
B_HALF = 128
B_BLOCK = 128
B_Q_W = B_Q_HEADS * HEAD_DIM
B_KV_W = B_KV_HEADS * HEAD_DIM
NUM_BUCKETS = 32
MAX_DISTANCE = 1024
N_BIAS_HEADS = A_HEADS + B_Q_HEADS
SPLITS = (A_QKV_W, A_QKV_W, A_QKV_W, B_Q_W, B_KV_W, B_KV_W, D_MODEL, D_MODEL)
C_IN = sum(SPLITS)
D_FF = -(-8 * D_MODEL // (3 * 256)) * 256
DEEPNORM_ALPHA = (2 * DEPTH) ** 0.25
DEEPNORM_BETA = (8 * DEPTH) ** -0.25
LN_EPS = 1e-5
NEG_INF = -1e30

kernel_name = 'hybrid_dilated_window_gqa_encoder'


def t5_bucket(rel):
    half = NUM_BUCKETS // 2
    max_exact = half // 2
    n = np.abs(rel)
    scaled = np.log(np.maximum(n, 1) / max_exact) / math.log(MAX_DISTANCE / max_exact)
    large = np.minimum(max_exact + (scaled * (half - max_exact)).astype(np.int64), half - 1)
    return (np.where(rel > 0, half, 0) + np.where(n < max_exact, n, large)).astype(np.int32)


def band_offsets(blk):
    qi = np.arange(blk)[:, None]
    kj = np.arange(3 * blk)[None, :]
    return kj - blk - qi


def banded_attention(q, k, v, bias, half, blk, sink=None):
    n_, hk, r, seq_len, dh = q.shape
    nb = -(-seq_len // blk)
    lp = nb * blk
    qb = jnp.pad(q, ((0, 0), (0, 0), (0, 0), (0, lp - seq_len), (0, 0)))
    qb = qb.reshape(n_, hk, r, nb, blk, dh).astype(jnp.float32)

    def windows(t):
        tp = jnp.pad(t, ((0, 0), (0, 0), (blk, lp - seq_len + blk), (0, 0)))
        tp = tp.reshape(n_, hk, nb + 2, blk, dh)
        return jnp.concatenate([tp[:, :, :nb], tp[:, :, 1:nb + 1], tp[:, :, 2:]], axis=3).astype(jnp.float32)

    kw, vw = windows(k), windows(v)
    rel = band_offsets(blk)
    key_pos = (np.arange(nb)[:, None] - 1) * blk + np.arange(3 * blk)[None, :]
    mask = (np.abs(rel) <= half)[None] & ((key_pos >= 0) & (key_pos < seq_len))[:, None, :]
    s = jnp.einsum('nhrcid,nhcjd->nhrcij', qb, kw) * (dh ** -0.5) + bias[:, :, None]
    s = jnp.where(mask, s, NEG_INF)
    m = s.max(-1)
    if sink is not None:
        sk = sink.astype(jnp.float32)[:, :, None, None]
        m = jnp.maximum(m, sk)
    p = jnp.exp(s - m[..., None])
    den = p.sum(-1)
    if sink is not None:
        den = den + jnp.exp(sk - m)
    o = jnp.einsum('nhrcij,nhcjd->nhrcid', p, vw) / den[..., None]
    o = o.reshape(n_, hk, r, lp, dh)[..., :seq_len, :]
    lse = (m + jnp.log(den)).reshape(n_, hk, r, lp)[..., :seq_len]
    return o, lse


def dilated_mixture(q, k, v, rel_bias):
    bt, s_len, _ = q.shape
    hg = A_HEADS_PER_GROUP
    shp = (bt, s_len, len(A_GROUPS), hg, HEAD_DIM)
    q, k, v = q.reshape(shp), k.reshape(shp), v.reshape(shp)
    rel = band_offsets(A_BLOCK)
    outs, lses = [], []
    for g, (window, dil) in enumerate(A_GROUPS):
        half = window // (2 * dil)
        sub_len = s_len // dil

        def strided(t):
            t = t[:, :, g].reshape(bt, sub_len, dil, hg, HEAD_DIM)
            return t.transpose(0, 2, 3, 1, 4).reshape(bt * dil, hg, sub_len, HEAD_DIM)

        cols = slice(g * hg, (g + 1) * hg)
        bias = rel_bias[t5_bucket(rel * dil)][..., cols]
        bias = bias.transpose(2, 0, 1)[:, None].astype(jnp.float32)
        o, lse = banded_attention(strided(q)[:, :, None], strided(k), strided(v), bias, half, A_BLOCK)
        o = o[:, :, 0].reshape(bt, dil, hg, sub_len, HEAD_DIM).transpose(0, 3, 1, 2, 4)
        outs.append(o.reshape(bt, s_len, hg, HEAD_DIM))
        lse = lse[:, :, 0].reshape(bt, dil, hg, sub_len).transpose(0, 3, 1, 2)
        lses.append(lse.reshape(bt, s_len, hg))
    w = jax.nn.softmax(jnp.stack(lses), axis=0)
    o = jnp.einsum('gbsh,gbshd->bshd', w, jnp.stack(outs))
    return o.reshape(bt, s_len, A_OUT_W)


def windowed_gqa(q, k, v, rel_bias, sink):
    bt, s_len, _ = q.shape
    rep = B_Q_HEADS // B_KV_HEADS
    q = q.reshape(bt, s_len, B_KV_HEADS, rep, HEAD_DIM).transpose(0, 2, 3, 1, 4)
    k = k.reshape(bt, s_len, B_KV_HEADS, HEAD_DIM).transpose(0, 2, 1, 3)
    v = v.reshape(bt, s_len, B_KV_HEADS, HEAD_DIM).transpose(0, 2, 1, 3)
    bias = rel_bias[t5_bucket(band_offsets(B_BLOCK))][..., A_HEADS:]
    bias = bias.transpose(2, 0, 1).reshape(B_KV_HEADS, rep, B_BLOCK, 3 * B_BLOCK).astype(jnp.float32)
    o, _ = banded_attention(q, k, v, bias, B_HALF, B_BLOCK, sink.reshape(B_KV_HEADS, rep))
    return o.transpose(0, 3, 1, 2, 4).reshape(bt, s_len, B_Q_W)


def layer_norm(x, g, b):
    xf = x.astype(jnp.float32)
    mu = xf.mean(-1, keepdims=True)
    var = jnp.square(xf - mu).mean(-1, keepdims=True)
    return ((xf - mu) * lax.rsqrt(var + LN_EPS) * g + b).astype(x.dtype)


def hybrid_layer(x, rel_bias, w_in, sink, w_pa, w_pb, w_out, ln1_g, ln1_b, w_up, w_down, ln2_g, ln2_b):
    dt = x.dtype
    split_points = [int(c) for c in np.cumsum(SPLITS)[:-1]]
    proj = jnp.einsum('bsd,dc->bsc', x, w_in)
    qa, ka, va, qb, kb, vb, ga, gb = jnp.split(proj, split_points, axis=-1)
    ya = dilated_mixture(qa, ka, va, rel_bias).astype(dt) @ w_pa
    yb = windowed_gqa(qb, kb, vb, rel_bias, sink).astype(dt) @ w_pb
    merged = jax.nn.sigmoid(ga) * ya + jax.nn.sigmoid(gb) * yb
    x = layer_norm(DEEPNORM_ALPHA * x + merged @ w_out, ln1_g, ln1_b)
    gate, up = jnp.split(x @ w_up, 2, axis=-1)
    x = layer_norm(DEEPNORM_ALPHA * x + (jax.nn.silu(gate) * up) @ w_down, ln2_g, ln2_b)
    return x


def setup_inputs(seed: int = 0) -> dict:
    key = jax.random.key(seed)
    ks = jax.random.split(key, 13)
    beta = DEEPNORM_BETA
    nrm = jax.random.normal
    col_scale = np.ones((C_IN,), np.float32)
    col_scale[2 * A_QKV_W:3 * A_QKV_W] = beta
    vb0 = 3 * A_QKV_W + B_Q_W + B_KV_W
    col_scale[vb0:vb0 + B_KV_W] = beta
    x = nrm(ks[0], (BATCH, SEQ, D_MODEL), jnp.float32)
    rel_bias = 0.5 * nrm(ks[1], (NUM_BUCKETS, N_BIAS_HEADS), jnp.float32)
    w_in = nrm(ks[2], (DEPTH, D_MODEL, C_IN), jnp.float32) * (D_MODEL ** -0.5) * jnp.asarray(col_scale)
    sink = 0.5 * nrm(ks[3], (DEPTH, B_Q_HEADS), jnp.float32)
    w_pa = nrm(ks[4], (DEPTH, A_OUT_W, D_MODEL), jnp.float32) * (A_OUT_W ** -0.5) * beta
    w_pb = nrm(ks[5], (DEPTH, B_Q_W, D_MODEL), jnp.float32) * (B_Q_W ** -0.5) * beta
    w_out = nrm(ks[6], (DEPTH, D_MODEL, D_MODEL), jnp.float32) * (D_MODEL ** -0.5) * beta
    ln1_g = 1.0 + 0.02 * nrm(ks[7], (DEPTH, D_MODEL), jnp.float32)
    ln1_b = 0.02 * nrm(ks[8], (DEPTH, D_MODEL), jnp.float32)
    w_up = nrm(ks[9], (DEPTH, D_MODEL, 2 * D_FF), jnp.float32) * (D_MODEL ** -0.5) * beta
    w_down = nrm(ks[10], (DEPTH, D_FF, D_MODEL), jnp.float32) * (D_FF ** -0.5) * beta
    ln2_g = 1.0 + 0.02 * nrm(ks[11], (DEPTH, D_MODEL), jnp.float32)
    ln2_b = 0.02 * nrm(ks[12], (DEPTH, D_MODEL), jnp.float32)
    return {'x': x, 'rel_bias': rel_bias, 'w_in': w_in, 'sink': sink, 'w_pa': w_pa, 'w_pb': w_pb,
            'w_out': w_out, 'ln1_g': ln1_g, 'ln1_b': ln1_b, 'w_up': w_up, 'w_down': w_down,
            'ln2_g': ln2_g, 'ln2_b': ln2_b}


def reference(x, rel_bias, w_in, sink, w_pa, w_pb, w_out, ln1_g, ln1_b, w_up, w_down, ln2_g, ln2_b):
    for l in range(DEPTH):
        x = hybrid_layer(x, rel_bias, w_in[l], sink[l], w_pa[l], w_pb[l], w_out[l],
                         ln1_g[l], ln1_b[l], w_up[l], w_down[l], ln2_g[l], ln2_b[l])
    return x
```

```cpp
#include <hip/hip_runtime.h>
#include <hip/hip_cooperative_groups.h>
#include <cstdio>
#include <cstdint>
namespace cg = cooperative_groups;
namespace pg8 {
#define PG8_LAS __attribute__((address_space(3)))
typedef unsigned short bf16_t;
typedef short bf16x8 __attribute__((ext_vector_type(8)));
typedef float f32x4 __attribute__((ext_vector_type(4)));
typedef unsigned u32x4 __attribute__((ext_vector_type(4)));
constexpr int BM = 256, BK = 64, HALF = 128, HTB = HALF * BK * 2  , STAGE_BYTES = 8 * HTB, NXCD = 8, WGM = 8;

__host__ __device__ __forceinline__ int lds_byte(int r, int c) { const int st = (r >> 4) * 2 + (c >> 5), rr = r & 15, cc = c & 31, ob = rr * 64 + cc * 2; return st * 1024 + (ob ^ (((ob >> 9) & 1) << 5)); }
__host__ __device__ __forceinline__ void stage_rc(int b, int& R, int& C) { const int st = b / 1024, sb = b % 1024, swz = sb ^ (((sb >> 9) & 1) << 5); R = (st >> 1) * 16 + swz / 64; C = (st & 1) * 32 + (swz % 64) / 2; }
__host__ __device__ __forceinline__ int perm32(int rho) { const int n = rho >> 4, i = rho & 15; return 8 * (i >> 2) + 4 * n + (i & 3); }

struct Unit { int pm, pn; };
struct Gemm { const bf16_t* A; const bf16_t* Bt; int M, N, K; };

struct StaticOrder {
    int nM, nN, nwg, G, c;
    __host__ __device__ void init(int M, int N, int G_, int c_) { nM = M / BM; nN = N / BM; nwg = nM * nN; G = G_; c = c_; }
    __host__ __device__ bool next(int i, Unit& u) const {
        const long L = (long)i * G + c; if (L >= nwg) return false;
        int wgid = (int)L; { const int q = nwg / NXCD, r = nwg % NXCD, xcd = wgid % NXCD, off = wgid / NXCD; wgid = (xcd < r ? xcd * (q + 1) : r * (q + 1) + (xcd - r) * q) + off; }
        const int nig = WGM * nN, gid = wgid / nig, fm = gid * WGM, gsz = (nM - fm) < WGM ? (nM - fm) : WGM;
        u.pm = fm + ((wgid % nig) % gsz); u.pn = (wgid % nig) / gsz; return true;
    }
    __device__ __forceinline__ void a_ready(const Unit&) const {}
    __device__ __forceinline__ void done(const Unit&) const {}
};

__device__ __forceinline__ unsigned cvt_pk_bf16(float lo, float hi) { unsigned r; asm("v_cvt_pk_bf16_f32 %0, %1, %2" : "=v"(r) : "v"(lo), "v"(hi)); return r; }
typedef float f32x2 __attribute__((ext_vector_type(2)));
template <int ACT  > struct EpiBf16 {
    static constexpr bool PERM = true, AFTER_DRAIN = false; static_assert(ACT == 0 || ACT == 1, "EpiBf16: ACT is 0 (none) or 1 (gelu_pk)");
    bf16_t* O; int ldc; const float* bias; int split_cols; size_t split_stride; float scale0;
    __device__ __forceinline__ void operator()(const f32x4 (&acc)[2][2][4][2], const Unit& u, int wr, int wc, int fr, int fq) const {
        const int row0 = u.pm * BM + wr * 64 + fr; int colt = u.pn * BM; bf16_t* base = O;
        float sc = 1.f; if (split_cols) { const int t = colt / split_cols; base += (size_t)t * split_stride; colt -= t * split_cols; if (t == 0) sc = scale0; }
        const int col0 = colt + wc * 32 + 8 * fq, bcol0 = u.pn * BM + wc * 32 + 8 * fq;
        f32x4 bv[2][2];
#pragma unroll
        for (int bj = 0; bj < 2; ++bj)
#pragma unroll
            for (int n = 0; n < 2; ++n) bv[bj][n] = bias ? *(const f32x4*)(bias + bcol0 + bj * HALF + 4 * n) : (f32x4){0.f, 0.f, 0.f, 0.f};
#pragma unroll
        for (int ai = 0; ai < 2; ++ai)
#pragma unroll
            for (int m = 0; m < 4; ++m) { bf16_t* rowp = base + (size_t)(row0 + ai * HALF + m * 16) * ldc + col0;
#pragma unroll
                for (int bj = 0; bj < 2; ++bj) { f32x4 v0 = acc[ai][bj][m][0] + bv[bj][0], v1 = acc[ai][bj][m][1] + bv[bj][1];
                    v0 = v0 * sc; v1 = v1 * sc; u32x4 w; w.x = cvt_pk_bf16(v0[0], v0[1]); w.y = cvt_pk_bf16(v0[2], v0[3]); w.z = cvt_pk_bf16(v1[0], v1[1]); w.w = cvt_pk_bf16(v1[2], v1[3]);
                    *(u32x4*)(rowp + bj * HALF) = w; } }
    }
};
__device__ __forceinline__ float sigmoidf_fast(float x) { return __builtin_amdgcn_rcpf(1.0f + __builtin_amdgcn_exp2f(-1.4426950408889634f * x)); }
__device__ __forceinline__ float bf_lo(unsigned w) { return __uint_as_float(w << 16); }
__device__ __forceinline__ float bf_hi(unsigned w) { return __uint_as_float(w & 0xffff0000u); }
struct EpiGate {
    static constexpr bool PERM = true, AFTER_DRAIN = false;
    bf16_t* O; int ldo; const bf16_t* G; int ldg; int add;
    __device__ __forceinline__ void operator()(const f32x4 (&acc)[2][2][4][2], const Unit& u, int wr, int wc, int fr, int fq) const {
        const int row0 = u.pm * BM + wr * 64 + fr, col0 = u.pn * BM + wc * 32 + 8 * fq;
#pragma unroll
        for (int ai = 0; ai < 2; ++ai)
#pragma unroll
            for (int m = 0; m < 4; ++m) { const size_t r = (size_t)(row0 + ai * HALF + m * 16); bf16_t* rowp = O + r * ldo + col0; const bf16_t* gp = G + r * ldg + col0;
#pragma unroll
                for (int bj = 0; bj < 2; ++bj) { const u32x4 gw = *(const u32x4*)(gp + bj * HALF); f32x4 v0 = acc[ai][bj][m][0], v1 = acc[ai][bj][m][1];
                    v0[0] *= sigmoidf_fast(bf_lo(gw.x)); v0[1] *= sigmoidf_fast(bf_hi(gw.x)); v0[2] *= sigmoidf_fast(bf_lo(gw.y)); v0[3] *= sigmoidf_fast(bf_hi(gw.y));
                    v1[0] *= sigmoidf_fast(bf_lo(gw.z)); v1[1] *= sigmoidf_fast(bf_hi(gw.z)); v1[2] *= sigmoidf_fast(bf_lo(gw.w)); v1[3] *= sigmoidf_fast(bf_hi(gw.w));
                    if (add) { const u32x4 pw = *(const u32x4*)(rowp + bj * HALF);
                        v0[0] += bf_lo(pw.x); v0[1] += bf_hi(pw.x); v0[2] += bf_lo(pw.y); v0[3] += bf_hi(pw.y); v1[0] += bf_lo(pw.z); v1[1] += bf_hi(pw.z); v1[2] += bf_lo(pw.w); v1[3] += bf_hi(pw.w); }
                    u32x4 w; w.x = cvt_pk_bf16(v0[0], v0[1]); w.y = cvt_pk_bf16(v0[2], v0[3]); w.z = cvt_pk_bf16(v1[0], v1[1]); w.w = cvt_pk_bf16(v1[2], v1[3]);
                    *(u32x4*)(rowp + bj * HALF) = w; } }
    }
};
struct EpiResid {
    static constexpr bool PERM = false, AFTER_DRAIN = false;
    const float* X; float* Y; int ldc; float alpha;
    __device__ __forceinline__ void operator()(const f32x4 (&acc)[2][2][4][2], const Unit& u, int wr, int wc, int fr, int fq) const {
        const int row0 = u.pm * BM + wr * 64 + fr, col0 = u.pn * BM + wc * 32 + 4 * fq;
#pragma unroll
        for (int ai = 0; ai < 2; ++ai)
#pragma unroll
            for (int m = 0; m < 4; ++m) { const size_t off = (size_t)(row0 + ai * HALF + m * 16) * ldc + col0;
#pragma unroll
                for (int bj = 0; bj < 2; ++bj)
#pragma unroll
                    for (int n = 0; n < 2; ++n) { const f32x4 xv = *(const f32x4*)(X + off + bj * HALF + n * 16); *(f32x4*)(Y + off + bj * HALF + n * 16) = xv * alpha + acc[ai][bj][m][n]; }
                asm volatile("" ::: "memory"); }
    }
};
struct EpiSwiglu {
    static constexpr bool PERM = true, AFTER_DRAIN = false;
    bf16_t* Hh; int ldh;
    __device__ __forceinline__ void operator()(const f32x4 (&acc)[2][2][4][2], const Unit& u, int wr, int wc, int fr, int fq) const {
        const int row0 = u.pm * BM + wr * 64 + fr, col0 = u.pn * HALF + wc * 32 + 8 * fq;
#pragma unroll
        for (int ai = 0; ai < 2; ++ai)
#pragma unroll
            for (int m = 0; m < 4; ++m) { bf16_t* rowp = Hh + (size_t)(row0 + ai * HALF + m * 16) * ldh + col0; float hv[8];
#pragma unroll
                for (int n = 0; n < 2; ++n)
#pragma unroll
                    for (int j = 0; j < 4; ++j) { const float g = acc[ai][0][m][n][j], up = acc[ai][1][m][n][j]; hv[n * 4 + j] = g * sigmoidf_fast(g) * up; }
                u32x4 w; w.x = cvt_pk_bf16(hv[0], hv[1]); w.y = cvt_pk_bf16(hv[2], hv[3]); w.z = cvt_pk_bf16(hv[4], hv[5]); w.w = cvt_pk_bf16(hv[6], hv[7]);
                *(u32x4*)rowp = w; }
    }
};
template <class Epi, class Sched, bool ALIGN_EPI = false, bool SP2 = false>
__device__ __forceinline__ void gemm_phase(PG8_LAS unsigned char* lds, const Gemm g, const Sched& S, const Epi& E) {
    int tid_ = threadIdx.x; asm volatile("" : "+v"(tid_));
    const int tid = tid_, wid = __builtin_amdgcn_readfirstlane(tid >> 6), lane = tid & 63, wr = wid >> 2, wc = wid & 3, fr = lane & 15, fq = lane >> 4;
    const int K = g.K, nt = K / BK;
    unsigned voffA[2], voffB[2];
#pragma unroll
    for (int i = 0; i < 2; ++i) { int R, C; stage_rc(tid * 16 + i * 8192, R, C); const int Rb = Epi::PERM ? ((R & ~31) + perm32(R & 31)) : R;
        voffA[i] = (unsigned)(R * K + C) * 2u; voffB[i] = (unsigned)(Rb * K + C) * 2u; }
    const size_t kstep = (size_t)(BK * 2);
    const size_t hstep = (size_t)HALF * K * 2;
    const size_t tstep = 2 * hstep;
    const unsigned ldsw = (unsigned)wid * 1024u;
    const int aoff = lds_byte(wr * 64 + fr, fq * 8), boff = lds_byte(wc * 32 + fr, fq * 8);
#define PG8_SA(b, h) (((b) * 2 + (h)) * HTB)
#define PG8_SB(b, h) ((4 + (b) * 2 + (h)) * HTB)
#define PG8_STAGE(bufoff, gbase, voff) do { _Pragma("unroll") for (int _i = 0; _i < 2; ++_i) \
        __builtin_amdgcn_global_load_lds((const unsigned*)((const char*)(gbase) + (voff)[_i]), (PG8_LAS unsigned*)(lds + (bufoff) + ldsw + _i * 8192), 16, 0, 0); } while (0)
#define PG8_LDA(dst, b, h) do { _Pragma("unroll") for (int m = 0; m < 4; ++m) _Pragma("unroll") for (int k = 0; k < 2; ++k) dst[m][k] = *(const PG8_LAS bf16x8*)(lds + PG8_SA(b, h) + aoff + m * 2048 + k * 1024); } while (0)
#define PG8_LDB(dst, b, h) do { _Pragma("unroll") for (int n = 0; n < 2; ++n) _Pragma("unroll") for (int k = 0; k < 2; ++k) dst[n][k] = *(const PG8_LAS bf16x8*)(lds + PG8_SB(b, h) + boff + n * 2048 + k * 1024); } while (0)
#define PG8_MMA(ai, bj, At, Bt) do { __builtin_amdgcn_s_setprio(1); _Pragma("unroll") for (int m = 0; m < 4; ++m) _Pragma("unroll") for (int n = 0; n < 2; ++n) _Pragma("unroll") for (int k = 0; k < 2; ++k) \
        acc[ai][bj][m][n] = __builtin_amdgcn_mfma_f32_16x16x32_bf16(Bt[n][k], At[m][k], acc[ai][bj][m][n], 0, 0, 0); __builtin_amdgcn_s_setprio(0); } while (0)
#define PG8_WAIT_V(n) asm volatile("s_waitcnt vmcnt(" #n ")" ::: "memory")
#define PG8_WAIT_L(n) asm volatile("s_waitcnt lgkmcnt(" #n ")" ::: "memory")
#define PG8_BAR __builtin_amdgcn_s_barrier()
#define PG8_SCHED __builtin_amdgcn_sched_barrier(0)
    Unit cur, nxt; int ui = 0;
    if (!S.next(0, cur)) return;
    f32x4 acc[2][2][4][2];
#pragma unroll
    for (int a = 0; a < 2; ++a)
#pragma unroll
        for (int b = 0; b < 2; ++b)
#pragma unroll
            for (int m = 0; m < 4; ++m)
#pragma unroll
                for (int n = 0; n < 2; ++n) acc[a][b][m][n] = (f32x4){0.f, 0.f, 0.f, 0.f};
    bf16x8 At[4][2], B0[2][2], B1[2][2];
    const char* cA = (const char*)g.A + (size_t)cur.pm * tstep; const char* cB = (const char*)g.Bt + (size_t)cur.pn * tstep;
    S.a_ready(cur);
    if constexpr (SP2) {
        PG8_STAGE(PG8_SB(0, 0), cB, voffB); PG8_STAGE(PG8_SB(0, 1), cB + hstep, voffB); PG8_STAGE(PG8_SA(0, 0), cA, voffA); PG8_STAGE(PG8_SA(0, 1), cA + hstep, voffA);
        if (wr == 1) PG8_BAR;
        PG8_WAIT_V(2); PG8_BAR;
        PG8_STAGE(PG8_SB(1, 0), cB + kstep, voffB); PG8_STAGE(PG8_SA(1, 0), cA + kstep, voffA); PG8_STAGE(PG8_SB(1, 1), cB + hstep + kstep, voffB);
        PG8_WAIT_V(6); PG8_BAR;
    } else {
        PG8_STAGE(PG8_SB(0, 0), cB, voffB); PG8_STAGE(PG8_SA(0, 0), cA, voffA); PG8_STAGE(PG8_SB(0, 1), cB + hstep, voffB); PG8_STAGE(PG8_SA(0, 1), cA + hstep, voffA);
        if (wr == 1) PG8_BAR;
        PG8_WAIT_V(4); PG8_BAR;
        PG8_STAGE(PG8_SB(1, 0), cB + kstep, voffB); PG8_STAGE(PG8_SA(1, 0), cA + kstep, voffA); PG8_STAGE(PG8_SB(1, 1), cB + hstep + kstep, voffB);
        PG8_WAIT_V(6); PG8_BAR;
    }
    for (;;) {
        const bool has_next = S.next(ui + 1, nxt);
        const char* nA = has_next ? (const char*)g.A + (size_t)nxt.pm * tstep : cA; const char* nB = has_next ? (const char*)g.Bt + (size_t)nxt.pn * tstep : cB;
        for (int t = 0; t < nt; t += 2) {
            const bool last = (t == nt - 2);
            const char* a1 = cA + (size_t)(t + 1) * kstep;
            const char* a2 = last ? nA : cA + (size_t)(t + 2) * kstep; const char* b2 = last ? nB : cB + (size_t)(t + 2) * kstep;
            const char* a3 = a2 + kstep; const char* b3 = b2 + kstep;
            if (last && has_next) S.a_ready(nxt);
            if constexpr (SP2) {
            PG8_LDB(B0, 0, 0); PG8_LDB(B1, 0, 1); PG8_SCHED; PG8_LDA(At, 0, 0); PG8_STAGE(PG8_SA(1, 1), a1 + hstep, voffA);
            PG8_WAIT_V(8); PG8_WAIT_L(0); PG8_BAR; PG8_MMA(0, 0, At, B0); PG8_MMA(0, 1, At, B1); PG8_BAR; PG8_SCHED;
            PG8_LDA(At, 0, 1); PG8_STAGE(PG8_SB(0, 0), b2, voffB); PG8_STAGE(PG8_SB(0, 1), b2 + hstep, voffB); PG8_STAGE(PG8_SA(0, 0), a2, voffA);
            PG8_WAIT_V(8); PG8_WAIT_L(0); PG8_BAR; PG8_MMA(1, 0, At, B0); PG8_MMA(1, 1, At, B1); PG8_BAR; PG8_SCHED;
            PG8_LDB(B0, 1, 0); PG8_LDB(B1, 1, 1); PG8_SCHED; PG8_LDA(At, 1, 0); PG8_STAGE(PG8_SA(0, 1), a2 + hstep, voffA);
            PG8_WAIT_V(8); PG8_WAIT_L(0); PG8_BAR; PG8_MMA(0, 0, At, B0); PG8_MMA(0, 1, At, B1); PG8_BAR; PG8_SCHED;
            PG8_LDA(At, 1, 1); PG8_STAGE(PG8_SB(1, 0), b3, voffB); PG8_STAGE(PG8_SB(1, 1), b3 + hstep, voffB); PG8_STAGE(PG8_SA(1, 0), a3, voffA);
            PG8_WAIT_V(8); PG8_WAIT_L(0); PG8_BAR; PG8_MMA(1, 0, At, B0); PG8_MMA(1, 1, At, B1); PG8_BAR; PG8_SCHED;
            } else {
            PG8_LDB(B0, 0, 0); PG8_SCHED; PG8_LDA(At, 0, 0); PG8_STAGE(PG8_SA(1, 1), a1 + hstep, voffA);
            PG8_WAIT_L(8); PG8_BAR; PG8_WAIT_L(0); PG8_MMA(0, 0, At, B0); PG8_BAR; PG8_SCHED;
            PG8_LDB(B1, 0, 1); PG8_STAGE(PG8_SB(0, 0), b2, voffB);
            PG8_BAR; PG8_WAIT_L(0); PG8_MMA(0, 1, At, B1); PG8_BAR;
            PG8_LDA(At, 0, 1); PG8_STAGE(PG8_SA(0, 0), a2, voffA);
            PG8_BAR; PG8_WAIT_L(0); PG8_MMA(1, 0, At, B0); PG8_BAR; PG8_SCHED;
            PG8_STAGE(PG8_SB(0, 1), b2 + hstep, voffB);
            PG8_WAIT_V(6); PG8_BAR; PG8_MMA(1, 1, At, B1); PG8_BAR;
            PG8_LDB(B0, 1, 0); PG8_SCHED; PG8_LDA(At, 1, 0); PG8_STAGE(PG8_SA(0, 1), a2 + hstep, voffA);
            PG8_WAIT_L(8); PG8_BAR; PG8_WAIT_L(0); PG8_MMA(0, 0, At, B0); PG8_BAR; PG8_SCHED;
            PG8_LDB(B1, 1, 1); PG8_STAGE(PG8_SB(1, 0), b3, voffB);
            PG8_BAR; PG8_WAIT_L(0); PG8_MMA(0, 1, At, B1); PG8_BAR;
            PG8_LDA(At, 1, 1); PG8_STAGE(PG8_SA(1, 0), a3, voffA);
            PG8_BAR; PG8_WAIT_L(0); PG8_MMA(1, 0, At, B0); PG8_BAR; PG8_SCHED;
            PG8_STAGE(PG8_SB(1, 1), b3 + hstep, voffB);
            PG8_WAIT_V(6); PG8_BAR; PG8_MMA(1, 1, At, B1); PG8_BAR;
            }
        }
        if constexpr (ALIGN_EPI) { if (wr == 0) PG8_BAR; }
        if constexpr (!Epi::AFTER_DRAIN) { E(acc, cur, wr, wc, fr, fq); S.done(cur); }
        if (!has_next) break;
#pragma unroll
        for (int a = 0; a < 2; ++a)
#pragma unroll
            for (int b = 0; b < 2; ++b)
#pragma unroll
                for (int m = 0; m < 4; ++m)
#pragma unroll
                    for (int n = 0; n < 2; ++n) acc[a][b][m][n] = (f32x4){0.f, 0.f, 0.f, 0.f};
        cur = nxt; cA = nA; cB = nB; ++ui;
        if constexpr (ALIGN_EPI) { if (wr == 1) PG8_BAR; }
    }
    PG8_WAIT_V(0);
    if constexpr (!ALIGN_EPI) { if (wr == 0) PG8_BAR; }
    PG8_BAR;
    if constexpr (Epi::AFTER_DRAIN) { E.fused(acc, cur, wr, wc, fr, fq, lds, wid, lane); S.done(cur); }
#undef PG8_SA
#undef PG8_SB
#undef PG8_STAGE
#undef PG8_LDA
#undef PG8_LDB
#undef PG8_MMA
#undef PG8_WAIT_V
#undef PG8_WAIT_L
#undef PG8_BAR
#undef PG8_SCHED
}
}

#ifndef EN_INPROJ
#define EN_INPROJ 1
#endif
#ifndef EN_GATE
#define EN_GATE 1
#endif
#ifndef EN_RESID
#define EN_RESID 1
#endif
#ifndef EN_SWIGLU
#define EN_SWIGLU 1
#endif
#ifndef EN_ATTN
#define EN_ATTN 1
#endif
#ifndef EN_PRO
#define EN_PRO 1
#endif
#define LAS __attribute__((address_space(3)))
typedef unsigned short bf16;
typedef short bf16x8 __attribute__((ext_vector_type(8)));
typedef short s16x4 __attribute__((ext_vector_type(4)));
typedef float f32x4 __attribute__((ext_vector_type(4)));
typedef float f32x16 __attribute__((ext_vector_type(16)));
typedef unsigned u32x4 __attribute__((ext_vector_type(4)));
typedef unsigned u32x2 __attribute__((ext_vector_type(2)));

constexpr int T = 32768, TH = 16384, D = 2048, CIN = 10240, DFF = 5632, NUP = 11264, SEQ = 16384;
constexpr int NWAVES = 8, NTHREADS = 512;
constexpr float ALPHA = 1.41421356237309515f;
constexpr float LN_EPS = 1e-5f;
constexpr float LOG2E = 1.4426950408889634f;
constexpr int LDS_BYTES = 163840;
constexpr int NPHASES = 27;

constexpr size_t MiB = (size_t)1 << 20;
constexpr size_t WS_TAB = 0;
constexpr size_t WS_W0 = 1 * MiB, WS_WL = 120 * MiB;
constexpr size_t WO_IN = 0, WO_PA = WO_IN + (size_t)CIN * D, WO_PB = WO_PA + (size_t)D * 512, WO_OUT = WO_PB + (size_t)D * 1024, WO_UP = WO_OUT + (size_t)D * D,
                 WO_DN = WO_UP + (size_t)NUP * D, WO_END = WO_DN + (size_t)D * DFF;
static_assert(WO_END * 2 <= WS_WL, "weight block");
constexpr size_t WS_XB = 241 * MiB;
constexpr size_t WS_PROJ = 369 * MiB;
constexpr size_t WS_AR = 689 * MiB;
constexpr size_t WS_LSE = 737 * MiB;
constexpr size_t WS_AO = 738 * MiB;
constexpr size_t WS_BO = 754 * MiB;
constexpr size_t WS_H = 369 * MiB;
constexpr size_t WS_END = 786 * MiB;

struct Params {
    const float* x; const float* rel_bias; const float* w_in; const float* sink; const float* w_pa; const float* w_pb; const float* w_out;
    const float* ln1_g; const float* ln1_b; const float* w_up; const float* w_down; const float* ln2_g; const float* ln2_b;
    float* out; unsigned char* ws; int ph_lo, ph_hi;
};

__device__ __forceinline__ unsigned pk2(float a, float b) { return pg8::cvt_pk_bf16(a, b); }
__device__ __forceinline__ float shx(float v, int o, int lane) { return __int_as_float(__builtin_amdgcn_ds_bpermute((lane ^ o) << 2, __float_as_int(v))); }
__device__ __forceinline__ float wave_sum(float v, int lane) {
#pragma unroll
    for (int o = 1; o < 64; o <<= 1) v += shx(v, o, lane);
    return v;
}
#define LDS_WAIT() asm volatile("s_waitcnt lgkmcnt(0)" ::: "memory")

__device__ __forceinline__ void transpose_item(const float* __restrict__ W, int K, int N, bf16* WT, int k0, int n0, int row0, LAS float* scr, int lane) {
#pragma unroll 8
    for (int i = 0; i < 32; ++i) { const int kk = 2 * i + (lane >> 5); scr[kk * 33 + (lane & 31)] = W[(size_t)(k0 + kk) * N + n0 + (lane & 31)]; }
    LDS_WAIT();
    const int c = lane & 7;
#pragma unroll
    for (int j = 0; j < 4; ++j) { const int n = (lane >> 3) + 8 * j; const LAS float* s = scr + (8 * c) * 33 + n;
        u32x4 o; o.x = pk2(s[0 * 33], s[1 * 33]); o.y = pk2(s[2 * 33], s[3 * 33]); o.z = pk2(s[4 * 33], s[5 * 33]); o.w = pk2(s[6 * 33], s[7 * 33]);
        *(u32x4*)(WT + (size_t)(row0 + n) * K + k0 + 8 * c) = o; }
    LDS_WAIT();
}
__device__ __forceinline__ int t5_bucket(int rel) {
    const int n = rel < 0 ? -rel : rel; int b;
    if (n < 8) b = n; else { const int e = (int)(__builtin_log2f((float)n * 0.125f) * (8.0f / 7.0f)); b = 8 + e; if (b > 15) b = 15; }
    return b + (rel > 0 ? 16 : 0);
}
__device__ __forceinline__ void phase_prologue(const Params& p, LAS unsigned char* lds, int gw, int NGW, int wave, int lane) {
    LAS float* scr = (LAS float*)(lds + wave * 16384);
    constexpr int I_IN = (D / 64) * (CIN / 32), I_PA = (512 / 64) * (D / 32), I_PB = (1024 / 64) * (D / 32), I_OUT = (D / 64) * (D / 32), I_UP = (D / 64) * (NUP / 32), I_DN = (DFF / 64) * (D / 32);
    constexpr int I_LAYER = I_IN + I_PA + I_PB + I_OUT + I_UP + I_DN;
    for (int it = gw; it < 2 * I_LAYER; it += NGW) {
        const int l = it / I_LAYER; int r = it - l * I_LAYER;
        bf16* wl = (bf16*)(p.ws + WS_W0 + (size_t)l * WS_WL);
        const float* W; int K, N; bf16* WT; bool up = false;
        if (r < I_IN) { W = p.w_in + (size_t)l * D * CIN; K = D; N = CIN; WT = wl + WO_IN; }
        else if ((r -= I_IN) < I_PA) { W = p.w_pa + (size_t)l * 512 * D; K = 512; N = D; WT = wl + WO_PA; }
        else if ((r -= I_PA) < I_PB) { W = p.w_pb + (size_t)l * 1024 * D; K = 1024; N = D; WT = wl + WO_PB; }
        else if ((r -= I_PB) < I_OUT) { W = p.w_out + (size_t)l * D * D; K = D; N = D; WT = wl + WO_OUT; }
        else if ((r -= I_OUT) < I_UP) { W = p.w_up + (size_t)l * D * NUP; K = D; N = NUP; WT = wl + WO_UP; up = true; }
        else { r -= I_UP; W = p.w_down + (size_t)l * DFF * D; K = DFF; N = D; WT = wl + WO_DN; }
        const int nblk = N / 32, kb = r / nblk, nb = r - kb * nblk, n0 = 32 * nb;
        int row0 = n0;
        if (up) { const int j0 = n0 < DFF ? n0 : n0 - DFF; row0 = (j0 >> 7) * 256 + (n0 < DFF ? 0 : 128) + (j0 & 127); }
        transpose_item(W, K, N, WT, 64 * kb, n0, row0, scr, lane);
    }
    { const size_t gt = (size_t)gw * 64 + lane, NT = (size_t)NGW * 64; bf16* xb = (bf16*)(p.ws + WS_XB);
      for (size_t i = gt; i < (size_t)T * D / 8; i += NT) { const f32x4 a = *(const f32x4*)(p.x + i * 8), b = *(const f32x4*)(p.x + i * 8 + 4);
          u32x4 o; o.x = pk2(a[0], a[1]); o.y = pk2(a[2], a[3]); o.z = pk2(b[0], b[1]); o.w = pk2(b[2], b[3]); *(u32x4*)(xb + i * 8) = o; } }
    { float* tabA = (float*)(p.ws + WS_TAB); float* tabB = (float*)(p.ws + WS_TAB + 8192);
      const int gt = gw * 64 + lane;
      if (gt < 12 * 129) { const int hh = gt / 129, i = gt - hh * 129, g = hh >> 2, dil = g == 0 ? 1 : (g == 1 ? 4 : 16); tabA[hh * 132 + i] = p.rel_bias[t5_bucket((i - 64) * dil) * 20 + hh] * LOG2E; }
      else if (gt < 12 * 129 + 8 * 257) { const int q = gt - 12 * 129, hh = q / 257, i = q - hh * 257; tabB[hh * 260 + i] = p.rel_bias[t5_bucket(i - 128) * 20 + 12 + hh] * LOG2E; } }
}

constexpr int AT_KS = 0, AT_VS = 8704, AT_TAB = 8704 + 10240, AT_WAVE_BYTES = 8704 + 10240 + 1040;
static_assert(AT_WAVE_BYTES * NWAVES <= LDS_BYTES, "attention LDS");
#define TR4(r0, r1, r2, r3, base, o0, o1, o2, o3) asm volatile("ds_read_b64_tr_b16 %0, %4 offset:%5\n\tds_read_b64_tr_b16 %1, %4 offset:%6\n\tds_read_b64_tr_b16 %2, %4 offset:%7\n\tds_read_b64_tr_b16 %3, %4 offset:%8\n\ts_waitcnt lgkmcnt(0)" \
    : "=&v"(r0), "=&v"(r1), "=&v"(r2), "=&v"(r3) : "v"(base), "i"(o0), "i"(o1), "i"(o2), "i"(o3) : "memory")
#define PK8(L, Hh) (bf16x8){L[0], L[1], L[2], L[3], Hh[0], Hh[1], Hh[2], Hh[3]}

__device__ __forceinline__ void attn_item(LAS unsigned char* wl, int lane, const bf16* __restrict__ P, int qcol, int kcol, int vcol, int r, int dil, int sub_len, int q0, int W, int nkt,
                                          const float* __restrict__ tab, float m_init, float l_init, bf16* O, int o_ld, int ocol, float* lse, int lse_idx) {
    const int hl = lane >> 5, ql = lane & 31;
    LAS float* tabs = (LAS float*)(wl + AT_TAB);
    for (int i = lane; i < 2 * W + 1; i += 64) tabs[i] = tab[i];
    bf16x8 qf[8];
    { const bf16* qp = P + (size_t)(r + (q0 + ql) * dil) * CIN + qcol + 8 * hl;
#pragma unroll
      for (int s = 0; s < 8; ++s) qf[s] = *(const bf16x8*)(qp + 16 * s); }
    u32x4 kreg[8], vreg[8];
    const int lrow = lane >> 4, lch = lane & 15;
#define AT_LOAD(kt) do { _Pragma("unroll") for (int jj = 0; jj < 8; ++jj) { int sub = q0 - W + 32 * (kt) + 4 * jj + lrow; sub = sub < 0 ? 0 : (sub >= sub_len ? sub_len - 1 : sub); \
        const bf16* rp = P + (size_t)(r + sub * dil) * CIN + 8 * lch; kreg[jj] = *(const u32x4*)(rp + kcol); vreg[jj] = *(const u32x4*)(rp + vcol); } } while (0)
    f32x16 o0, o1, o2, o3;
#pragma unroll
    for (int i = 0; i < 16; ++i) { o0[i] = 0.f; o1[i] = 0.f; o2[i] = 0.f; o3[i] = 0.f; }
    float m = m_init, l = l_init;
    const float c = 0.08838834764831845f * LOG2E;
    const unsigned vb = (unsigned)(uintptr_t)(wl + AT_VS) + (unsigned)((4 * hl + ((lane & 15) >> 2)) * 320 + (16 * ((lane >> 4) & 1) + 4 * (lane & 3)) * 2);
    const LAS unsigned char* kb = wl + AT_KS + ql * 272 + 16 * hl;
    for (int kt = 0; kt < nkt; ++kt) {
        AT_LOAD(kt);
#pragma unroll
        for (int jj = 0; jj < 8; ++jj) { *(LAS u32x4*)(wl + AT_KS + (4 * jj + lrow) * 272 + 16 * lch) = kreg[jj]; *(LAS u32x4*)(wl + AT_VS + (4 * jj + lrow) * 320 + 16 * lch) = vreg[jj]; }
        f32x16 sc;
#pragma unroll
        for (int i = 0; i < 16; ++i) sc[i] = 0.f;
#pragma unroll
        for (int s = 0; s < 8; ++s) { const bf16x8 kf = *(const LAS bf16x8*)(kb + 32 * s); sc = __builtin_amdgcn_mfma_f32_32x32x16_bf16(kf, qf[s], sc, 0, 0, 0); }
        const int dbase = -W + 32 * kt - ql + 4 * hl;
        float tmax = -__builtin_inff();
#pragma unroll
        for (int i = 0; i < 16; ++i) { const int dlt = dbase + 8 * (i >> 2) + (i & 3); const int ks = q0 + ql + dlt; const bool ok = (dlt >= -W) && (dlt <= W) && (ks >= 0) && (ks < sub_len);
            int ti = dlt + W; ti = ti < 0 ? 0 : (ti > 2 * W ? 2 * W : ti);
            const float v = ok ? fmaf(sc[i], c, tabs[ti]) : -__builtin_inff(); sc[i] = v; tmax = fmaxf(tmax, v); }
        tmax = fmaxf(tmax, shx(tmax, 32, lane));
        const float mn = fmaxf(m, tmax), alpha = __builtin_amdgcn_exp2f(m - mn); m = mn;
        float ps = 0.f;
#pragma unroll
        for (int i = 0; i < 16; ++i) { sc[i] = __builtin_amdgcn_exp2f(sc[i] - mn); ps += sc[i]; }
        l = l * alpha + ps;
#pragma unroll
        for (int i = 0; i < 16; ++i) { o0[i] *= alpha; o1[i] *= alpha; o2[i] *= alpha; o3[i] *= alpha; }
        bf16x8 p0, p1;
        { u32x4 w0, w1; w0.x = pk2(sc[0], sc[1]); w0.y = pk2(sc[2], sc[3]); w0.z = pk2(sc[4], sc[5]); w0.w = pk2(sc[6], sc[7]);
          w1.x = pk2(sc[8], sc[9]); w1.y = pk2(sc[10], sc[11]); w1.z = pk2(sc[12], sc[13]); w1.w = pk2(sc[14], sc[15]);
          p0 = *reinterpret_cast<bf16x8*>(&w0); p1 = *reinterpret_cast<bf16x8*>(&w1); }
        { s16x4 a0, a1, b0, b1;
          TR4(a0, a1, b0, b1, vb, 0, 2560, 5120, 7680); __builtin_amdgcn_sched_barrier(0);
          o0 = __builtin_amdgcn_mfma_f32_32x32x16_bf16(PK8(a0, a1), p0, o0, 0, 0, 0); o0 = __builtin_amdgcn_mfma_f32_32x32x16_bf16(PK8(b0, b1), p1, o0, 0, 0, 0);
          TR4(a0, a1, b0, b1, vb, 64, 64 + 2560, 64 + 5120, 64 + 7680); __builtin_amdgcn_sched_barrier(0);
          o1 = __builtin_amdgcn_mfma_f32_32x32x16_bf16(PK8(a0, a1), p0, o1, 0, 0, 0); o1 = __builtin_amdgcn_mfma_f32_32x32x16_bf16(PK8(b0, b1), p1, o1, 0, 0, 0);
          TR4(a0, a1, b0, b1, vb, 128, 128 + 2560, 128 + 5120, 128 + 7680); __builtin_amdgcn_sched_barrier(0);
          o2 = __builtin_amdgcn_mfma_f32_32x32x16_bf16(PK8(a0, a1), p0, o2, 0, 0, 0); o2 = __builtin_amdgcn_mfma_f32_32x32x16_bf16(PK8(b0, b1), p1, o2, 0, 0, 0);
          TR4(a0, a1, b0, b1, vb, 192, 192 + 2560, 192 + 5120, 192 + 7680); __builtin_amdgcn_sched_barrier(0);
          o3 = __builtin_amdgcn_mfma_f32_32x32x16_bf16(PK8(a0, a1), p0, o3, 0, 0, 0); o3 = __builtin_amdgcn_mfma_f32_32x32x16_bf16(PK8(b0, b1), p1, o3, 0, 0, 0); }
    }
#undef AT_LOAD
    const float lt = l + shx(l, 32, lane), inv = 1.0f / lt;
    const size_t tok = (size_t)(r + (q0 + ql) * dil);
    bf16* op = O + tok * o_ld + ocol + 4 * hl;
#pragma unroll
    for (int g = 0; g < 4; ++g) {
        u32x2 w;
        w.x = pk2(o0[4 * g] * inv, o0[4 * g + 1] * inv); w.y = pk2(o0[4 * g + 2] * inv, o0[4 * g + 3] * inv); *(u32x2*)(op + 8 * g) = w;
        w.x = pk2(o1[4 * g] * inv, o1[4 * g + 1] * inv); w.y = pk2(o1[4 * g + 2] * inv, o1[4 * g + 3] * inv); *(u32x2*)(op + 32 + 8 * g) = w;
        w.x = pk2(o2[4 * g] * inv, o2[4 * g + 1] * inv); w.y = pk2(o2[4 * g + 2] * inv, o2[4 * g + 3] * inv); *(u32x2*)(op + 64 + 8 * g) = w;
        w.x = pk2(o3[4 * g] * inv, o3[4 * g + 1] * inv); w.y = pk2(o3[4 * g + 2] * inv, o3[4 * g + 3] * inv); *(u32x2*)(op + 96 + 8 * g) = w;
    }
    if (lse && hl == 0) lse[tok * 12 + lse_idx] = m + __builtin_log2f(lt);
    LDS_WAIT();
}

__device__ __forceinline__ void phase_attention(unsigned char* ws, const float* sinkp, LAS unsigned char* lds, int layer, int gw, int NGW, int wave, int lane) {
    LAS unsigned char* wl = lds + wave * AT_WAVE_BYTES;
    const bf16* P = (const bf16*)(ws + WS_PROJ);
    const float* tabA = (const float*)(ws + WS_TAB); const float* tabB = (const float*)(ws + WS_TAB + 8192);
    constexpr int NA = 12 * 512, NB = 8 * 512;
    for (int it = gw; it < NA + NB; it += NGW) {
        int qcol, kcol, vcol, r, dil, q0, W, nkt, o_ld, ocol, lse_idx; const float* tab; float m0, l0; bf16* O; float* lse;
        if (it < NA) {
            const int g = it >> 11, rem = it & 2047, h = rem >> 9, qt = rem & 511, hh = g * 4 + h;
            dil = g == 0 ? 1 : (g == 1 ? 4 : 16); const int tpr = 512 / dil; r = qt / tpr; q0 = (qt - r * tpr) * 32;
            qcol = hh * 128; kcol = 1536 + hh * 128; vcol = 3072 + hh * 128; W = 64; nkt = 5; tab = tabA + hh * 132; m0 = -1e30f; l0 = 0.f;
            O = (bf16*)(ws + WS_AR); o_ld = 1536; ocol = hh * 128; lse = (float*)(ws + WS_LSE); lse_idx = hh;
        } else {
            const int j = it - NA, rep = j & 3, qt = (j >> 2) & 511, kvh = j >> 11, qh = kvh * 4 + rep;
            dil = 1; r = 0; q0 = qt * 32; qcol = 4608 + qh * 128; kcol = 5632 + kvh * 128; vcol = 5888 + kvh * 128; W = 128; nkt = 9; tab = tabB + qh * 260;
            m0 = sinkp[layer * 8 + qh] * LOG2E; l0 = (lane < 32) ? 1.f : 0.f;
            O = (bf16*)(ws + WS_BO); o_ld = 1024; ocol = qh * 128; lse = nullptr; lse_idx = 0;
        }
        attn_item(wl, lane, P, qcol, kcol, vcol, r, dil, SEQ / dil, q0, W, nkt, tab, m0, l0, O, o_ld, ocol, lse, lse_idx);
    }
}

__device__ __forceinline__ void phase_amerge(const Params& p, int gw, int NGW, int lane) {
    const bf16* AR = (const bf16*)(p.ws + WS_AR); const float* LSE = (const float*)(p.ws + WS_LSE); bf16* AO = (bf16*)(p.ws + WS_AO);
    const size_t gt = (size_t)gw * 64 + lane, NT = (size_t)NGW * 64;
    for (size_t i = gt; i < (size_t)TH * 64; i += NT) {
        const size_t t = i >> 6; const int ch = (int)(i & 63), h = ch >> 4, dc = ch & 15;
        const float l0 = LSE[t * 12 + h], l1 = LSE[t * 12 + 4 + h], l2 = LSE[t * 12 + 8 + h];
        const float mx = fmaxf(l0, fmaxf(l1, l2));
        float w0 = __builtin_amdgcn_exp2f(l0 - mx), w1 = __builtin_amdgcn_exp2f(l1 - mx), w2 = __builtin_amdgcn_exp2f(l2 - mx);
        const float inv = 1.0f / (w0 + w1 + w2); w0 *= inv; w1 *= inv; w2 *= inv;
        const bf16* ap = AR + t * 1536 + h * 128 + dc * 8;
        const u32x4 a = *(const u32x4*)ap, b = *(const u32x4*)(ap + 512), cc = *(const u32x4*)(ap + 1024);
        u32x4 o;
        o.x = pk2(w0 * pg8::bf_lo(a.x) + w1 * pg8::bf_lo(b.x) + w2 * pg8::bf_lo(cc.x), w0 * pg8::bf_hi(a.x) + w1 * pg8::bf_hi(b.x) + w2 * pg8::bf_hi(cc.x));
        o.y = pk2(w0 * pg8::bf_lo(a.y) + w1 * pg8::bf_lo(b.y) + w2 * pg8::bf_lo(cc.y), w0 * pg8::bf_hi(a.y) + w1 * pg8::bf_hi(b.y) + w2 * pg8::bf_hi(cc.y));
        o.z = pk2(w0 * pg8::bf_lo(a.z) + w1 * pg8::bf_lo(b.z) + w2 * pg8::bf_lo(cc.z), w0 * pg8::bf_hi(a.z) + w1 * pg8::bf_hi(b.z) + w2 * pg8::bf_hi(cc.z));
        o.w = pk2(w0 * pg8::bf_lo(a.w) + w1 * pg8::bf_lo(b.w) + w2 * pg8::bf_lo(cc.w), w0 * pg8::bf_hi(a.w) + w1 * pg8::bf_hi(b.w) + w2 * pg8::bf_hi(cc.w));
        *(u32x4*)(AO + t * 512 + h * 128 + dc * 8) = o;
    }
}

__device__ __forceinline__ void phase_ln(float* Y, bf16* XB, const float* __restrict__ gam, const float* __restrict__ bet, int gw, int NGW, int lane) {
    for (int row = gw; row < T; row += NGW) {
        f32x4* yr = (f32x4*)(Y + (size_t)row * D) + lane;
        f32x4 v[8]; float s = 0.f;
#pragma unroll
        for (int j = 0; j < 8; ++j) { v[j] = yr[64 * j]; s += (v[j][0] + v[j][1]) + (v[j][2] + v[j][3]); }
        const float mean = wave_sum(s, lane) * (1.f / D); float s2 = 0.f;
#pragma unroll
        for (int j = 0; j < 8; ++j) { v[j] = v[j] - mean; s2 += (v[j][0] * v[j][0] + v[j][1] * v[j][1]) + (v[j][2] * v[j][2] + v[j][3] * v[j][3]); }
        const float rstd = 1.0f / sqrtf(wave_sum(s2, lane) * (1.f / D) + LN_EPS);
#pragma unroll
        for (int j = 0; j < 8; ++j) { const f32x4 gg = *((const f32x4*)gam + lane + 64 * j), bb = *((const f32x4*)bet + lane + 64 * j);
            const f32x4 o = v[j] * rstd * gg + bb; yr[64 * j] = o;
            if (XB) { u32x2 w; w.x = pk2(o[0], o[1]); w.y = pk2(o[2], o[3]); *((u32x2*)(XB + (size_t)row * D) + lane + 64 * j) = w; } }
    }
}

__global__ void __launch_bounds__(NTHREADS, 2) fwd_mega(Params p_arg) {
    extern __shared__ __attribute__((aligned(16))) unsigned char lds_raw[];
    LAS unsigned char* lds = (LAS unsigned char*)lds_raw;
    const int ph_lo = p_arg.ph_lo, ph_hi = p_arg.ph_hi;
    for (int ph = ph_lo; ph < ph_hi; ++ph) {
        if (ph > ph_lo) cg::this_grid().sync();
        Params p;
#if defined(__HIP_DEVICE_COMPILE__)
        { const __attribute__((address_space(4))) Params* pp = (const __attribute__((address_space(4))) Params*)__builtin_amdgcn_kernarg_segment_ptr(); asm volatile("" : "+s"(pp));
          p.x = pp->x; p.rel_bias = pp->rel_bias; p.w_in = pp->w_in; p.sink = pp->sink; p.w_pa = pp->w_pa; p.w_pb = pp->w_pb; p.w_out = pp->w_out; p.ln1_g = pp->ln1_g; p.ln1_b = pp->ln1_b;
          p.w_up = pp->w_up; p.w_down = pp->w_down; p.ln2_g = pp->ln2_g; p.ln2_b = pp->ln2_b; p.out = pp->out; p.ws = pp->ws; p.ph_lo = pp->ph_lo; p.ph_hi = pp->ph_hi; }
#else
        p = p_arg;
#endif
        int tid_ = threadIdx.x, bx_ = blockIdx.x; asm volatile("" : "+v"(tid_), "+s"(bx_));
        const int tid = tid_, lane = tid & 63, wave = __builtin_amdgcn_readfirstlane(tid >> 6);
        const int G = gridDim.x, bx = bx_, vcu = (G % 8 == 0) ? (bx % 8) * (G / 8) + bx / 8 : bx;
        const int gw = vcu * NWAVES + wave, NGW = G * NWAVES;
        unsigned char* ws = p.ws; bf16* XB = (bf16*)(ws + WS_XB);
        if (ph == 0) {
#if EN_PRO
 phase_prologue(p, lds, gw, NGW, wave, lane);
#endif
 continue; }
        const int q = ph - 1, layer = q / 13, s = q - layer * 13;
        const bf16* wl = (const bf16*)(ws + WS_W0 + (size_t)layer * WS_WL);
        if (s < 8) {
            const int half = s >> 2, sub = s & 3;
            if (sub == 0) {
                pg8::Gemm g{XB + (size_t)half * TH * D, wl + WO_IN, TH, CIN, D}; pg8::StaticOrder S; S.init(TH, CIN, G, bx);
                pg8::EpiBf16<0> E{(bf16*)(ws + WS_PROJ), CIN, nullptr, 0, 0, 1.f};

#if EN_INPROJ
 pg8::gemm_phase<pg8::EpiBf16<0>, pg8::StaticOrder, true, true>(lds, g, S, E);
#endif

            } else if (sub == 1) {
#if EN_ATTN
 phase_attention(ws, p.sink, lds, layer, gw, NGW, wave, lane);
#endif

            } else if (sub == 2) { phase_amerge(p, gw, NGW, lane);
            } else {
                for (int k = 0; k < 2; ++k) {
                    pg8::Gemm g{k == 0 ? (const bf16*)(ws + WS_AO) : (const bf16*)(ws + WS_BO), wl + (k == 0 ? WO_PA : WO_PB), TH, D, k == 0 ? 512 : 1024};
                    pg8::StaticOrder S; S.init(TH, D, G, bx);
                    pg8::EpiGate E{XB + (size_t)half * TH * D, D, (const bf16*)(ws + WS_PROJ) + (k == 0 ? 6144 : 8192), CIN, k};

#if EN_GATE
 pg8::gemm_phase<pg8::EpiGate, pg8::StaticOrder, true, true>(lds, g, S, E);
#endif

                }
            }
        } else if (s == 8 || s == 11) {
            const bool dn = (s == 11);
            pg8::Gemm g{dn ? (const bf16*)(ws + WS_H) : XB, wl + (dn ? WO_DN : WO_OUT), T, D, dn ? DFF : D}; pg8::StaticOrder S; S.init(T, D, G, bx);
            pg8::EpiResid E{(!dn && layer == 0) ? p.x : p.out, p.out, D, ALPHA};

#if EN_RESID
 pg8::gemm_phase<pg8::EpiResid, pg8::StaticOrder, true, true>(lds, g, S, E);
#endif

        } else if (s == 9) { phase_ln(p.out, XB, p.ln1_g + layer * D, p.ln1_b + layer * D, gw, NGW, lane);
        } else if (s == 10) {
            pg8::Gemm g{XB, wl + WO_UP, T, NUP, D}; pg8::StaticOrder S; S.init(T, NUP, G, bx);
            pg8::EpiSwiglu E{(bf16*)(ws + WS_H), DFF};

#if EN_SWIGLU
 pg8::gemm_phase<pg8::EpiSwiglu, pg8::StaticOrder, true, true>(lds, g, S, E);
#endif

        } else { phase_ln(p.out, (layer == 1) ? nullptr : XB, p.ln2_g + layer * D, p.ln2_b + layer * D, gw, NGW, lane); }
    }
}

#ifndef MK_PER_PHASE
#define MK_PER_PHASE 0
#endif
extern "C" void kernel_launch(void* const* d_in, const int* in_sizes, int n_in, void* d_out, int out_size, void* d_ws, size_t ws_size, hipStream_t stream) {
    static int grid = 0;
    if (grid == 0) {
        if (n_in != 13 || ws_size < WS_END) { fprintf(stderr, "kernel_launch: unexpected inputs (n_in %d, ws %zu)\n", n_in, ws_size); grid = -1; return; }
        int dev = 0, cus = 0;
        if (hipGetDevice(&dev) != hipSuccess || hipDeviceGetAttribute(&cus, hipDeviceAttributeMultiprocessorCount, dev) != hipSuccess) { grid = -1; return; }
        if (hipFuncSetAttribute((const void*)fwd_mega, hipFuncAttributeMaxDynamicSharedMemorySize, LDS_BYTES) != hipSuccess) { fprintf(stderr, "kernel_launch: hipFuncSetAttribute failed\n"); grid = -1; return; }
        (void)hipGetLastError();
        grid = cus;
    }
    if (grid < 0) return;
    Params p{};
    p.x = (const float*)d_in[0]; p.rel_bias = (const float*)d_in[1]; p.w_in = (const float*)d_in[2]; p.sink = (const float*)d_in[3]; p.w_pa = (const float*)d_in[4]; p.w_pb = (const float*)d_in[5];
    p.w_out = (const float*)d_in[6]; p.ln1_g = (const float*)d_in[7]; p.ln1_b = (const float*)d_in[8]; p.w_up = (const float*)d_in[9]; p.w_down = (const float*)d_in[10];
    p.ln2_g = (const float*)d_in[11]; p.ln2_b = (const float*)d_in[12]; p.out = (float*)d_out; p.ws = (unsigned char*)d_ws;
#if MK_PER_PHASE
    for (int ph = 0; ph < NPHASES; ++ph) { p.ph_lo = ph; p.ph_hi = ph + 1; hipLaunchKernelGGL(fwd_mega, dim3(grid), dim3(NTHREADS), LDS_BYTES, stream, p); }
#else
    p.ph_lo = 0; p.ph_hi = NPHASES;
    void* args[] = {&p};
    hipError_t e = hipLaunchCooperativeKernel((const void*)fwd_mega, dim3(grid), dim3(NTHREADS), args, LDS_BYTES, stream);
    if (e != hipSuccess) fprintf(stderr, "kernel_launch: cooperative launch failed: %s (grid %d)\n", hipGetErrorString(e), grid);
#endif
}
```

```cpp
#include <hip/hip_runtime.h>
#include <hip/hip_cooperative_groups.h>
#include <cstdio>
#include <cstdint>
namespace cg = cooperative_groups;
namespace pg8 {
#define PG8_LAS __attribute__((address_space(3)))
typedef unsigned short bf16_t;
typedef short bf16x8 __attribute__((ext_vector_type(8)));
typedef float f32x4 __attribute__((ext_vector_type(4)));
typedef unsigned u32x4 __attribute__((ext_vector_type(4)));
typedef int v8i32 __attribute__((ext_vector_type(8)));
typedef int v4i32 __attribute__((ext_vector_type(4)));
constexpr int FP8_SCALE_X = 0x79797979, FP8_SCALE_W = 0x79797979;
constexpr int BM = 256, BK = 64, HALF = 128, HTB = HALF * BK * 2  , STAGE_BYTES = 8 * HTB, NXCD = 8, WGM = 8;

__host__ __device__ __forceinline__ int lds_byte(int r, int c) { const int st = (r >> 4) * 2 + (c >> 5), rr = r & 15, cc = c & 31, ob = rr * 64 + cc * 2; return st * 1024 + (ob ^ (((ob >> 9) & 1) << 5)); }
__host__ __device__ __forceinline__ void stage_rc(int b, int& R, int& C) { const int st = b / 1024, sb = b % 1024, swz = sb ^ (((sb >> 9) & 1) << 5); R = (st >> 1) * 16 + swz / 64; C = (st & 1) * 32 + (swz % 64) / 2; }
__host__ __device__ __forceinline__ int perm32(int rho) { const int n = rho >> 4, i = rho & 15; return 8 * (i >> 2) + 4 * n + (i & 3); }

struct Unit { int pm, pn; };
struct Gemm { const bf16_t* A; const bf16_t* Bt; int M, N, K; };

struct StaticOrder {
    int nM, nN, nwg, G, c;
    __host__ __device__ void init(int M, int N, int G_, int c_) { nM = M / BM; nN = N / BM; nwg = nM * nN; G = G_; c = c_; }
    __host__ __device__ bool next(int i, Unit& u) const {
        const long L = (long)i * G + c; if (L >= nwg) return false;
        int wgid = (int)L; { const int q = nwg / NXCD, r = nwg % NXCD, xcd = wgid % NXCD, off = wgid / NXCD; wgid = (xcd < r ? xcd * (q + 1) : r * (q + 1) + (xcd - r) * q) + off; }
        const int nig = WGM * nN, gid = wgid / nig, fm = gid * WGM, gsz = (nM - fm) < WGM ? (nM - fm) : WGM;
        u.pm = fm + ((wgid % nig) % gsz); u.pn = (wgid % nig) / gsz; return true;
    }
    __device__ __forceinline__ void a_ready(const Unit&) const {}
    __device__ __forceinline__ void done(const Unit&) const {}
};

__device__ __forceinline__ unsigned cvt_pk_bf16(float lo, float hi) { unsigned r; asm("v_cvt_pk_bf16_f32 %0, %1, %2" : "=v"(r) : "v"(lo), "v"(hi)); return r; }
typedef float f32x2 __attribute__((ext_vector_type(2)));
template <int ACT  > struct EpiBf16 {
    static constexpr bool PERM = true, AFTER_DRAIN = false; static_assert(ACT == 0 || ACT == 1, "EpiBf16: ACT is 0 (none) or 1 (gelu_pk)");
    bf16_t* O; int ldc; const float* bias; int split_cols; size_t split_stride; float scale0;
    __device__ __forceinline__ void operator()(const f32x4 (&acc)[2][2][4][2], const Unit& u, int wr, int wc, int fr, int fq) const {
        const int row0 = u.pm * BM + wr * 64 + fr; int colt = u.pn * BM; bf16_t* base = O;
        float sc = 1.f; if (split_cols) { const int t = colt / split_cols; base += (size_t)t * split_stride; colt -= t * split_cols; if (t == 0) sc = scale0; }
        const int col0 = colt + wc * 32 + 8 * fq, bcol0 = u.pn * BM + wc * 32 + 8 * fq;
        f32x4 bv[2][2];
#pragma unroll
        for (int bj = 0; bj < 2; ++bj)
#pragma unroll
            for (int n = 0; n < 2; ++n) bv[bj][n] = bias ? *(const f32x4*)(bias + bcol0 + bj * HALF + 4 * n) : (f32x4){0.f, 0.f, 0.f, 0.f};
#pragma unroll
        for (int ai = 0; ai < 2; ++ai)
#pragma unroll
            for (int m = 0; m < 4; ++m) { bf16_t* rowp = base + (size_t)(row0 + ai * HALF + m * 16) * ldc + col0;
#pragma unroll
                for (int bj = 0; bj < 2; ++bj) { f32x4 v0 = acc[ai][bj][m][0] + bv[bj][0], v1 = acc[ai][bj][m][1] + bv[bj][1];
                    v0 = v0 * sc; v1 = v1 * sc; u32x4 w; w.x = cvt_pk_bf16(v0[0], v0[1]); w.y = cvt_pk_bf16(v0[2], v0[3]); w.z = cvt_pk_bf16(v1[0], v1[1]); w.w = cvt_pk_bf16(v1[2], v1[3]);
                    *(u32x4*)(rowp + bj * HALF) = w; } }
    }
};
__device__ __forceinline__ float sigmoidf_fast(float x) { return __builtin_amdgcn_rcpf(1.0f + __builtin_amdgcn_exp2f(-1.4426950408889634f * x)); }
__device__ __forceinline__ float bf_lo(unsigned w) { return __uint_as_float(w << 16); }
__device__ __forceinline__ float bf_hi(unsigned w) { return __uint_as_float(w & 0xffff0000u); }
struct EpiGate {
    static constexpr bool PERM = true, AFTER_DRAIN = false;
    bf16_t* O; int ldo; const bf16_t* G; int ldg; int add;
    __device__ __forceinline__ void operator()(const f32x4 (&acc)[2][2][4][2], const Unit& u, int wr, int wc, int fr, int fq) const {
        const int row0 = u.pm * BM + wr * 64 + fr, col0 = u.pn * BM + wc * 32 + 8 * fq;
#pragma unroll
        for (int ai = 0; ai < 2; ++ai)
#pragma unroll
            for (int m = 0; m < 4; ++m) { const size_t r = (size_t)(row0 + ai * HALF + m * 16); bf16_t* rowp = O + r * ldo + col0; const bf16_t* gp = G + r * ldg + col0;
#pragma unroll
                for (int bj = 0; bj < 2; ++bj) { const u32x4 gw = *(const u32x4*)(gp + bj * HALF); f32x4 v0 = acc[ai][bj][m][0], v1 = acc[ai][bj][m][1];
                    v0[0] *= sigmoidf_fast(bf_lo(gw.x)); v0[1] *= sigmoidf_fast(bf_hi(gw.x)); v0[2] *= sigmoidf_fast(bf_lo(gw.y)); v0[3] *= sigmoidf_fast(bf_hi(gw.y));
                    v1[0] *= sigmoidf_fast(bf_lo(gw.z)); v1[1] *= sigmoidf_fast(bf_hi(gw.z)); v1[2] *= sigmoidf_fast(bf_lo(gw.w)); v1[3] *= sigmoidf_fast(bf_hi(gw.w));
                    if (add) { const u32x4 pw = *(const u32x4*)(rowp + bj * HALF);
                        v0[0] += bf_lo(pw.x); v0[1] += bf_hi(pw.x); v0[2] += bf_lo(pw.y); v0[3] += bf_hi(pw.y); v1[0] += bf_lo(pw.z); v1[1] += bf_hi(pw.z); v1[2] += bf_lo(pw.w); v1[3] += bf_hi(pw.w); }
                    u32x4 w; w.x = cvt_pk_bf16(v0[0], v0[1]); w.y = cvt_pk_bf16(v0[2], v0[3]); w.z = cvt_pk_bf16(v1[0], v1[1]); w.w = cvt_pk_bf16(v1[2], v1[3]);
                    *(u32x4*)(rowp + bj * HALF) = w; } }
    }
};
struct EpiResid {
    static constexpr bool PERM = false, AFTER_DRAIN = false;
    const float* X; float* Y; int ldc; float alpha;
    __device__ __forceinline__ void operator()(const f32x4 (&acc)[2][2][4][2], const Unit& u, int wr, int wc, int fr, int fq) const {
        const int row0 = u.pm * BM + wr * 64 + fr, col0 = u.pn * BM + wc * 32 + 4 * fq;
#pragma unroll
        for (int ai = 0; ai < 2; ++ai)
#pragma unroll
            for (int m = 0; m < 4; ++m) { const size_t off = (size_t)(row0 + ai * HALF + m * 16) * ldc + col0;
#pragma unroll
                for (int bj = 0; bj < 2; ++bj)
#pragma unroll
                    for (int n = 0; n < 2; ++n) { const f32x4 xv = *(const f32x4*)(X + off + bj * HALF + n * 16); *(f32x4*)(Y + off + bj * HALF + n * 16) = xv * alpha + acc[ai][bj][m][n]; }
                asm volatile("" ::: "memory"); }
    }
};
struct EpiSwiglu {
    static constexpr bool PERM = true, AFTER_DRAIN = false;
    bf16_t* Hh; int ldh;
    __device__ __forceinline__ void operator()(const f32x4 (&acc)[2][2][4][2], const Unit& u, int wr, int wc, int fr, int fq) const {
        const int row0 = u.pm * BM + wr * 64 + fr, col0 = u.pn * HALF + wc * 32 + 8 * fq;
#pragma unroll
        for (int ai = 0; ai < 2; ++ai)
#pragma unroll
            for (int m = 0; m < 4; ++m) { bf16_t* rowp = Hh + (size_t)(row0 + ai * HALF + m * 16) * ldh + col0; float hv[8];
#pragma unroll
                for (int n = 0; n < 2; ++n)
#pragma unroll
                    for (int j = 0; j < 4; ++j) { const float g = acc[ai][0][m][n][j], up = acc[ai][1][m][n][j]; hv[n * 4 + j] = g * sigmoidf_fast(g) * up; }
                u32x4 w; w.x = cvt_pk_bf16(hv[0], hv[1]); w.y = cvt_pk_bf16(hv[2], hv[3]); w.z = cvt_pk_bf16(hv[4], hv[5]); w.w = cvt_pk_bf16(hv[6], hv[7]);
                *(u32x4*)rowp = w; }
    }
};
template <class Epi, class Sched, bool ALIGN_EPI = false, bool SP2 = false, bool FP8 = false>
__device__ __forceinline__ void gemm_phase(PG8_LAS unsigned char* lds, const Gemm g, const Sched& S, const Epi& E) {
    int tid_ = threadIdx.x; asm volatile("" : "+v"(tid_));
    const int tid = tid_, wid = __builtin_amdgcn_readfirstlane(tid >> 6), lane = tid & 63, wr = wid >> 2, wc = wid & 3, fr = lane & 15, fq = lane >> 4;
    const int K = g.K, nt = K / BK;
    unsigned voffA[2], voffB[2];
#pragma unroll
    for (int i = 0; i < 2; ++i) { int R, C; stage_rc(tid * 16 + i * 8192, R, C); const int Rb = Epi::PERM ? ((R & ~31) + perm32(R & 31)) : R;
        voffA[i] = (unsigned)(R * K + C) * 2u; voffB[i] = (unsigned)(Rb * K + C) * 2u; }
    const size_t r64step = (size_t)64 * K * 2;
    const size_t kstep = (size_t)(BK * 2);
    const size_t hstep = (size_t)HALF * K * 2;
    const size_t tstep = 2 * hstep;
    const unsigned ldsw = (unsigned)wid * 1024u;
    const int aoff = FP8 ? lds_byte(wr * 64 + fr, (fq >> 1) * 32 + (fq & 1) * 16) : lds_byte(wr * 64 + fr, fq * 8), boff = FP8 ? lds_byte(wc * 32 + fr, (fq >> 1) * 32 + (fq & 1) * 16) : lds_byte(wc * 32 + fr, fq * 8);
#define PG8_SA(b, h) (((b) * 2 + (h)) * HTB)
#define PG8_SB(b, h) ((4 + (b) * 2 + (h)) * HTB)
#define PG8_STAGE(bufoff, gbase, voff) do { _Pragma("unroll") for (int _i = 0; _i < 2; ++_i) { const char* _gb = (const char*)(gbase) + (size_t)_i * r64step; asm volatile("" : "+s"(_gb));     \
        __builtin_amdgcn_global_load_lds((const unsigned*)(_gb + (voff)[0]), (PG8_LAS unsigned*)(lds + (bufoff) + ldsw + _i * 8192), 16, 0, 0); } } while (0)
#define PG8_LD8(p_) __builtin_shufflevector(*(const PG8_LAS v4i32*)(p_), *(const PG8_LAS v4i32*)((p_) + 16), 0, 1, 2, 3, 4, 5, 6, 7)
#define PG8_LDA(dst, b, h) do { if constexpr (FP8) { _Pragma("unroll") for (int m = 0; m < 4; ++m) dst##8[m] = PG8_LD8(lds + PG8_SA(b, h) + aoff + m * 2048); } \
        else { _Pragma("unroll") for (int m = 0; m < 4; ++m) _Pragma("unroll") for (int k = 0; k < 2; ++k) dst[m][k] = *(const PG8_LAS bf16x8*)(lds + PG8_SA(b, h) + aoff + m * 2048 + k * 1024); } } while (0)
#define PG8_LDB(dst, b, h) do { if constexpr (FP8) { _Pragma("unroll") for (int n = 0; n < 2; ++n) dst##8[n] = PG8_LD8(lds + PG8_SB(b, h) + boff + n * 2048); } \
        else { _Pragma("unroll") for (int n = 0; n < 2; ++n) _Pragma("unroll") for (int k = 0; k < 2; ++k) dst[n][k] = *(const PG8_LAS bf16x8*)(lds + PG8_SB(b, h) + boff + n * 2048 + k * 1024); } } while (0)
#define PG8_MMA(ai, bj, At, Bt) do { __builtin_amdgcn_s_setprio(1); if constexpr (FP8) { _Pragma("unroll") for (int m = 0; m < 4; ++m) _Pragma("unroll") for (int n = 0; n < 2; ++n) \
            acc[ai][bj][m][n] = __builtin_amdgcn_mfma_scale_f32_16x16x128_f8f6f4(Bt##8[n], At##8[m], acc[ai][bj][m][n], 0, 0, 0, FP8_SCALE_W, 0, FP8_SCALE_X); } \
        else { _Pragma("unroll") for (int m = 0; m < 4; ++m) _Pragma("unroll") for (int n = 0; n < 2; ++n) _Pragma("unroll") for (int k = 0; k < 2; ++k) \
        acc[ai][bj][m][n] = __builtin_amdgcn_mfma_f32_16x16x32_bf16(Bt[n][k], At[m][k], acc[ai][bj][m][n], 0, 0, 0); } __builtin_amdgcn_s_setprio(0); } while (0)
#define PG8_WAIT_V(n) asm volatile("s_waitcnt vmcnt(" #n ")" ::: "memory")
#define PG8_WAIT_L(n) asm volatile("s_waitcnt lgkmcnt(" #n ")" ::: "memory")
#define PG8_BAR __builtin_amdgcn_s_barrier()
#define PG8_SCHED __builtin_amdgcn_sched_barrier(0)
    Unit cur, nxt; int ui = 0;
    if (!S.next(0, cur)) return;
    f32x4 acc[2][2][4][2];
#pragma unroll
    for (int a = 0; a < 2; ++a)
#pragma unroll
        for (int b = 0; b < 2; ++b)
#pragma unroll
            for (int m = 0; m < 4; ++m)
#pragma unroll
                for (int n = 0; n < 2; ++n) acc[a][b][m][n] = (f32x4){0.f, 0.f, 0.f, 0.f};
    bf16x8 At[4][2], B0[2][2], B1[2][2]; v8i32 At8[4], B08[2], B18[2];
    const char* cA = (const char*)g.A + (size_t)cur.pm * tstep; const char* cB = (const char*)g.Bt + (size_t)cur.pn * tstep;
    S.a_ready(cur);
    if constexpr (SP2) {
        PG8_STAGE(PG8_SB(0, 0), cB, voffB); PG8_STAGE(PG8_SB(0, 1), cB + hstep, voffB); PG8_STAGE(PG8_SA(0, 0), cA, voffA); PG8_STAGE(PG8_SA(0, 1), cA + hstep, voffA);
        if (wr == 1) PG8_BAR;
        PG8_WAIT_V(2); PG8_BAR;
        PG8_STAGE(PG8_SB(1, 0), cB + kstep, voffB); PG8_STAGE(PG8_SA(1, 0), cA + kstep, voffA); PG8_STAGE(PG8_SB(1, 1), cB + hstep + kstep, voffB);
        PG8_WAIT_V(6); PG8_BAR;
    } else {
        PG8_STAGE(PG8_SB(0, 0), cB, voffB); PG8_STAGE(PG8_SA(0, 0), cA, voffA); PG8_STAGE(PG8_SB(0, 1), cB + hstep, voffB); PG8_STAGE(PG8_SA(0, 1), cA + hstep, voffA);
        if (wr == 1) PG8_BAR;
        PG8_WAIT_V(4); PG8_BAR;
        PG8_STAGE(PG8_SB(1, 0), cB + kstep, voffB); PG8_STAGE(PG8_SA(1, 0), cA + kstep, voffA); PG8_STAGE(PG8_SB(1, 1), cB + hstep + kstep, voffB);
        PG8_WAIT_V(6); PG8_BAR;
    }
    for (;;) {
        const bool has_next = S.next(ui + 1, nxt);
        const char* nA = has_next ? (const char*)g.A + (size_t)nxt.pm * tstep : cA; const char* nB = has_next ? (const char*)g.Bt + (size_t)nxt.pn * tstep : cB;
        for (int t = 0; t < nt; t += 2) {
            const bool last = (t == nt - 2);
            const char* a1 = cA + (size_t)(t + 1) * kstep;
            const char* a2 = last ? nA : cA + (size_t)(t + 2) * kstep; const char* b2 = last ? nB : cB + (size_t)(t + 2) * kstep;
            const char* a3 = a2 + kstep; const char* b3 = b2 + kstep;
            if (last && has_next) S.a_ready(nxt);
            if constexpr (SP2) {
            PG8_LDB(B0, 0, 0); PG8_LDB(B1, 0, 1); PG8_SCHED; PG8_LDA(At, 0, 0); PG8_STAGE(PG8_SA(1, 1), a1 + hstep, voffA);
            PG8_WAIT_V(8); PG8_WAIT_L(0); PG8_BAR; PG8_MMA(0, 0, At, B0); PG8_MMA(0, 1, At, B1); PG8_BAR; PG8_SCHED;
            PG8_LDA(At, 0, 1); PG8_STAGE(PG8_SB(0, 0), b2, voffB); PG8_STAGE(PG8_SB(0, 1), b2 + hstep, voffB); PG8_STAGE(PG8_SA(0, 0), a2, voffA);
            PG8_WAIT_V(8); PG8_WAIT_L(0); PG8_BAR; PG8_MMA(1, 0, At, B0); PG8_MMA(1, 1, At, B1); PG8_BAR; PG8_SCHED;
            PG8_LDB(B0, 1, 0); PG8_LDB(B1, 1, 1); PG8_SCHED; PG8_LDA(At, 1, 0); PG8_STAGE(PG8_SA(0, 1), a2 + hstep, voffA);
            PG8_WAIT_V(8); PG8_WAIT_L(0); PG8_BAR; PG8_MMA(0, 0, At, B0); PG8_MMA(0, 1, At, B1); PG8_BAR; PG8_SCHED;
            PG8_LDA(At, 1, 1); PG8_STAGE(PG8_SB(1, 0), b3, voffB); PG8_STAGE(PG8_SB(1, 1), b3 + hstep, voffB); PG8_STAGE(PG8_SA(1, 0), a3, voffA);
            PG8_WAIT_V(8); PG8_WAIT_L(0); PG8_BAR; PG8_MMA(1, 0, At, B0); PG8_MMA(1, 1, At, B1); PG8_BAR; PG8_SCHED;
            } else {
            PG8_LDB(B0, 0, 0); PG8_SCHED; PG8_LDA(At, 0, 0); PG8_STAGE(PG8_SA(1, 1), a1 + hstep, voffA);
            PG8_WAIT_L(8); PG8_BAR; PG8_WAIT_L(0); PG8_MMA(0, 0, At, B0); PG8_BAR; PG8_SCHED;
            PG8_LDB(B1, 0, 1); PG8_STAGE(PG8_SB(0, 0), b2, voffB);
            PG8_BAR; PG8_WAIT_L(0); PG8_MMA(0, 1, At, B1); PG8_BAR;
            PG8_LDA(At, 0, 1); PG8_STAGE(PG8_SA(0, 0), a2, voffA);
            PG8_BAR; PG8_WAIT_L(0); PG8_MMA(1, 0, At, B0); PG8_BAR; PG8_SCHED;
            PG8_STAGE(PG8_SB(0, 1), b2 + hstep, voffB);
            PG8_WAIT_V(6); PG8_BAR; PG8_MMA(1, 1, At, B1); PG8_BAR;
            PG8_LDB(B0, 1, 0); PG8_SCHED; PG8_LDA(At, 1, 0); PG8_STAGE(PG8_SA(0, 1), a2 + hstep, voffA);
            PG8_WAIT_L(8); PG8_BAR; PG8_WAIT_L(0); PG8_MMA(0, 0, At, B0); PG8_BAR; PG8_SCHED;
            PG8_LDB(B1, 1, 1); PG8_STAGE(PG8_SB(1, 0), b3, voffB);
            PG8_BAR; PG8_WAIT_L(0); PG8_MMA(0, 1, At, B1); PG8_BAR;
            PG8_LDA(At, 1, 1); PG8_STAGE(PG8_SA(1, 0), a3, voffA);
            PG8_BAR; PG8_WAIT_L(0); PG8_MMA(1, 0, At, B0); PG8_BAR; PG8_SCHED;
            PG8_STAGE(PG8_SB(1, 1), b3 + hstep, voffB);
            PG8_WAIT_V(6); PG8_BAR; PG8_MMA(1, 1, At, B1); PG8_BAR;
            }
        }
        if constexpr (ALIGN_EPI) { if (wr == 0) PG8_BAR; }
        if constexpr (!Epi::AFTER_DRAIN) { int t2_ = threadIdx.x; asm volatile("" : "+v"(t2_)); const int fr_ = t2_ & 15, fq_ = (t2_ & 63) >> 4;
            E(acc, cur, wr, wc, fr_, fq_); S.done(cur); }
        if (!has_next) break;
#pragma unroll
        for (int a = 0; a < 2; ++a)
#pragma unroll
            for (int b = 0; b < 2; ++b)
#pragma unroll
                for (int m = 0; m < 4; ++m)
#pragma unroll
                    for (int n = 0; n < 2; ++n) acc[a][b][m][n] = (f32x4){0.f, 0.f, 0.f, 0.f};
        cur = nxt; cA = nA; cB = nB; ++ui;
        if constexpr (ALIGN_EPI) { if (wr == 1) PG8_BAR; }
    }
    PG8_WAIT_V(0);
    if constexpr (!ALIGN_EPI) { if (wr == 0) PG8_BAR; }
    PG8_BAR;
    if constexpr (Epi::AFTER_DRAIN) { E.fused(acc, cur, wr, wc, fr, fq, lds, wid, lane); S.done(cur); }
#undef PG8_SA
#undef PG8_SB
#undef PG8_STAGE
#undef PG8_LD8
#undef PG8_LDA
#undef PG8_LDB
#undef PG8_MMA
#undef PG8_WAIT_V
#undef PG8_WAIT_L
#undef PG8_BAR
#undef PG8_SCHED
}
}

#ifndef EN_INPROJ
#define EN_INPROJ 1
#endif
#ifndef EN_GATE
#define EN_GATE 1
#endif
#ifndef EN_RESID
#define EN_RESID 1
#endif
#ifndef EN_SWIGLU
#define EN_SWIGLU 1
#endif
#ifndef EN_ATTN
#define EN_ATTN 1
#endif
#ifndef EN_PRO
#define EN_PRO 1
#endif
#define LAS __attribute__((address_space(3)))
typedef unsigned short bf16;
typedef short bf16x8 __attribute__((ext_vector_type(8)));
typedef short s16x4 __attribute__((ext_vector_type(4)));
typedef float f32x4 __attribute__((ext_vector_type(4)));
typedef float f32x16 __attribute__((ext_vector_type(16)));
typedef unsigned u32x4 __attribute__((ext_vector_type(4)));
typedef unsigned u32x2 __attribute__((ext_vector_type(2)));

constexpr int T = 32768, TH = 16384, D = 2048, CIN = 10240, DFF = 5632, NUP = 11264, SEQ = 16384;
constexpr int NWAVES = 8, NTHREADS = 512;
constexpr float ALPHA = 1.41421356237309515f;
constexpr float LN_EPS = 1e-5f;
constexpr float LOG2E = 1.4426950408889634f;
constexpr int LDS_BYTES = 163840;
constexpr int NPHASES = 27;

constexpr size_t MiB = (size_t)1 << 20;
constexpr size_t WS_TAB = 0;
constexpr size_t WS_W0 = 1 * MiB, WS_WL = 120 * MiB;
constexpr size_t WO_IN = 0, WO_PA = WO_IN + (size_t)CIN * D, WO_PB = WO_PA + (size_t)D * 512, WO_OUT = WO_PB + (size_t)D * 1024, WO_UP = WO_OUT + (size_t)D * D,
                 WO_DN = WO_UP + (size_t)NUP * D, WO_END = WO_DN + (size_t)D * DFF;
static_assert(WO_END * 2 <= WS_WL, "weight block");
constexpr size_t WS_XB = 241 * MiB;
constexpr size_t WS_PROJ = 369 * MiB;
constexpr size_t WS_AR = 689 * MiB;
constexpr size_t WS_LSE = 737 * MiB;
constexpr size_t WS_AO = 738 * MiB;
constexpr size_t WS_BO = 754 * MiB;
constexpr size_t WS_H = 369 * MiB;
constexpr size_t WS_X8 = 800 * MiB;
constexpr size_t WS_END = 864 * MiB;

struct Params;
typedef const __attribute__((address_space(4))) Params* PP;
struct Params {
    const float* x; const float* rel_bias; const float* w_in; const float* sink; const float* w_pa; const float* w_pb; const float* w_out;
    const float* ln1_g; const float* ln1_b; const float* w_up; const float* w_down; const float* ln2_g; const float* ln2_b;
    float* out; unsigned char* ws; int ph_lo, ph_hi;
};

__device__ __forceinline__ unsigned pk2(float a, float b) { return pg8::cvt_pk_bf16(a, b); }
__device__ __forceinline__ float shx(float v, int o, int lane) { return __int_as_float(__builtin_amdgcn_ds_bpermute((lane ^ o) << 2, __float_as_int(v))); }
__device__ __forceinline__ float wave_sum(float v, int lane) {
#pragma unroll
    for (int o = 1; o < 64; o <<= 1) v += shx(v, o, lane);
    return v;
}
#define LDS_WAIT() asm volatile("s_waitcnt lgkmcnt(0)" ::: "memory")

__device__ __forceinline__ void transpose_item(const float* __restrict__ W, int K, int N, bf16* WT, int k0, int n0, int row0, LAS float* scr, int lane) {
#pragma unroll 8
    for (int i = 0; i < 32; ++i) { const int kk = 2 * i + (lane >> 5); scr[kk * 33 + (lane & 31)] = W[(size_t)(k0 + kk) * N + n0 + (lane & 31)]; }
    LDS_WAIT();
    const int c = lane & 7;
#pragma unroll
    for (int j = 0; j < 4; ++j) { const int n = (lane >> 3) + 8 * j; const LAS float* s = scr + (8 * c) * 33 + n;
        u32x4 o; o.x = pk2(s[0 * 33], s[1 * 33]); o.y = pk2(s[2 * 33], s[3 * 33]); o.z = pk2(s[4 * 33], s[5 * 33]); o.w = pk2(s[6 * 33], s[7 * 33]);
        *(u32x4*)(WT + (size_t)(row0 + n) * K + k0 + 8 * c) = o; }
    LDS_WAIT();
}
__device__ __forceinline__ unsigned pk4_fp8(float a, float b, float c, float d) { unsigned w = 0; w = __builtin_amdgcn_cvt_pk_fp8_f32(a, b, w, false); w = __builtin_amdgcn_cvt_pk_fp8_f32(c, d, w, true); return w; }
__device__ __forceinline__ void transpose_item_fp8(const float* __restrict__ W, int K, int N, unsigned char* WT, int k0, int n0, LAS float* scr, int lane, float scale) {
#pragma unroll 8
    for (int i = 0; i < 32; ++i) { const int kk = 2 * i + (lane >> 5); scr[kk * 33 + (lane & 31)] = W[(size_t)(k0 + kk) * N + n0 + (lane & 31)]; }
    LDS_WAIT();
    const int n = lane >> 1, kh = lane & 1; const LAS float* sp = scr + (32 * kh) * 33 + n;
    u32x4 o0, o1;
    o0.x = pk4_fp8(sp[0 * 33] * scale, sp[1 * 33] * scale, sp[2 * 33] * scale, sp[3 * 33] * scale); o0.y = pk4_fp8(sp[4 * 33] * scale, sp[5 * 33] * scale, sp[6 * 33] * scale, sp[7 * 33] * scale);
    o0.z = pk4_fp8(sp[8 * 33] * scale, sp[9 * 33] * scale, sp[10 * 33] * scale, sp[11 * 33] * scale); o0.w = pk4_fp8(sp[12 * 33] * scale, sp[13 * 33] * scale, sp[14 * 33] * scale, sp[15 * 33] * scale);
    o1.x = pk4_fp8(sp[16 * 33] * scale, sp[17 * 33] * scale, sp[18 * 33] * scale, sp[19 * 33] * scale); o1.y = pk4_fp8(sp[20 * 33] * scale, sp[21 * 33] * scale, sp[22 * 33] * scale, sp[23 * 33] * scale);
    o1.z = pk4_fp8(sp[24 * 33] * scale, sp[25 * 33] * scale, sp[26 * 33] * scale, sp[27 * 33] * scale); o1.w = pk4_fp8(sp[28 * 33] * scale, sp[29 * 33] * scale, sp[30 * 33] * scale, sp[31 * 33] * scale);
    unsigned char* dst = WT + (size_t)(n0 + n) * K + k0 + 32 * kh;
    *(u32x4*)dst = o0; *(u32x4*)(dst + 16) = o1;
    LDS_WAIT();
}
__device__ __forceinline__ int t5_bucket(int rel) {
    const int n = rel < 0 ? -rel : rel; int b;
    if (n < 8) b = n; else { const int e = (int)(__builtin_log2f((float)n * 0.125f) * (8.0f / 7.0f)); b = 8 + e; if (b > 15) b = 15; }
    return b + (rel > 0 ? 16 : 0);
}
__device__ __forceinline__ void phase_prologue(PP pp, LAS unsigned char* lds, int gw, int NGW, int wave, int lane) {
    LAS float* scr = (LAS float*)(lds + wave * 16384);
    constexpr int I_IN = (D / 64) * (CIN / 32), I_PA = (512 / 64) * (D / 32), I_PB = (1024 / 64) * (D / 32), I_OUT = (D / 64) * (D / 32), I_UP = (D / 64) * (NUP / 32), I_DN = (DFF / 64) * (D / 32);
    constexpr int I_LAYER = I_IN + I_PA + I_PB + I_OUT + I_UP + I_DN;
    for (int it = gw; it < 2 * I_LAYER; it += NGW) {
        const int l = it / I_LAYER; int r = it - l * I_LAYER;
        bf16* wl = (bf16*)(pp->ws + WS_W0 + (size_t)l * WS_WL);
        const float* W; int K, N; bf16* WT; bool up = false, r0_in = false;
        if (r < I_IN) { W = pp->w_in + (size_t)l * D * CIN; K = D; N = CIN; WT = wl + WO_IN; r0_in = true; }
        else if ((r -= I_IN) < I_PA) { W = pp->w_pa + (size_t)l * 512 * D; K = 512; N = D; WT = wl + WO_PA; }
        else if ((r -= I_PA) < I_PB) { W = pp->w_pb + (size_t)l * 1024 * D; K = 1024; N = D; WT = wl + WO_PB; }
        else if ((r -= I_PB) < I_OUT) { W = pp->w_out + (size_t)l * D * D; K = D; N = D; WT = wl + WO_OUT; }
        else if ((r -= I_OUT) < I_UP) { W = pp->w_up + (size_t)l * D * NUP; K = D; N = NUP; WT = wl + WO_UP; up = true; }
        else { r -= I_UP; W = pp->w_down + (size_t)l * DFF * D; K = DFF; N = D; WT = wl + WO_DN; }
        const int nblk = N / 32, kb = r / nblk, nb = r - kb * nblk, n0 = 32 * nb;
        int row0 = n0;
        if (up) { const int j0 = n0 < DFF ? n0 : n0 - DFF; row0 = (j0 >> 7) * 256 + (n0 < DFF ? 0 : 128) + (j0 & 127); }
        if (r0_in) transpose_item_fp8(W, K, N, (unsigned char*)WT, 64 * kb, n0, scr, lane, 128.0f);
        else transpose_item(W, K, N, WT, 64 * kb, n0, row0, scr, lane);
    }
    { const size_t gt = (size_t)gw * 64 + lane, NT = (size_t)NGW * 64; unsigned char* x8 = pp->ws + WS_X8;
      for (size_t i = gt; i < (size_t)T * D / 16; i += NT) { const f32x4 a = *(const f32x4*)(pp->x + i * 16) * 32.f, b = *(const f32x4*)(pp->x + i * 16 + 4) * 32.f, c = *(const f32x4*)(pp->x + i * 16 + 8) * 32.f, d = *(const f32x4*)(pp->x + i * 16 + 12) * 32.f;
          u32x4 o; o.x = pk4_fp8(a[0], a[1], a[2], a[3]); o.y = pk4_fp8(b[0], b[1], b[2], b[3]); o.z = pk4_fp8(c[0], c[1], c[2], c[3]); o.w = pk4_fp8(d[0], d[1], d[2], d[3]); *(u32x4*)(x8 + i * 16) = o; } }
    { float* tabA = (float*)(pp->ws + WS_TAB); float* tabB = (float*)(pp->ws + WS_TAB + 8192);
      const int gt = gw * 64 + lane;
      if (gt < 12 * 129) { const int hh = gt / 129, i = gt - hh * 129, g = hh >> 2, dil = g == 0 ? 1 : (g == 1 ? 4 : 16); tabA[hh * 132 + i] = pp->rel_bias[t5_bucket((i - 64) * dil) * 20 + hh] * LOG2E; }
      else if (gt < 12 * 129 + 8 * 257) { const int q = gt - 12 * 129, hh = q / 257, i = q - hh * 257; tabB[hh * 260 + i] = pp->rel_bias[t5_bucket(i - 128) * 20 + 12 + hh] * LOG2E; } }
}

constexpr int AT_KS = 0, AT_VS = 8704, AT_TAB = 8704 + 10240, AT_WAVE_BYTES = 8704 + 10240 + 1040;
static_assert(AT_WAVE_BYTES * NWAVES <= LDS_BYTES, "attention LDS");
#define TR4(r0, r1, r2, r3, base, o0, o1, o2, o3) asm volatile("ds_read_b64_tr_b16 %0, %4 offset:%5\n\tds_read_b64_tr_b16 %1, %4 offset:%6\n\tds_read_b64_tr_b16 %2, %4 offset:%7\n\tds_read_b64_tr_b16 %3, %4 offset:%8\n\ts_waitcnt lgkmcnt(0)" \
    : "=&v"(r0), "=&v"(r1), "=&v"(r2), "=&v"(r3) : "v"(base), "i"(o0), "i"(o1), "i"(o2), "i"(o3) : "memory")
#define PK8(L, Hh) (bf16x8){L[0], L[1], L[2], L[3], Hh[0], Hh[1], Hh[2], Hh[3]}

__device__ __forceinline__ void attn_item(LAS unsigned char* wl, int lane, const bf16* __restrict__ P, int qcol, int kcol, int vcol, int r, int dil, int sub_len, int q0, int W, int nkt,
                                          const float* __restrict__ tab, float m_init, float l_init, bf16* O, int o_ld, int ocol, float* lse, int lse_idx) {
    const int hl = lane >> 5, ql = lane & 31;
    LAS float* tabs = (LAS float*)(wl + AT_TAB);
    for (int i = lane; i < 2 * W + 1; i += 64) tabs[i] = tab[i];
    bf16x8 qf[8];
    { const bf16* qp = P + (size_t)(r + (q0 + ql) * dil) * CIN + qcol + 8 * hl;
#pragma unroll
      for (int s = 0; s < 8; ++s) qf[s] = *(const bf16x8*)(qp + 16 * s); }
    u32x4 kreg[8], vreg[8];
    const int lrow = lane >> 4, lch = lane & 15;
#define AT_LOAD(kt) do { _Pragma("unroll") for (int jj = 0; jj < 8; ++jj) { int sub = q0 - W + 32 * (kt) + 4 * jj + lrow; sub = sub < 0 ? 0 : (sub >= sub_len ? sub_len - 1 : sub); \
        const bf16* rp = P + (size_t)(r + sub * dil) * CIN + 8 * lch; kreg[jj] = *(const u32x4*)(rp + kcol); vreg[jj] = *(const u32x4*)(rp + vcol); } } while (0)
    f32x16 o0, o1, o2, o3;
#pragma unroll
    for (int i = 0; i < 16; ++i) { o0[i] = 0.f; o1[i] = 0.f; o2[i] = 0.f; o3[i] = 0.f; }
    float m = m_init, l = l_init;
    const float c = 0.08838834764831845f * LOG2E;
    const unsigned vb = (unsigned)(uintptr_t)(wl + AT_VS) + (unsigned)((4 * hl + ((lane & 15) >> 2)) * 320 + (16 * ((lane >> 4) & 1) + 4 * (lane & 3)) * 2);
    const LAS unsigned char* kb = wl + AT_KS + ql * 272 + 16 * hl;
    for (int kt = 0; kt < nkt; ++kt) {
        AT_LOAD(kt);
#pragma unroll
        for (int jj = 0; jj < 8; ++jj) { *(LAS u32x4*)(wl + AT_KS + (4 * jj + lrow) * 272 + 16 * lch) = kreg[jj]; *(LAS u32x4*)(wl + AT_VS + (4 * jj + lrow) * 320 + 16 * lch) = vreg[jj]; }
        f32x16 sc;
#pragma unroll
        for (int i = 0; i < 16; ++i) sc[i] = 0.f;
#pragma unroll
        for (int s = 0; s < 8; ++s) { const bf16x8 kf = *(const LAS bf16x8*)(kb + 32 * s); sc = __builtin_amdgcn_mfma_f32_32x32x16_bf16(kf, qf[s], sc, 0, 0, 0); }
        const int dbase = -W + 32 * kt - ql + 4 * hl;
        float tmax = -__builtin_inff();
#pragma unroll
        for (int i = 0; i < 16; ++i) { const int dlt = dbase + 8 * (i >> 2) + (i & 3); const int ks = q0 + ql + dlt; const bool ok = (dlt >= -W) && (dlt <= W) && (ks >= 0) && (ks < sub_len);
            int ti = dlt + W; ti = ti < 0 ? 0 : (ti > 2 * W ? 2 * W : ti);
            const float v = ok ? fmaf(sc[i], c, tabs[ti]) : -__builtin_inff(); sc[i] = v; tmax = fmaxf(tmax, v); }
        tmax = fmaxf(tmax, shx(tmax, 32, lane));
        const float mn = fmaxf(m, tmax), alpha = __builtin_amdgcn_exp2f(m - mn); m = mn;
        float ps = 0.f;
#pragma unroll
        for (int i = 0; i < 16; ++i) { sc[i] = __builtin_amdgcn_exp2f(sc[i] - mn); ps += sc[i]; }
        l = l * alpha + ps;
#pragma unroll
        for (int i = 0; i < 16; ++i) { o0[i] *= alpha; o1[i] *= alpha; o2[i] *= alpha; o3[i] *= alpha; }
        bf16x8 p0, p1;
        { u32x4 w0, w1; w0.x = pk2(sc[0], sc[1]); w0.y = pk2(sc[2], sc[3]); w0.z = pk2(sc[4], sc[5]); w0.w = pk2(sc[6], sc[7]);
          w1.x = pk2(sc[8], sc[9]); w1.y = pk2(sc[10], sc[11]); w1.z = pk2(sc[12], sc[13]); w1.w = pk2(sc[14], sc[15]);
          p0 = *reinterpret_cast<bf16x8*>(&w0); p1 = *reinterpret_cast<bf16x8*>(&w1); }
        { s16x4 a0, a1, b0, b1;
          TR4(a0, a1, b0, b1, vb, 0, 2560, 5120, 7680); __builtin_amdgcn_sched_barrier(0);
          o0 = __builtin_amdgcn_mfma_f32_32x32x16_bf16(PK8(a0, a1), p0, o0, 0, 0, 0); o0 = __builtin_amdgcn_mfma_f32_32x32x16_bf16(PK8(b0, b1), p1, o0, 0, 0, 0);
          TR4(a0, a1, b0, b1, vb, 64, 64 + 2560, 64 + 5120, 64 + 7680); __builtin_amdgcn_sched_barrier(0);
          o1 = __builtin_amdgcn_mfma_f32_32x32x16_bf16(PK8(a0, a1), p0, o1, 0, 0, 0); o1 = __builtin_amdgcn_mfma_f32_32x32x16_bf16(PK8(b0, b1), p1, o1, 0, 0, 0);
          TR4(a0, a1, b0, b1, vb, 128, 128 + 2560, 128 + 5120, 128 + 7680); __builtin_amdgcn_sched_barrier(0);
          o2 = __builtin_amdgcn_mfma_f32_32x32x16_bf16(PK8(a0, a1), p0, o2, 0, 0, 0); o2 = __builtin_amdgcn_mfma_f32_32x32x16_bf16(PK8(b0, b1), p1, o2, 0, 0, 0);
          TR4(a0, a1, b0, b1, vb, 192, 192 + 2560, 192 + 5120, 192 + 7680); __builtin_amdgcn_sched_barrier(0);
          o3 = __builtin_amdgcn_mfma_f32_32x32x16_bf16(PK8(a0, a1), p0, o3, 0, 0, 0); o3 = __builtin_amdgcn_mfma_f32_32x32x16_bf16(PK8(b0, b1), p1, o3, 0, 0, 0); }
    }
#undef AT_LOAD
    const float lt = l + shx(l, 32, lane), inv = 1.0f / lt;
    const size_t tok = (size_t)(r + (q0 + ql) * dil);
    bf16* op = O + tok * o_ld + ocol + 4 * hl;
#pragma unroll
    for (int g = 0; g < 4; ++g) {
        u32x2 w;
        w.x = pk2(o0[4 * g] * inv, o0[4 * g + 1] * inv); w.y = pk2(o0[4 * g + 2] * inv, o0[4 * g + 3] * inv); *(u32x2*)(op + 8 * g) = w;
        w.x = pk2(o1[4 * g] * inv, o1[4 * g + 1] * inv); w.y = pk2(o1[4 * g + 2] * inv, o1[4 * g + 3] * inv); *(u32x2*)(op + 32 + 8 * g) = w;
        w.x = pk2(o2[4 * g] * inv, o2[4 * g + 1] * inv); w.y = pk2(o2[4 * g + 2] * inv, o2[4 * g + 3] * inv); *(u32x2*)(op + 64 + 8 * g) = w;
        w.x = pk2(o3[4 * g] * inv, o3[4 * g + 1] * inv); w.y = pk2(o3[4 * g + 2] * inv, o3[4 * g + 3] * inv); *(u32x2*)(op + 96 + 8 * g) = w;
    }
    if (lse && hl == 0) lse[tok * 12 + lse_idx] = m + __builtin_log2f(lt);
    LDS_WAIT();
}

__device__ __forceinline__ void phase_attention(unsigned char* ws, const float* sinkp, LAS unsigned char* lds, int layer, int gw, int NGW, int wave, int lane) {
    LAS unsigned char* wl = lds + wave * AT_WAVE_BYTES;
    const bf16* P = (const bf16*)(ws + WS_PROJ);
    const float* tabA = (const float*)(ws + WS_TAB); const float* tabB = (const float*)(ws + WS_TAB + 8192);
    constexpr int NA = 12 * 512, NB = 8 * 512;
    for (int it = gw; it < NA + NB; it += NGW) {
        int qcol, kcol, vcol, r, dil, q0, W, nkt, o_ld, ocol, lse_idx; const float* tab; float m0, l0; bf16* O; float* lse;
        if (it < NA) {
            const int g = it >> 11, rem = it & 2047, h = rem >> 9, qt = rem & 511, hh = g * 4 + h;
            dil = g == 0 ? 1 : (g == 1 ? 4 : 16); const int tpr = 512 / dil; r = qt / tpr; q0 = (qt - r * tpr) * 32;
            qcol = hh * 128; kcol = 1536 + hh * 128; vcol = 3072 + hh * 128; W = 64; nkt = 5; tab = tabA + hh * 132; m0 = -1e30f; l0 = 0.f;
            O = (bf16*)(ws + WS_AR); o_ld = 1536; ocol = hh * 128; lse = (float*)(ws + WS_LSE); lse_idx = hh;
        } else {
            const int j = it - NA, rep = j & 3, qt = (j >> 2) & 511, kvh = j >> 11, qh = kvh * 4 + rep;
            dil = 1; r = 0; q0 = qt * 32; qcol = 4608 + qh * 128; kcol = 5632 + kvh * 128; vcol = 5888 + kvh * 128; W = 128; nkt = 9; tab = tabB + qh * 260;
            m0 = sinkp[layer * 8 + qh] * LOG2E; l0 = (lane < 32) ? 1.f : 0.f;
            O = (bf16*)(ws + WS_BO); o_ld = 1024; ocol = qh * 128; lse = nullptr; lse_idx = 0;
        }
        attn_item(wl, lane, P, qcol, kcol, vcol, r, dil, SEQ / dil, q0, W, nkt, tab, m0, l0, O, o_ld, ocol, lse, lse_idx);
    }
}

__device__ __forceinline__ void phase_amerge(unsigned char* ws, int gw, int NGW, int lane) {
    const bf16* AR = (const bf16*)(ws + WS_AR); const float* LSE = (const float*)(ws + WS_LSE); bf16* AO = (bf16*)(ws + WS_AO);
    const size_t gt = (size_t)gw * 64 + lane, NT = (size_t)NGW * 64;
    for (size_t i = gt; i < (size_t)TH * 64; i += NT) {
        const size_t t = i >> 6; const int ch = (int)(i & 63), h = ch >> 4, dc = ch & 15;
        const float l0 = LSE[t * 12 + h], l1 = LSE[t * 12 + 4 + h], l2 = LSE[t * 12 + 8 + h];
        const float mx = fmaxf(l0, fmaxf(l1, l2));
        float w0 = __builtin_amdgcn_exp2f(l0 - mx), w1 = __builtin_amdgcn_exp2f(l1 - mx), w2 = __builtin_amdgcn_exp2f(l2 - mx);
        const float inv = 1.0f / (w0 + w1 + w2); w0 *= inv; w1 *= inv; w2 *= inv;
        const bf16* ap = AR + t * 1536 + h * 128 + dc * 8;
        const u32x4 a = *(const u32x4*)ap, b = *(const u32x4*)(ap + 512), cc = *(const u32x4*)(ap + 1024);
        u32x4 o;
        o.x = pk2(w0 * pg8::bf_lo(a.x) + w1 * pg8::bf_lo(b.x) + w2 * pg8::bf_lo(cc.x), w0 * pg8::bf_hi(a.x) + w1 * pg8::bf_hi(b.x) + w2 * pg8::bf_hi(cc.x));
        o.y = pk2(w0 * pg8::bf_lo(a.y) + w1 * pg8::bf_lo(b.y) + w2 * pg8::bf_lo(cc.y), w0 * pg8::bf_hi(a.y) + w1 * pg8::bf_hi(b.y) + w2 * pg8::bf_hi(cc.y));
        o.z = pk2(w0 * pg8::bf_lo(a.z) + w1 * pg8::bf_lo(b.z) + w2 * pg8::bf_lo(cc.z), w0 * pg8::bf_hi(a.z) + w1 * pg8::bf_hi(b.z) + w2 * pg8::bf_hi(cc.z));
        o.w = pk2(w0 * pg8::bf_lo(a.w) + w1 * pg8::bf_lo(b.w) + w2 * pg8::bf_lo(cc.w), w0 * pg8::bf_hi(a.w) + w1 * pg8::bf_hi(b.w) + w2 * pg8::bf_hi(cc.w));
        *(u32x4*)(AO + t * 512 + h * 128 + dc * 8) = o;
    }
}

__device__ __forceinline__ void phase_ln(float* Y, bf16* XB, unsigned char* X8, const float* __restrict__ gam, const float* __restrict__ bet, int gw, int NGW, int lane) {
    for (int row = gw; row < T; row += NGW) {
        f32x4* yr = (f32x4*)(Y + (size_t)row * D) + lane;
        f32x4 v[8]; float s = 0.f;
#pragma unroll
        for (int j = 0; j < 8; ++j) { v[j] = yr[64 * j]; s += (v[j][0] + v[j][1]) + (v[j][2] + v[j][3]); }
        const float mean = wave_sum(s, lane) * (1.f / D); float s2 = 0.f;
#pragma unroll
        for (int j = 0; j < 8; ++j) { v[j] = v[j] - mean; s2 += (v[j][0] * v[j][0] + v[j][1] * v[j][1]) + (v[j][2] * v[j][2] + v[j][3] * v[j][3]); }
        const float rstd = 1.0f / sqrtf(wave_sum(s2, lane) * (1.f / D) + LN_EPS);
#pragma unroll
        for (int j = 0; j < 8; ++j) { const f32x4 gg = *((const f32x4*)gam + lane + 64 * j), bb = *((const f32x4*)bet + lane + 64 * j);
            const f32x4 o = v[j] * rstd * gg + bb; yr[64 * j] = o;
            if (XB) { u32x2 w; w.x = pk2(o[0], o[1]); w.y = pk2(o[2], o[3]); *((u32x2*)(XB + (size_t)row * D) + lane + 64 * j) = w; }
            if (X8) *((unsigned*)(X8 + (size_t)row * D) + lane + 64 * j) = pk4_fp8(o[0] * 32.f, o[1] * 32.f, o[2] * 32.f, o[3] * 32.f); }
    }
}

__global__ void __launch_bounds__(NTHREADS, 2) fwd_mega(Params p_arg) {
    extern __shared__ __attribute__((aligned(16))) unsigned char lds_raw[];
    LAS unsigned char* lds = (LAS unsigned char*)lds_raw;
    const int ph_lo = p_arg.ph_lo, ph_hi = p_arg.ph_hi;
    for (int ph = ph_lo; ph < ph_hi; ++ph) {
        if (ph > ph_lo) cg::this_grid().sync();
#if defined(__HIP_DEVICE_COMPILE__)
        PP p = (PP)__builtin_amdgcn_kernarg_segment_ptr(); asm volatile("" : "+s"(p));
#else
        PP p = (PP)(uintptr_t)0; (void)p_arg;
#endif
        int tid_ = threadIdx.x, bx_ = blockIdx.x; asm volatile("" : "+v"(tid_), "+s"(bx_));
        const int tid = tid_, lane = tid & 63, wave = __builtin_amdgcn_readfirstlane(tid >> 6);
        const int G = gridDim.x, bx = bx_, vcu = (G % 8 == 0) ? (bx % 8) * (G / 8) + bx / 8 : bx;
        const int gw = vcu * NWAVES + wave, NGW = G * NWAVES;
        unsigned char* ws = p->ws; bf16* XB = (bf16*)(ws + WS_XB);
        if (ph == 0) {
#if EN_PRO
 phase_prologue(p, lds, gw, NGW, wave, lane);
#endif
 continue; }
        const int q = ph - 1, layer = q / 13, s = q - layer * 13;
        const bf16* wl = (const bf16*)(ws + WS_W0 + (size_t)layer * WS_WL);
        if (s < 8) {
            const int half = s >> 2, sub = s & 3;
            if (sub == 0) {
                pg8::Gemm g{(const bf16*)(ws + WS_X8 + (size_t)half * TH * D), wl + WO_IN, TH, CIN, D / 2}; pg8::StaticOrder S; S.init(TH, CIN, G, bx);
                pg8::EpiBf16<0> E{(bf16*)(ws + WS_PROJ), CIN, nullptr, 0, 0, 1.f};

#if EN_INPROJ
 pg8::gemm_phase<pg8::EpiBf16<0>, pg8::StaticOrder, true, true, true>(lds, g, S, E);
#endif

            } else if (sub == 1) {
#if EN_ATTN
 phase_attention(ws, p->sink, lds, layer, gw, NGW, wave, lane);
#endif

            } else if (sub == 2) { phase_amerge(ws, gw, NGW, lane);
            } else {
                for (int k = 0; k < 2; ++k) {
                    pg8::Gemm g{k == 0 ? (const bf16*)(ws + WS_AO) : (const bf16*)(ws + WS_BO), wl + (k == 0 ? WO_PA : WO_PB), TH, D, k == 0 ? 512 : 1024};
                    pg8::StaticOrder S; S.init(TH, D, G, bx);
                    pg8::EpiGate E{XB + (size_t)half * TH * D, D, (const bf16*)(ws + WS_PROJ) + (k == 0 ? 6144 : 8192), CIN, k};

#if EN_GATE
 pg8::gemm_phase<pg8::EpiGate, pg8::StaticOrder, true, true>(lds, g, S, E);
#endif

                }
            }
        } else if (s == 8 || s == 11) {
            const bool dn = (s == 11);
            pg8::Gemm g{dn ? (const bf16*)(ws + WS_H) : XB, wl + (dn ? WO_DN : WO_OUT), T, D, dn ? DFF : D}; pg8::StaticOrder S; S.init(T, D, G, bx);
            pg8::EpiResid E{(!dn && layer == 0) ? p->x : p->out, p->out, D, ALPHA};

#if EN_RESID
 pg8::gemm_phase<pg8::EpiResid, pg8::StaticOrder, true, true>(lds, g, S, E);
#endif

        } else if (s == 9) { phase_ln(p->out, XB, nullptr, p->ln1_g + layer * D, p->ln1_b + layer * D, gw, NGW, lane);
        } else if (s == 10) {
            pg8::Gemm g{XB, wl + WO_UP, T, NUP, D}; pg8::StaticOrder S; S.init(T, NUP, G, bx);
            pg8::EpiSwiglu E{(bf16*)(ws + WS_H), DFF};

#if EN_SWIGLU
 pg8::gemm_phase<pg8::EpiSwiglu, pg8::StaticOrder, true, true>(lds, g, S, E);
#endif

        } else { phase_ln(p->out, nullptr, (layer == 1) ? nullptr : ws + WS_X8, p->ln2_g + layer * D, p->ln2_b + layer * D, gw, NGW, lane); }
    }
}

#ifndef MK_PER_PHASE
#define MK_PER_PHASE 0
#endif
extern "C" void kernel_launch(void* const* d_in, const int* in_sizes, int n_in, void* d_out, int out_size, void* d_ws, size_t ws_size, hipStream_t stream) {
    static int grid = 0;
    if (grid == 0) {
        if (n_in != 13 || ws_size < WS_END) { fprintf(stderr, "kernel_launch: unexpected inputs (n_in %d, ws %zu)\n", n_in, ws_size); grid = -1; return; }
        int dev = 0, cus = 0;
        if (hipGetDevice(&dev) != hipSuccess || hipDeviceGetAttribute(&cus, hipDeviceAttributeMultiprocessorCount, dev) != hipSuccess) { grid = -1; return; }
        if (hipFuncSetAttribute((const void*)fwd_mega, hipFuncAttributeMaxDynamicSharedMemorySize, LDS_BYTES) != hipSuccess) { fprintf(stderr, "kernel_launch: hipFuncSetAttribute failed\n"); grid = -1; return; }
        (void)hipGetLastError();
        grid = cus;
    }
    if (grid < 0) return;
    Params p{};
    p.x = (const float*)d_in[0]; p.rel_bias = (const float*)d_in[1]; p.w_in = (const float*)d_in[2]; p.sink = (const float*)d_in[3]; p.w_pa = (const float*)d_in[4]; p.w_pb = (const float*)d_in[5];
    p.w_out = (const float*)d_in[6]; p.ln1_g = (const float*)d_in[7]; p.ln1_b = (const float*)d_in[8]; p.w_up = (const float*)d_in[9]; p.w_down = (const float*)d_in[10];
    p.ln2_g = (const float*)d_in[11]; p.ln2_b = (const float*)d_in[12]; p.out = (float*)d_out; p.ws = (unsigned char*)d_ws;
#if MK_PER_PHASE
    for (int ph = 0; ph < NPHASES; ++ph) { p.ph_lo = ph; p.ph_hi = ph + 1; hipLaunchKernelGGL(fwd_mega, dim3(grid), dim3(NTHREADS), LDS_BYTES, stream, p); }
#else
    p.ph_lo = 0; p.ph_hi = NPHASES;
    void* args[] = {&p};
    hipError_t e = hipLaunchCooperativeKernel((const void*)fwd_mega, dim3(grid), dim3(NTHREADS), args, LDS_BYTES, stream);
    if (e != hipSuccess) fprintf(stderr, "kernel_launch: cooperative launch failed: %s (grid %d)\n", hipGetErrorString(e), grid);
#endif
}
```

```cpp
#include <hip/hip_runtime.h>
#include <hip/hip_cooperative_groups.h>
#include <cstdio>
#include <cstdint>
namespace cg = cooperative_groups;
namespace pg8 {
#define PG8_LAS __attribute__((address_space(3)))
typedef unsigned short bf16_t;
typedef short bf16x8 __attribute__((ext_vector_type(8)));
typedef float f32x4 __attribute__((ext_vector_type(4)));
typedef unsigned u32x4 __attribute__((ext_vector_type(4)));
typedef unsigned u32x2 __attribute__((ext_vector_type(2)));
typedef int v8i32 __attribute__((ext_vector_type(8)));
typedef int v4i32 __attribute__((ext_vector_type(4)));
constexpr int FP8_SCALE_X = 0x79797979, FP8_SCALE_W = 0x79797979;
constexpr int BM = 256, BK = 64, HALF = 128, HTB = HALF * BK * 2  , STAGE_BYTES = 8 * HTB, NXCD = 8, WGM = 8;

__host__ __device__ __forceinline__ int lds_byte(int r, int c) { const int st = (r >> 4) * 2 + (c >> 5), rr = r & 15, cc = c & 31, ob = rr * 64 + cc * 2; return st * 1024 + (ob ^ (((ob >> 9) & 1) << 5)); }
__host__ __device__ __forceinline__ void stage_rc(int b, int& R, int& C) { const int st = b / 1024, sb = b % 1024, swz = sb ^ (((sb >> 9) & 1) << 5); R = (st >> 1) * 16 + swz / 64; C = (st & 1) * 32 + (swz % 64) / 2; }
__host__ __device__ __forceinline__ int perm32(int rho) { const int n = rho >> 4, i = rho & 15; return 8 * (i >> 2) + 4 * n + (i & 3); }

struct Unit { int pm, pn; };
struct Gemm { const bf16_t* A; const bf16_t* Bt; int M, N, K; int sx = 0x79797979, sw = 0x79797979; };

struct StaticOrder {
    int nM, nN, nwg, G, c;
    __host__ __device__ void init(int M, int N, int G_, int c_) { nM = M / BM; nN = N / BM; nwg = nM * nN; G = G_; c = c_; }
    __host__ __device__ bool next(int i, Unit& u) const {
        const long L = (long)i * G + c; if (L >= nwg) return false;
        int wgid = (int)L; { const int q = nwg / NXCD, r = nwg % NXCD, xcd = wgid % NXCD, off = wgid / NXCD; wgid = (xcd < r ? xcd * (q + 1) : r * (q + 1) + (xcd - r) * q) + off; }
        const int nig = WGM * nN, gid = wgid / nig, fm = gid * WGM, gsz = (nM - fm) < WGM ? (nM - fm) : WGM;
        u.pm = fm + ((wgid % nig) % gsz); u.pn = (wgid % nig) / gsz; return true;
    }
    __device__ __forceinline__ void a_ready(const Unit&) const {}
    __device__ __forceinline__ void done(const Unit&) const {}
};

__device__ __forceinline__ unsigned cvt_pk_bf16(float lo, float hi) { unsigned r; asm("v_cvt_pk_bf16_f32 %0, %1, %2" : "=v"(r) : "v"(lo), "v"(hi)); return r; }
typedef float f32x2 __attribute__((ext_vector_type(2)));
template <int ACT  > struct EpiBf16 {
    static constexpr bool PERM = true, AFTER_DRAIN = false; static_assert(ACT == 0 || ACT == 1, "EpiBf16: ACT is 0 (none) or 1 (gelu_pk)");
    bf16_t* O; int ldc; const float* bias; int split_cols; size_t split_stride; float scale0;
    __device__ __forceinline__ void operator()(const f32x4 (&acc)[2][2][4][2], const Unit& u, int wr, int wc, int fr, int fq) const {
        const int row0 = u.pm * BM + wr * 64 + fr; int colt = u.pn * BM; bf16_t* base = O;
        float sc = 1.f; if (split_cols) { const int t = colt / split_cols; base += (size_t)t * split_stride; colt -= t * split_cols; if (t == 0) sc = scale0; }
        const int col0 = colt + wc * 32 + 8 * fq, bcol0 = u.pn * BM + wc * 32 + 8 * fq;
        f32x4 bv[2][2];
#pragma unroll
        for (int bj = 0; bj < 2; ++bj)
#pragma unroll
            for (int n = 0; n < 2; ++n) bv[bj][n] = bias ? *(const f32x4*)(bias + bcol0 + bj * HALF + 4 * n) : (f32x4){0.f, 0.f, 0.f, 0.f};
#pragma unroll
        for (int ai = 0; ai < 2; ++ai)
#pragma unroll
            for (int m = 0; m < 4; ++m) { bf16_t* rowp = base + (size_t)(row0 + ai * HALF + m * 16) * ldc + col0;
#pragma unroll
                for (int bj = 0; bj < 2; ++bj) { f32x4 v0 = acc[ai][bj][m][0] + bv[bj][0], v1 = acc[ai][bj][m][1] + bv[bj][1];
                    v0 = v0 * sc; v1 = v1 * sc; u32x4 w; w.x = cvt_pk_bf16(v0[0], v0[1]); w.y = cvt_pk_bf16(v0[2], v0[3]); w.z = cvt_pk_bf16(v1[0], v1[1]); w.w = cvt_pk_bf16(v1[2], v1[3]);
                    *(u32x4*)(rowp + bj * HALF) = w; } }
    }
};
__device__ __forceinline__ float sigmoidf_fast(float x) { return __builtin_amdgcn_rcpf(1.0f + __builtin_amdgcn_exp2f(-1.4426950408889634f * x)); }
__device__ __forceinline__ float bf_lo(unsigned w) { return __uint_as_float(w << 16); }
__device__ __forceinline__ float bf_hi(unsigned w) { return __uint_as_float(w & 0xffff0000u); }
__device__ __forceinline__ float clamp448(float v) { return __builtin_fminf(__builtin_fmaxf(v, -448.f), 448.f); }
__device__ __forceinline__ unsigned pk4_fp8(float a, float b, float c, float d) { unsigned w = 0; w = __builtin_amdgcn_cvt_pk_fp8_f32(clamp448(a), clamp448(b), w, false); w = __builtin_amdgcn_cvt_pk_fp8_f32(clamp448(c), clamp448(d), w, true); return w; }
struct EpiGate {
    static constexpr bool PERM = true, AFTER_DRAIN = false;
    bf16_t* Tm; unsigned char* O8; int ldo; const bf16_t* G; int ldg; int add; float oscale;
    __device__ __forceinline__ void operator()(const f32x4 (&acc)[2][2][4][2], const Unit& u, int wr, int wc, int fr, int fq) const {
        const int row0 = u.pm * BM + wr * 64 + fr, col0 = u.pn * BM + wc * 32 + 8 * fq;
#pragma unroll
        for (int ai = 0; ai < 2; ++ai)
#pragma unroll
            for (int m = 0; m < 4; ++m) { const size_t r = (size_t)(row0 + ai * HALF + m * 16); bf16_t* rowp = Tm + r * ldo + col0; const bf16_t* gp = G + r * ldg + col0;
#pragma unroll
                for (int bj = 0; bj < 2; ++bj) { const u32x4 gw = *(const u32x4*)(gp + bj * HALF); f32x4 v0 = acc[ai][bj][m][0], v1 = acc[ai][bj][m][1];
                    v0[0] *= sigmoidf_fast(bf_lo(gw.x)); v0[1] *= sigmoidf_fast(bf_hi(gw.x)); v0[2] *= sigmoidf_fast(bf_lo(gw.y)); v0[3] *= sigmoidf_fast(bf_hi(gw.y));
                    v1[0] *= sigmoidf_fast(bf_lo(gw.z)); v1[1] *= sigmoidf_fast(bf_hi(gw.z)); v1[2] *= sigmoidf_fast(bf_lo(gw.w)); v1[3] *= sigmoidf_fast(bf_hi(gw.w));
                    if (add) { const u32x4 pw = *(const u32x4*)(rowp + bj * HALF);
                        v0[0] += bf_lo(pw.x); v0[1] += bf_hi(pw.x); v0[2] += bf_lo(pw.y); v0[3] += bf_hi(pw.y); v1[0] += bf_lo(pw.z); v1[1] += bf_hi(pw.z); v1[2] += bf_lo(pw.w); v1[3] += bf_hi(pw.w);
                        v0 = v0 * oscale; v1 = v1 * oscale; u32x2 w8; w8.x = pk4_fp8(v0[0], v0[1], v0[2], v0[3]); w8.y = pk4_fp8(v1[0], v1[1], v1[2], v1[3]);
                        *(u32x2*)(O8 + r * ldo + col0 + bj * HALF) = w8; }
                    else { u32x4 w; w.x = cvt_pk_bf16(v0[0], v0[1]); w.y = cvt_pk_bf16(v0[2], v0[3]); w.z = cvt_pk_bf16(v1[0], v1[1]); w.w = cvt_pk_bf16(v1[2], v1[3]);
                        *(u32x4*)(rowp + bj * HALF) = w; } } }
    }
};
typedef void* vptr_t; typedef const __attribute__((address_space(4))) vptr_t* ArgV;
struct EpiResid {
    static constexpr bool PERM = false, AFTER_DRAIN = false;
    ArgV args; int xi, gi, bi; int ldc; float alpha; size_t goff; size_t st_off;
    __device__ __forceinline__ void operator()(const f32x4 (&acc)[2][2][4][2], const Unit& u, int wr, int wc, int fr, int fq) const {
        ArgV a_ = args; asm volatile("" : "+s"(a_));
        float* Y = (float*)a_[13]; const float* X = xi >= 0 ? (const float*)a_[xi] : (const float*)Y;
        const float* st = xi >= 0 ? nullptr : (const float*)((const unsigned char*)a_[14] + st_off);
        const float* g = (const float*)a_[gi < 0 ? 0 : gi] + goff; const float* b = (const float*)a_[bi < 0 ? 0 : bi] + goff;
        const int row0 = u.pm * BM + wr * 64 + fr, col0 = u.pn * BM + wc * 32 + 4 * fq;
#pragma unroll
        for (int ai = 0; ai < 2; ++ai)
#pragma unroll
            for (int m = 0; m < 4; ++m) { const int r = row0 + ai * HALF + m * 16; const size_t off = (size_t)r * ldc + col0;
                float mean = 0.f, rstd = 1.f; if (st) { const f32x2 sv = *(const f32x2*)(st + 2 * (size_t)r); mean = sv.x; rstd = sv.y; }
#pragma unroll
                for (int bj = 0; bj < 2; ++bj)
#pragma unroll
                    for (int n = 0; n < 2; ++n) { f32x4 xv = *(const f32x4*)(X + off + bj * HALF + n * 16);
                        if (st) { const f32x4 gv = *(const f32x4*)(g + col0 + bj * HALF + n * 16), bv = *(const f32x4*)(b + col0 + bj * HALF + n * 16); xv = (xv - mean) * rstd * gv + bv; }
                        *(f32x4*)(Y + off + bj * HALF + n * 16) = xv * alpha + acc[ai][bj][m][n]; }
                asm volatile("" ::: "memory"); }
    }
};
struct EpiSwiglu {
    static constexpr bool PERM = true, AFTER_DRAIN = false;
    bf16_t* Hh; int ldh;
    __device__ __forceinline__ void operator()(const f32x4 (&acc)[2][2][4][2], const Unit& u, int wr, int wc, int fr, int fq) const {
        const int row0 = u.pm * BM + wr * 64 + fr, col0 = u.pn * HALF + wc * 32 + 8 * fq;
#pragma unroll
        for (int ai = 0; ai < 2; ++ai)
#pragma unroll
            for (int m = 0; m < 4; ++m) { bf16_t* rowp = Hh + (size_t)(row0 + ai * HALF + m * 16) * ldh + col0; float hv[8];
#pragma unroll
                for (int n = 0; n < 2; ++n)
#pragma unroll
                    for (int j = 0; j < 4; ++j) { const float g = acc[ai][0][m][n][j], up = acc[ai][1][m][n][j]; hv[n * 4 + j] = g * sigmoidf_fast(g) * up; }
                u32x4 w; w.x = cvt_pk_bf16(hv[0], hv[1]); w.y = cvt_pk_bf16(hv[2], hv[3]); w.z = cvt_pk_bf16(hv[4], hv[5]); w.w = cvt_pk_bf16(hv[6], hv[7]);
                *(u32x4*)rowp = w; }
    }
};
template <class Epi, class Sched, bool ALIGN_EPI = false, bool SP2 = false, bool FP8 = false>
__device__ __forceinline__ void gemm_phase(PG8_LAS unsigned char* lds, const Gemm g, const Sched& S, const Epi& E) {
    int tid_ = threadIdx.x; asm volatile("" : "+v"(tid_));
    const int tid = tid_, wid = __builtin_amdgcn_readfirstlane(tid >> 6), lane = tid & 63, wr = wid >> 2, wc = wid & 3, fr = lane & 15, fq = lane >> 4;
    const int K = g.K, nt = K / BK;
    unsigned voffA[2], voffB[2];
#pragma unroll
    for (int i = 0; i < 2; ++i) { int R, C; stage_rc(tid * 16 + i * 8192, R, C); const int Rb = Epi::PERM ? ((R & ~31) + perm32(R & 31)) : R;
        voffA[i] = (unsigned)(R * K + C) * 2u; voffB[i] = (unsigned)(Rb * K + C) * 2u; }
    const size_t r64step = (size_t)64 * K * 2;
    const size_t kstep = (size_t)(BK * 2);
    const size_t hstep = (size_t)HALF * K * 2;
    const size_t tstep = 2 * hstep;
    const unsigned ldsw = (unsigned)wid * 1024u;
    const int aoff = FP8 ? lds_byte(wr * 64 + fr, (fq >> 1) * 32 + (fq & 1) * 16) : lds_byte(wr * 64 + fr, fq * 8), boff = FP8 ? lds_byte(wc * 32 + fr, (fq >> 1) * 32 + (fq & 1) * 16) : lds_byte(wc * 32 + fr, fq * 8);
#define PG8_SA(b, h) (((b) * 2 + (h)) * HTB)
#define PG8_SB(b, h) ((4 + (b) * 2 + (h)) * HTB)
#define PG8_STAGE(bufoff, gbase, voff) do { _Pragma("unroll") for (int _i = 0; _i < 2; ++_i) { const char* _gb = (const char*)(gbase) + (size_t)_i * r64step; asm volatile("" : "+s"(_gb));     \
        __builtin_amdgcn_global_load_lds((const unsigned*)(_gb + (voff)[0]), (PG8_LAS unsigned*)(lds + (bufoff) + ldsw + _i * 8192), 16, 0, 0); } } while (0)
#define PG8_LD8(p_) __builtin_shufflevector(*(const PG8_LAS v4i32*)(p_), *(const PG8_LAS v4i32*)((p_) + 16), 0, 1, 2, 3, 4, 5, 6, 7)
#define PG8_LDA(dst, b, h) do { if constexpr (FP8) { _Pragma("unroll") for (int m = 0; m < 4; ++m) dst##8[m] = PG8_LD8(lds + PG8_SA(b, h) + aoff + m * 2048); } \
        else { _Pragma("unroll") for (int m = 0; m < 4; ++m) _Pragma("unroll") for (int k = 0; k < 2; ++k) dst[m][k] = *(const PG8_LAS bf16x8*)(lds + PG8_SA(b, h) + aoff + m * 2048 + k * 1024); } } while (0)
#define PG8_LDB(dst, b, h) do { if constexpr (FP8) { _Pragma("unroll") for (int n = 0; n < 2; ++n) dst##8[n] = PG8_LD8(lds + PG8_SB(b, h) + boff + n * 2048); } \
        else { _Pragma("unroll") for (int n = 0; n < 2; ++n) _Pragma("unroll") for (int k = 0; k < 2; ++k) dst[n][k] = *(const PG8_LAS bf16x8*)(lds + PG8_SB(b, h) + boff + n * 2048 + k * 1024); } } while (0)
#define PG8_MMA(ai, bj, At, Bt) do { __builtin_amdgcn_s_setprio(1); if constexpr (FP8) { _Pragma("unroll") for (int m = 0; m < 4; ++m) _Pragma("unroll") for (int n = 0; n < 2; ++n) \
            acc[ai][bj][m][n] = __builtin_amdgcn_mfma_scale_f32_16x16x128_f8f6f4(Bt##8[n], At##8[m], acc[ai][bj][m][n], 0, 0, 0, g.sw, 0, g.sx); } \
        else { _Pragma("unroll") for (int m = 0; m < 4; ++m) _Pragma("unroll") for (int n = 0; n < 2; ++n) _Pragma("unroll") for (int k = 0; k < 2; ++k) \
        acc[ai][bj][m][n] = __builtin_amdgcn_mfma_f32_16x16x32_bf16(Bt[n][k], At[m][k], acc[ai][bj][m][n], 0, 0, 0); } __builtin_amdgcn_s_setprio(0); } while (0)
#define PG8_WAIT_V(n) asm volatile("s_waitcnt vmcnt(" #n ")" ::: "memory")
#define PG8_WAIT_L(n) asm volatile("s_waitcnt lgkmcnt(" #n ")" ::: "memory")
#define PG8_BAR __builtin_amdgcn_s_barrier()
#define PG8_SCHED __builtin_amdgcn_sched_barrier(0)
    Unit cur, nxt; int ui = 0;
    if (!S.next(0, cur)) return;
    f32x4 acc[2][2][4][2];
#pragma unroll
    for (int a = 0; a < 2; ++a)
#pragma unroll
        for (int b = 0; b < 2; ++b)
#pragma unroll
            for (int m = 0; m < 4; ++m)
#pragma unroll
                for (int n = 0; n < 2; ++n) acc[a][b][m][n] = (f32x4){0.f, 0.f, 0.f, 0.f};
    bf16x8 At[4][2], B0[2][2], B1[2][2]; v8i32 At8[4], B08[2], B18[2];
    const char* cA = (const char*)g.A + (size_t)cur.pm * tstep; const char* cB = (const char*)g.Bt + (size_t)cur.pn * tstep;
    S.a_ready(cur);
    if constexpr (SP2) {
        PG8_STAGE(PG8_SB(0, 0), cB, voffB); PG8_STAGE(PG8_SB(0, 1), cB + hstep, voffB); PG8_STAGE(PG8_SA(0, 0), cA, voffA); PG8_STAGE(PG8_SA(0, 1), cA + hstep, voffA);
        if (wr == 1) PG8_BAR;
        PG8_WAIT_V(2); PG8_BAR;
        PG8_STAGE(PG8_SB(1, 0), cB + kstep, voffB); PG8_STAGE(PG8_SA(1, 0), cA + kstep, voffA); PG8_STAGE(PG8_SB(1, 1), cB + hstep + kstep, voffB);
        PG8_WAIT_V(6); PG8_BAR;
    } else {
        PG8_STAGE(PG8_SB(0, 0), cB, voffB); PG8_STAGE(PG8_SA(0, 0), cA, voffA); PG8_STAGE(PG8_SB(0, 1), cB + hstep, voffB); PG8_STAGE(PG8_SA(0, 1), cA + hstep, voffA);
        if (wr == 1) PG8_BAR;
        PG8_WAIT_V(4); PG8_BAR;
        PG8_STAGE(PG8_SB(1, 0), cB + kstep, voffB); PG8_STAGE(PG8_SA(1, 0), cA + kstep, voffA); PG8_STAGE(PG8_SB(1, 1), cB + hstep + kstep, voffB);
        PG8_WAIT_V(6); PG8_BAR;
    }
    for (;;) {
        const bool has_next = S.next(ui + 1, nxt);
        const char* nA = has_next ? (const char*)g.A + (size_t)nxt.pm * tstep : cA; const char* nB = has_next ? (const char*)g.Bt + (size_t)nxt.pn * tstep : cB;
        for (int t = 0; t < nt; t += 2) {
            const bool last = (t == nt - 2);
            const char* a1 = cA + (size_t)(t + 1) * kstep;
            const char* a2 = last ? nA : cA + (size_t)(t + 2) * kstep; const char* b2 = last ? nB : cB + (size_t)(t + 2) * kstep;
            const char* a3 = a2 + kstep; const char* b3 = b2 + kstep;
            if (last && has_next) S.a_ready(nxt);
            if constexpr (SP2) {
            PG8_LDB(B0, 0, 0); PG8_LDB(B1, 0, 1); PG8_SCHED; PG8_LDA(At, 0, 0); PG8_STAGE(PG8_SA(1, 1), a1 + hstep, voffA);
            PG8_WAIT_V(8); PG8_WAIT_L(0); PG8_BAR; PG8_MMA(0, 0, At, B0); PG8_MMA(0, 1, At, B1); PG8_BAR; PG8_SCHED;
            PG8_LDA(At, 0, 1); PG8_STAGE(PG8_SB(0, 0), b2, voffB); PG8_STAGE(PG8_SB(0, 1), b2 + hstep, voffB); PG8_STAGE(PG8_SA(0, 0), a2, voffA);
            PG8_WAIT_V(8); PG8_WAIT_L(0); PG8_BAR; PG8_MMA(1, 0, At, B0); PG8_MMA(1, 1, At, B1); PG8_BAR; PG8_SCHED;
            PG8_LDB(B0, 1, 0); PG8_LDB(B1, 1, 1); PG8_SCHED; PG8_LDA(At, 1, 0); PG8_STAGE(PG8_SA(0, 1), a2 + hstep, voffA);
            PG8_WAIT_V(8); PG8_WAIT_L(0); PG8_BAR; PG8_MMA(0, 0, At, B0); PG8_MMA(0, 1, At, B1); PG8_BAR; PG8_SCHED;
            PG8_LDA(At, 1, 1); PG8_STAGE(PG8_SB(1, 0), b3, voffB); PG8_STAGE(PG8_SB(1, 1), b3 + hstep, voffB); PG8_STAGE(PG8_SA(1, 0), a3, voffA);
            PG8_WAIT_V(8); PG8_WAIT_L(0); PG8_BAR; PG8_MMA(1, 0, At, B0); PG8_MMA(1, 1, At, B1); PG8_BAR; PG8_SCHED;
            } else {
            PG8_LDB(B0, 0, 0); PG8_SCHED; PG8_LDA(At, 0, 0); PG8_STAGE(PG8_SA(1, 1), a1 + hstep, voffA);
            PG8_WAIT_L(8); PG8_BAR; PG8_WAIT_L(0); PG8_MMA(0, 0, At, B0); PG8_BAR; PG8_SCHED;
            PG8_LDB(B1, 0, 1); PG8_STAGE(PG8_SB(0, 0), b2, voffB);
            PG8_BAR; PG8_WAIT_L(0); PG8_MMA(0, 1, At, B1); PG8_BAR;
            PG8_LDA(At, 0, 1); PG8_STAGE(PG8_SA(0, 0), a2, voffA);
            PG8_BAR; PG8_WAIT_L(0); PG8_MMA(1, 0, At, B0); PG8_BAR; PG8_SCHED;
            PG8_STAGE(PG8_SB(0, 1), b2 + hstep, voffB);
            PG8_WAIT_V(6); PG8_BAR; PG8_MMA(1, 1, At, B1); PG8_BAR;
            PG8_LDB(B0, 1, 0); PG8_SCHED; PG8_LDA(At, 1, 0); PG8_STAGE(PG8_SA(0, 1), a2 + hstep, voffA);
            PG8_WAIT_L(8); PG8_BAR; PG8_WAIT_L(0); PG8_MMA(0, 0, At, B0); PG8_BAR; PG8_SCHED;
            PG8_LDB(B1, 1, 1); PG8_STAGE(PG8_SB(1, 0), b3, voffB);
            PG8_BAR; PG8_WAIT_L(0); PG8_MMA(0, 1, At, B1); PG8_BAR;
            PG8_LDA(At, 1, 1); PG8_STAGE(PG8_SA(1, 0), a3, voffA);
            PG8_BAR; PG8_WAIT_L(0); PG8_MMA(1, 0, At, B0); PG8_BAR; PG8_SCHED;
            PG8_STAGE(PG8_SB(1, 1), b3 + hstep, voffB);
            PG8_WAIT_V(6); PG8_BAR; PG8_MMA(1, 1, At, B1); PG8_BAR;
            }
        }
        if constexpr (ALIGN_EPI) { if (wr == 0) PG8_BAR; }
        if constexpr (!Epi::AFTER_DRAIN) { int t2_ = threadIdx.x; asm volatile("" : "+v"(t2_)); const int fr_ = t2_ & 15, fq_ = (t2_ & 63) >> 4;
            E(acc, cur, wr, wc, fr_, fq_); S.done(cur); }
        if (!has_next) break;
#pragma unroll
        for (int a = 0; a < 2; ++a)
#pragma unroll
            for (int b = 0; b < 2; ++b)
#pragma unroll
                for (int m = 0; m < 4; ++m)
#pragma unroll
                    for (int n = 0; n < 2; ++n) acc[a][b][m][n] = (f32x4){0.f, 0.f, 0.f, 0.f};
        cur = nxt; cA = nA; cB = nB; ++ui;
        if constexpr (ALIGN_EPI) { if (wr == 1) PG8_BAR; }
    }
    PG8_WAIT_V(0);
    if constexpr (!ALIGN_EPI) { if (wr == 0) PG8_BAR; }
    PG8_BAR;
    if constexpr (Epi::AFTER_DRAIN) { E.fused(acc, cur, wr, wc, fr, fq, lds, wid, lane); S.done(cur); }
#undef PG8_SA
#undef PG8_SB
#undef PG8_STAGE
#undef PG8_LD8
#undef PG8_LDA
#undef PG8_LDB
#undef PG8_MMA
#undef PG8_WAIT_V
#undef PG8_WAIT_L
#undef PG8_BAR
#undef PG8_SCHED
}
}

#ifndef PROBE_MASK
#define PROBE_MASK 0
#endif
#ifndef EN_INPROJ
#define EN_INPROJ 1
#endif
#ifndef EN_GATE
#define EN_GATE 1
#endif
#ifndef EN_RESID
#define EN_RESID 1
#endif
#ifndef EN_SWIGLU
#define EN_SWIGLU 1
#endif
#ifndef EN_ATTN
#define EN_ATTN 1
#endif
#ifndef EN_PRO
#define EN_PRO 1
#endif
#define LAS __attribute__((address_space(3)))
typedef unsigned short bf16;
typedef short bf16x8 __attribute__((ext_vector_type(8)));
typedef short s16x4 __attribute__((ext_vector_type(4)));
typedef float f32x4 __attribute__((ext_vector_type(4)));
typedef float f32x16 __attribute__((ext_vector_type(16)));
typedef unsigned u32x4 __attribute__((ext_vector_type(4)));
typedef unsigned u32x2 __attribute__((ext_vector_type(2)));

constexpr int T = 32768, TH = 16384, D = 2048, CIN = 10240, DFF = 5632, NUP = 11264, SEQ = 16384;
constexpr int NWAVES = 8, NTHREADS = 512;
constexpr float ALPHA = 1.41421356237309515f;
constexpr float LN_EPS = 1e-5f;
constexpr float LOG2E = 1.4426950408889634f;
constexpr int LDS_BYTES = 163840;
constexpr int NPHASES = 27;

constexpr size_t MiB = (size_t)1 << 20;
constexpr size_t WS_TAB = 0;
constexpr size_t WS_W0 = 1 * MiB, WS_WL = 120 * MiB;
constexpr size_t WO_IN = 0, WO_PA = WO_IN + (size_t)CIN * D, WO_PB = WO_PA + (size_t)D * 512, WO_OUT = WO_PB + (size_t)D * 1024, WO_UP = WO_OUT + (size_t)D * D,
                 WO_DN = WO_UP + (size_t)NUP * D, WO_END = WO_DN + (size_t)D * DFF;
static_assert(WO_END * 2 <= WS_WL, "weight block");
constexpr size_t WS_XB = 241 * MiB;
constexpr size_t WS_PROJ = 369 * MiB;
constexpr size_t WS_AR = 689 * MiB;
constexpr size_t WS_LSE = 737 * MiB;
constexpr size_t WS_AO = 738 * MiB;
constexpr size_t WS_BO = 754 * MiB;
constexpr size_t WS_H = 369 * MiB;
constexpr size_t WS_X8 = 800 * MiB;
constexpr size_t WS_ST = 864 * MiB;
constexpr size_t WS_END = 865 * MiB;

struct Params;
typedef const __attribute__((address_space(4))) Params* PP;
struct Params {
    const float* x; const float* rel_bias; const float* w_in; const float* sink; const float* w_pa; const float* w_pb; const float* w_out;
    const float* ln1_g; const float* ln1_b; const float* w_up; const float* w_down; const float* ln2_g; const float* ln2_b;
    float* out; unsigned char* ws; int ph_lo, ph_hi;
};

__device__ __forceinline__ unsigned pk2(float a, float b) { return pg8::cvt_pk_bf16(a, b); }
__device__ __forceinline__ float shx(float v, int o, int lane) { return __int_as_float(__builtin_amdgcn_ds_bpermute((lane ^ o) << 2, __float_as_int(v))); }
__device__ __forceinline__ float wave_sum(float v, int lane) {
#pragma unroll
    for (int o = 1; o < 64; o <<= 1) v += shx(v, o, lane);
    return v;
}
#define LDS_WAIT() asm volatile("s_waitcnt lgkmcnt(0)" ::: "memory")

__device__ __forceinline__ void transpose_item(const float* __restrict__ W, int K, int N, bf16* WT, int k0, int n0, int row0, LAS float* scr, int lane) {
#pragma unroll 8
    for (int i = 0; i < 32; ++i) { const int kk = 2 * i + (lane >> 5); scr[kk * 33 + (lane & 31)] = W[(size_t)(k0 + kk) * N + n0 + (lane & 31)]; }
    LDS_WAIT();
    const int c = lane & 7;
#pragma unroll
    for (int j = 0; j < 4; ++j) { const int n = (lane >> 3) + 8 * j; const LAS float* s = scr + (8 * c) * 33 + n;
        u32x4 o; o.x = pk2(s[0 * 33], s[1 * 33]); o.y = pk2(s[2 * 33], s[3 * 33]); o.z = pk2(s[4 * 33], s[5 * 33]); o.w = pk2(s[6 * 33], s[7 * 33]);
        *(u32x4*)(WT + (size_t)(row0 + n) * K + k0 + 8 * c) = o; }
    LDS_WAIT();
}
using pg8::pk4_fp8;
__device__ __forceinline__ void transpose_item_fp8(const float* __restrict__ W, int K, int N, unsigned char* WT, int k0, int n0, LAS float* scr, int lane, float scale) {
#pragma unroll 8
    for (int i = 0; i < 32; ++i) { const int kk = 2 * i + (lane >> 5); scr[kk * 33 + (lane & 31)] = W[(size_t)(k0 + kk) * N + n0 + (lane & 31)]; }
    LDS_WAIT();
    const int n = lane >> 1, kh = lane & 1; const LAS float* sp = scr + (32 * kh) * 33 + n;
    u32x4 o0, o1;
    o0.x = pk4_fp8(sp[0 * 33] * scale, sp[1 * 33] * scale, sp[2 * 33] * scale, sp[3 * 33] * scale); o0.y = pk4_fp8(sp[4 * 33] * scale, sp[5 * 33] * scale, sp[6 * 33] * scale, sp[7 * 33] * scale);
    o0.z = pk4_fp8(sp[8 * 33] * scale, sp[9 * 33] * scale, sp[10 * 33] * scale, sp[11 * 33] * scale); o0.w = pk4_fp8(sp[12 * 33] * scale, sp[13 * 33] * scale, sp[14 * 33] * scale, sp[15 * 33] * scale);
    o1.x = pk4_fp8(sp[16 * 33] * scale, sp[17 * 33] * scale, sp[18 * 33] * scale, sp[19 * 33] * scale); o1.y = pk4_fp8(sp[20 * 33] * scale, sp[21 * 33] * scale, sp[22 * 33] * scale, sp[23 * 33] * scale);
    o1.z = pk4_fp8(sp[24 * 33] * scale, sp[25 * 33] * scale, sp[26 * 33] * scale, sp[27 * 33] * scale); o1.w = pk4_fp8(sp[28 * 33] * scale, sp[29 * 33] * scale, sp[30 * 33] * scale, sp[31 * 33] * scale);
    unsigned char* dst = WT + (size_t)(n0 + n) * K + k0 + 32 * kh;
    *(u32x4*)dst = o0; *(u32x4*)(dst + 16) = o1;
    LDS_WAIT();
}
__device__ __forceinline__ int t5_bucket(int rel) {
    const int n = rel < 0 ? -rel : rel; int b;
    if (n < 8) b = n; else { const int e = (int)(__builtin_log2f((float)n * 0.125f) * (8.0f / 7.0f)); b = 8 + e; if (b > 15) b = 15; }
    return b + (rel > 0 ? 16 : 0);
}
__device__ __forceinline__ void phase_prologue(PP pp, LAS unsigned char* lds, int gw, int NGW, int wave, int lane) {
    LAS float* scr = (LAS float*)(lds + wave * 16384);
    constexpr int I_IN = (D / 64) * (CIN / 32), I_PA = (512 / 64) * (D / 32), I_PB = (1024 / 64) * (D / 32), I_OUT = (D / 64) * (D / 32), I_UP = (D / 64) * (NUP / 32), I_DN = (DFF / 64) * (D / 32);
    constexpr int I_LAYER = I_IN + I_PA + I_PB + I_OUT + I_UP + I_DN;
    for (int it = gw; it < 2 * I_LAYER; it += NGW) {
        const int l = it / I_LAYER; int r = it - l * I_LAYER;
        bf16* wl = (bf16*)(pp->ws + WS_W0 + (size_t)l * WS_WL);
        const float* W; int K, N; bf16* WT; bool up = false, r0_in = false;
        if (r < I_IN) { W = pp->w_in + (size_t)l * D * CIN; K = D; N = CIN; WT = wl + WO_IN; r0_in = true; }
        else if ((r -= I_IN) < I_PA) { r0_in = true; W = pp->w_pa + (size_t)l * 512 * D; K = 512; N = D; WT = wl + WO_PA; }
        else if ((r -= I_PA) < I_PB) { r0_in = true; W = pp->w_pb + (size_t)l * 1024 * D; K = 1024; N = D; WT = wl + WO_PB; }
        else if ((r -= I_PB) < I_OUT) { r0_in = true; W = pp->w_out + (size_t)l * D * D; K = D; N = D; WT = wl + WO_OUT; }
        else if ((r -= I_OUT) < I_UP) { W = pp->w_up + (size_t)l * D * NUP; K = D; N = NUP; WT = wl + WO_UP; up = true; }
        else { r -= I_UP; W = pp->w_down + (size_t)l * DFF * D; K = DFF; N = D; WT = wl + WO_DN; }
        const int nblk = N / 32, kb = r / nblk, nb = r - kb * nblk, n0 = 32 * nb;
        int row0 = n0;
        if (up) { const int j0 = n0 < DFF ? n0 : n0 - DFF; row0 = (j0 >> 7) * 256 + (n0 < DFF ? 0 : 128) + (j0 & 127); }
        if (r0_in) transpose_item_fp8(W, K, N, (unsigned char*)WT, 64 * kb, n0, scr, lane, 128.0f);
        else transpose_item(W, K, N, WT, 64 * kb, n0, row0, scr, lane);
    }
    { const size_t gt = (size_t)gw * 64 + lane, NT = (size_t)NGW * 64; unsigned char* x8 = pp->ws + WS_X8;
      for (size_t i = gt; i < (size_t)T * D / 16; i += NT) { const f32x4 a = *(const f32x4*)(pp->x + i * 16) * 32.f, b = *(const f32x4*)(pp->x + i * 16 + 4) * 32.f, c = *(const f32x4*)(pp->x + i * 16 + 8) * 32.f, d = *(const f32x4*)(pp->x + i * 16 + 12) * 32.f;
          u32x4 o; o.x = pk4_fp8(a[0], a[1], a[2], a[3]); o.y = pk4_fp8(b[0], b[1], b[2], b[3]); o.z = pk4_fp8(c[0], c[1], c[2], c[3]); o.w = pk4_fp8(d[0], d[1], d[2], d[3]); *(u32x4*)(x8 + i * 16) = o; } }
    { float* tabA = (float*)(pp->ws + WS_TAB); float* tabB = (float*)(pp->ws + WS_TAB + 8192);
      const int gt = gw * 64 + lane;
      if (gt < 12 * 129) { const int hh = gt / 129, i = gt - hh * 129, g = hh >> 2, dil = g == 0 ? 1 : (g == 1 ? 4 : 16); tabA[hh * 132 + i] = pp->rel_bias[t5_bucket((i - 64) * dil) * 20 + hh] * LOG2E; }
      else if (gt < 12 * 129 + 8 * 257) { const int q = gt - 12 * 129, hh = q / 257, i = q - hh * 257; tabB[hh * 260 + i] = pp->rel_bias[t5_bucket(i - 128) * 20 + 12 + hh] * LOG2E; } }
}

constexpr int AT_KS = 0, AT_VS = 8704, AT_TAB = 8704 + 10240, AT_WAVE_BYTES = 8704 + 10240 + 1040;
static_assert(AT_WAVE_BYTES * NWAVES <= LDS_BYTES, "attention LDS");
#define TR4(r0, r1, r2, r3, base, o0, o1, o2, o3) asm volatile("ds_read_b64_tr_b16 %0, %4 offset:%5\n\tds_read_b64_tr_b16 %1, %4 offset:%6\n\tds_read_b64_tr_b16 %2, %4 offset:%7\n\tds_read_b64_tr_b16 %3, %4 offset:%8\n\ts_waitcnt lgkmcnt(0)" \
    : "=&v"(r0), "=&v"(r1), "=&v"(r2), "=&v"(r3) : "v"(base), "i"(o0), "i"(o1), "i"(o2), "i"(o3) : "memory")
#define PK8(L, Hh) (bf16x8){L[0], L[1], L[2], L[3], Hh[0], Hh[1], Hh[2], Hh[3]}

__device__ __forceinline__ void attn_item(LAS unsigned char* wl, int lane, const bf16* __restrict__ P, int qcol, int kcol, int vcol, int r, int dil, int sub_len, int q0, int W, int nkt,
                                          const float* __restrict__ tab, float m_init, float l_init, bf16* O, int o_ld, int ocol, float* lse, int lse_idx, bool o8) {
    const int hl = lane >> 5, ql = lane & 31;
    LAS float* tabs = (LAS float*)(wl + AT_TAB);
    for (int i = lane; i < 2 * W + 1; i += 64) tabs[i] = tab[i];
    bf16x8 qf[8];
    { const bf16* qp = P + (size_t)(r + (q0 + ql) * dil) * CIN + qcol + 8 * hl;
#pragma unroll
      for (int s = 0; s < 8; ++s) qf[s] = *(const bf16x8*)(qp + 16 * s); }
    u32x4 kreg[8], vreg[8];
    const int lrow = lane >> 4, lch = lane & 15;
#define AT_LOAD(kt) do { _Pragma("unroll") for (int jj = 0; jj < 8; ++jj) { int sub = q0 - W + 32 * (kt) + 4 * jj + lrow; sub = sub < 0 ? 0 : (sub >= sub_len ? sub_len - 1 : sub); \
        const bf16* rp = P + (size_t)(r + sub * dil) * CIN + 8 * lch; kreg[jj] = *(const u32x4*)(rp + kcol); vreg[jj] = *(const u32x4*)(rp + vcol); } } while (0)
    f32x16 o0, o1, o2, o3;
#pragma unroll
    for (int i = 0; i < 16; ++i) { o0[i] = 0.f; o1[i] = 0.f; o2[i] = 0.f; o3[i] = 0.f; }
    float m = m_init, l = l_init;
    const float c = 0.08838834764831845f * LOG2E;
    const unsigned vb = (unsigned)(uintptr_t)(wl + AT_VS) + (unsigned)((4 * hl + ((lane & 15) >> 2)) * 320 + (16 * ((lane >> 4) & 1) + 4 * (lane & 3)) * 2);
    const LAS unsigned char* kb = wl + AT_KS + ql * 272 + 16 * hl;
    for (int kt = 0; kt < nkt; ++kt) {
        AT_LOAD(kt);
#pragma unroll
        for (int jj = 0; jj < 8; ++jj) { *(LAS u32x4*)(wl + AT_KS + (4 * jj + lrow) * 272 + 16 * lch) = kreg[jj]; *(LAS u32x4*)(wl + AT_VS + (4 * jj + lrow) * 320 + 16 * lch) = vreg[jj]; }
        f32x16 sc;
#pragma unroll
        for (int i = 0; i < 16; ++i) sc[i] = 0.f;
#pragma unroll
        for (int s = 0; s < 8; ++s) { const bf16x8 kf = *(const LAS bf16x8*)(kb + 32 * s); sc = __builtin_amdgcn_mfma_f32_32x32x16_bf16(kf, qf[s], sc, 0, 0, 0); }
        const int dbase = -W + 32 * kt - ql + 4 * hl;
        float tmax = -__builtin_inff();
#pragma unroll
        for (int i = 0; i < 16; ++i) { const int dlt = dbase + 8 * (i >> 2) + (i & 3); const int ks = q0 + ql + dlt; const bool ok = (dlt >= -W) && (dlt <= W) && (ks >= 0) && (ks < sub_len);
            int ti = dlt + W; ti = ti < 0 ? 0 : (ti > 2 * W ? 2 * W : ti);
            const float v = ok ? fmaf(sc[i], c, tabs[ti]) : -__builtin_inff(); sc[i] = v; tmax = fmaxf(tmax, v); }
        tmax = fmaxf(tmax, shx(tmax, 32, lane));
        const float mn = fmaxf(m, tmax), alpha = __builtin_amdgcn_exp2f(m - mn); m = mn;
        float ps = 0.f;
#pragma unroll
        for (int i = 0; i < 16; ++i) { sc[i] = __builtin_amdgcn_exp2f(sc[i] - mn); ps += sc[i]; }
        l = l * alpha + ps;
#pragma unroll
        for (int i = 0; i < 16; ++i) { o0[i] *= alpha; o1[i] *= alpha; o2[i] *= alpha; o3[i] *= alpha; }
        bf16x8 p0, p1;
        { u32x4 w0, w1; w0.x = pk2(sc[0], sc[1]); w0.y = pk2(sc[2], sc[3]); w0.z = pk2(sc[4], sc[5]); w0.w = pk2(sc[6], sc[7]);
          w1.x = pk2(sc[8], sc[9]); w1.y = pk2(sc[10], sc[11]); w1.z = pk2(sc[12], sc[13]); w1.w = pk2(sc[14], sc[15]);
          p0 = *reinterpret_cast<bf16x8*>(&w0); p1 = *reinterpret_cast<bf16x8*>(&w1); }
        { s16x4 a0, a1, b0, b1;
          TR4(a0, a1, b0, b1, vb, 0, 2560, 5120, 7680); __builtin_amdgcn_sched_barrier(0);
          o0 = __builtin_amdgcn_mfma_f32_32x32x16_bf16(PK8(a0, a1), p0, o0, 0, 0, 0); o0 = __builtin_amdgcn_mfma_f32_32x32x16_bf16(PK8(b0, b1), p1, o0, 0, 0, 0);
          TR4(a0, a1, b0, b1, vb, 64, 64 + 2560, 64 + 5120, 64 + 7680); __builtin_amdgcn_sched_barrier(0);
          o1 = __builtin_amdgcn_mfma_f32_32x32x16_bf16(PK8(a0, a1), p0, o1, 0, 0, 0); o1 = __builtin_amdgcn_mfma_f32_32x32x16_bf16(PK8(b0, b1), p1, o1, 0, 0, 0);
          TR4(a0, a1, b0, b1, vb, 128, 128 + 2560, 128 + 5120, 128 + 7680); __builtin_amdgcn_sched_barrier(0);
          o2 = __builtin_amdgcn_mfma_f32_32x32x16_bf16(PK8(a0, a1), p0, o2, 0, 0, 0); o2 = __builtin_amdgcn_mfma_f32_32x32x16_bf16(PK8(b0, b1), p1, o2, 0, 0, 0);
          TR4(a0, a1, b0, b1, vb, 192, 192 + 2560, 192 + 5120, 192 + 7680); __builtin_amdgcn_sched_barrier(0);
          o3 = __builtin_amdgcn_mfma_f32_32x32x16_bf16(PK8(a0, a1), p0, o3, 0, 0, 0); o3 = __builtin_amdgcn_mfma_f32_32x32x16_bf16(PK8(b0, b1), p1, o3, 0, 0, 0); }
    }
#undef AT_LOAD
    const float lt = l + shx(l, 32, lane), inv = 1.0f / lt;
    const size_t tok = (size_t)(r + (q0 + ql) * dil);
    if (o8) {
        unsigned char* op = (unsigned char*)O + tok * o_ld + ocol + 4 * hl; const float i64 = inv * 64.f;
#pragma unroll
        for (int g = 0; g < 4; ++g) {
            *(unsigned*)(op + 8 * g) = pk4_fp8(o0[4 * g] * i64, o0[4 * g + 1] * i64, o0[4 * g + 2] * i64, o0[4 * g + 3] * i64);
            *(unsigned*)(op + 32 + 8 * g) = pk4_fp8(o1[4 * g] * i64, o1[4 * g + 1] * i64, o1[4 * g + 2] * i64, o1[4 * g + 3] * i64);
            *(unsigned*)(op + 64 + 8 * g) = pk4_fp8(o2[4 * g] * i64, o2[4 * g + 1] * i64, o2[4 * g + 2] * i64, o2[4 * g + 3] * i64);
            *(unsigned*)(op + 96 + 8 * g) = pk4_fp8(o3[4 * g] * i64, o3[4 * g + 1] * i64, o3[4 * g + 2] * i64, o3[4 * g + 3] * i64);
        }
    } else {
    bf16* op = O + tok * o_ld + ocol + 4 * hl;
#pragma unroll
    for (int g = 0; g < 4; ++g) {
        u32x2 w;
        w.x = pk2(o0[4 * g] * inv, o0[4 * g + 1] * inv); w.y = pk2(o0[4 * g + 2] * inv, o0[4 * g + 3] * inv); *(u32x2*)(op + 8 * g) = w;
        w.x = pk2(o1[4 * g] * inv, o1[4 * g + 1] * inv); w.y = pk2(o1[4 * g + 2] * inv, o1[4 * g + 3] * inv); *(u32x2*)(op + 32 + 8 * g) = w;
        w.x = pk2(o2[4 * g] * inv, o2[4 * g + 1] * inv); w.y = pk2(o2[4 * g + 2] * inv, o2[4 * g + 3] * inv); *(u32x2*)(op + 64 + 8 * g) = w;
        w.x = pk2(o3[4 * g] * inv, o3[4 * g + 1] * inv); w.y = pk2(o3[4 * g + 2] * inv, o3[4 * g + 3] * inv); *(u32x2*)(op + 96 + 8 * g) = w;
    }
    }
    if (lse && hl == 0) lse[tok * 12 + lse_idx] = m + __builtin_log2f(lt);
    LDS_WAIT();
}

__device__ __forceinline__ void phase_attention(unsigned char* ws, const float* sinkp, LAS unsigned char* lds, int layer, int gw, int NGW, int wave, int lane) {
    LAS unsigned char* wl = lds + wave * AT_WAVE_BYTES;
    const bf16* P = (const bf16*)(ws + WS_PROJ);
    const float* tabA = (const float*)(ws + WS_TAB); const float* tabB = (const float*)(ws + WS_TAB + 8192);
    constexpr int NA = 12 * 512, NB = 8 * 512;
    for (int it = gw; it < NA + NB; it += NGW) {
        int qcol, kcol, vcol, r, dil, q0, W, nkt, o_ld, ocol, lse_idx; const float* tab; float m0, l0; bf16* O; float* lse;
        if (it < NA) {
            const int g = it >> 11, rem = it & 2047, h = rem >> 9, qt = rem & 511, hh = g * 4 + h;
            dil = g == 0 ? 1 : (g == 1 ? 4 : 16); const int tpr = 512 / dil; r = qt / tpr; q0 = (qt - r * tpr) * 32;
            qcol = hh * 128; kcol = 1536 + hh * 128; vcol = 3072 + hh * 128; W = 64; nkt = 5; tab = tabA + hh * 132; m0 = -1e30f; l0 = 0.f;
            O = (bf16*)(ws + WS_AR); o_ld = 1536; ocol = hh * 128; lse = (float*)(ws + WS_LSE); lse_idx = hh;
        } else {
            const int j = it - NA, rep = j & 3, qt = (j >> 2) & 511, kvh = j >> 11, qh = kvh * 4 + rep;
            dil = 1; r = 0; q0 = qt * 32; qcol = 4608 + qh * 128; kcol = 5632 + kvh * 128; vcol = 5888 + kvh * 128; W = 128; nkt = 9; tab = tabB + qh * 260;
            m0 = sinkp[layer * 8 + qh] * LOG2E; l0 = (lane < 32) ? 1.f : 0.f;
            O = (bf16*)(ws + WS_BO); o_ld = 1024; ocol = qh * 128; lse = nullptr; lse_idx = 0;
        }
        attn_item(wl, lane, P, qcol, kcol, vcol, r, dil, SEQ / dil, q0, W, nkt, tab, m0, l0, O, o_ld, ocol, lse, lse_idx, it >= NA);
    }
}

__device__ __forceinline__ void phase_amerge(unsigned char* ws, int gw, int NGW, int lane) {
    const bf16* AR = (const bf16*)(ws + WS_AR); const float* LSE = (const float*)(ws + WS_LSE); unsigned char* AO8 = ws + WS_AO;
    const size_t gt = (size_t)gw * 64 + lane, NT = (size_t)NGW * 64;
    for (size_t i = gt; i < (size_t)TH * 64; i += NT) {
        const size_t t = i >> 6; const int ch = (int)(i & 63), h = ch >> 4, dc = ch & 15;
        const float l0 = LSE[t * 12 + h], l1 = LSE[t * 12 + 4 + h], l2 = LSE[t * 12 + 8 + h];
        const float mx = fmaxf(l0, fmaxf(l1, l2));
        float w0 = __builtin_amdgcn_exp2f(l0 - mx), w1 = __builtin_amdgcn_exp2f(l1 - mx), w2 = __builtin_amdgcn_exp2f(l2 - mx);
        const float inv = 1.0f / (w0 + w1 + w2); w0 *= inv; w1 *= inv; w2 *= inv;
        const bf16* ap = AR + t * 1536 + h * 128 + dc * 8;
        const u32x4 a = *(const u32x4*)ap, b = *(const u32x4*)(ap + 512), cc = *(const u32x4*)(ap + 1024);
        w0 *= 64.f; w1 *= 64.f; w2 *= 64.f;
        u32x2 o;
        o.x = pk4_fp8(w0 * pg8::bf_lo(a.x) + w1 * pg8::bf_lo(b.x) + w2 * pg8::bf_lo(cc.x), w0 * pg8::bf_hi(a.x) + w1 * pg8::bf_hi(b.x) + w2 * pg8::bf_hi(cc.x),
                      w0 * pg8::bf_lo(a.y) + w1 * pg8::bf_lo(b.y) + w2 * pg8::bf_lo(cc.y), w0 * pg8::bf_hi(a.y) + w1 * pg8::bf_hi(b.y) + w2 * pg8::bf_hi(cc.y));
        o.y = pk4_fp8(w0 * pg8::bf_lo(a.z) + w1 * pg8::bf_lo(b.z) + w2 * pg8::bf_lo(cc.z), w0 * pg8::bf_hi(a.z) + w1 * pg8::bf_hi(b.z) + w2 * pg8::bf_hi(cc.z),
                      w0 * pg8::bf_lo(a.w) + w1 * pg8::bf_lo(b.w) + w2 * pg8::bf_lo(cc.w), w0 * pg8::bf_hi(a.w) + w1 * pg8::bf_hi(b.w) + w2 * pg8::bf_hi(cc.w));
        *(u32x2*)(AO8 + t * 512 + h * 128 + dc * 8) = o;
    }
}

__device__ __forceinline__ void phase_ln(float* Y, bf16* XB, unsigned char* X8, float* st, bool inplace, const float* __restrict__ gam, const float* __restrict__ bet, int gw, int NGW, int lane) {
    for (int row = gw; row < T; row += NGW) {
        f32x4* yr = (f32x4*)(Y + (size_t)row * D) + lane;
        f32x4 v[8]; float s = 0.f;
#pragma unroll
        for (int j = 0; j < 8; ++j) { v[j] = yr[64 * j]; s += (v[j][0] + v[j][1]) + (v[j][2] + v[j][3]); }
        const float mean = wave_sum(s, lane) * (1.f / D); float s2 = 0.f;
#pragma unroll
        for (int j = 0; j < 8; ++j) { v[j] = v[j] - mean; s2 += (v[j][0] * v[j][0] + v[j][1] * v[j][1]) + (v[j][2] * v[j][2] + v[j][3] * v[j][3]); }
        const float rstd = 1.0f / sqrtf(wave_sum(s2, lane) * (1.f / D) + LN_EPS);
        if (st && lane == 0) { st[2 * (size_t)row] = mean; st[2 * (size_t)row + 1] = rstd; }
#pragma unroll
        for (int j = 0; j < 8; ++j) { const f32x4 gg = *((const f32x4*)gam + lane + 64 * j), bb = *((const f32x4*)bet + lane + 64 * j);
            const f32x4 o = v[j] * rstd * gg + bb;
            if (inplace) yr[64 * j] = o;
            if (XB) { u32x2 w; w.x = pk2(o[0], o[1]); w.y = pk2(o[2], o[3]); *((u32x2*)(XB + (size_t)row * D) + lane + 64 * j) = w; }
            if (X8) *((unsigned*)(X8 + (size_t)row * D) + lane + 64 * j) = pk4_fp8(o[0] * 32.f, o[1] * 32.f, o[2] * 32.f, o[3] * 32.f); }
    }
}

__global__ void __launch_bounds__(NTHREADS, 2) fwd_mega(Params p_arg) {
    extern __shared__ __attribute__((aligned(16))) unsigned char lds_raw[];
    LAS unsigned char* lds = (LAS unsigned char*)lds_raw;
    const int ph_lo = p_arg.ph_lo, ph_hi = p_arg.ph_hi;
    for (int ph = ph_lo; ph < ph_hi; ++ph) {
      for (int rep = 0; rep < 2; ++rep) {
        if (ph > ph_lo || rep > 0) cg::this_grid().sync();
#if defined(__HIP_DEVICE_COMPILE__)
        PP p = (PP)__builtin_amdgcn_kernarg_segment_ptr(); asm volatile("" : "+s"(p));
#else
        PP p = (PP)(uintptr_t)0; (void)p_arg;
#endif
        int tid_ = threadIdx.x, bx_ = blockIdx.x; asm volatile("" : "+v"(tid_), "+s"(bx_));
        const int tid = tid_, lane = tid & 63, wave = __builtin_amdgcn_readfirstlane(tid >> 6);
        const int G = gridDim.x, bx = bx_, vcu = (G % 8 == 0) ? (bx % 8) * (G / 8) + bx / 8 : bx;
        const int gw = vcu * NWAVES + wave, NGW = G * NWAVES;
        unsigned char* ws = p->ws; bf16* XB = (bf16*)(ws + WS_XB);
        if (ph == 0) {
#if EN_PRO
 phase_prologue(p, lds, gw, NGW, wave, lane);
#endif
 if (rep == 0 && (PROBE_MASK & 1)) continue; else break; }
        const int q = ph - 1, layer = q / 13, s = q - layer * 13;
        const bf16* wl = (const bf16*)(ws + WS_W0 + (size_t)layer * WS_WL);
        const bool dbl = (s < 8 && (s & 3) == 1 && (PROBE_MASK & 2)) || (s < 8 && (s & 3) == 2 && (PROBE_MASK & 4)) || ((s == 9 || (s == 12 && layer == 0)) && (PROBE_MASK & 8)) || (s < 8 && (s & 3) == 0 && (PROBE_MASK & 16)) || (s == 10 && (PROBE_MASK & 32)) || (s < 8 && (s & 3) == 3 && (PROBE_MASK & 64));
        if (s < 8) {
            const int half = s >> 2, sub = s & 3;
            if (sub == 0) {
                pg8::Gemm g{(const bf16*)(ws + WS_X8 + (size_t)half * TH * D), wl + WO_IN, TH, CIN, D / 2}; pg8::StaticOrder S; S.init(TH, CIN, G, bx);
                pg8::EpiBf16<0> E{(bf16*)(ws + WS_PROJ), CIN, nullptr, 0, 0, 1.f};

#if EN_INPROJ
 pg8::gemm_phase<pg8::EpiBf16<0>, pg8::StaticOrder, true, true, true>(lds, g, S, E);
#endif

            } else if (sub == 1) {
#if EN_ATTN
 phase_attention(ws, p->sink, lds, layer, gw, NGW, wave, lane);
#endif

            } else if (sub == 2) { phase_amerge(ws, gw, NGW, lane);
            } else {
                for (int k = 0; k < 2; ++k) {
                    pg8::Gemm g{k == 0 ? (const bf16*)(ws + WS_AO) : (const bf16*)(ws + WS_BO), wl + (k == 0 ? WO_PA : WO_PB), TH, D, k == 0 ? 256 : 512, 0x79797979, 0x78787878};
                    pg8::StaticOrder S; S.init(TH, D, G, bx);
                    pg8::EpiGate E{(bf16*)(ws + WS_XB + 64 * MiB), ws + WS_XB + (size_t)half * TH * D, D, (const bf16*)(ws + WS_PROJ) + (k == 0 ? 6144 : 8192), CIN, k, 512.f};

#if EN_GATE
 pg8::gemm_phase<pg8::EpiGate, pg8::StaticOrder, true, true, true>(lds, g, S, E);
#endif

                }
            }
        } else if (s == 8 || s == 11) {
            const bool dn = (s == 11);
            pg8::StaticOrder S; S.init(T, D, G, bx);
            const bool raw = (!dn && layer == 0);
            pg8::EpiResid E{(pg8::ArgV)p, raw ? 0 : -1, dn ? 7 : 11, dn ? 8 : 12, D, ALPHA, (size_t)(dn ? layer : (layer > 0 ? layer - 1 : 0)) * D, WS_ST};
#if EN_RESID
            if (dn) { pg8::Gemm g{(const bf16*)(ws + WS_H), wl + WO_DN, T, D, DFF}; pg8::gemm_phase<pg8::EpiResid, pg8::StaticOrder, true, true>(lds, g, S, E); }
            else { pg8::Gemm g{(const bf16*)(ws + WS_XB), wl + WO_OUT, T, D, D / 2, 0x76767676, 0x78787878}; pg8::gemm_phase<pg8::EpiResid, pg8::StaticOrder, true, true, true>(lds, g, S, E); }
#endif
        } else if (s == 9) { phase_ln(p->out, XB, nullptr, (float*)(ws + WS_ST), false, p->ln1_g + layer * D, p->ln1_b + layer * D, gw, NGW, lane);
        } else if (s == 10) {
            pg8::Gemm g{XB, wl + WO_UP, T, NUP, D}; pg8::StaticOrder S; S.init(T, NUP, G, bx);
            pg8::EpiSwiglu E{(bf16*)(ws + WS_H), DFF};

#if EN_SWIGLU
 pg8::gemm_phase<pg8::EpiSwiglu, pg8::StaticOrder, true, true>(lds, g, S, E);
#endif

        } else { phase_ln(p->out, nullptr, (layer == 1) ? nullptr : ws + WS_X8, (layer == 1) ? nullptr : (float*)(ws + WS_ST), layer == 1, p->ln2_g + layer * D, p->ln2_b + layer * D, gw, NGW, lane); }
        if (!(rep == 0 && dbl)) break;
      }
    }
}

#ifndef MK_PER_PHASE
#define MK_PER_PHASE 0
#endif
extern "C" void kernel_launch(void* const* d_in, const int* in_sizes, int n_in, void* d_out, int out_size, void* d_ws, size_t ws_size, hipStream_t stream) {
    static int grid = 0;
    if (grid == 0) {
        if (n_in != 13 || ws_size < WS_END) { fprintf(stderr, "kernel_launch: unexpected inputs (n_in %d, ws %zu)\n", n_in, ws_size); grid = -1; return; }
        int dev = 0, cus = 0;
        if (hipGetDevice(&dev) != hipSuccess || hipDeviceGetAttribute(&cus, hipDeviceAttributeMultiprocessorCount, dev) != hipSuccess) { grid = -1; return; }
        if (hipFuncSetAttribute((const void*)fwd_mega, hipFuncAttributeMaxDynamicSharedMemorySize, LDS_BYTES) != hipSuccess) { fprintf(stderr, "kernel_launch: hipFuncSetAttribute failed\n"); grid = -1; return; }
        (void)hipGetLastError();
        grid = cus;
    }
    if (grid < 0) return;
    Params p{};
    p.x = (const float*)d_in[0]; p.rel_bias = (const float*)d_in[1]; p.w_in = (const float*)d_in[2]; p.sink = (const float*)d_in[3]; p.w_pa = (const float*)d_in[4]; p.w_pb = (const float*)d_in[5];
    p.w_out = (const float*)d_in[6]; p.ln1_g = (const float*)d_in[7]; p.ln1_b = (const float*)d_in[8]; p.w_up = (const float*)d_in[9]; p.w_down = (const float*)d_in[10];
    p.ln2_g = (const float*)d_in[11]; p.ln2_b = (const float*)d_in[12]; p.out = (float*)d_out; p.ws = (unsigned char*)d_ws;
#if MK_PER_PHASE
    for (int ph = 0; ph < NPHASES; ++ph) { p.ph_lo = ph; p.ph_hi = ph + 1; hipLaunchKernelGGL(fwd_mega, dim3(grid), dim3(NTHREADS), LDS_BYTES, stream, p); }
#else
    p.ph_lo = 0; p.ph_hi = NPHASES;
    void* args[] = {&p};
    hipError_t e = hipLaunchCooperativeKernel((const void*)fwd_mega, dim3(grid), dim3(NTHREADS), args, LDS_BYTES, stream);
    if (e != hipSuccess) fprintf(stderr, "kernel_launch: cooperative launch failed: %s (grid %d)\n", hipGetErrorString(e), grid);
#endif
}
```

```cpp
#include <hip/hip_runtime.h>
#include <hip/hip_cooperative_groups.h>
#include <cstdio>
#include <cstdint>
namespace cg = cooperative_groups;
namespace pg8 {
#define PG8_LAS __attribute__((address_space(3)))
typedef unsigned short bf16_t;
typedef short bf16x8 __attribute__((ext_vector_type(8)));
typedef float f32x4 __attribute__((ext_vector_type(4)));
typedef unsigned u32x4 __attribute__((ext_vector_type(4)));
typedef unsigned u32x2 __attribute__((ext_vector_type(2)));
typedef int v8i32 __attribute__((ext_vector_type(8)));
typedef int v4i32 __attribute__((ext_vector_type(4)));
constexpr int FP8_SCALE_X = 0x79797979, FP8_SCALE_W = 0x79797979;
constexpr int BM = 256, BK = 64, HALF = 128, HTB = HALF * BK * 2  , STAGE_BYTES = 8 * HTB, NXCD = 8, WGM = 8;

__host__ __device__ __forceinline__ int lds_byte(int r, int c) { const int st = (r >> 4) * 2 + (c >> 5), rr = r & 15, cc = c & 31, ob = rr * 64 + cc * 2; return st * 1024 + (ob ^ (((ob >> 9) & 1) << 5)); }
__host__ __device__ __forceinline__ void stage_rc(int b, int& R, int& C) { const int st = b / 1024, sb = b % 1024, swz = sb ^ (((sb >> 9) & 1) << 5); R = (st >> 1) * 16 + swz / 64; C = (st & 1) * 32 + (swz % 64) / 2; }
__host__ __device__ __forceinline__ int perm32(int rho) { const int n = rho >> 4, i = rho & 15; return 8 * (i >> 2) + 4 * n + (i & 3); }

struct Unit { int pm, pn; };
struct Gemm { const bf16_t* A; const bf16_t* Bt; int M, N, K; int sx = 0x79797979, sw = 0x79797979; };

struct StaticOrder {
    int nM, nN, nwg, G, c;
    __host__ __device__ void init(int M, int N, int G_, int c_) { nM = M / BM; nN = N / BM; nwg = nM * nN; G = G_; c = c_; }
    __host__ __device__ bool next(int i, Unit& u) const {
        const long L = (long)i * G + c; if (L >= nwg) return false;
        int wgid = (int)L; { const int q = nwg / NXCD, r = nwg % NXCD, xcd = wgid % NXCD, off = wgid / NXCD; wgid = (xcd < r ? xcd * (q + 1) : r * (q + 1) + (xcd - r) * q) + off; }
        const int nig = WGM * nN, gid = wgid / nig, fm = gid * WGM, gsz = (nM - fm) < WGM ? (nM - fm) : WGM;
        u.pm = fm + ((wgid % nig) % gsz); u.pn = (wgid % nig) / gsz; return true;
    }
    __device__ __forceinline__ void a_ready(const Unit&) const {}
    __device__ __forceinline__ void done(const Unit&) const {}
};

__device__ __forceinline__ unsigned cvt_pk_bf16(float lo, float hi) { unsigned r; asm("v_cvt_pk_bf16_f32 %0, %1, %2" : "=v"(r) : "v"(lo), "v"(hi)); return r; }
typedef float f32x2 __attribute__((ext_vector_type(2)));
template <int ACT  > struct EpiBf16 {
    static constexpr bool PERM = true, AFTER_DRAIN = false; static_assert(ACT == 0 || ACT == 1, "EpiBf16: ACT is 0 (none) or 1 (gelu_pk)");
    bf16_t* O; int ldc; const float* bias; int split_cols; size_t split_stride; float scale0;
    __device__ __forceinline__ void operator()(const f32x4 (&acc)[2][2][4][2], const Unit& u, int wr, int wc, int fr, int fq) const {
        const int row0 = u.pm * BM + wr * 64 + fr; int colt = u.pn * BM; bf16_t* base = O;
        float sc = 1.f; if (split_cols) { const int t = colt / split_cols; base += (size_t)t * split_stride; colt -= t * split_cols; if (t == 0) sc = scale0; }
        const int col0 = colt + wc * 32 + 8 * fq, bcol0 = u.pn * BM + wc * 32 + 8 * fq;
        f32x4 bv[2][2];
#pragma unroll
        for (int bj = 0; bj < 2; ++bj)
#pragma unroll
            for (int n = 0; n < 2; ++n) bv[bj][n] = bias ? *(const f32x4*)(bias + bcol0 + bj * HALF + 4 * n) : (f32x4){0.f, 0.f, 0.f, 0.f};
#pragma unroll
        for (int ai = 0; ai < 2; ++ai)
#pragma unroll
            for (int m = 0; m < 4; ++m) { bf16_t* rowp = base + (size_t)(row0 + ai * HALF + m * 16) * ldc + col0;
#pragma unroll
                for (int bj = 0; bj < 2; ++bj) { f32x4 v0 = acc[ai][bj][m][0] + bv[bj][0], v1 = acc[ai][bj][m][1] + bv[bj][1];
                    v0 = v0 * sc; v1 = v1 * sc; u32x4 w; w.x = cvt_pk_bf16(v0[0], v0[1]); w.y = cvt_pk_bf16(v0[2], v0[3]); w.z = cvt_pk_bf16(v1[0], v1[1]); w.w = cvt_pk_bf16(v1[2], v1[3]);
                    *(u32x4*)(rowp + bj * HALF) = w; } }
    }
};
__device__ __forceinline__ float sigmoidf_fast(float x) { return __builtin_amdgcn_rcpf(1.0f + __builtin_amdgcn_exp2f(-1.4426950408889634f * x)); }
__device__ __forceinline__ float bf_lo(unsigned w) { return __uint_as_float(w << 16); }
__device__ __forceinline__ float bf_hi(unsigned w) { return __uint_as_float(w & 0xffff0000u); }
__device__ __forceinline__ float clamp448(float v) { return __builtin_fminf(__builtin_fmaxf(v, -448.f), 448.f); }
__device__ __forceinline__ unsigned pk4_fp8(float a, float b, float c, float d) { unsigned w = 0; w = __builtin_amdgcn_cvt_pk_fp8_f32(clamp448(a), clamp448(b), w, false); w = __builtin_amdgcn_cvt_pk_fp8_f32(clamp448(c), clamp448(d), w, true); return w; }
struct EpiGate {
    static constexpr bool PERM = true, AFTER_DRAIN = false;
    bf16_t* Tm; unsigned char* O8; int ldo; const bf16_t* G; int ldg; int add; float oscale;
    __device__ __forceinline__ void operator()(const f32x4 (&acc)[2][2][4][2], const Unit& u, int wr, int wc, int fr, int fq) const {
        const int row0 = u.pm * BM + wr * 64 + fr, col0 = u.pn * BM + wc * 32 + 8 * fq;
#pragma unroll
        for (int ai = 0; ai < 2; ++ai)
#pragma unroll
            for (int m = 0; m < 4; ++m) { const size_t r = (size_t)(row0 + ai * HALF + m * 16); bf16_t* rowp = Tm + r * ldo + col0; const bf16_t* gp = G + r * ldg + col0;
#pragma unroll
                for (int bj = 0; bj < 2; ++bj) { const u32x4 gw = *(const u32x4*)(gp + bj * HALF); f32x4 v0 = acc[ai][bj][m][0], v1 = acc[ai][bj][m][1];
                    v0[0] *= sigmoidf_fast(bf_lo(gw.x)); v0[1] *= sigmoidf_fast(bf_hi(gw.x)); v0[2] *= sigmoidf_fast(bf_lo(gw.y)); v0[3] *= sigmoidf_fast(bf_hi(gw.y));
                    v1[0] *= sigmoidf_fast(bf_lo(gw.z)); v1[1] *= sigmoidf_fast(bf_hi(gw.z)); v1[2] *= sigmoidf_fast(bf_lo(gw.w)); v1[3] *= sigmoidf_fast(bf_hi(gw.w));
                    if (add) { const u32x4 pw = *(const u32x4*)(rowp + bj * HALF);
                        v0[0] += bf_lo(pw.x); v0[1] += bf_hi(pw.x); v0[2] += bf_lo(pw.y); v0[3] += bf_hi(pw.y); v1[0] += bf_lo(pw.z); v1[1] += bf_hi(pw.z); v1[2] += bf_lo(pw.w); v1[3] += bf_hi(pw.w);
                        v0 = v0 * oscale; v1 = v1 * oscale; u32x2 w8; w8.x = pk4_fp8(v0[0], v0[1], v0[2], v0[3]); w8.y = pk4_fp8(v1[0], v1[1], v1[2], v1[3]);
                        *(u32x2*)(O8 + r * ldo + col0 + bj * HALF) = w8; }
                    else { u32x4 w; w.x = cvt_pk_bf16(v0[0], v0[1]); w.y = cvt_pk_bf16(v0[2], v0[3]); w.z = cvt_pk_bf16(v1[0], v1[1]); w.w = cvt_pk_bf16(v1[2], v1[3]);
                        *(u32x4*)(rowp + bj * HALF) = w; } } }
    }
};
typedef void* vptr_t; typedef const __attribute__((address_space(4))) vptr_t* ArgV;
struct EpiResid {
    static constexpr bool PERM = false, AFTER_DRAIN = false;
    ArgV args; int xi, gi, bi; int ldc; float alpha; size_t goff; size_t st_off;
    __device__ __forceinline__ void operator()(const f32x4 (&acc)[2][2][4][2], const Unit& u, int wr, int wc, int fr, int fq) const {
        ArgV a_ = args; asm volatile("" : "+s"(a_));
        float* Y = (float*)a_[13]; const float* X = xi >= 0 ? (const float*)a_[xi] : (const float*)Y;
        const float* st = xi >= 0 ? nullptr : (const float*)((const unsigned char*)a_[14] + st_off);
        const float* g = (const float*)a_[gi < 0 ? 0 : gi] + goff; const float* b = (const float*)a_[bi < 0 ? 0 : bi] + goff;
        const int row0 = u.pm * BM + wr * 64 + fr, col0 = u.pn * BM + wc * 32 + 4 * fq;
#pragma unroll
        for (int ai = 0; ai < 2; ++ai)
#pragma unroll
            for (int m = 0; m < 4; ++m) { const int r = row0 + ai * HALF + m * 16; const size_t off = (size_t)r * ldc + col0;
                float mean = 0.f, rstd = 1.f; if (st) { const f32x2 sv = *(const f32x2*)(st + 2 * (size_t)r); mean = sv.x; rstd = sv.y; }
#pragma unroll
                for (int bj = 0; bj < 2; ++bj)
#pragma unroll
                    for (int n = 0; n < 2; ++n) { f32x4 xv = *(const f32x4*)(X + off + bj * HALF + n * 16);
                        if (st) { const f32x4 gv = *(const f32x4*)(g + col0 + bj * HALF + n * 16), bv = *(const f32x4*)(b + col0 + bj * HALF + n * 16); xv = (xv - mean) * rstd * gv + bv; }
                        *(f32x4*)(Y + off + bj * HALF + n * 16) = xv * alpha + acc[ai][bj][m][n]; }
                asm volatile("" ::: "memory"); }
    }
};
struct EpiSwiglu {
    static constexpr bool PERM = true, AFTER_DRAIN = false;
    bf16_t* Hh; int ldh;
    __device__ __forceinline__ void operator()(const f32x4 (&acc)[2][2][4][2], const Unit& u, int wr, int wc, int fr, int fq) const {
        const int row0 = u.pm * BM + wr * 64 + fr, col0 = u.pn * HALF + wc * 32 + 8 * fq;
#pragma unroll
        for (int ai = 0; ai < 2; ++ai)
#pragma unroll
            for (int m = 0; m < 4; ++m) { bf16_t* rowp = Hh + (size_t)(row0 + ai * HALF + m * 16) * ldh + col0; float hv[8];
#pragma unroll
                for (int n = 0; n < 2; ++n)
#pragma unroll
                    for (int j = 0; j < 4; ++j) { const float g = acc[ai][0][m][n][j], up = acc[ai][1][m][n][j]; hv[n * 4 + j] = g * sigmoidf_fast(g) * up; }
                u32x4 w; w.x = cvt_pk_bf16(hv[0], hv[1]); w.y = cvt_pk_bf16(hv[2], hv[3]); w.z = cvt_pk_bf16(hv[4], hv[5]); w.w = cvt_pk_bf16(hv[6], hv[7]);
                *(u32x4*)rowp = w; }
    }
};
template <class Epi, class Sched, bool ALIGN_EPI = false, bool SP2 = false, bool FP8 = false>
__device__ __forceinline__ void gemm_phase(PG8_LAS unsigned char* lds, const Gemm g, const Sched& S, const Epi& E) {
    int tid_ = threadIdx.x; asm volatile("" : "+v"(tid_));
    const int tid = tid_, wid = __builtin_amdgcn_readfirstlane(tid >> 6), lane = tid & 63, wr = wid >> 2, wc = wid & 3, fr = lane & 15, fq = lane >> 4;
    const int K = g.K, nt = K / BK;
    unsigned voffA[2], voffB[2];
#pragma unroll
    for (int i = 0; i < 2; ++i) { int R, C; stage_rc(tid * 16 + i * 8192, R, C); const int Rb = Epi::PERM ? ((R & ~31) + perm32(R & 31)) : R;
        voffA[i] = (unsigned)(R * K + C) * 2u; voffB[i] = (unsigned)(Rb * K + C) * 2u; }
    const size_t r64step = (size_t)64 * K * 2;
    const size_t kstep = (size_t)(BK * 2);
    const size_t hstep = (size_t)HALF * K * 2;
    const size_t tstep = 2 * hstep;
    const unsigned ldsw = (unsigned)wid * 1024u;
    const int aoff = FP8 ? lds_byte(wr * 64 + fr, (fq >> 1) * 32 + (fq & 1) * 16) : lds_byte(wr * 64 + fr, fq * 8), boff = FP8 ? lds_byte(wc * 32 + fr, (fq >> 1) * 32 + (fq & 1) * 16) : lds_byte(wc * 32 + fr, fq * 8);
#define PG8_SA(b, h) (((b) * 2 + (h)) * HTB)
#define PG8_SB(b, h) ((4 + (b) * 2 + (h)) * HTB)
#define PG8_STAGE(bufoff, gbase, voff) do { _Pragma("unroll") for (int _i = 0; _i < 2; ++_i) { const char* _gb = (const char*)(gbase) + (size_t)_i * r64step; asm volatile("" : "+s"(_gb));     \
        __builtin_amdgcn_global_load_lds((const unsigned*)(_gb + (voff)[0]), (PG8_LAS unsigned*)(lds + (bufoff) + ldsw + _i * 8192), 16, 0, 0); } } while (0)
#define PG8_LD8(p_) __builtin_shufflevector(*(const PG8_LAS v4i32*)(p_), *(const PG8_LAS v4i32*)((p_) + 16), 0, 1, 2, 3, 4, 5, 6, 7)
#define PG8_LDA(dst, b, h) do { if constexpr (FP8) { _Pragma("unroll") for (int m = 0; m < 4; ++m) dst##8[m] = PG8_LD8(lds + PG8_SA(b, h) + aoff + m * 2048); } \
        else { _Pragma("unroll") for (int m = 0; m < 4; ++m) _Pragma("unroll") for (int k = 0; k < 2; ++k) dst[m][k] = *(const PG8_LAS bf16x8*)(lds + PG8_SA(b, h) + aoff + m * 2048 + k * 1024); } } while (0)
#define PG8_LDB(dst, b, h) do { if constexpr (FP8) { _Pragma("unroll") for (int n = 0; n < 2; ++n) dst##8[n] = PG8_LD8(lds + PG8_SB(b, h) + boff + n * 2048); } \
        else { _Pragma("unroll") for (int n = 0; n < 2; ++n) _Pragma("unroll") for (int k = 0; k < 2; ++k) dst[n][k] = *(const PG8_LAS bf16x8*)(lds + PG8_SB(b, h) + boff + n * 2048 + k * 1024); } } while (0)
#define PG8_MMA(ai, bj, At, Bt) do { __builtin_amdgcn_s_setprio(1); if constexpr (FP8) { _Pragma("unroll") for (int m = 0; m < 4; ++m) _Pragma("unroll") for (int n = 0; n < 2; ++n) \
            acc[ai][bj][m][n] = __builtin_amdgcn_mfma_scale_f32_16x16x128_f8f6f4(Bt##8[n], At##8[m], acc[ai][bj][m][n], 0, 0, 0, g.sw, 0, g.sx); } \
        else { _Pragma("unroll") for (int m = 0; m < 4; ++m) _Pragma("unroll") for (int n = 0; n < 2; ++n) _Pragma("unroll") for (int k = 0; k < 2; ++k) \
        acc[ai][bj][m][n] = __builtin_amdgcn_mfma_f32_16x16x32_bf16(Bt[n][k], At[m][k], acc[ai][bj][m][n], 0, 0, 0); } __builtin_amdgcn_s_setprio(0); } while (0)
#define PG8_WAIT_V(n) asm volatile("s_waitcnt vmcnt(" #n ")" ::: "memory")
#define PG8_WAIT_L(n) asm volatile("s_waitcnt lgkmcnt(" #n ")" ::: "memory")
#define PG8_BAR __builtin_amdgcn_s_barrier()
#define PG8_SCHED __builtin_amdgcn_sched_barrier(0)
    Unit cur, nxt; int ui = 0;
    if (!S.next(0, cur)) return;
    f32x4 acc[2][2][4][2];
#pragma unroll
    for (int a = 0; a < 2; ++a)
#pragma unroll
        for (int b = 0; b < 2; ++b)
#pragma unroll
            for (int m = 0; m < 4; ++m)
#pragma unroll
                for (int n = 0; n < 2; ++n) acc[a][b][m][n] = (f32x4){0.f, 0.f, 0.f, 0.f};
    bf16x8 At[4][2], B0[2][2], B1[2][2]; v8i32 At8[4], B08[2], B18[2];
    const char* cA = (const char*)g.A + (size_t)cur.pm * tstep; const char* cB = (const char*)g.Bt + (size_t)cur.pn * tstep;
    S.a_ready(cur);
    if constexpr (SP2) {
        PG8_STAGE(PG8_SB(0, 0), cB, voffB); PG8_STAGE(PG8_SB(0, 1), cB + hstep, voffB); PG8_STAGE(PG8_SA(0, 0), cA, voffA); PG8_STAGE(PG8_SA(0, 1), cA + hstep, voffA);
        if (wr == 1) PG8_BAR;
        PG8_WAIT_V(2); PG8_BAR;
        PG8_STAGE(PG8_SB(1, 0), cB + kstep, voffB); PG8_STAGE(PG8_SA(1, 0), cA + kstep, voffA); PG8_STAGE(PG8_SB(1, 1), cB + hstep + kstep, voffB);
        PG8_WAIT_V(6); PG8_BAR;
    } else {
        PG8_STAGE(PG8_SB(0, 0), cB, voffB); PG8_STAGE(PG8_SA(0, 0), cA, voffA); PG8_STAGE(PG8_SB(0, 1), cB + hstep, voffB); PG8_STAGE(PG8_SA(0, 1), cA + hstep, voffA);
        if (wr == 1) PG8_BAR;
        PG8_WAIT_V(4); PG8_BAR;
        PG8_STAGE(PG8_SB(1, 0), cB + kstep, voffB); PG8_STAGE(PG8_SA(1, 0), cA + kstep, voffA); PG8_STAGE(PG8_SB(1, 1), cB + hstep + kstep, voffB);
        PG8_WAIT_V(6); PG8_BAR;
    }
    for (;;) {
        const bool has_next = S.next(ui + 1, nxt);
        const char* nA = has_next ? (const char*)g.A + (size_t)nxt.pm * tstep : cA; const char* nB = has_next ? (const char*)g.Bt + (size_t)nxt.pn * tstep : cB;
        for (int t = 0; t < nt; t += 2) {
            const bool last = (t == nt - 2);
            const char* a1 = cA + (size_t)(t + 1) * kstep;
            const char* a2 = last ? nA : cA + (size_t)(t + 2) * kstep; const char* b2 = last ? nB : cB + (size_t)(t + 2) * kstep;
            const char* a3 = a2 + kstep; const char* b3 = b2 + kstep;
            if (last && has_next) S.a_ready(nxt);
            if constexpr (SP2) {
            PG8_LDB(B0, 0, 0); PG8_LDB(B1, 0, 1); PG8_SCHED; PG8_LDA(At, 0, 0); PG8_STAGE(PG8_SA(1, 1), a1 + hstep, voffA);
            PG8_WAIT_V(8); PG8_WAIT_L(0); PG8_BAR; PG8_MMA(0, 0, At, B0); PG8_MMA(0, 1, At, B1); PG8_BAR; PG8_SCHED;
            PG8_LDA(At, 0, 1); PG8_STAGE(PG8_SB(0, 0), b2, voffB); PG8_STAGE(PG8_SB(0, 1), b2 + hstep, voffB); PG8_STAGE(PG8_SA(0, 0), a2, voffA);
            PG8_WAIT_V(8); PG8_WAIT_L(0); PG8_BAR; PG8_MMA(1, 0, At, B0); PG8_MMA(1, 1, At, B1); PG8_BAR; PG8_SCHED;
            PG8_LDB(B0, 1, 0); PG8_LDB(B1, 1, 1); PG8_SCHED; PG8_LDA(At, 1, 0); PG8_STAGE(PG8_SA(0, 1), a2 + hstep, voffA);
            PG8_WAIT_V(8); PG8_WAIT_L(0); PG8_BAR; PG8_MMA(0, 0, At, B0); PG8_MMA(0, 1, At, B1); PG8_BAR; PG8_SCHED;
            PG8_LDA(At, 1, 1); PG8_STAGE(PG8_SB(1, 0), b3, voffB); PG8_STAGE(PG8_SB(1, 1), b3 + hstep, voffB); PG8_STAGE(PG8_SA(1, 0), a3, voffA);
            PG8_WAIT_V(8); PG8_WAIT_L(0); PG8_BAR; PG8_MMA(1, 0, At, B0); PG8_MMA(1, 1, At, B1); PG8_BAR; PG8_SCHED;
            } else {
            PG8_LDB(B0, 0, 0); PG8_SCHED; PG8_LDA(At, 0, 0); PG8_STAGE(PG8_SA(1, 1), a1 + hstep, voffA);
            PG8_WAIT_L(8); PG8_BAR; PG8_WAIT_L(0); PG8_MMA(0, 0, At, B0); PG8_BAR; PG8_SCHED;
            PG8_LDB(B1, 0, 1); PG8_STAGE(PG8_SB(0, 0), b2, voffB);
            PG8_BAR; PG8_WAIT_L(0); PG8_MMA(0, 1, At, B1); PG8_BAR;
            PG8_LDA(At, 0, 1); PG8_STAGE(PG8_SA(0, 0), a2, voffA);
            PG8_BAR; PG8_WAIT_L(0); PG8_MMA(1, 0, At, B0); PG8_BAR; PG8_SCHED;
            PG8_STAGE(PG8_SB(0, 1), b2 + hstep, voffB);
            PG8_WAIT_V(6); PG8_BAR; PG8_MMA(1, 1, At, B1); PG8_BAR;
            PG8_LDB(B0, 1, 0); PG8_SCHED; PG8_LDA(At, 1, 0); PG8_STAGE(PG8_SA(0, 1), a2 + hstep, voffA);
            PG8_WAIT_L(8); PG8_BAR; PG8_WAIT_L(0); PG8_MMA(0, 0, At, B0); PG8_BAR; PG8_SCHED;
            PG8_LDB(B1, 1, 1); PG8_STAGE(PG8_SB(1, 0), b3, voffB);
            PG8_BAR; PG8_WAIT_L(0); PG8_MMA(0, 1, At, B1); PG8_BAR;
            PG8_LDA(At, 1, 1); PG8_STAGE(PG8_SA(1, 0), a3, voffA);
            PG8_BAR; PG8_WAIT_L(0); PG8_MMA(1, 0, At, B0); PG8_BAR; PG8_SCHED;
            PG8_STAGE(PG8_SB(1, 1), b3 + hstep, voffB);
            PG8_WAIT_V(6); PG8_BAR; PG8_MMA(1, 1, At, B1); PG8_BAR;
            }
        }
        if constexpr (ALIGN_EPI) { if (wr == 0) PG8_BAR; }
        if constexpr (!Epi::AFTER_DRAIN) { int t2_ = threadIdx.x; asm volatile("" : "+v"(t2_)); const int fr_ = t2_ & 15, fq_ = (t2_ & 63) >> 4;
            E(acc, cur, wr, wc, fr_, fq_); S.done(cur); }
        if (!has_next) break;
#pragma unroll
        for (int a = 0; a < 2; ++a)
#pragma unroll
            for (int b = 0; b < 2; ++b)
#pragma unroll
                for (int m = 0; m < 4; ++m)
#pragma unroll
                    for (int n = 0; n < 2; ++n) acc[a][b][m][n] = (f32x4){0.f, 0.f, 0.f, 0.f};
        cur = nxt; cA = nA; cB = nB; ++ui;
        if constexpr (ALIGN_EPI) { if (wr == 1) PG8_BAR; }
    }
    PG8_WAIT_V(0);
    if constexpr (!ALIGN_EPI) { if (wr == 0) PG8_BAR; }
    PG8_BAR;
    if constexpr (Epi::AFTER_DRAIN) { E.fused(acc, cur, wr, wc, fr, fq, lds, wid, lane); S.done(cur); }
#undef PG8_SA
#undef PG8_SB
#undef PG8_STAGE
#undef PG8_LD8
#undef PG8_LDA
#undef PG8_LDB
#undef PG8_MMA
#undef PG8_WAIT_V
#undef PG8_WAIT_L
#undef PG8_BAR
#undef PG8_SCHED
}
}

#ifndef PROBE_MASK
#define PROBE_MASK 0
#endif
#ifndef EN_INPROJ
#define EN_INPROJ 1
#endif
#ifndef EN_GATE
#define EN_GATE 1
#endif
#ifndef EN_RESID
#define EN_RESID 1
#endif
#ifndef EN_SWIGLU
#define EN_SWIGLU 1
#endif
#ifndef EN_ATTN
#define EN_ATTN 1
#endif
#ifndef EN_PRO
#define EN_PRO 1
#endif
#define LAS __attribute__((address_space(3)))
typedef unsigned short bf16;
typedef short bf16x8 __attribute__((ext_vector_type(8)));
typedef short s16x4 __attribute__((ext_vector_type(4)));
typedef float f32x4 __attribute__((ext_vector_type(4)));
typedef float f32x16 __attribute__((ext_vector_type(16)));
typedef unsigned u32x4 __attribute__((ext_vector_type(4)));
typedef unsigned u32x2 __attribute__((ext_vector_type(2)));

constexpr int T = 32768, TH = 16384, D = 2048, CIN = 10240, DFF = 5632, NUP = 11264, SEQ = 16384;
constexpr int NWAVES = 8, NTHREADS = 512;
constexpr float ALPHA = 1.41421356237309515f;
constexpr float LN_EPS = 1e-5f;
constexpr float LOG2E = 1.4426950408889634f;
constexpr int LDS_BYTES = 163840;
constexpr int NPHASES = 27;

constexpr size_t MiB = (size_t)1 << 20;
constexpr size_t WS_TAB = 0;
constexpr size_t WS_W0 = 1 * MiB, WS_WL = 120 * MiB;
constexpr size_t WO_IN = 0, WO_PA = WO_IN + (size_t)CIN * D, WO_PB = WO_PA + (size_t)D * 512, WO_OUT = WO_PB + (size_t)D * 1024, WO_UP = WO_OUT + (size_t)D * D,
                 WO_DN = WO_UP + (size_t)NUP * D, WO_END = WO_DN + (size_t)D * DFF;
static_assert(WO_END * 2 <= WS_WL, "weight block");
constexpr size_t WS_XB = 241 * MiB;
constexpr size_t WS_PROJ = 369 * MiB;
constexpr size_t WS_AR = 689 * MiB;
constexpr size_t WS_LSE = 737 * MiB;
constexpr size_t WS_AO = 738 * MiB;
constexpr size_t WS_BO = 754 * MiB;
constexpr size_t WS_H = 369 * MiB;
constexpr size_t WS_X8 = 800 * MiB;
constexpr size_t WS_ST = 864 * MiB;
constexpr size_t WS_END = 865 * MiB;

struct Params;
typedef const __attribute__((address_space(4))) Params* PP;
struct Params {
    const float* x; const float* rel_bias; const float* w_in; const float* sink; const float* w_pa; const float* w_pb; const float* w_out;
    const float* ln1_g; const float* ln1_b; const float* w_up; const float* w_down; const float* ln2_g; const float* ln2_b;
    float* out; unsigned char* ws; int ph_lo, ph_hi;
};

__device__ __forceinline__ unsigned pk2(float a, float b) { return pg8::cvt_pk_bf16(a, b); }
__device__ __forceinline__ float shx(float v, int o, int lane) { return __int_as_float(__builtin_amdgcn_ds_bpermute((lane ^ o) << 2, __float_as_int(v))); }
__device__ __forceinline__ float wave_sum(float v, int lane) {
#pragma unroll
    for (int o = 1; o < 64; o <<= 1) v += shx(v, o, lane);
    return v;
}
#define LDS_WAIT() asm volatile("s_waitcnt lgkmcnt(0)" ::: "memory")

__device__ __forceinline__ void transpose_item(const float* __restrict__ W, int K, int N, bf16* WT, int k0, int n0, int row0, LAS float* scr, int lane) {
    { f32x4 tv[8];
#pragma unroll
      for (int i = 0; i < 8; ++i) tv[i] = *(const f32x4*)(W + (size_t)(k0 + 8 * i + (lane >> 3)) * N + n0 + 4 * (lane & 7));
#pragma unroll
      for (int i = 0; i < 8; ++i) { LAS float* d_ = scr + (8 * i + (lane >> 3)) * 33 + 4 * (lane & 7); d_[0] = tv[i][0]; d_[1] = tv[i][1]; d_[2] = tv[i][2]; d_[3] = tv[i][3]; } }
    LDS_WAIT();
    const int c = lane & 7;
#pragma unroll
    for (int j = 0; j < 4; ++j) { const int n = (lane >> 3) + 8 * j; const LAS float* s = scr + (8 * c) * 33 + n;
        u32x4 o; o.x = pk2(s[0 * 33], s[1 * 33]); o.y = pk2(s[2 * 33], s[3 * 33]); o.z = pk2(s[4 * 33], s[5 * 33]); o.w = pk2(s[6 * 33], s[7 * 33]);
        *(u32x4*)(WT + (size_t)(row0 + n) * K + k0 + 8 * c) = o; }
    LDS_WAIT();
}
using pg8::pk4_fp8;
__device__ __forceinline__ void transpose_item_fp8(const float* __restrict__ W, int K, int N, unsigned char* WT, int k0, int n0, LAS float* scr, int lane, float scale) {
    { f32x4 tv[8];
#pragma unroll
      for (int i = 0; i < 8; ++i) tv[i] = *(const f32x4*)(W + (size_t)(k0 + 8 * i + (lane >> 3)) * N + n0 + 4 * (lane & 7));
#pragma unroll
      for (int i = 0; i < 8; ++i) { LAS float* d_ = scr + (8 * i + (lane >> 3)) * 33 + 4 * (lane & 7); d_[0] = tv[i][0]; d_[1] = tv[i][1]; d_[2] = tv[i][2]; d_[3] = tv[i][3]; } }
    LDS_WAIT();
    const int n = lane >> 1, kh = lane & 1; const LAS float* sp = scr + (32 * kh) * 33 + n;
    u32x4 o0, o1;
    o0.x = pk4_fp8(sp[0 * 33] * scale, sp[1 * 33] * scale, sp[2 * 33] * scale, sp[3 * 33] * scale); o0.y = pk4_fp8(sp[4 * 33] * scale, sp[5 * 33] * scale, sp[6 * 33] * scale, sp[7 * 33] * scale);
    o0.z = pk4_fp8(sp[8 * 33] * scale, sp[9 * 33] * scale, sp[10 * 33] * scale, sp[11 * 33] * scale); o0.w = pk4_fp8(sp[12 * 33] * scale, sp[13 * 33] * scale, sp[14 * 33] * scale, sp[15 * 33] * scale);
    o1.x = pk4_fp8(sp[16 * 33] * scale, sp[17 * 33] * scale, sp[18 * 33] * scale, sp[19 * 33] * scale); o1.y = pk4_fp8(sp[20 * 33] * scale, sp[21 * 33] * scale, sp[22 * 33] * scale, sp[23 * 33] * scale);
    o1.z = pk4_fp8(sp[24 * 33] * scale, sp[25 * 33] * scale, sp[26 * 33] * scale, sp[27 * 33] * scale); o1.w = pk4_fp8(sp[28 * 33] * scale, sp[29 * 33] * scale, sp[30 * 33] * scale, sp[31 * 33] * scale);
    unsigned char* dst = WT + (size_t)(n0 + n) * K + k0 + 32 * kh;
    *(u32x4*)dst = o0; *(u32x4*)(dst + 16) = o1;
    LDS_WAIT();
}
__device__ __forceinline__ int t5_bucket(int rel) {
    const int n = rel < 0 ? -rel : rel; int b;
    if (n < 8) b = n; else { const int e = (int)(__builtin_log2f((float)n * 0.125f) * (8.0f / 7.0f)); b = 8 + e; if (b > 15) b = 15; }
    return b + (rel > 0 ? 16 : 0);
}
__device__ __forceinline__ void phase_prologue(PP pp, LAS unsigned char* lds, int gw, int NGW, int wave, int lane) {
    LAS float* scr = (LAS float*)(lds + wave * 16384);
    constexpr int I_IN = (D / 64) * (CIN / 32), I_PA = (512 / 64) * (D / 32), I_PB = (1024 / 64) * (D / 32), I_OUT = (D / 64) * (D / 32), I_UP = (D / 64) * (NUP / 32), I_DN = (DFF / 64) * (D / 32);
    constexpr int I_LAYER = I_IN + I_PA + I_PB + I_OUT + I_UP + I_DN;
    for (int it = gw; it < 2 * I_LAYER; it += NGW) {
        const int l = it / I_LAYER; int r = it - l * I_LAYER;
        bf16* wl = (bf16*)(pp->ws + WS_W0 + (size_t)l * WS_WL);
        const float* W; int K, N; bf16* WT; bool up = false, r0_in = false;
        if (r < I_IN) { W = pp->w_in + (size_t)l * D * CIN; K = D; N = CIN; WT = wl + WO_IN; r0_in = true; }
        else if ((r -= I_IN) < I_PA) { r0_in = true; W = pp->w_pa + (size_t)l * 512 * D; K = 512; N = D; WT = wl + WO_PA; }
        else if ((r -= I_PA) < I_PB) { r0_in = true; W = pp->w_pb + (size_t)l * 1024 * D; K = 1024; N = D; WT = wl + WO_PB; }
        else if ((r -= I_PB) < I_OUT) { r0_in = true; W = pp->w_out + (size_t)l * D * D; K = D; N = D; WT = wl + WO_OUT; }
        else if ((r -= I_OUT) < I_UP) { W = pp->w_up + (size_t)l * D * NUP; K = D; N = NUP; WT = wl + WO_UP; up = true; }
        else { r -= I_UP; W = pp->w_down + (size_t)l * DFF * D; K = DFF; N = D; WT = wl + WO_DN; }
        const int nblk = N / 32, kb = r / nblk, nb = r - kb * nblk, n0 = 32 * nb;
        int row0 = n0;
        if (up) { const int j0 = n0 < DFF ? n0 : n0 - DFF; row0 = (j0 >> 7) * 256 + (n0 < DFF ? 0 : 128) + (j0 & 127); }
        if (r0_in) transpose_item_fp8(W, K, N, (unsigned char*)WT, 64 * kb, n0, scr, lane, 128.0f);
        else transpose_item(W, K, N, WT, 64 * kb, n0, row0, scr, lane);
    }
    { const size_t gt = (size_t)gw * 64 + lane, NT = (size_t)NGW * 64; unsigned char* x8 = pp->ws + WS_X8;
      for (size_t i = gt; i < (size_t)T * D / 16; i += NT) { const f32x4 a = *(const f32x4*)(pp->x + i * 16) * 32.f, b = *(const f32x4*)(pp->x + i * 16 + 4) * 32.f, c = *(const f32x4*)(pp->x + i * 16 + 8) * 32.f, d = *(const f32x4*)(pp->x + i * 16 + 12) * 32.f;
          u32x4 o; o.x = pk4_fp8(a[0], a[1], a[2], a[3]); o.y = pk4_fp8(b[0], b[1], b[2], b[3]); o.z = pk4_fp8(c[0], c[1], c[2], c[3]); o.w = pk4_fp8(d[0], d[1], d[2], d[3]); *(u32x4*)(x8 + i * 16) = o; } }
    { float* tabA = (float*)(pp->ws + WS_TAB); float* tabB = (float*)(pp->ws + WS_TAB + 8192);
      const int gt = gw * 64 + lane;
      if (gt < 12 * 129) { const int hh = gt / 129, i = gt - hh * 129, g = hh >> 2, dil = g == 0 ? 1 : (g == 1 ? 4 : 16); tabA[hh * 132 + i] = pp->rel_bias[t5_bucket((i - 64) * dil) * 20 + hh] * LOG2E; }
      else if (gt < 12 * 129 + 8 * 257) { const int q = gt - 12 * 129, hh = q / 257, i = q - hh * 257; tabB[hh * 260 + i] = pp->rel_bias[t5_bucket(i - 128) * 20 + 12 + hh] * LOG2E; } }
}

constexpr int AT_KS = 0, AT_VS = 8704, AT_TAB = 8704 + 10240, AT_WAVE_BYTES = 8704 + 10240 + 1296;
static_assert(AT_WAVE_BYTES * NWAVES <= LDS_BYTES, "attention LDS");
#define TR4(r0, r1, r2, r3, base, o0, o1, o2, o3) asm volatile("ds_read_b64_tr_b16 %0, %4 offset:%5\n\tds_read_b64_tr_b16 %1, %4 offset:%6\n\tds_read_b64_tr_b16 %2, %4 offset:%7\n\tds_read_b64_tr_b16 %3, %4 offset:%8\n\ts_waitcnt lgkmcnt(0)" \
    : "=&v"(r0), "=&v"(r1), "=&v"(r2), "=&v"(r3) : "v"(base), "i"(o0), "i"(o1), "i"(o2), "i"(o3) : "memory")
#define PK8(L, Hh) (bf16x8){L[0], L[1], L[2], L[3], Hh[0], Hh[1], Hh[2], Hh[3]}

__device__ __forceinline__ void attn_item(LAS unsigned char* wl, int lane, const bf16* __restrict__ P, int qcol, int kcol, int vcol, int r, int dil, int sub_len, int q0, int W, int nkt,
                                          const float* __restrict__ tab, float m_init, float l_init, bf16* O, int o_ld, int ocol, float* lse, int lse_idx, bool o8) {
    const int hl = lane >> 5, ql = lane & 31;
    LAS float* tabs = (LAS float*)(wl + AT_TAB);
    { float tv[6];
#pragma unroll
      for (int u = 0; u < 6; ++u) { const int src = lane + 64 * u - 32; const int sc_ = src < 0 ? 0 : (src > 2 * W ? 2 * W : src); tv[u] = tab[sc_]; }
#pragma unroll
      for (int u = 0; u < 6; ++u) { const int i = lane + 64 * u, src = i - 32; if (i < 2 * W + 65) tabs[i] = (src >= 0 && src <= 2 * W) ? tv[u] : -__builtin_inff(); } }
    bf16x8 qf[8];
    { const bf16* qp = P + (size_t)(r + (q0 + ql) * dil) * CIN + qcol + 8 * hl;
#pragma unroll
      for (int s = 0; s < 8; ++s) qf[s] = *(const bf16x8*)(qp + 16 * s); }
    u32x4 kreg[8], vreg[8];
    const int lrow = lane >> 4, lch = lane & 15;
    const char* Pk = (const char*)(P + kcol); const char* Pv = (const char*)(P + vcol);
    const unsigned rstride = 4u * (unsigned)dil * (unsigned)(CIN * 2);
#define AT_EDGE(kt_) ((q0 - W + 32 * (kt_) < 0) || (q0 - W + 32 * (kt_) + 31 >= sub_len))
#define AT_ROFF(kt_, jj) ({ int sub = q0 - W + 32 * (kt_) + 4 * (jj) + lrow; sub = sub < 0 ? 0 : (sub >= sub_len ? sub_len - 1 : sub); (unsigned)(r + sub * dil) * (unsigned)(CIN * 2) + 16u * lch; })
#define AT_LOADX(dst, Pb, kt) do { const int kt_ = (kt) < nkt ? (kt) : nkt - 1; \
        if (AT_EDGE(kt_)) { _Pragma("unroll") for (int jj = 0; jj < 8; ++jj) dst[jj] = *(const u32x4*)(Pb + AT_ROFF(kt_, jj)); } \
        else { const unsigned off0 = (unsigned)(r + (q0 - W + 32 * kt_ + lrow) * dil) * (unsigned)(CIN * 2) + 16u * lch; \
               _Pragma("unroll") for (int jj = 0; jj < 8; ++jj) { const char* pb_ = Pb + (size_t)jj * rstride; dst[jj] = *(const u32x4*)(pb_ + off0); } } } while (0)
#define AT_LOADK(kt) AT_LOADX(kreg, Pk, kt)
#define AT_LOADV(kt) AT_LOADX(vreg, Pv, kt)
    AT_LOADK(0); AT_LOADV(0);
    f32x16 o0, o1, o2, o3;
#pragma unroll
    for (int i = 0; i < 16; ++i) { o0[i] = 0.f; o1[i] = 0.f; o2[i] = 0.f; o3[i] = 0.f; }
    float m = m_init, l = l_init;
    const float c = 0.08838834764831845f * LOG2E;
    const unsigned vb = (unsigned)(uintptr_t)(wl + AT_VS) + (unsigned)((4 * hl + ((lane & 15) >> 2)) * 320 + (16 * ((lane >> 4) & 1) + 4 * (lane & 3)) * 2);
    const LAS unsigned char* kb = wl + AT_KS + ql * 272 + 16 * hl;
    for (int kt = 0; kt < nkt; ++kt) {
#pragma unroll
        for (int jj = 0; jj < 8; ++jj) *(LAS u32x4*)(wl + AT_KS + (4 * jj + lrow) * 272 + 16 * lch) = kreg[jj];
        AT_LOADK(kt + 1);
        f32x16 sc;
#pragma unroll
        for (int i = 0; i < 16; ++i) sc[i] = 0.f;
#pragma unroll
        for (int s = 0; s < 8; ++s) { const bf16x8 kf = *(const LAS bf16x8*)(kb + 32 * s); sc = __builtin_amdgcn_mfma_f32_32x32x16_bf16(kf, qf[s], sc, 0, 0, 0); }
        const LAS float* tb = tabs + (32 * kt - ql + 4 * hl + 32);
        float tmax = -__builtin_inff();
#pragma unroll
        for (int i = 0; i < 16; ++i) { sc[i] = fmaf(sc[i], c, tb[8 * (i >> 2) + (i & 3)]); }
        if (AT_EDGE(kt)) {
            const int ks0 = q0 - W + 32 * kt + 4 * hl;
#pragma unroll
            for (int i = 0; i < 16; ++i) { const int ks = ks0 + 8 * (i >> 2) + (i & 3); if (ks < 0 || ks >= sub_len) sc[i] = -__builtin_inff(); }
        }
#pragma unroll
        for (int i = 0; i < 16; ++i) tmax = fmaxf(tmax, sc[i]);
        tmax = fmaxf(tmax, shx(tmax, 32, lane));
        if (__builtin_amdgcn_ballot_w64(tmax > m + 8.0f) != 0ull) {
            const float mn = fmaxf(m, tmax), alpha = __builtin_amdgcn_exp2f(m - mn); m = mn; l *= alpha;
#pragma unroll
            for (int i = 0; i < 16; ++i) { o0[i] *= alpha; o1[i] *= alpha; o2[i] *= alpha; o3[i] *= alpha; }
        }
        float ps = 0.f;
#pragma unroll
        for (int i = 0; i < 16; ++i) { sc[i] = __builtin_amdgcn_exp2f(sc[i] - m); ps += sc[i]; }
        l += ps;
        bf16x8 p0, p1;
        { u32x4 w0, w1; w0.x = pk2(sc[0], sc[1]); w0.y = pk2(sc[2], sc[3]); w0.z = pk2(sc[4], sc[5]); w0.w = pk2(sc[6], sc[7]);
          w1.x = pk2(sc[8], sc[9]); w1.y = pk2(sc[10], sc[11]); w1.z = pk2(sc[12], sc[13]); w1.w = pk2(sc[14], sc[15]);
          p0 = *reinterpret_cast<bf16x8*>(&w0); p1 = *reinterpret_cast<bf16x8*>(&w1); }
#pragma unroll
        for (int jj = 0; jj < 8; ++jj) *(LAS u32x4*)(wl + AT_VS + (4 * jj + lrow) * 320 + 16 * lch) = vreg[jj];
        AT_LOADV(kt + 1);
        { s16x4 a0, a1, b0, b1;
          TR4(a0, a1, b0, b1, vb, 0, 2560, 5120, 7680); __builtin_amdgcn_sched_barrier(0);
          o0 = __builtin_amdgcn_mfma_f32_32x32x16_bf16(PK8(a0, a1), p0, o0, 0, 0, 0); o0 = __builtin_amdgcn_mfma_f32_32x32x16_bf16(PK8(b0, b1), p1, o0, 0, 0, 0);
          TR4(a0, a1, b0, b1, vb, 64, 64 + 2560, 64 + 5120, 64 + 7680); __builtin_amdgcn_sched_barrier(0);
          o1 = __builtin_amdgcn_mfma_f32_32x32x16_bf16(PK8(a0, a1), p0, o1, 0, 0, 0); o1 = __builtin_amdgcn_mfma_f32_32x32x16_bf16(PK8(b0, b1), p1, o1, 0, 0, 0);
          TR4(a0, a1, b0, b1, vb, 128, 128 + 2560, 128 + 5120, 128 + 7680); __builtin_amdgcn_sched_barrier(0);
          o2 = __builtin_amdgcn_mfma_f32_32x32x16_bf16(PK8(a0, a1), p0, o2, 0, 0, 0); o2 = __builtin_amdgcn_mfma_f32_32x32x16_bf16(PK8(b0, b1), p1, o2, 0, 0, 0);
          TR4(a0, a1, b0, b1, vb, 192, 192 + 2560, 192 + 5120, 192 + 7680); __builtin_amdgcn_sched_barrier(0);
          o3 = __builtin_amdgcn_mfma_f32_32x32x16_bf16(PK8(a0, a1), p0, o3, 0, 0, 0); o3 = __builtin_amdgcn_mfma_f32_32x32x16_bf16(PK8(b0, b1), p1, o3, 0, 0, 0); }
    }
#undef AT_LOADK
#undef AT_LOADV
#undef AT_LOADX
#undef AT_ROFF
#undef AT_EDGE
    const float lt = l + shx(l, 32, lane), inv = 1.0f / lt;
    const size_t tok = (size_t)(r + (q0 + ql) * dil);
    if (o8) {
        unsigned char* op = (unsigned char*)O + tok * o_ld + ocol + 4 * hl; const float i64 = inv * 64.f;
#pragma unroll
        for (int g = 0; g < 4; ++g) {
            *(unsigned*)(op + 8 * g) = pk4_fp8(o0[4 * g] * i64, o0[4 * g + 1] * i64, o0[4 * g + 2] * i64, o0[4 * g + 3] * i64);
            *(unsigned*)(op + 32 + 8 * g) = pk4_fp8(o1[4 * g] * i64, o1[4 * g + 1] * i64, o1[4 * g + 2] * i64, o1[4 * g + 3] * i64);
            *(unsigned*)(op + 64 + 8 * g) = pk4_fp8(o2[4 * g] * i64, o2[4 * g + 1] * i64, o2[4 * g + 2] * i64, o2[4 * g + 3] * i64);
            *(unsigned*)(op + 96 + 8 * g) = pk4_fp8(o3[4 * g] * i64, o3[4 * g + 1] * i64, o3[4 * g + 2] * i64, o3[4 * g + 3] * i64);
        }
    } else {
    bf16* op = O + tok * o_ld + ocol + 4 * hl;
#pragma unroll
    for (int g = 0; g < 4; ++g) {
        u32x2 w;
        w.x = pk2(o0[4 * g] * inv, o0[4 * g + 1] * inv); w.y = pk2(o0[4 * g + 2] * inv, o0[4 * g + 3] * inv); *(u32x2*)(op + 8 * g) = w;
        w.x = pk2(o1[4 * g] * inv, o1[4 * g + 1] * inv); w.y = pk2(o1[4 * g + 2] * inv, o1[4 * g + 3] * inv); *(u32x2*)(op + 32 + 8 * g) = w;
        w.x = pk2(o2[4 * g] * inv, o2[4 * g + 1] * inv); w.y = pk2(o2[4 * g + 2] * inv, o2[4 * g + 3] * inv); *(u32x2*)(op + 64 + 8 * g) = w;
        w.x = pk2(o3[4 * g] * inv, o3[4 * g + 1] * inv); w.y = pk2(o3[4 * g + 2] * inv, o3[4 * g + 3] * inv); *(u32x2*)(op + 96 + 8 * g) = w;
    }
    }
    if (lse && hl == 0) lse[tok * 12 + lse_idx] = m + __builtin_log2f(lt);
    LDS_WAIT();
}

__device__ __forceinline__ void phase_attention(unsigned char* ws, const float* sinkp, LAS unsigned char* lds, int layer, int gw, int NGW, int wave, int lane) {
    LAS unsigned char* wl = lds + wave * AT_WAVE_BYTES;
    const bf16* P = (const bf16*)(ws + WS_PROJ);
    const float* tabA = (const float*)(ws + WS_TAB); const float* tabB = (const float*)(ws + WS_TAB + 8192);
    constexpr int NA = 12 * 512, NB = 8 * 512;
    for (int it = gw; it < NA + NB; it += NGW) {
        int qcol, kcol, vcol, r, dil, q0, W, nkt, o_ld, ocol, lse_idx; const float* tab; float m0, l0; bf16* O; float* lse;
        if (it < NA) {
            const int g = it >> 11, rem = it & 2047, h = rem >> 9, qt = rem & 511, hh = g * 4 + h;
            dil = g == 0 ? 1 : (g == 1 ? 4 : 16); const int tpr = 512 / dil; r = qt / tpr; q0 = (qt - r * tpr) * 32;
            qcol = hh * 128; kcol = 1536 + hh * 128; vcol = 3072 + hh * 128; W = 64; nkt = 5; tab = tabA + hh * 132; m0 = -1e30f; l0 = 0.f;
            O = (bf16*)(ws + WS_AR); o_ld = 1536; ocol = hh * 128; lse = (float*)(ws + WS_LSE); lse_idx = hh;
        } else {
            const int j = it - NA, rep = j & 3, qt = (j >> 2) & 511, kvh = j >> 11, qh = kvh * 4 + rep;
            dil = 1; r = 0; q0 = qt * 32; qcol = 4608 + qh * 128; kcol = 5632 + kvh * 128; vcol = 5888 + kvh * 128; W = 128; nkt = 9; tab = tabB + qh * 260;
            m0 = sinkp[layer * 8 + qh] * LOG2E; l0 = (lane < 32) ? 1.f : 0.f;
            O = (bf16*)(ws + WS_BO); o_ld = 1024; ocol = qh * 128; lse = nullptr; lse_idx = 0;
        }
        attn_item(wl, lane, P, qcol, kcol, vcol, r, dil, SEQ / dil, q0, W, nkt, tab, m0, l0, O, o_ld, ocol, lse, lse_idx, it >= NA);
    }
}

__device__ __forceinline__ void phase_amerge(unsigned char* ws, int gw, int NGW, int lane) {
    const bf16* AR = (const bf16*)(ws + WS_AR); const float* LSE = (const float*)(ws + WS_LSE); unsigned char* AO8 = ws + WS_AO;
    const size_t gt = (size_t)gw * 64 + lane, NT = (size_t)NGW * 64;
    for (size_t i = gt; i < (size_t)TH * 64; i += NT) {
        const size_t t = i >> 6; const int ch = (int)(i & 63), h = ch >> 4, dc = ch & 15;
        const float l0 = LSE[t * 12 + h], l1 = LSE[t * 12 + 4 + h], l2 = LSE[t * 12 + 8 + h];
        const float mx = fmaxf(l0, fmaxf(l1, l2));
        float w0 = __builtin_amdgcn_exp2f(l0 - mx), w1 = __builtin_amdgcn_exp2f(l1 - mx), w2 = __builtin_amdgcn_exp2f(l2 - mx);
        const float inv = 1.0f / (w0 + w1 + w2); w0 *= inv; w1 *= inv; w2 *= inv;
        const bf16* ap = AR + t * 1536 + h * 128 + dc * 8;
        const u32x4 a = *(const u32x4*)ap, b = *(const u32x4*)(ap + 512), cc = *(const u32x4*)(ap + 1024);
        w0 *= 64.f; w1 *= 64.f; w2 *= 64.f;
        u32x2 o;
        o.x = pk4_fp8(w0 * pg8::bf_lo(a.x) + w1 * pg8::bf_lo(b.x) + w2 * pg8::bf_lo(cc.x), w0 * pg8::bf_hi(a.x) + w1 * pg8::bf_hi(b.x) + w2 * pg8::bf_hi(cc.x),
                      w0 * pg8::bf_lo(a.y) + w1 * pg8::bf_lo(b.y) + w2 * pg8::bf_lo(cc.y), w0 * pg8::bf_hi(a.y) + w1 * pg8::bf_hi(b.y) + w2 * pg8::bf_hi(cc.y));
        o.y = pk4_fp8(w0 * pg8::bf_lo(a.z) + w1 * pg8::bf_lo(b.z) + w2 * pg8::bf_lo(cc.z), w0 * pg8::bf_hi(a.z) + w1 * pg8::bf_hi(b.z) + w2 * pg8::bf_hi(cc.z),
                      w0 * pg8::bf_lo(a.w) + w1 * pg8::bf_lo(b.w) + w2 * pg8::bf_lo(cc.w), w0 * pg8::bf_hi(a.w) + w1 * pg8::bf_hi(b.w) + w2 * pg8::bf_hi(cc.w));
        *(u32x2*)(AO8 + t * 512 + h * 128 + dc * 8) = o;
    }
}

__device__ __forceinline__ void phase_ln(float* Y, bf16* XB, unsigned char* X8, float* st, bool inplace, const float* __restrict__ gam, const float* __restrict__ bet, int gw, int NGW, int lane) {
    for (int row = gw; row < T; row += NGW) {
        f32x4* yr = (f32x4*)(Y + (size_t)row * D) + lane;
        f32x4 v[8]; float s = 0.f;
#pragma unroll
        for (int j = 0; j < 8; ++j) { v[j] = yr[64 * j]; s += (v[j][0] + v[j][1]) + (v[j][2] + v[j][3]); }
        const float mean = wave_sum(s, lane) * (1.f / D); float s2 = 0.f;
#pragma unroll
        for (int j = 0; j < 8; ++j) { v[j] = v[j] - mean; s2 += (v[j][0] * v[j][0] + v[j][1] * v[j][1]) + (v[j][2] * v[j][2] + v[j][3] * v[j][3]); }
        const float rstd = 1.0f / sqrtf(wave_sum(s2, lane) * (1.f / D) + LN_EPS);
        if (st && lane == 0) { st[2 * (size_t)row] = mean; st[2 * (size_t)row + 1] = rstd; }
#pragma unroll
        for (int j = 0; j < 8; ++j) { const f32x4 gg = *((const f32x4*)gam + lane + 64 * j), bb = *((const f32x4*)bet + lane + 64 * j);
            const f32x4 o = v[j] * rstd * gg + bb;
            if (inplace) yr[64 * j] = o;
            if (XB) { u32x2 w; w.x = pk2(o[0], o[1]); w.y = pk2(o[2], o[3]); *((u32x2*)(XB + (size_t)row * D) + lane + 64 * j) = w; }
            if (X8) *((unsigned*)(X8 + (size_t)row * D) + lane + 64 * j) = pk4_fp8(o[0] * 32.f, o[1] * 32.f, o[2] * 32.f, o[3] * 32.f); }
    }
}

__global__ void __launch_bounds__(NTHREADS, 2) fwd_mega(Params p_arg) {
    extern __shared__ __attribute__((aligned(16))) unsigned char lds_raw[];
    LAS unsigned char* lds = (LAS unsigned char*)lds_raw;
    const int ph_lo = p_arg.ph_lo, ph_hi = p_arg.ph_hi;
    for (int ph = ph_lo; ph < ph_hi; ++ph) {
      for (int rep = 0; rep < 2; ++rep) {
        if (ph > ph_lo || rep > 0) cg::this_grid().sync();
#if defined(__HIP_DEVICE_COMPILE__)
        PP p = (PP)__builtin_amdgcn_kernarg_segment_ptr(); asm volatile("" : "+s"(p));
#else
        PP p = (PP)(uintptr_t)0; (void)p_arg;
#endif
        int tid_ = threadIdx.x, bx_ = blockIdx.x; asm volatile("" : "+v"(tid_), "+s"(bx_));
        const int tid = tid_, lane = tid & 63, wave = __builtin_amdgcn_readfirstlane(tid >> 6);
        const int G = gridDim.x, bx = bx_, vcu = (G % 8 == 0) ? (bx % 8) * (G / 8) + bx / 8 : bx;
        const int gw = vcu * NWAVES + wave, NGW = G * NWAVES;
        unsigned char* ws = p->ws; bf16* XB = (bf16*)(ws + WS_XB);
        if (ph == 0) {
#if EN_PRO
 phase_prologue(p, lds, gw, NGW, wave, lane);
#endif
 if (rep == 0 && (PROBE_MASK & 1)) continue; else break; }
        const int q = ph - 1, layer = q / 13, s = q - layer * 13;
        const bf16* wl = (const bf16*)(ws + WS_W0 + (size_t)layer * WS_WL);
        const bool dbl = (s < 8 && (s & 3) == 1 && (PROBE_MASK & 2)) || (s < 8 && (s & 3) == 2 && (PROBE_MASK & 4)) || ((s == 9 || (s == 12 && layer == 0)) && (PROBE_MASK & 8)) || (s < 8 && (s & 3) == 0 && (PROBE_MASK & 16)) || (s == 10 && (PROBE_MASK & 32)) || (s < 8 && (s & 3) == 3 && (PROBE_MASK & 64));
        if (s < 8) {
            const int half = s >> 2, sub = s & 3;
            if (sub == 0) {
                pg8::Gemm g{(const bf16*)(ws + WS_X8 + (size_t)half * TH * D), wl + WO_IN, TH, CIN, D / 2}; pg8::StaticOrder S; S.init(TH, CIN, G, bx);
                pg8::EpiBf16<0> E{(bf16*)(ws + WS_PROJ), CIN, nullptr, 0, 0, 1.f};

#if EN_INPROJ
 pg8::gemm_phase<pg8::EpiBf16<0>, pg8::StaticOrder, true, true, true>(lds, g, S, E);
#endif

            } else if (sub == 1) {
#if EN_ATTN
 phase_attention(ws, p->sink, lds, layer, gw, NGW, wave, lane);
#endif

            } else if (sub == 2) { phase_amerge(ws, gw, NGW, lane);
            } else {
                for (int k = 0; k < 2; ++k) {
                    pg8::Gemm g{k == 0 ? (const bf16*)(ws + WS_AO) : (const bf16*)(ws + WS_BO), wl + (k == 0 ? WO_PA : WO_PB), TH, D, k == 0 ? 256 : 512, 0x79797979, 0x78787878};
                    pg8::StaticOrder S; S.init(TH, D, G, bx);
                    pg8::EpiGate E{(bf16*)(ws + WS_XB + 64 * MiB), ws + WS_XB + (size_t)half * TH * D, D, (const bf16*)(ws + WS_PROJ) + (k == 0 ? 6144 : 8192), CIN, k, 512.f};

#if EN_GATE
 pg8::gemm_phase<pg8::EpiGate, pg8::StaticOrder, true, true, true>(lds, g, S, E);
#endif

                }
            }
        } else if (s == 8 || s == 11) {
            const bool dn = (s == 11);
            pg8::StaticOrder S; S.init(T, D, G, bx);
            const bool raw = (!dn && layer == 0);
            pg8::EpiResid E{(pg8::ArgV)p, raw ? 0 : -1, dn ? 7 : 11, dn ? 8 : 12, D, ALPHA, (size_t)(dn ? layer : (layer > 0 ? layer - 1 : 0)) * D, WS_ST};
#if EN_RESID
            if (dn) { pg8::Gemm g{(const bf16*)(ws + WS_H), wl + WO_DN, T, D, DFF}; pg8::gemm_phase<pg8::EpiResid, pg8::StaticOrder, true, true>(lds, g, S, E); }
            else { pg8::Gemm g{(const bf16*)(ws + WS_XB), wl + WO_OUT, T, D, D / 2, 0x76767676, 0x78787878}; pg8::gemm_phase<pg8::EpiResid, pg8::StaticOrder, true, true, true>(lds, g, S, E); }
#endif
        } else if (s == 9) { phase_ln(p->out, XB, nullptr, (float*)(ws + WS_ST), false, p->ln1_g + layer * D, p->ln1_b + layer * D, gw, NGW, lane);
        } else if (s == 10) {
            pg8::Gemm g{XB, wl + WO_UP, T, NUP, D}; pg8::StaticOrder S; S.init(T, NUP, G, bx);
            pg8::EpiSwiglu E{(bf16*)(ws + WS_H), DFF};

#if EN_SWIGLU
 pg8::gemm_phase<pg8::EpiSwiglu, pg8::StaticOrder, true, true>(lds, g, S, E);
#endif

        } else { phase_ln(p->out, nullptr, (layer == 1) ? nullptr : ws + WS_X8, (layer == 1) ? nullptr : (float*)(ws + WS_ST), layer == 1, p->ln2_g + layer * D, p->ln2_b + layer * D, gw, NGW, lane); }
        if (!(rep == 0 && dbl)) break;
      }
    }
}

#ifndef MK_PER_PHASE
#define MK_PER_PHASE 0
#endif
extern "C" void kernel_launch(void* const* d_in, const int* in_sizes, int n_in, void* d_out, int out_size, void* d_ws, size_t ws_size, hipStream_t stream) {
    static int grid = 0;
    if (grid == 0) {
        if (n_in != 13 || ws_size < WS_END) { fprintf(stderr, "kernel_launch: unexpected inputs (n_in %d, ws %zu)\n", n_in, ws_size); grid = -1; return; }
        int dev = 0, cus = 0;
        if (hipGetDevice(&dev) != hipSuccess || hipDeviceGetAttribute(&cus, hipDeviceAttributeMultiprocessorCount, dev) != hipSuccess) { grid = -1; return; }
        if (hipFuncSetAttribute((const void*)fwd_mega, hipFuncAttributeMaxDynamicSharedMemorySize, LDS_BYTES) != hipSuccess) { fprintf(stderr, "kernel_launch: hipFuncSetAttribute failed\n"); grid = -1; return; }
        (void)hipGetLastError();
        grid = cus;
    }
    if (grid < 0) return;
    Params p{};
    p.x = (const float*)d_in[0]; p.rel_bias = (const float*)d_in[1]; p.w_in = (const float*)d_in[2]; p.sink = (const float*)d_in[3]; p.w_pa = (const float*)d_in[4]; p.w_pb = (const float*)d_in[5];
    p.w_out = (const float*)d_in[6]; p.ln1_g = (const float*)d_in[7]; p.ln1_b = (const float*)d_in[8]; p.w_up = (const float*)d_in[9]; p.w_down = (const float*)d_in[10];
    p.ln2_g = (const float*)d_in[11]; p.ln2_b = (const float*)d_in[12]; p.out = (float*)d_out; p.ws = (unsigned char*)d_ws;
#if MK_PER_PHASE
    for (int ph = 0; ph < NPHASES; ++ph) { p.ph_lo = ph; p.ph_hi = ph + 1; hipLaunchKernelGGL(fwd_mega, dim3(grid), dim3(NTHREADS), LDS_BYTES, stream, p); }
#else
    p.ph_lo = 0; p.ph_hi = NPHASES;
    void* args[] = {&p};
    hipError_t e = hipLaunchCooperativeKernel((const void*)fwd_mega, dim3(grid), dim3(NTHREADS), args, LDS_BYTES, stream);
    if (e != hipSuccess) fprintf(stderr, "kernel_launch: cooperative launch failed: %s (grid %d)\n", hipGetErrorString(e), grid);
#endif
}
```

```cpp
#include <hip/hip_runtime.h>
#include <hip/hip_cooperative_groups.h>
#include <cstdio>
#include <cstdint>
namespace cg = cooperative_groups;
namespace pg8 {
#define PG8_LAS __attribute__((address_space(3)))
typedef unsigned short bf16_t;
typedef short bf16x8 __attribute__((ext_vector_type(8)));
typedef float f32x4 __attribute__((ext_vector_type(4)));
typedef unsigned u32x4 __attribute__((ext_vector_type(4)));
typedef unsigned u32x2 __attribute__((ext_vector_type(2)));
typedef int v8i32 __attribute__((ext_vector_type(8)));
typedef int v4i32 __attribute__((ext_vector_type(4)));
constexpr int FP8_SCALE_X = 0x79797979, FP8_SCALE_W = 0x79797979;
constexpr int BM = 256, BK = 64, HALF = 128, HTB = HALF * BK * 2  , STAGE_BYTES = 8 * HTB, NXCD = 8, WGM = 8;

__host__ __device__ __forceinline__ int lds_byte(int r, int c) { const int st = (r >> 4) * 2 + (c >> 5), rr = r & 15, cc = c & 31, ob = rr * 64 + cc * 2; return st * 1024 + (ob ^ (((ob >> 9) & 1) << 5)); }
__host__ __device__ __forceinline__ void stage_rc(int b, int& R, int& C) { const int st = b / 1024, sb = b % 1024, swz = sb ^ (((sb >> 9) & 1) << 5); R = (st >> 1) * 16 + swz / 64; C = (st & 1) * 32 + (swz % 64) / 2; }
__host__ __device__ __forceinline__ int perm32(int rho) { const int n = rho >> 4, i = rho & 15; return 8 * (i >> 2) + 4 * n + (i & 3); }

struct Unit { int pm, pn; };
struct Gemm { const bf16_t* A; const bf16_t* Bt; int M, N, K; int sx = 0x79797979, sw = 0x79797979; };

struct StaticOrder {
    int nM, nN, nwg, G, c;
    __host__ __device__ void init(int M, int N, int G_, int c_) { nM = M / BM; nN = N / BM; nwg = nM * nN; G = G_; c = c_; }
    __host__ __device__ bool next(int i, Unit& u) const {
        const long L = (long)i * G + c; if (L >= nwg) return false;
        int wgid = (int)L; { const int q = nwg / NXCD, r = nwg % NXCD, xcd = wgid % NXCD, off = wgid / NXCD; wgid = (xcd < r ? xcd * (q + 1) : r * (q + 1) + (xcd - r) * q) + off; }
        const int nig = WGM * nN, gid = wgid / nig, fm = gid * WGM, gsz = (nM - fm) < WGM ? (nM - fm) : WGM;
        u.pm = fm + ((wgid % nig) % gsz); u.pn = (wgid % nig) / gsz; return true;
    }
    __device__ __forceinline__ void a_ready(const Unit&) const {}
    __device__ __forceinline__ void done(const Unit&) const {}
};

__device__ __forceinline__ unsigned cvt_pk_bf16(float lo, float hi) { unsigned r; asm("v_cvt_pk_bf16_f32 %0, %1, %2" : "=v"(r) : "v"(lo), "v"(hi)); return r; }
typedef float f32x2 __attribute__((ext_vector_type(2)));
template <int ACT  > struct EpiBf16 {
    static constexpr bool PERM = true, AFTER_DRAIN = false; static_assert(ACT == 0 || ACT == 1, "EpiBf16: ACT is 0 (none) or 1 (gelu_pk)");
    bf16_t* O; int ldc; const float* bias; int split_cols; size_t split_stride; float scale0;
    __device__ __forceinline__ void operator()(const f32x4 (&acc)[2][2][4][2], const Unit& u, int wr, int wc, int fr, int fq) const {
        const int row0 = u.pm * BM + wr * 64 + fr; int colt = u.pn * BM; bf16_t* base = O;
        float sc = 1.f; if (split_cols) { const int t = colt / split_cols; base += (size_t)t * split_stride; colt -= t * split_cols; if (t == 0) sc = scale0; }
        const int col0 = colt + wc * 32 + 8 * fq, bcol0 = u.pn * BM + wc * 32 + 8 * fq;
        f32x4 bv[2][2];
#pragma unroll
        for (int bj = 0; bj < 2; ++bj)
#pragma unroll
            for (int n = 0; n < 2; ++n) bv[bj][n] = bias ? *(const f32x4*)(bias + bcol0 + bj * HALF + 4 * n) : (f32x4){0.f, 0.f, 0.f, 0.f};
#pragma unroll
        for (int ai = 0; ai < 2; ++ai)
#pragma unroll
            for (int m = 0; m < 4; ++m) { bf16_t* rowp = base + (size_t)(row0 + ai * HALF + m * 16) * ldc + col0;
#pragma unroll
                for (int bj = 0; bj < 2; ++bj) { f32x4 v0 = acc[ai][bj][m][0] + bv[bj][0], v1 = acc[ai][bj][m][1] + bv[bj][1];
                    v0 = v0 * sc; v1 = v1 * sc; u32x4 w; w.x = cvt_pk_bf16(v0[0], v0[1]); w.y = cvt_pk_bf16(v0[2], v0[3]); w.z = cvt_pk_bf16(v1[0], v1[1]); w.w = cvt_pk_bf16(v1[2], v1[3]);
                    *(u32x4*)(rowp + bj * HALF) = w; } }
    }
};
__device__ __forceinline__ float sigmoidf_fast(float x) { return __builtin_amdgcn_rcpf(1.0f + __builtin_amdgcn_exp2f(-1.4426950408889634f * x)); }
__device__ __forceinline__ float bf_lo(unsigned w) { return __uint_as_float(w << 16); }
__device__ __forceinline__ float bf_hi(unsigned w) { return __uint_as_float(w & 0xffff0000u); }
__device__ __forceinline__ float clamp448(float v) { return __builtin_fminf(__builtin_fmaxf(v, -448.f), 448.f); }
__device__ __forceinline__ unsigned pk4_fp8(float a, float b, float c, float d) { unsigned w = 0; w = __builtin_amdgcn_cvt_pk_fp8_f32(clamp448(a), clamp448(b), w, false); w = __builtin_amdgcn_cvt_pk_fp8_f32(clamp448(c), clamp448(d), w, true); return w; }
struct EpiGate {
    static constexpr bool PERM = true, AFTER_DRAIN = false;
    bf16_t* Tm; unsigned char* O8; int ldo; const bf16_t* G; int ldg; int add; float oscale;
    __device__ __forceinline__ void operator()(const f32x4 (&acc)[2][2][4][2], const Unit& u, int wr, int wc, int fr, int fq) const {
        const int row0 = u.pm * BM + wr * 64 + fr, col0 = u.pn * BM + wc * 32 + 8 * fq;
#pragma unroll
        for (int ai = 0; ai < 2; ++ai)
#pragma unroll
            for (int m = 0; m < 4; ++m) { const size_t r = (size_t)(row0 + ai * HALF + m * 16); bf16_t* rowp = Tm + r * ldo + col0; const bf16_t* gp = G + r * ldg + col0;
#pragma unroll
                for (int bj = 0; bj < 2; ++bj) { const u32x4 gw = *(const u32x4*)(gp + bj * HALF); f32x4 v0 = acc[ai][bj][m][0], v1 = acc[ai][bj][m][1];
                    v0[0] *= sigmoidf_fast(bf_lo(gw.x)); v0[1] *= sigmoidf_fast(bf_hi(gw.x)); v0[2] *= sigmoidf_fast(bf_lo(gw.y)); v0[3] *= sigmoidf_fast(bf_hi(gw.y));
                    v1[0] *= sigmoidf_fast(bf_lo(gw.z)); v1[1] *= sigmoidf_fast(bf_hi(gw.z)); v1[2] *= sigmoidf_fast(bf_lo(gw.w)); v1[3] *= sigmoidf_fast(bf_hi(gw.w));
                    if (add) { const u32x4 pw = *(const u32x4*)(rowp + bj * HALF);
                        v0[0] += bf_lo(pw.x); v0[1] += bf_hi(pw.x); v0[2] += bf_lo(pw.y); v0[3] += bf_hi(pw.y); v1[0] += bf_lo(pw.z); v1[1] += bf_hi(pw.z); v1[2] += bf_lo(pw.w); v1[3] += bf_hi(pw.w);
                        v0 = v0 * oscale; v1 = v1 * oscale; u32x2 w8; w8.x = pk4_fp8(v0[0], v0[1], v0[2], v0[3]); w8.y = pk4_fp8(v1[0], v1[1], v1[2], v1[3]);
                        *(u32x2*)(O8 + r * ldo + col0 + bj * HALF) = w8; }
                    else { u32x4 w; w.x = cvt_pk_bf16(v0[0], v0[1]); w.y = cvt_pk_bf16(v0[2], v0[3]); w.z = cvt_pk_bf16(v1[0], v1[1]); w.w = cvt_pk_bf16(v1[2], v1[3]);
                        *(u32x4*)(rowp + bj * HALF) = w; } } }
    }
};
typedef void* vptr_t; typedef const __attribute__((address_space(4))) vptr_t* ArgV;
struct EpiResid {
    static constexpr bool PERM = false, AFTER_DRAIN = false;
    ArgV args; int xi, gi, bi; int ldc; float alpha; size_t goff; size_t st_off;
    __device__ __forceinline__ void operator()(const f32x4 (&acc)[2][2][4][2], const Unit& u, int wr, int wc, int fr, int fq) const {
        ArgV a_ = args; asm volatile("" : "+s"(a_));
        float* Y = (float*)a_[13]; const float* X = xi >= 0 ? (const float*)a_[xi] : (const float*)Y;
        const float* st = xi >= 0 ? nullptr : (const float*)((const unsigned char*)a_[14] + st_off);
        const float* g = (const float*)a_[gi < 0 ? 0 : gi] + goff; const float* b = (const float*)a_[bi < 0 ? 0 : bi] + goff;
        const int row0 = u.pm * BM + wr * 64 + fr, col0 = u.pn * BM + wc * 32 + 4 * fq;
#pragma unroll
        for (int ai = 0; ai < 2; ++ai)
#pragma unroll
            for (int m = 0; m < 4; ++m) { const int r = row0 + ai * HALF + m * 16; const size_t off = (size_t)r * ldc + col0;
                float mean = 0.f, rstd = 1.f; if (st) { const f32x2 sv = *(const f32x2*)(st + 2 * (size_t)r); mean = sv.x; rstd = sv.y; }
#pragma unroll
                for (int bj = 0; bj < 2; ++bj)
#pragma unroll
                    for (int n = 0; n < 2; ++n) { f32x4 xv = *(const f32x4*)(X + off + bj * HALF + n * 16);
                        if (st) { const f32x4 gv = *(const f32x4*)(g + col0 + bj * HALF + n * 16), bv = *(const f32x4*)(b + col0 + bj * HALF + n * 16); xv = (xv - mean) * rstd * gv + bv; }
                        *(f32x4*)(Y + off + bj * HALF + n * 16) = xv * alpha + acc[ai][bj][m][n]; }
                asm volatile("" ::: "memory"); }
    }
};
struct EpiSwiglu {
    static constexpr bool PERM = true, AFTER_DRAIN = false;
    bf16_t* Hh; int ldh;
    __device__ __forceinline__ void operator()(const f32x4 (&acc)[2][2][4][2], const Unit& u, int wr, int wc, int fr, int fq) const {
        const int row0 = u.pm * BM + wr * 64 + fr, col0 = u.pn * HALF + wc * 32 + 8 * fq;
#pragma unroll
        for (int ai = 0; ai < 2; ++ai)
#pragma unroll
            for (int m = 0; m < 4; ++m) { bf16_t* rowp = Hh + (size_t)(row0 + ai * HALF + m * 16) * ldh + col0; float hv[8];
#pragma unroll
                for (int n = 0; n < 2; ++n)
#pragma unroll
                    for (int j = 0; j < 4; ++j) { const float g = acc[ai][0][m][n][j], up = acc[ai][1][m][n][j]; hv[n * 4 + j] = g * sigmoidf_fast(g) * up; }
                u32x4 w; w.x = cvt_pk_bf16(hv[0], hv[1]); w.y = cvt_pk_bf16(hv[2], hv[3]); w.z = cvt_pk_bf16(hv[4], hv[5]); w.w = cvt_pk_bf16(hv[6], hv[7]);
                *(u32x4*)rowp = w; }
    }
};
template <class Epi, class Sched, bool ALIGN_EPI = false, bool SP2 = false, bool FP8 = false>
__device__ __forceinline__ void gemm_phase(PG8_LAS unsigned char* lds, const Gemm g, const Sched& S, const Epi& E) {
    int tid_ = threadIdx.x; asm volatile("" : "+v"(tid_));
    const int tid = tid_, wid = __builtin_amdgcn_readfirstlane(tid >> 6), lane = tid & 63, wr = wid >> 2, wc = wid & 3, fr = lane & 15, fq = lane >> 4;
    const int K = g.K, nt = K / BK;
    unsigned voffA[2], voffB[2];
#pragma unroll
    for (int i = 0; i < 2; ++i) { int R, C; stage_rc(tid * 16 + i * 8192, R, C); const int Rb = Epi::PERM ? ((R & ~31) + perm32(R & 31)) : R;
        voffA[i] = (unsigned)(R * K + C) * 2u; voffB[i] = (unsigned)(Rb * K + C) * 2u; }
    const size_t r64step = (size_t)64 * K * 2;
    const size_t kstep = (size_t)(BK * 2);
    const size_t hstep = (size_t)HALF * K * 2;
    const size_t tstep = 2 * hstep;
    const unsigned ldsw = (unsigned)wid * 1024u;
    const int aoff = FP8 ? lds_byte(wr * 64 + fr, (fq >> 1) * 32 + (fq & 1) * 16) : lds_byte(wr * 64 + fr, fq * 8), boff = FP8 ? lds_byte(wc * 32 + fr, (fq >> 1) * 32 + (fq & 1) * 16) : lds_byte(wc * 32 + fr, fq * 8);
#define PG8_SA(b, h) (((b) * 2 + (h)) * HTB)
#define PG8_SB(b, h) ((4 + (b) * 2 + (h)) * HTB)
#define PG8_STAGE(bufoff, gbase, voff) do { _Pragma("unroll") for (int _i = 0; _i < 2; ++_i) { const char* _gb = (const char*)(gbase) + (size_t)_i * r64step; asm volatile("" : "+s"(_gb));     \
        __builtin_amdgcn_global_load_lds((const unsigned*)(_gb + (voff)[0]), (PG8_LAS unsigned*)(lds + (bufoff) + ldsw + _i * 8192), 16, 0, 0); } } while (0)
#define PG8_LD8(p_) __builtin_shufflevector(*(const PG8_LAS v4i32*)(p_), *(const PG8_LAS v4i32*)((p_) + 16), 0, 1, 2, 3, 4, 5, 6, 7)
#define PG8_LDA(dst, b, h) do { if constexpr (FP8) { _Pragma("unroll") for (int m = 0; m < 4; ++m) dst##8[m] = PG8_LD8(lds + PG8_SA(b, h) + aoff + m * 2048); } \
        else { _Pragma("unroll") for (int m = 0; m < 4; ++m) _Pragma("unroll") for (int k = 0; k < 2; ++k) dst[m][k] = *(const PG8_LAS bf16x8*)(lds + PG8_SA(b, h) + aoff + m * 2048 + k * 1024); } } while (0)
#define PG8_LDB(dst, b, h) do { if constexpr (FP8) { _Pragma("unroll") for (int n = 0; n < 2; ++n) dst##8[n] = PG8_LD8(lds + PG8_SB(b, h) + boff + n * 2048); } \
        else { _Pragma("unroll") for (int n = 0; n < 2; ++n) _Pragma("unroll") for (int k = 0; k < 2; ++k) dst[n][k] = *(const PG8_LAS bf16x8*)(lds + PG8_SB(b, h) + boff + n * 2048 + k * 1024); } } while (0)
#define PG8_MMA(ai, bj, At, Bt) do { __builtin_amdgcn_s_setprio(1); if constexpr (FP8) { _Pragma("unroll") for (int m = 0; m < 4; ++m) _Pragma("unroll") for (int n = 0; n < 2; ++n) \
            acc[ai][bj][m][n] = __builtin_amdgcn_mfma_scale_f32_16x16x128_f8f6f4(Bt##8[n], At##8[m], acc[ai][bj][m][n], 0, 0, 0, g.sw, 0, g.sx); } \
        else { _Pragma("unroll") for (int m = 0; m < 4; ++m) _Pragma("unroll") for (int n = 0; n < 2; ++n) _Pragma("unroll") for (int k = 0; k < 2; ++k) \
        acc[ai][bj][m][n] = __builtin_amdgcn_mfma_f32_16x16x32_bf16(Bt[n][k], At[m][k], acc[ai][bj][m][n], 0, 0, 0); } __builtin_amdgcn_s_setprio(0); } while (0)
#define PG8_WAIT_V(n) asm volatile("s_waitcnt vmcnt(" #n ")" ::: "memory")
#define PG8_WAIT_L(n) asm volatile("s_waitcnt lgkmcnt(" #n ")" ::: "memory")
#define PG8_BAR __builtin_amdgcn_s_barrier()
#define PG8_SCHED __builtin_amdgcn_sched_barrier(0)
    Unit cur, nxt; int ui = 0;
    if (!S.next(0, cur)) return;
    f32x4 acc[2][2][4][2];
#pragma unroll
    for (int a = 0; a < 2; ++a)
#pragma unroll
        for (int b = 0; b < 2; ++b)
#pragma unroll
            for (int m = 0; m < 4; ++m)
#pragma unroll
                for (int n = 0; n < 2; ++n) acc[a][b][m][n] = (f32x4){0.f, 0.f, 0.f, 0.f};
    bf16x8 At[4][2], B0[2][2], B1[2][2]; v8i32 At8[4], B08[2], B18[2];
    const char* cA = (const char*)g.A + (size_t)cur.pm * tstep; const char* cB = (const char*)g.Bt + (size_t)cur.pn * tstep;
    S.a_ready(cur);
    if constexpr (SP2) {
        PG8_STAGE(PG8_SB(0, 0), cB, voffB); PG8_STAGE(PG8_SB(0, 1), cB + hstep, voffB); PG8_STAGE(PG8_SA(0, 0), cA, voffA); PG8_STAGE(PG8_SA(0, 1), cA + hstep, voffA);
        if (wr == 1) PG8_BAR;
        PG8_WAIT_V(2); PG8_BAR;
        PG8_STAGE(PG8_SB(1, 0), cB + kstep, voffB); PG8_STAGE(PG8_SA(1, 0), cA + kstep, voffA); PG8_STAGE(PG8_SB(1, 1), cB + hstep + kstep, voffB);
        PG8_WAIT_V(6); PG8_BAR;
    } else {
        PG8_STAGE(PG8_SB(0, 0), cB, voffB); PG8_STAGE(PG8_SA(0, 0), cA, voffA); PG8_STAGE(PG8_SB(0, 1), cB + hstep, voffB); PG8_STAGE(PG8_SA(0, 1), cA + hstep, voffA);
        if (wr == 1) PG8_BAR;
        PG8_WAIT_V(4); PG8_BAR;
        PG8_STAGE(PG8_SB(1, 0), cB + kstep, voffB); PG8_STAGE(PG8_SA(1, 0), cA + kstep, voffA); PG8_STAGE(PG8_SB(1, 1), cB + hstep + kstep, voffB);
        PG8_WAIT_V(6); PG8_BAR;
    }
    for (;;) {
        const bool has_next = S.next(ui + 1, nxt);
        const char* nA = has_next ? (const char*)g.A + (size_t)nxt.pm * tstep : cA; const char* nB = has_next ? (const char*)g.Bt + (size_t)nxt.pn * tstep : cB;
        for (int t = 0; t < nt; t += 2) {
            const bool last = (t == nt - 2);
            const char* a1 = cA + (size_t)(t + 1) * kstep;
            const char* a2 = last ? nA : cA + (size_t)(t + 2) * kstep; const char* b2 = last ? nB : cB + (size_t)(t + 2) * kstep;
            const char* a3 = a2 + kstep; const char* b3 = b2 + kstep;
            if (last && has_next) S.a_ready(nxt);
            if constexpr (SP2) {
            PG8_LDB(B0, 0, 0); PG8_LDB(B1, 0, 1); PG8_SCHED; PG8_LDA(At, 0, 0); PG8_STAGE(PG8_SA(1, 1), a1 + hstep, voffA);
            PG8_WAIT_V(8); PG8_WAIT_L(0); PG8_BAR; PG8_MMA(0, 0, At, B0); PG8_MMA(0, 1, At, B1); PG8_BAR; PG8_SCHED;
            PG8_LDA(At, 0, 1); PG8_STAGE(PG8_SB(0, 0), b2, voffB); PG8_STAGE(PG8_SB(0, 1), b2 + hstep, voffB); PG8_STAGE(PG8_SA(0, 0), a2, voffA);
            PG8_WAIT_V(8); PG8_WAIT_L(0); PG8_BAR; PG8_MMA(1, 0, At, B0); PG8_MMA(1, 1, At, B1); PG8_BAR; PG8_SCHED;
            PG8_LDB(B0, 1, 0); PG8_LDB(B1, 1, 1); PG8_SCHED; PG8_LDA(At, 1, 0); PG8_STAGE(PG8_SA(0, 1), a2 + hstep, voffA);
            PG8_WAIT_V(8); PG8_WAIT_L(0); PG8_BAR; PG8_MMA(0, 0, At, B0); PG8_MMA(0, 1, At, B1); PG8_BAR; PG8_SCHED;
            PG8_LDA(At, 1, 1); PG8_STAGE(PG8_SB(1, 0), b3, voffB); PG8_STAGE(PG8_SB(1, 1), b3 + hstep, voffB); PG8_STAGE(PG8_SA(1, 0), a3, voffA);
            PG8_WAIT_V(8); PG8_WAIT_L(0); PG8_BAR; PG8_MMA(1, 0, At, B0); PG8_MMA(1, 1, At, B1); PG8_BAR; PG8_SCHED;
            } else {
            PG8_LDB(B0, 0, 0); PG8_SCHED; PG8_LDA(At, 0, 0); PG8_STAGE(PG8_SA(1, 1), a1 + hstep, voffA);
            PG8_WAIT_L(8); PG8_BAR; PG8_WAIT_L(0); PG8_MMA(0, 0, At, B0); PG8_BAR; PG8_SCHED;
            PG8_LDB(B1, 0, 1); PG8_STAGE(PG8_SB(0, 0), b2, voffB);
            PG8_BAR; PG8_WAIT_L(0); PG8_MMA(0, 1, At, B1); PG8_BAR;
            PG8_LDA(At, 0, 1); PG8_STAGE(PG8_SA(0, 0), a2, voffA);
            PG8_BAR; PG8_WAIT_L(0); PG8_MMA(1, 0, At, B0); PG8_BAR; PG8_SCHED;
            PG8_STAGE(PG8_SB(0, 1), b2 + hstep, voffB);
            PG8_WAIT_V(6); PG8_BAR; PG8_MMA(1, 1, At, B1); PG8_BAR;
            PG8_LDB(B0, 1, 0); PG8_SCHED; PG8_LDA(At, 1, 0); PG8_STAGE(PG8_SA(0, 1), a2 + hstep, voffA);
            PG8_WAIT_L(8); PG8_BAR; PG8_WAIT_L(0); PG8_MMA(0, 0, At, B0); PG8_BAR; PG8_SCHED;
            PG8_LDB(B1, 1, 1); PG8_STAGE(PG8_SB(1, 0), b3, voffB);
            PG8_BAR; PG8_WAIT_L(0); PG8_MMA(0, 1, At, B1); PG8_BAR;
            PG8_LDA(At, 1, 1); PG8_STAGE(PG8_SA(1, 0), a3, voffA);
            PG8_BAR; PG8_WAIT_L(0); PG8_MMA(1, 0, At, B0); PG8_BAR; PG8_SCHED;
            PG8_STAGE(PG8_SB(1, 1), b3 + hstep, voffB);
            PG8_WAIT_V(6); PG8_BAR; PG8_MMA(1, 1, At, B1); PG8_BAR;
            }
        }
        if constexpr (ALIGN_EPI) { if (wr == 0) PG8_BAR; }
        if constexpr (!Epi::AFTER_DRAIN) { int t2_ = threadIdx.x; asm volatile("" : "+v"(t2_)); const int fr_ = t2_ & 15, fq_ = (t2_ & 63) >> 4;
            E(acc, cur, wr, wc, fr_, fq_); S.done(cur); }
        if (!has_next) break;
#pragma unroll
        for (int a = 0; a < 2; ++a)
#pragma unroll
            for (int b = 0; b < 2; ++b)
#pragma unroll
                for (int m = 0; m < 4; ++m)
#pragma unroll
                    for (int n = 0; n < 2; ++n) acc[a][b][m][n] = (f32x4){0.f, 0.f, 0.f, 0.f};
        cur = nxt; cA = nA; cB = nB; ++ui;
        if constexpr (ALIGN_EPI) { if (wr == 1) PG8_BAR; }
    }
    PG8_WAIT_V(0);
    if constexpr (!ALIGN_EPI) { if (wr == 0) PG8_BAR; }
    PG8_BAR;
    if constexpr (Epi::AFTER_DRAIN) { E.fused(acc, cur, wr, wc, fr, fq, lds, wid, lane); S.done(cur); }
#undef PG8_SA
#undef PG8_SB
#undef PG8_STAGE
#undef PG8_LD8
#undef PG8_LDA
#undef PG8_LDB
#undef PG8_MMA
#undef PG8_WAIT_V
#undef PG8_WAIT_L
#undef PG8_BAR
#undef PG8_SCHED
}
}

#ifndef PROBE_MASK
#define PROBE_MASK 0
#endif
#ifndef EN_INPROJ
#define EN_INPROJ 1
#endif
#ifndef EN_GATE
#define EN_GATE 1
#endif
#ifndef EN_RESID
#define EN_RESID 1
#endif
#ifndef EN_SWIGLU
#define EN_SWIGLU 1
#endif
#ifndef EN_ATTN
#define EN_ATTN 1
#endif
#ifndef EN_PRO
#define EN_PRO 1
#endif
#define LAS __attribute__((address_space(3)))
typedef unsigned short bf16;
typedef short bf16x8 __attribute__((ext_vector_type(8)));
typedef short s16x4 __attribute__((ext_vector_type(4)));
typedef float f32x4 __attribute__((ext_vector_type(4)));
typedef float f32x16 __attribute__((ext_vector_type(16)));
typedef unsigned u32x4 __attribute__((ext_vector_type(4)));
typedef unsigned u32x2 __attribute__((ext_vector_type(2)));

constexpr int T = 32768, TH = 16384, D = 2048, CIN = 10240, DFF = 5632, NUP = 11264, SEQ = 16384;
constexpr int NWAVES = 8, NTHREADS = 512;
constexpr float ALPHA = 1.41421356237309515f;
constexpr float LN_EPS = 1e-5f;
constexpr float LOG2E = 1.4426950408889634f;
constexpr int LDS_BYTES = 163840, LDS_BARST = 163824;
constexpr int NPHASES = 27;

constexpr size_t MiB = (size_t)1 << 20;
constexpr size_t WS_TAB = 0;
constexpr size_t WS_BAR = 256 * 1024;
constexpr size_t WS_W0 = 1 * MiB, WS_WL = 120 * MiB;
constexpr size_t WO_IN = 0, WO_PA = WO_IN + (size_t)CIN * D, WO_PB = WO_PA + (size_t)D * 512, WO_OUT = WO_PB + (size_t)D * 1024, WO_UP = WO_OUT + (size_t)D * D,
                 WO_DN = WO_UP + (size_t)NUP * D, WO_END = WO_DN + (size_t)D * DFF;
static_assert(WO_END * 2 <= WS_WL, "weight block");
constexpr size_t WS_XB = 241 * MiB;
constexpr size_t WS_PROJ = 369 * MiB;
constexpr size_t WS_AR = 689 * MiB;
constexpr size_t WS_LSE = 737 * MiB;
constexpr size_t WS_AO = 738 * MiB;
constexpr size_t WS_BO = 754 * MiB;
constexpr size_t WS_H = 369 * MiB;
constexpr size_t WS_X8 = 800 * MiB;
constexpr size_t WS_ST = 864 * MiB;
constexpr size_t WS_END = 865 * MiB;

struct Params;
typedef const __attribute__((address_space(4))) Params* PP;
struct Params {
    const float* x; const float* rel_bias; const float* w_in; const float* sink; const float* w_pa; const float* w_pb; const float* w_out;
    const float* ln1_g; const float* ln1_b; const float* w_up; const float* w_down; const float* ln2_g; const float* ln2_b;
    float* out; unsigned char* ws; int ph_lo, ph_hi;
};

__device__ __forceinline__ unsigned pk2(float a, float b) { return pg8::cvt_pk_bf16(a, b); }
__device__ __forceinline__ float shx(float v, int o, int lane) { return __int_as_float(__builtin_amdgcn_ds_bpermute((lane ^ o) << 2, __float_as_int(v))); }
__device__ __forceinline__ float wave_sum(float v, int lane) {
#pragma unroll
    for (int o = 1; o < 64; o <<= 1) v += shx(v, o, lane);
    return v;
}
#define LDS_WAIT() asm volatile("s_waitcnt lgkmcnt(0)" ::: "memory")

#define XB_TMO      128
#define XB_XCNT(j)  (256  + 64 * (j))
#define XB_XSUB(j)  (1280 + 64 * (j))
#define XB_XGEN(j)  (2304 + 64 * (j))
#define XB_TOP      3328
#define XB_TOPGEN   3392
#define XCD_BAR_WORDS 3456
#define XB_SPIN_CAP (1u << 18)

__device__ __forceinline__ unsigned xb_ld(unsigned* p)              { return __hip_atomic_load(p, __ATOMIC_RELAXED, __HIP_MEMORY_SCOPE_AGENT); }
__device__ __forceinline__ unsigned xb_add(unsigned* p, unsigned v) { return __hip_atomic_fetch_add(p, v, __ATOMIC_RELAXED, __HIP_MEMORY_SCOPE_AGENT); }
__device__ __forceinline__ unsigned xb_xcc_id() { return (unsigned)__builtin_amdgcn_s_getreg((3 << 11) | 20) & 0xFu; }
#define XB_SPIN(cond, bar) do { unsigned _sp = 0; while (cond) { __builtin_amdgcn_s_sleep(1); \
    if ((++_sp & 255u) == 0u) { if (xb_ld(&(bar)[XB_TMO])) break; if (_sp > XB_SPIN_CAP) { atomicAdd(&(bar)[XB_TMO], 1u); break; } } } } while (0)

struct XcdBarrier {
    unsigned* bar; unsigned x;
    volatile LAS unsigned* st;
};

__device__ __forceinline__ XcdBarrier xcd_barrier_post(unsigned* bar, volatile LAS unsigned* st) {
    XcdBarrier b; b.bar = bar; b.x = xb_xcc_id(); b.st = st;
    if (threadIdx.x == 0) (void)xb_add(&bar[XB_XCNT(b.x)], 1u);
    return b;
}
__device__ __forceinline__ void xcd_barrier_complete(unsigned* bar, unsigned x, unsigned& nloc, unsigned& nx) {
    const unsigned G = gridDim.x * gridDim.y * gridDim.z;
    unsigned sum, cnt, mine, sp = 0u;
    for (;;) {
        sum = 0u; cnt = 0u; mine = 0u;
#pragma unroll
        for (unsigned j = 0; j < 16; ++j) { const unsigned c = xb_ld(&bar[XB_XCNT(j)]); sum += c; cnt += (c > 0u) ? 1u : 0u; mine = (j == x) ? c : mine; }
        if (sum == G) break;
        __builtin_amdgcn_s_sleep(1);
        if ((++sp & 255u) == 0u) { if (xb_ld(&bar[XB_TMO])) break; if (sp > XB_SPIN_CAP) { atomicAdd(&bar[XB_TMO], 1u); break; } }
    }
    nloc = mine > 0u ? mine : 1u; nx = cnt > 0u ? cnt : 1u;
}

__device__ __forceinline__ void xcd_barrier(const XcdBarrier& b) {
    asm volatile("s_waitcnt vmcnt(0)" ::: "memory");
    __syncthreads();
    if (threadIdx.x == 0) {
        unsigned* bar = b.bar;
        __builtin_amdgcn_s_waitcnt(0);
        unsigned nloc = b.st[0], nx = b.st[1];
        if (nloc == 0u) { xcd_barrier_complete(bar, b.x, nloc, nx); b.st[0] = nloc; b.st[1] = nx; }
        const unsigned old = xb_add(&bar[XB_XSUB(b.x)], 1u);
        const unsigned gen = old / nloc;
        if (old + 1u == (gen + 1u) * nloc) {
            __builtin_amdgcn_fence(__ATOMIC_RELEASE, "agent");
            asm volatile("s_waitcnt vmcnt(0)" ::: "memory");
            const unsigned og = xb_add(&bar[XB_TOP], 1u);
            const unsigned tg = og / nx;
            if (og + 1u == (tg + 1u) * nx) xb_add(&bar[XB_TOPGEN], 1u);
            else XB_SPIN(xb_ld(&bar[XB_TOPGEN]) == tg, bar);
            __builtin_amdgcn_fence(__ATOMIC_ACQUIRE, "agent");
            xb_add(&bar[XB_XGEN(b.x)], 1u);
            asm volatile("s_waitcnt vmcnt(0)" ::: "memory");
        } else {
            XB_SPIN(xb_ld(&bar[XB_XGEN(b.x)]) == gen, bar);
            __builtin_amdgcn_fence(__ATOMIC_ACQUIRE, "agent");
            asm volatile("s_waitcnt vmcnt(0)" ::: "memory");
        }
    }
    __syncthreads();
}


__device__ __forceinline__ void transpose_item(const float* __restrict__ W, int K, int N, bf16* WT, int k0, int n0, int row0, LAS float* scr, int lane) {
    { f32x4 tv[8];
#pragma unroll
      for (int i = 0; i < 8; ++i) tv[i] = *(const f32x4*)(W + (size_t)(k0 + 8 * i + (lane >> 3)) * N + n0 + 4 * (lane & 7));
#pragma unroll
      for (int i = 0; i < 8; ++i) { LAS float* d_ = scr + (8 * i + (lane >> 3)) * 33 + 4 * (lane & 7); d_[0] = tv[i][0]; d_[1] = tv[i][1]; d_[2] = tv[i][2]; d_[3] = tv[i][3]; } }
    LDS_WAIT();
    const int c = lane & 7;
#pragma unroll
    for (int j = 0; j < 4; ++j) { const int n = (lane >> 3) + 8 * j; const LAS float* s = scr + (8 * c) * 33 + n;
        u32x4 o; o.x = pk2(s[0 * 33], s[1 * 33]); o.y = pk2(s[2 * 33], s[3 * 33]); o.z = pk2(s[4 * 33], s[5 * 33]); o.w = pk2(s[6 * 33], s[7 * 33]);
        *(u32x4*)(WT + (size_t)(row0 + n) * K + k0 + 8 * c) = o; }
    LDS_WAIT();
}
using pg8::pk4_fp8;
__device__ __forceinline__ void transpose_item_fp8(const float* __restrict__ W, int K, int N, unsigned char* WT, int k0, int n0, LAS float* scr, int lane, float scale) {
    { f32x4 tv[8];
#pragma unroll
      for (int i = 0; i < 8; ++i) tv[i] = *(const f32x4*)(W + (size_t)(k0 + 8 * i + (lane >> 3)) * N + n0 + 4 * (lane & 7));
#pragma unroll
      for (int i = 0; i < 8; ++i) { LAS float* d_ = scr + (8 * i + (lane >> 3)) * 33 + 4 * (lane & 7); d_[0] = tv[i][0]; d_[1] = tv[i][1]; d_[2] = tv[i][2]; d_[3] = tv[i][3]; } }
    LDS_WAIT();
    const int n = lane >> 1, kh = lane & 1; const LAS float* sp = scr + (32 * kh) * 33 + n;
    u32x4 o0, o1;
    o0.x = pk4_fp8(sp[0 * 33] * scale, sp[1 * 33] * scale, sp[2 * 33] * scale, sp[3 * 33] * scale); o0.y = pk4_fp8(sp[4 * 33] * scale, sp[5 * 33] * scale, sp[6 * 33] * scale, sp[7 * 33] * scale);
    o0.z = pk4_fp8(sp[8 * 33] * scale, sp[9 * 33] * scale, sp[10 * 33] * scale, sp[11 * 33] * scale); o0.w = pk4_fp8(sp[12 * 33] * scale, sp[13 * 33] * scale, sp[14 * 33] * scale, sp[15 * 33] * scale);
    o1.x = pk4_fp8(sp[16 * 33] * scale, sp[17 * 33] * scale, sp[18 * 33] * scale, sp[19 * 33] * scale); o1.y = pk4_fp8(sp[20 * 33] * scale, sp[21 * 33] * scale, sp[22 * 33] * scale, sp[23 * 33] * scale);
    o1.z = pk4_fp8(sp[24 * 33] * scale, sp[25 * 33] * scale, sp[26 * 33] * scale, sp[27 * 33] * scale); o1.w = pk4_fp8(sp[28 * 33] * scale, sp[29 * 33] * scale, sp[30 * 33] * scale, sp[31 * 33] * scale);
    unsigned char* dst = WT + (size_t)(n0 + n) * K + k0 + 32 * kh;
    *(u32x4*)dst = o0; *(u32x4*)(dst + 16) = o1;
    LDS_WAIT();
}
__device__ __forceinline__ int t5_bucket(int rel) {
    const int n = rel < 0 ? -rel : rel; int b;
    if (n < 8) b = n; else { const int e = (int)(__builtin_log2f((float)n * 0.125f) * (8.0f / 7.0f)); b = 8 + e; if (b > 15) b = 15; }
    return b + (rel > 0 ? 16 : 0);
}
__device__ __forceinline__ void phase_prologue(PP pp, LAS unsigned char* lds, int gw, int NGW, int wave, int lane) {
    LAS float* scr = (LAS float*)(lds + wave * 16384);
    constexpr int I_IN = (D / 64) * (CIN / 32), I_PA = (512 / 64) * (D / 32), I_PB = (1024 / 64) * (D / 32), I_OUT = (D / 64) * (D / 32), I_UP = (D / 64) * (NUP / 32), I_DN = (DFF / 64) * (D / 32);
    constexpr int I_LAYER = I_IN + I_PA + I_PB + I_OUT + I_UP + I_DN;
    for (int it = gw; it < 2 * I_LAYER; it += NGW) {
        const int l = it / I_LAYER; int r = it - l * I_LAYER;
        bf16* wl = (bf16*)(pp->ws + WS_W0 + (size_t)l * WS_WL);
        const float* W; int K, N; bf16* WT; bool up = false, r0_in = false;
        if (r < I_IN) { W = pp->w_in + (size_t)l * D * CIN; K = D; N = CIN; WT = wl + WO_IN; r0_in = true; }
        else if ((r -= I_IN) < I_PA) { r0_in = true; W = pp->w_pa + (size_t)l * 512 * D; K = 512; N = D; WT = wl + WO_PA; }
        else if ((r -= I_PA) < I_PB) { r0_in = true; W = pp->w_pb + (size_t)l * 1024 * D; K = 1024; N = D; WT = wl + WO_PB; }
        else if ((r -= I_PB) < I_OUT) { r0_in = true; W = pp->w_out + (size_t)l * D * D; K = D; N = D; WT = wl + WO_OUT; }
        else if ((r -= I_OUT) < I_UP) { W = pp->w_up + (size_t)l * D * NUP; K = D; N = NUP; WT = wl + WO_UP; up = true; }
        else { r -= I_UP; W = pp->w_down + (size_t)l * DFF * D; K = DFF; N = D; WT = wl + WO_DN; }
        const int nblk = N / 32, kb = r / nblk, nb = r - kb * nblk, n0 = 32 * nb;
        int row0 = n0;
        if (up) { const int j0 = n0 < DFF ? n0 : n0 - DFF; row0 = (j0 >> 7) * 256 + (n0 < DFF ? 0 : 128) + (j0 & 127); }
        if (r0_in) transpose_item_fp8(W, K, N, (unsigned char*)WT, 64 * kb, n0, scr, lane, 128.0f);
        else transpose_item(W, K, N, WT, 64 * kb, n0, row0, scr, lane);
    }
    { const size_t gt = (size_t)gw * 64 + lane, NT = (size_t)NGW * 64; unsigned char* x8 = pp->ws + WS_X8;
      for (size_t i = gt; i < (size_t)T * D / 16; i += NT) { const f32x4 a = *(const f32x4*)(pp->x + i * 16) * 32.f, b = *(const f32x4*)(pp->x + i * 16 + 4) * 32.f, c = *(const f32x4*)(pp->x + i * 16 + 8) * 32.f, d = *(const f32x4*)(pp->x + i * 16 + 12) * 32.f;
          u32x4 o; o.x = pk4_fp8(a[0], a[1], a[2], a[3]); o.y = pk4_fp8(b[0], b[1], b[2], b[3]); o.z = pk4_fp8(c[0], c[1], c[2], c[3]); o.w = pk4_fp8(d[0], d[1], d[2], d[3]); *(u32x4*)(x8 + i * 16) = o; } }
    if (blockIdx.x == 0) { unsigned* barw = (unsigned*)(pp->ws + WS_BAR); for (int i = threadIdx.x; i < XCD_BAR_WORDS; i += NTHREADS) barw[i] = 0u; }
    { float* tabA = (float*)(pp->ws + WS_TAB); float* tabB = (float*)(pp->ws + WS_TAB + 8192);
      const int gt = gw * 64 + lane;
      if (gt < 12 * 129) { const int hh = gt / 129, i = gt - hh * 129, g = hh >> 2, dil = g == 0 ? 1 : (g == 1 ? 4 : 16); tabA[hh * 132 + i] = pp->rel_bias[t5_bucket((i - 64) * dil) * 20 + hh] * LOG2E; }
      else if (gt < 12 * 129 + 8 * 257) { const int q = gt - 12 * 129, hh = q / 257, i = q - hh * 257; tabB[hh * 260 + i] = pp->rel_bias[t5_bucket(i - 128) * 20 + 12 + hh] * LOG2E; } }
}

constexpr int AT_KS = 0, AT_VS = 8704, AT_TAB = 8704 + 10240, AT_WAVE_BYTES = 8704 + 10240 + 1296;
static_assert(AT_WAVE_BYTES * NWAVES <= LDS_BYTES, "attention LDS");
#define TR4(r0, r1, r2, r3, base, o0, o1, o2, o3) asm volatile("ds_read_b64_tr_b16 %0, %4 offset:%5\n\tds_read_b64_tr_b16 %1, %4 offset:%6\n\tds_read_b64_tr_b16 %2, %4 offset:%7\n\tds_read_b64_tr_b16 %3, %4 offset:%8\n\ts_waitcnt lgkmcnt(0)" \
    : "=&v"(r0), "=&v"(r1), "=&v"(r2), "=&v"(r3) : "v"(base), "i"(o0), "i"(o1), "i"(o2), "i"(o3) : "memory")
#define PK8(L, Hh) (bf16x8){L[0], L[1], L[2], L[3], Hh[0], Hh[1], Hh[2], Hh[3]}

__device__ __forceinline__ void attn_item(LAS unsigned char* wl, int lane, const bf16* __restrict__ P, int qcol, int kcol, int vcol, int r, int dil, int sub_len, int q0, int W, int nkt,
                                          const float* __restrict__ tab, float m_init, float l_init, bf16* O, int o_ld, int ocol, float* lse, int lse_idx, bool o8) {
    const int hl = lane >> 5, ql = lane & 31;
    LAS float* tabs = (LAS float*)(wl + AT_TAB);
    { float tv[6];
#pragma unroll
      for (int u = 0; u < 6; ++u) { const int src = lane + 64 * u - 32; const int sc_ = src < 0 ? 0 : (src > 2 * W ? 2 * W : src); tv[u] = tab[sc_]; }
#pragma unroll
      for (int u = 0; u < 6; ++u) { const int i = lane + 64 * u, src = i - 32; if (i < 2 * W + 65) tabs[i] = (src >= 0 && src <= 2 * W) ? tv[u] : -__builtin_inff(); } }
    bf16x8 qf[8];
    { const bf16* qp = P + (size_t)(r + (q0 + ql) * dil) * CIN + qcol + 8 * hl;
#pragma unroll
      for (int s = 0; s < 8; ++s) qf[s] = *(const bf16x8*)(qp + 16 * s); }
    u32x4 kreg[8], vreg[8];
    const int lrow = lane >> 4, lch = lane & 15;
    const char* Pk = (const char*)(P + kcol); const char* Pv = (const char*)(P + vcol);
    const unsigned rstride = 4u * (unsigned)dil * (unsigned)(CIN * 2);
#define AT_EDGE(kt_) ((q0 - W + 32 * (kt_) < 0) || (q0 - W + 32 * (kt_) + 31 >= sub_len))
#define AT_ROFF(kt_, jj) ({ int sub = q0 - W + 32 * (kt_) + 4 * (jj) + lrow; sub = sub < 0 ? 0 : (sub >= sub_len ? sub_len - 1 : sub); (unsigned)(r + sub * dil) * (unsigned)(CIN * 2) + 16u * lch; })
#define AT_LOADX(dst, Pb, kt) do { const int kt_ = (kt) < nkt ? (kt) : nkt - 1; \
        if (AT_EDGE(kt_)) { _Pragma("unroll") for (int jj = 0; jj < 8; ++jj) dst[jj] = *(const u32x4*)(Pb + AT_ROFF(kt_, jj)); } \
        else { const unsigned off0 = (unsigned)(r + (q0 - W + 32 * kt_ + lrow) * dil) * (unsigned)(CIN * 2) + 16u * lch; \
               _Pragma("unroll") for (int jj = 0; jj < 8; ++jj) { const char* pb_ = Pb + (size_t)jj * rstride; dst[jj] = *(const u32x4*)(pb_ + off0); } } } while (0)
#define AT_LOADK(kt) AT_LOADX(kreg, Pk, kt)
#define AT_LOADV(kt) AT_LOADX(vreg, Pv, kt)
    AT_LOADK(0); AT_LOADV(0);
    f32x16 o0, o1, o2, o3;
#pragma unroll
    for (int i = 0; i < 16; ++i) { o0[i] = 0.f; o1[i] = 0.f; o2[i] = 0.f; o3[i] = 0.f; }
    float m = m_init, l = l_init;
    const float c = 0.08838834764831845f * LOG2E;
    const unsigned vb = (unsigned)(uintptr_t)(wl + AT_VS) + (unsigned)((4 * hl + ((lane & 15) >> 2)) * 320 + (16 * ((lane >> 4) & 1) + 4 * (lane & 3)) * 2);
    const LAS unsigned char* kb = wl + AT_KS + ql * 272 + 16 * hl;
    for (int kt = 0; kt < nkt; ++kt) {
#pragma unroll
        for (int jj = 0; jj < 8; ++jj) *(LAS u32x4*)(wl + AT_KS + (4 * jj + lrow) * 272 + 16 * lch) = kreg[jj];
        AT_LOADK(kt + 1);
        f32x16 sc;
#pragma unroll
        for (int i = 0; i < 16; ++i) sc[i] = 0.f;
#pragma unroll
        for (int s = 0; s < 8; ++s) { const bf16x8 kf = *(const LAS bf16x8*)(kb + 32 * s); sc = __builtin_amdgcn_mfma_f32_32x32x16_bf16(kf, qf[s], sc, 0, 0, 0); }
        const LAS float* tb = tabs + (32 * kt - ql + 4 * hl + 32);
        float tmax = -__builtin_inff();
#pragma unroll
        for (int i = 0; i < 16; ++i) { sc[i] = fmaf(sc[i], c, tb[8 * (i >> 2) + (i & 3)]); }
        if (AT_EDGE(kt)) {
            const int ks0 = q0 - W + 32 * kt + 4 * hl;
#pragma unroll
            for (int i = 0; i < 16; ++i) { const int ks = ks0 + 8 * (i >> 2) + (i & 3); if (ks < 0 || ks >= sub_len) sc[i] = -__builtin_inff(); }
        }
#pragma unroll
        for (int i = 0; i < 16; ++i) tmax = fmaxf(tmax, sc[i]);
        tmax = fmaxf(tmax, shx(tmax, 32, lane));
        if (__builtin_amdgcn_ballot_w64(tmax > m + 8.0f) != 0ull) {
            const float mn = fmaxf(m, tmax), alpha = __builtin_amdgcn_exp2f(m - mn); m = mn; l *= alpha;
#pragma unroll
            for (int i = 0; i < 16; ++i) { o0[i] *= alpha; o1[i] *= alpha; o2[i] *= alpha; o3[i] *= alpha; }
        }
        float ps = 0.f;
#pragma unroll
        for (int i = 0; i < 16; ++i) { sc[i] = __builtin_amdgcn_exp2f(sc[i] - m); ps += sc[i]; }
        l += ps;
        bf16x8 p0, p1;
        { u32x4 w0, w1; w0.x = pk2(sc[0], sc[1]); w0.y = pk2(sc[2], sc[3]); w0.z = pk2(sc[4], sc[5]); w0.w = pk2(sc[6], sc[7]);
          w1.x = pk2(sc[8], sc[9]); w1.y = pk2(sc[10], sc[11]); w1.z = pk2(sc[12], sc[13]); w1.w = pk2(sc[14], sc[15]);
          p0 = *reinterpret_cast<bf16x8*>(&w0); p1 = *reinterpret_cast<bf16x8*>(&w1); }
#pragma unroll
        for (int jj = 0; jj < 8; ++jj) *(LAS u32x4*)(wl + AT_VS + (4 * jj + lrow) * 320 + 16 * lch) = vreg[jj];
        AT_LOADV(kt + 1);
        { s16x4 a0, a1, b0, b1;
          TR4(a0, a1, b0, b1, vb, 0, 2560, 5120, 7680); __builtin_amdgcn_sched_barrier(0);
          o0 = __builtin_amdgcn_mfma_f32_32x32x16_bf16(PK8(a0, a1), p0, o0, 0, 0, 0); o0 = __builtin_amdgcn_mfma_f32_32x32x16_bf16(PK8(b0, b1), p1, o0, 0, 0, 0);
          TR4(a0, a1, b0, b1, vb, 64, 64 + 2560, 64 + 5120, 64 + 7680); __builtin_amdgcn_sched_barrier(0);
          o1 = __builtin_amdgcn_mfma_f32_32x32x16_bf16(PK8(a0, a1), p0, o1, 0, 0, 0); o1 = __builtin_amdgcn_mfma_f32_32x32x16_bf16(PK8(b0, b1), p1, o1, 0, 0, 0);
          TR4(a0, a1, b0, b1, vb, 128, 128 + 2560, 128 + 5120, 128 + 7680); __builtin_amdgcn_sched_barrier(0);
          o2 = __builtin_amdgcn_mfma_f32_32x32x16_bf16(PK8(a0, a1), p0, o2, 0, 0, 0); o2 = __builtin_amdgcn_mfma_f32_32x32x16_bf16(PK8(b0, b1), p1, o2, 0, 0, 0);
          TR4(a0, a1, b0, b1, vb, 192, 192 + 2560, 192 + 5120, 192 + 7680); __builtin_amdgcn_sched_barrier(0);
          o3 = __builtin_amdgcn_mfma_f32_32x32x16_bf16(PK8(a0, a1), p0, o3, 0, 0, 0); o3 = __builtin_amdgcn_mfma_f32_32x32x16_bf16(PK8(b0, b1), p1, o3, 0, 0, 0); }
    }
#undef AT_LOADK
#undef AT_LOADV
#undef AT_LOADX
#undef AT_ROFF
#undef AT_EDGE
    const float lt = l + shx(l, 32, lane), inv = 1.0f / lt;
    const size_t tok = (size_t)(r + (q0 + ql) * dil);
    if (o8) {
        unsigned char* op = (unsigned char*)O + tok * o_ld + ocol + 4 * hl; const float i64 = inv * 64.f;
#pragma unroll
        for (int g = 0; g < 4; ++g) {
            *(unsigned*)(op + 8 * g) = pk4_fp8(o0[4 * g] * i64, o0[4 * g + 1] * i64, o0[4 * g + 2] * i64, o0[4 * g + 3] * i64);
            *(unsigned*)(op + 32 + 8 * g) = pk4_fp8(o1[4 * g] * i64, o1[4 * g + 1] * i64, o1[4 * g + 2] * i64, o1[4 * g + 3] * i64);
            *(unsigned*)(op + 64 + 8 * g) = pk4_fp8(o2[4 * g] * i64, o2[4 * g + 1] * i64, o2[4 * g + 2] * i64, o2[4 * g + 3] * i64);
            *(unsigned*)(op + 96 + 8 * g) = pk4_fp8(o3[4 * g] * i64, o3[4 * g + 1] * i64, o3[4 * g + 2] * i64, o3[4 * g + 3] * i64);
        }
    } else {
    bf16* op = O + tok * o_ld + ocol + 4 * hl;
#pragma unroll
    for (int g = 0; g < 4; ++g) {
        u32x2 w;
        w.x = pk2(o0[4 * g] * inv, o0[4 * g + 1] * inv); w.y = pk2(o0[4 * g + 2] * inv, o0[4 * g + 3] * inv); *(u32x2*)(op + 8 * g) = w;
        w.x = pk2(o1[4 * g] * inv, o1[4 * g + 1] * inv); w.y = pk2(o1[4 * g + 2] * inv, o1[4 * g + 3] * inv); *(u32x2*)(op + 32 + 8 * g) = w;
        w.x = pk2(o2[4 * g] * inv, o2[4 * g + 1] * inv); w.y = pk2(o2[4 * g + 2] * inv, o2[4 * g + 3] * inv); *(u32x2*)(op + 64 + 8 * g) = w;
        w.x = pk2(o3[4 * g] * inv, o3[4 * g + 1] * inv); w.y = pk2(o3[4 * g + 2] * inv, o3[4 * g + 3] * inv); *(u32x2*)(op + 96 + 8 * g) = w;
    }
    }
    if (lse && hl == 0) lse[tok * 12 + lse_idx] = m + __builtin_log2f(lt);
    LDS_WAIT();
}

__device__ __forceinline__ void phase_attention(unsigned char* ws, const float* sinkp, LAS unsigned char* lds, int layer, int gw, int NGW, int wave, int lane) {
    LAS unsigned char* wl = lds + wave * AT_WAVE_BYTES;
    const bf16* P = (const bf16*)(ws + WS_PROJ);
    const float* tabA = (const float*)(ws + WS_TAB); const float* tabB = (const float*)(ws + WS_TAB + 8192);
    constexpr int NA = 12 * 512, NB = 8 * 512;
    for (int it = gw; it < NA + NB; it += NGW) {
        int qcol, kcol, vcol, r, dil, q0, W, nkt, o_ld, ocol, lse_idx; const float* tab; float m0, l0; bf16* O; float* lse;
        if (it < NA) {
            const int g = it >> 11, rem = it & 2047, h = rem >> 9, qt = rem & 511, hh = g * 4 + h;
            dil = g == 0 ? 1 : (g == 1 ? 4 : 16); const int tpr = 512 / dil; r = qt / tpr; q0 = (qt - r * tpr) * 32;
            qcol = hh * 128; kcol = 1536 + hh * 128; vcol = 3072 + hh * 128; W = 64; nkt = 5; tab = tabA + hh * 132; m0 = -1e30f; l0 = 0.f;
            O = (bf16*)(ws + WS_AR); o_ld = 1536; ocol = hh * 128; lse = (float*)(ws + WS_LSE); lse_idx = hh;
        } else {
            const int j = it - NA, rep = j & 3, qt = (j >> 2) & 511, kvh = j >> 11, qh = kvh * 4 + rep;
            dil = 1; r = 0; q0 = qt * 32; qcol = 4608 + qh * 128; kcol = 5632 + kvh * 128; vcol = 5888 + kvh * 128; W = 128; nkt = 9; tab = tabB + qh * 260;
            m0 = sinkp[layer * 8 + qh] * LOG2E; l0 = (lane < 32) ? 1.f : 0.f;
            O = (bf16*)(ws + WS_BO); o_ld = 1024; ocol = qh * 128; lse = nullptr; lse_idx = 0;
        }
        attn_item(wl, lane, P, qcol, kcol, vcol, r, dil, SEQ / dil, q0, W, nkt, tab, m0, l0, O, o_ld, ocol, lse, lse_idx, it >= NA);
    }
}

__device__ __forceinline__ void phase_amerge(unsigned char* ws, int gw, int NGW, int lane) {
    const bf16* AR = (const bf16*)(ws + WS_AR); const float* LSE = (const float*)(ws + WS_LSE); unsigned char* AO8 = ws + WS_AO;
    const size_t gt = (size_t)gw * 64 + lane, NT = (size_t)NGW * 64;
    for (size_t i = gt; i < (size_t)TH * 64; i += NT) {
        const size_t t = i >> 6; const int ch = (int)(i & 63), h = ch >> 4, dc = ch & 15;
        const float l0 = LSE[t * 12 + h], l1 = LSE[t * 12 + 4 + h], l2 = LSE[t * 12 + 8 + h];
        const float mx = fmaxf(l0, fmaxf(l1, l2));
        float w0 = __builtin_amdgcn_exp2f(l0 - mx), w1 = __builtin_amdgcn_exp2f(l1 - mx), w2 = __builtin_amdgcn_exp2f(l2 - mx);
        const float inv = 1.0f / (w0 + w1 + w2); w0 *= inv; w1 *= inv; w2 *= inv;
        const bf16* ap = AR + t * 1536 + h * 128 + dc * 8;
        const u32x4 a = *(const u32x4*)ap, b = *(const u32x4*)(ap + 512), cc = *(const u32x4*)(ap + 1024);
        w0 *= 64.f; w1 *= 64.f; w2 *= 64.f;
        u32x2 o;
        o.x = pk4_fp8(w0 * pg8::bf_lo(a.x) + w1 * pg8::bf_lo(b.x) + w2 * pg8::bf_lo(cc.x), w0 * pg8::bf_hi(a.x) + w1 * pg8::bf_hi(b.x) + w2 * pg8::bf_hi(cc.x),
                      w0 * pg8::bf_lo(a.y) + w1 * pg8::bf_lo(b.y) + w2 * pg8::bf_lo(cc.y), w0 * pg8::bf_hi(a.y) + w1 * pg8::bf_hi(b.y) + w2 * pg8::bf_hi(cc.y));
        o.y = pk4_fp8(w0 * pg8::bf_lo(a.z) + w1 * pg8::bf_lo(b.z) + w2 * pg8::bf_lo(cc.z), w0 * pg8::bf_hi(a.z) + w1 * pg8::bf_hi(b.z) + w2 * pg8::bf_hi(cc.z),
                      w0 * pg8::bf_lo(a.w) + w1 * pg8::bf_lo(b.w) + w2 * pg8::bf_lo(cc.w), w0 * pg8::bf_hi(a.w) + w1 * pg8::bf_hi(b.w) + w2 * pg8::bf_hi(cc.w));
        *(u32x2*)(AO8 + t * 512 + h * 128 + dc * 8) = o;
    }
}

__device__ __forceinline__ void phase_ln(float* Y, bf16* XB, unsigned char* X8, float* st, bool inplace, const float* __restrict__ gam, const float* __restrict__ bet, int gw, int NGW, int lane) {
    for (int row = gw; row < T; row += NGW) {
        f32x4* yr = (f32x4*)(Y + (size_t)row * D) + lane;
        f32x4 v[8]; float s = 0.f;
#pragma unroll
        for (int j = 0; j < 8; ++j) { v[j] = yr[64 * j]; s += (v[j][0] + v[j][1]) + (v[j][2] + v[j][3]); }
        const float mean = wave_sum(s, lane) * (1.f / D); float s2 = 0.f;
#pragma unroll
        for (int j = 0; j < 8; ++j) { v[j] = v[j] - mean; s2 += (v[j][0] * v[j][0] + v[j][1] * v[j][1]) + (v[j][2] * v[j][2] + v[j][3] * v[j][3]); }
        const float rstd = 1.0f / sqrtf(wave_sum(s2, lane) * (1.f / D) + LN_EPS);
        if (st && lane == 0) { st[2 * (size_t)row] = mean; st[2 * (size_t)row + 1] = rstd; }
#pragma unroll
        for (int j = 0; j < 8; ++j) { const f32x4 gg = *((const f32x4*)gam + lane + 64 * j), bb = *((const f32x4*)bet + lane + 64 * j);
            const f32x4 o = v[j] * rstd * gg + bb;
            if (inplace) yr[64 * j] = o;
            if (XB) { u32x2 w; w.x = pk2(o[0], o[1]); w.y = pk2(o[2], o[3]); *((u32x2*)(XB + (size_t)row * D) + lane + 64 * j) = w; }
            if (X8) *((unsigned*)(X8 + (size_t)row * D) + lane + 64 * j) = pk4_fp8(o[0] * 32.f, o[1] * 32.f, o[2] * 32.f, o[3] * 32.f); }
    }
}

__global__ void __launch_bounds__(NTHREADS, 2) fwd_mega(Params p_arg) {
    extern __shared__ __attribute__((aligned(16))) unsigned char lds_raw[];
    LAS unsigned char* lds = (LAS unsigned char*)lds_raw;
    const int ph_lo = p_arg.ph_lo, ph_hi = p_arg.ph_hi;
    if (threadIdx.x < 4) ((LAS unsigned*)(lds + LDS_BARST))[threadIdx.x] = 0u;
    __syncthreads();
    for (int ph = ph_lo; ph < ph_hi; ++ph) {
      for (int rep = 0; rep < 2; ++rep) {
        if (ph > ph_lo || rep > 0) {
#if defined(__HIP_DEVICE_COMPILE__)
            unsigned* barw = (unsigned*)(((PP)__builtin_amdgcn_kernarg_segment_ptr())->ws + WS_BAR);
            if (ph == 1 && rep == 0) { cg::this_grid().sync();
                (void)xcd_barrier_post(barw, (volatile LAS unsigned*)(lds + LDS_BARST)); }
            else { XcdBarrier xb_; xb_.bar = barw; xb_.x = xb_xcc_id(); xb_.st = (volatile LAS unsigned*)(lds + LDS_BARST); xcd_barrier(xb_); }
#endif
        }
#if defined(__HIP_DEVICE_COMPILE__)
        PP p = (PP)__builtin_amdgcn_kernarg_segment_ptr(); asm volatile("" : "+s"(p));
#else
        PP p = (PP)(uintptr_t)0; (void)p_arg;
#endif
        int tid_ = threadIdx.x, bx_ = blockIdx.x; asm volatile("" : "+v"(tid_), "+s"(bx_));
        const int tid = tid_, lane = tid & 63, wave = __builtin_amdgcn_readfirstlane(tid >> 6);
        const int G = gridDim.x, bx = bx_, vcu = (G % 8 == 0) ? (bx % 8) * (G / 8) + bx / 8 : bx;
        const int gw = vcu * NWAVES + wave, NGW = G * NWAVES;
        unsigned char* ws = p->ws; bf16* XB = (bf16*)(ws + WS_XB);
        if (ph == 0) {
#if EN_PRO
 phase_prologue(p, lds, gw, NGW, wave, lane);
#endif
 if (rep == 0 && (PROBE_MASK & 1)) continue; else break; }
        const int q = ph - 1, layer = q / 13, s = q - layer * 13;
        const bf16* wl = (const bf16*)(ws + WS_W0 + (size_t)layer * WS_WL);
        const bool dbl = (s < 8 && (s & 3) == 1 && (PROBE_MASK & 2)) || (s < 8 && (s & 3) == 2 && (PROBE_MASK & 4)) || ((s == 9 || (s == 12 && layer == 0)) && (PROBE_MASK & 8)) || (s < 8 && (s & 3) == 0 && (PROBE_MASK & 16)) || (s == 10 && (PROBE_MASK & 32)) || (s < 8 && (s & 3) == 3 && (PROBE_MASK & 64));
        if (s < 8) {
            const int half = s >> 2, sub = s & 3;
            if (sub == 0) {
                pg8::Gemm g{(const bf16*)(ws + WS_X8 + (size_t)half * TH * D), wl + WO_IN, TH, CIN, D / 2}; pg8::StaticOrder S; S.init(TH, CIN, G, bx);
                pg8::EpiBf16<0> E{(bf16*)(ws + WS_PROJ), CIN, nullptr, 0, 0, 1.f};

#if EN_INPROJ
 pg8::gemm_phase<pg8::EpiBf16<0>, pg8::StaticOrder, true, true, true>(lds, g, S, E);
#endif

            } else if (sub == 1) {
#if EN_ATTN
 phase_attention(ws, p->sink, lds, layer, gw, NGW, wave, lane);
#endif

            } else if (sub == 2) { phase_amerge(ws, gw, NGW, lane);
            } else {
                for (int k = 0; k < 2; ++k) {
                    pg8::Gemm g{k == 0 ? (const bf16*)(ws + WS_AO) : (const bf16*)(ws + WS_BO), wl + (k == 0 ? WO_PA : WO_PB), TH, D, k == 0 ? 256 : 512, 0x79797979, 0x78787878};
                    pg8::StaticOrder S; S.init(TH, D, G, bx);
                    pg8::EpiGate E{(bf16*)(ws + WS_XB + 64 * MiB), ws + WS_XB + (size_t)half * TH * D, D, (const bf16*)(ws + WS_PROJ) + (k == 0 ? 6144 : 8192), CIN, k, 512.f};

#if EN_GATE
 pg8::gemm_phase<pg8::EpiGate, pg8::StaticOrder, true, true, true>(lds, g, S, E);
#endif

                }
            }
        } else if (s == 8 || s == 11) {
            const bool dn = (s == 11);
            pg8::StaticOrder S; S.init(T, D, G, bx);
            const bool raw = (!dn && layer == 0);
            pg8::EpiResid E{(pg8::ArgV)p, raw ? 0 : -1, dn ? 7 : 11, dn ? 8 : 12, D, ALPHA, (size_t)(dn ? layer : (layer > 0 ? layer - 1 : 0)) * D, WS_ST};
#if EN_RESID
            if (dn) { pg8::Gemm g{(const bf16*)(ws + WS_H), wl + WO_DN, T, D, DFF}; pg8::gemm_phase<pg8::EpiResid, pg8::StaticOrder, true, true>(lds, g, S, E); }
            else { pg8::Gemm g{(const bf16*)(ws + WS_XB), wl + WO_OUT, T, D, D / 2, 0x76767676, 0x78787878}; pg8::gemm_phase<pg8::EpiResid, pg8::StaticOrder, true, true, true>(lds, g, S, E); }
#endif
        } else if (s == 9) { phase_ln(p->out, XB, nullptr, (float*)(ws + WS_ST), false, p->ln1_g + layer * D, p->ln1_b + layer * D, gw, NGW, lane);
        } else if (s == 10) {
            pg8::Gemm g{XB, wl + WO_UP, T, NUP, D}; pg8::StaticOrder S; S.init(T, NUP, G, bx);
            pg8::EpiSwiglu E{(bf16*)(ws + WS_H), DFF};

#if EN_SWIGLU
 pg8::gemm_phase<pg8::EpiSwiglu, pg8::StaticOrder, true, true>(lds, g, S, E);
#endif

        } else { phase_ln(p->out, nullptr, (layer == 1) ? nullptr : ws + WS_X8, (layer == 1) ? nullptr : (float*)(ws + WS_ST), layer == 1, p->ln2_g + layer * D, p->ln2_b + layer * D, gw, NGW, lane); }
        if (!(rep == 0 && dbl)) break;
      }
    }
}

#ifndef MK_PER_PHASE
#define MK_PER_PHASE 0
#endif
extern "C" void kernel_launch(void* const* d_in, const int* in_sizes, int n_in, void* d_out, int out_size, void* d_ws, size_t ws_size, hipStream_t stream) {
    static int grid = 0;
    if (grid == 0) {
        if (n_in != 13 || ws_size < WS_END) { fprintf(stderr, "kernel_launch: unexpected inputs (n_in %d, ws %zu)\n", n_in, ws_size); grid = -1; return; }
        int dev = 0, cus = 0;
        if (hipGetDevice(&dev) != hipSuccess || hipDeviceGetAttribute(&cus, hipDeviceAttributeMultiprocessorCount, dev) != hipSuccess) { grid = -1; return; }
        if (hipFuncSetAttribute((const void*)fwd_mega, hipFuncAttributeMaxDynamicSharedMemorySize, LDS_BYTES) != hipSuccess) { fprintf(stderr, "kernel_launch: hipFuncSetAttribute failed\n"); grid = -1; return; }
        (void)hipGetLastError();
        grid = cus;
    }
    if (grid < 0) return;
    Params p{};
    p.x = (const float*)d_in[0]; p.rel_bias = (const float*)d_in[1]; p.w_in = (const float*)d_in[2]; p.sink = (const float*)d_in[3]; p.w_pa = (const float*)d_in[4]; p.w_pb = (const float*)d_in[5];
    p.w_out = (const float*)d_in[6]; p.ln1_g = (const float*)d_in[7]; p.ln1_b = (const float*)d_in[8]; p.w_up = (const float*)d_in[9]; p.w_down = (const float*)d_in[10];
    p.ln2_g = (const float*)d_in[11]; p.ln2_b = (const float*)d_in[12]; p.out = (float*)d_out; p.ws = (unsigned char*)d_ws;
#if MK_PER_PHASE
    for (int ph = 0; ph < NPHASES; ++ph) { p.ph_lo = ph; p.ph_hi = ph + 1; hipLaunchKernelGGL(fwd_mega, dim3(grid), dim3(NTHREADS), LDS_BYTES, stream, p); }
#else
    p.ph_lo = 0; p.ph_hi = NPHASES;
    void* args[] = {&p};
    hipError_t e = hipLaunchCooperativeKernel((const void*)fwd_mega, dim3(grid), dim3(NTHREADS), args, LDS_BYTES, stream);
    if (e != hipSuccess) fprintf(stderr, "kernel_launch: cooperative launch failed: %s (grid %d)\n", hipGetErrorString(e), grid);
#endif
}
```

```cpp
#include <hip/hip_runtime.h>
#include <hip/hip_cooperative_groups.h>
#include <cstdio>
#include <cstdint>
namespace cg = cooperative_groups;
namespace pg8 {
#define PG8_LAS __attribute__((address_space(3)))
typedef unsigned short bf16_t;
typedef short bf16x8 __attribute__((ext_vector_type(8)));
typedef float f32x4 __attribute__((ext_vector_type(4)));
typedef unsigned u32x4 __attribute__((ext_vector_type(4)));
typedef unsigned u32x2 __attribute__((ext_vector_type(2)));
typedef int v8i32 __attribute__((ext_vector_type(8)));
typedef int v4i32 __attribute__((ext_vector_type(4)));
constexpr int FP8_SCALE_X = 0x79797979, FP8_SCALE_W = 0x79797979;
constexpr int BM = 256, BK = 64, HALF = 128, HTB = HALF * BK * 2  , STAGE_BYTES = 8 * HTB, NXCD = 8, WGM = 8;

__host__ __device__ __forceinline__ int lds_byte(int r, int c) { const int st = (r >> 4) * 2 + (c >> 5), rr = r & 15, cc = c & 31, ob = rr * 64 + cc * 2; return st * 1024 + (ob ^ (((ob >> 9) & 1) << 5)); }
__host__ __device__ __forceinline__ void stage_rc(int b, int& R, int& C) { const int st = b / 1024, sb = b % 1024, swz = sb ^ (((sb >> 9) & 1) << 5); R = (st >> 1) * 16 + swz / 64; C = (st & 1) * 32 + (swz % 64) / 2; }
__host__ __device__ __forceinline__ int x8(int r) { return ((r >> 1) & 3) | ((((r >> 2) ^ (r >> 3)) & 1) << 2); }
__host__ __device__ __forceinline__ int lds_byte8(int r, int c16) { return r * 128 + 16 * (c16 ^ x8(r & 15)); }
__host__ __device__ __forceinline__ void stage_rc8(int b, int& R, int& C) { R = b >> 7; C = 8 * (((b >> 4) & 7) ^ x8(R & 15)); }
__host__ __device__ __forceinline__ int perm32(int rho) { const int n = rho >> 4, i = rho & 15; return 8 * (i >> 2) + 4 * n + (i & 3); }

struct Unit { int pm, pn; };
struct Gemm { const bf16_t* A; const bf16_t* Bt; int M, N, K; int sx = 0x79797979, sw = 0x79797979; };

struct StaticOrder {
    int nM, nN, nwg, G, c;
    __host__ __device__ void init(int M, int N, int G_, int c_) { nM = M / BM; nN = N / BM; nwg = nM * nN; G = G_; c = c_; }
    __host__ __device__ bool next(int i, Unit& u) const {
        const long L = (long)i * G + c; if (L >= nwg) return false;
        int wgid = (int)L; { const int q = nwg / NXCD, r = nwg % NXCD, xcd = wgid % NXCD, off = wgid / NXCD; wgid = (xcd < r ? xcd * (q + 1) : r * (q + 1) + (xcd - r) * q) + off; }
        const int nig = WGM * nN, gid = wgid / nig, fm = gid * WGM, gsz = (nM - fm) < WGM ? (nM - fm) : WGM;
        u.pm = fm + ((wgid % nig) % gsz); u.pn = (wgid % nig) / gsz; return true;
    }
    __device__ __forceinline__ void a_ready(const Unit&) const {}
    __device__ __forceinline__ void done(const Unit&) const {}
};

__device__ __forceinline__ unsigned cvt_pk_bf16(float lo, float hi) { unsigned r; asm("v_cvt_pk_bf16_f32 %0, %1, %2" : "=v"(r) : "v"(lo), "v"(hi)); return r; }
typedef float f32x2 __attribute__((ext_vector_type(2)));
template <int ACT  > struct EpiBf16 {
    static constexpr bool PERM = true, AFTER_DRAIN = false; static_assert(ACT == 0 || ACT == 1, "EpiBf16: ACT is 0 (none) or 1 (gelu_pk)");
    bf16_t* O; int ldc; const float* bias; int split_cols; size_t split_stride; float scale0;
    __device__ __forceinline__ void operator()(const f32x4 (&acc)[2][2][4][2], const Unit& u, int wr, int wc, int fr, int fq) const {
        const int row0 = u.pm * BM + wr * 64 + fr; int colt = u.pn * BM; bf16_t* base = O;
        float sc = 1.f; if (split_cols) { const int t = colt / split_cols; base += (size_t)t * split_stride; colt -= t * split_cols; if (t == 0) sc = scale0; }
        const int col0 = colt + wc * 32 + 8 * fq, bcol0 = u.pn * BM + wc * 32 + 8 * fq;
        f32x4 bv[2][2];
#pragma unroll
        for (int bj = 0; bj < 2; ++bj)
#pragma unroll
            for (int n = 0; n < 2; ++n) bv[bj][n] = bias ? *(const f32x4*)(bias + bcol0 + bj * HALF + 4 * n) : (f32x4){0.f, 0.f, 0.f, 0.f};
#pragma unroll
        for (int ai = 0; ai < 2; ++ai)
#pragma unroll
            for (int m = 0; m < 4; ++m) { bf16_t* rowp = base + (size_t)(row0 + ai * HALF + m * 16) * ldc + col0;
#pragma unroll
                for (int bj = 0; bj < 2; ++bj) { f32x4 v0 = acc[ai][bj][m][0] + bv[bj][0], v1 = acc[ai][bj][m][1] + bv[bj][1];
                    v0 = v0 * sc; v1 = v1 * sc; u32x4 w; w.x = cvt_pk_bf16(v0[0], v0[1]); w.y = cvt_pk_bf16(v0[2], v0[3]); w.z = cvt_pk_bf16(v1[0], v1[1]); w.w = cvt_pk_bf16(v1[2], v1[3]);
                    *(u32x4*)(rowp + bj * HALF) = w; } }
    }
};
__device__ __forceinline__ float sigmoidf_fast(float x) { return __builtin_amdgcn_rcpf(1.0f + __builtin_amdgcn_exp2f(-1.4426950408889634f * x)); }
__device__ __forceinline__ float bf_lo(unsigned w) { return __uint_as_float(w << 16); }
__device__ __forceinline__ float bf_hi(unsigned w) { return __uint_as_float(w & 0xffff0000u); }
__device__ __forceinline__ float clamp448(float v) { return __builtin_fminf(__builtin_fmaxf(v, -448.f), 448.f); }
__device__ __forceinline__ unsigned pk4_fp8(float a, float b, float c, float d) { unsigned w = 0; w = __builtin_amdgcn_cvt_pk_fp8_f32(clamp448(a), clamp448(b), w, false); w = __builtin_amdgcn_cvt_pk_fp8_f32(clamp448(c), clamp448(d), w, true); return w; }
struct EpiGate {
    static constexpr bool PERM = true, AFTER_DRAIN = false;
    bf16_t* Tm; unsigned char* O8; int ldo; const bf16_t* G; int ldg; int add; float oscale;
    __device__ __forceinline__ void operator()(const f32x4 (&acc)[2][2][4][2], const Unit& u, int wr, int wc, int fr, int fq) const {
        const int row0 = u.pm * BM + wr * 64 + fr, col0 = u.pn * BM + wc * 32 + 8 * fq;
#pragma unroll
        for (int ai = 0; ai < 2; ++ai)
#pragma unroll
            for (int m = 0; m < 4; ++m) { const size_t r = (size_t)(row0 + ai * HALF + m * 16); bf16_t* rowp = Tm + r * ldo + col0; const bf16_t* gp = G + r * ldg + col0;
#pragma unroll
                for (int bj = 0; bj < 2; ++bj) { const u32x4 gw = *(const u32x4*)(gp + bj * HALF); f32x4 v0 = acc[ai][bj][m][0], v1 = acc[ai][bj][m][1];
                    v0[0] *= sigmoidf_fast(bf_lo(gw.x)); v0[1] *= sigmoidf_fast(bf_hi(gw.x)); v0[2] *= sigmoidf_fast(bf_lo(gw.y)); v0[3] *= sigmoidf_fast(bf_hi(gw.y));
                    v1[0] *= sigmoidf_fast(bf_lo(gw.z)); v1[1] *= sigmoidf_fast(bf_hi(gw.z)); v1[2] *= sigmoidf_fast(bf_lo(gw.w)); v1[3] *= sigmoidf_fast(bf_hi(gw.w));
                    if (add) { const u32x4 pw = *(const u32x4*)(rowp + bj * HALF);
                        v0[0] += bf_lo(pw.x); v0[1] += bf_hi(pw.x); v0[2] += bf_lo(pw.y); v0[3] += bf_hi(pw.y); v1[0] += bf_lo(pw.z); v1[1] += bf_hi(pw.z); v1[2] += bf_lo(pw.w); v1[3] += bf_hi(pw.w);
                        v0 = v0 * oscale; v1 = v1 * oscale; u32x2 w8; w8.x = pk4_fp8(v0[0], v0[1], v0[2], v0[3]); w8.y = pk4_fp8(v1[0], v1[1], v1[2], v1[3]);
                        *(u32x2*)(O8 + r * ldo + col0 + bj * HALF) = w8; }
                    else { u32x4 w; w.x = cvt_pk_bf16(v0[0], v0[1]); w.y = cvt_pk_bf16(v0[2], v0[3]); w.z = cvt_pk_bf16(v1[0], v1[1]); w.w = cvt_pk_bf16(v1[2], v1[3]);
                        *(u32x4*)(rowp + bj * HALF) = w; } } }
    }
};
typedef void* vptr_t; typedef const __attribute__((address_space(4))) vptr_t* ArgV;
struct EpiResid {
    static constexpr bool PERM = false, AFTER_DRAIN = false;
    ArgV args; int xi, gi, bi; int ldc; float alpha; size_t goff; size_t st_off;
    __device__ __forceinline__ void operator()(const f32x4 (&acc)[2][2][4][2], const Unit& u, int wr, int wc, int fr, int fq) const {
        ArgV a_ = args; asm volatile("" : "+s"(a_));
        float* Y = (float*)a_[13]; const float* X = xi >= 0 ? (const float*)a_[xi] : (const float*)Y;
        const float* st = xi >= 0 ? nullptr : (const float*)((const unsigned char*)a_[14] + st_off);
        const float* g = (const float*)a_[gi < 0 ? 0 : gi] + goff; const float* b = (const float*)a_[bi < 0 ? 0 : bi] + goff;
        const int row0 = u.pm * BM + wr * 64 + fr, col0 = u.pn * BM + wc * 32 + 4 * fq;
#pragma unroll
        for (int ai = 0; ai < 2; ++ai)
#pragma unroll
            for (int m = 0; m < 4; ++m) { const int r = row0 + ai * HALF + m * 16; const size_t off = (size_t)r * ldc + col0;
                float mean = 0.f, rstd = 1.f; if (st) { const f32x2 sv = *(const f32x2*)(st + 2 * (size_t)r); mean = sv.x; rstd = sv.y; }
#pragma unroll
                for (int bj = 0; bj < 2; ++bj)
#pragma unroll
                    for (int n = 0; n < 2; ++n) { f32x4 xv = *(const f32x4*)(X + off + bj * HALF + n * 16);
                        if (st) { const f32x4 gv = *(const f32x4*)(g + col0 + bj * HALF + n * 16), bv = *(const f32x4*)(b + col0 + bj * HALF + n * 16); xv = (xv - mean) * rstd * gv + bv; }
                        *(f32x4*)(Y + off + bj * HALF + n * 16) = xv * alpha + acc[ai][bj][m][n]; }
                asm volatile("" ::: "memory"); }
    }
};
struct EpiSwiglu {
    static constexpr bool PERM = true, AFTER_DRAIN = false;
    bf16_t* Hh; int ldh;
    __device__ __forceinline__ void operator()(const f32x4 (&acc)[2][2][4][2], const Unit& u, int wr, int wc, int fr, int fq) const {
        const int row0 = u.pm * BM + wr * 64 + fr, col0 = u.pn * HALF + wc * 32 + 8 * fq;
#pragma unroll
        for (int ai = 0; ai < 2; ++ai)
#pragma unroll
            for (int m = 0; m < 4; ++m) { bf16_t* rowp = Hh + (size_t)(row0 + ai * HALF + m * 16) * ldh + col0; float hv[8];
#pragma unroll
                for (int n = 0; n < 2; ++n)
#pragma unroll
                    for (int j = 0; j < 4; ++j) { const float g = acc[ai][0][m][n][j], up = acc[ai][1][m][n][j]; hv[n * 4 + j] = g * sigmoidf_fast(g) * up; }
                u32x4 w; w.x = cvt_pk_bf16(hv[0], hv[1]); w.y = cvt_pk_bf16(hv[2], hv[3]); w.z = cvt_pk_bf16(hv[4], hv[5]); w.w = cvt_pk_bf16(hv[6], hv[7]);
                *(u32x4*)rowp = w; }
    }
};
template <class Epi, class Sched, bool ALIGN_EPI = false, bool SP2 = false, bool FP8 = false>
__device__ __forceinline__ void gemm_phase(PG8_LAS unsigned char* lds, const Gemm g, const Sched& S, const Epi& E) {
    int tid_ = threadIdx.x; asm volatile("" : "+v"(tid_));
    const int tid = tid_, wid = __builtin_amdgcn_readfirstlane(tid >> 6), lane = tid & 63, wr = wid >> 2, wc = wid & 3, fr = lane & 15, fq = lane >> 4;
    const int K = g.K, nt = K / BK;
    unsigned voffA[2], voffB[2];
#pragma unroll
    for (int i = 0; i < 2; ++i) { int R, C; if constexpr (FP8) stage_rc8(tid * 16 + i * 8192, R, C); else stage_rc(tid * 16 + i * 8192, R, C); const int Rb = Epi::PERM ? ((R & ~31) + perm32(R & 31)) : R;
        voffA[i] = (unsigned)(R * K + C) * 2u; voffB[i] = (unsigned)(Rb * K + C) * 2u; }
    const size_t r64step = (size_t)64 * K * 2;
    const size_t kstep = (size_t)(BK * 2);
    const size_t hstep = (size_t)HALF * K * 2;
    const size_t tstep = 2 * hstep;
    const unsigned ldsw = (unsigned)wid * 1024u;
    const int aoff = FP8 ? lds_byte8(wr * 64 + fr, 2 * fq) : lds_byte(wr * 64 + fr, fq * 8), boff = FP8 ? lds_byte8(wc * 32 + fr, 2 * fq) : lds_byte(wc * 32 + fr, fq * 8);
    const int aoff1 = FP8 ? lds_byte8(wr * 64 + fr, 2 * fq + 1) : 0, boff1 = FP8 ? lds_byte8(wc * 32 + fr, 2 * fq + 1) : 0;
#define PG8_SA(b, h) (((b) * 2 + (h)) * HTB)
#define PG8_SB(b, h) ((4 + (b) * 2 + (h)) * HTB)
#define PG8_STAGE(bufoff, gbase, voff) do { _Pragma("unroll") for (int _i = 0; _i < 2; ++_i) { const char* _gb = (const char*)(gbase) + (size_t)_i * r64step; asm volatile("" : "+s"(_gb));     \
        __builtin_amdgcn_global_load_lds((const unsigned*)(_gb + (voff)[0]), (PG8_LAS unsigned*)(lds + (bufoff) + ldsw + _i * 8192), 16, 0, 0); } } while (0)
#define PG8_LD8(p_, q_) __builtin_shufflevector(*(const PG8_LAS v4i32*)(p_), *(const PG8_LAS v4i32*)(q_), 0, 1, 2, 3, 4, 5, 6, 7)
#define PG8_LDA(dst, b, h) do { if constexpr (FP8) { _Pragma("unroll") for (int m = 0; m < 4; ++m) dst##8[m] = PG8_LD8(lds + PG8_SA(b, h) + aoff + m * 2048, lds + PG8_SA(b, h) + aoff1 + m * 2048); } \
        else { _Pragma("unroll") for (int m = 0; m < 4; ++m) _Pragma("unroll") for (int k = 0; k < 2; ++k) dst[m][k] = *(const PG8_LAS bf16x8*)(lds + PG8_SA(b, h) + aoff + m * 2048 + k * 1024); } } while (0)
#define PG8_LDB(dst, b, h) do { if constexpr (FP8) { _Pragma("unroll") for (int n = 0; n < 2; ++n) dst##8[n] = PG8_LD8(lds + PG8_SB(b, h) + boff + n * 2048, lds + PG8_SB(b, h) + boff1 + n * 2048); } \
        else { _Pragma("unroll") for (int n = 0; n < 2; ++n) _Pragma("unroll") for (int k = 0; k < 2; ++k) dst[n][k] = *(const PG8_LAS bf16x8*)(lds + PG8_SB(b, h) + boff + n * 2048 + k * 1024); } } while (0)
#define PG8_MMA(ai, bj, At, Bt) do { __builtin_amdgcn_s_setprio(1); if constexpr (FP8) { _Pragma("unroll") for (int m = 0; m < 4; ++m) _Pragma("unroll") for (int n = 0; n < 2; ++n) \
            acc[ai][bj][m][n] = __builtin_amdgcn_mfma_scale_f32_16x16x128_f8f6f4(Bt##8[n], At##8[m], acc[ai][bj][m][n], 0, 0, 0, g.sw, 0, g.sx); } \
        else { _Pragma("unroll") for (int m = 0; m < 4; ++m) _Pragma("unroll") for (int n = 0; n < 2; ++n) _Pragma("unroll") for (int k = 0; k < 2; ++k) \
        acc[ai][bj][m][n] = __builtin_amdgcn_mfma_f32_16x16x32_bf16(Bt[n][k], At[m][k], acc[ai][bj][m][n], 0, 0, 0); } __builtin_amdgcn_s_setprio(0); } while (0)
#define PG8_WAIT_V(n) asm volatile("s_waitcnt vmcnt(" #n ")" ::: "memory")
#define PG8_WAIT_L(n) asm volatile("s_waitcnt lgkmcnt(" #n ")" ::: "memory")
#define PG8_BAR __builtin_amdgcn_s_barrier()
#define PG8_SCHED __builtin_amdgcn_sched_barrier(0)
    Unit cur, nxt; int ui = 0;
    if (!S.next(0, cur)) return;
    f32x4 acc[2][2][4][2];
#pragma unroll
    for (int a = 0; a < 2; ++a)
#pragma unroll
        for (int b = 0; b < 2; ++b)
#pragma unroll
            for (int m = 0; m < 4; ++m)
#pragma unroll
                for (int n = 0; n < 2; ++n) acc[a][b][m][n] = (f32x4){0.f, 0.f, 0.f, 0.f};
    bf16x8 At[4][2], B0[2][2], B1[2][2]; v8i32 At8[4], B08[2], B18[2];
    const char* cA = (const char*)g.A + (size_t)cur.pm * tstep; const char* cB = (const char*)g.Bt + (size_t)cur.pn * tstep;
    S.a_ready(cur);
    if constexpr (SP2) {
        PG8_STAGE(PG8_SB(0, 0), cB, voffB); PG8_STAGE(PG8_SB(0, 1), cB + hstep, voffB); PG8_STAGE(PG8_SA(0, 0), cA, voffA); PG8_STAGE(PG8_SA(0, 1), cA + hstep, voffA);
        if (wr == 1) PG8_BAR;
        PG8_WAIT_V(2); PG8_BAR;
        PG8_STAGE(PG8_SB(1, 0), cB + kstep, voffB); PG8_STAGE(PG8_SA(1, 0), cA + kstep, voffA); PG8_STAGE(PG8_SB(1, 1), cB + hstep + kstep, voffB);
        PG8_WAIT_V(6); PG8_BAR;
    } else {
        PG8_STAGE(PG8_SB(0, 0), cB, voffB); PG8_STAGE(PG8_SA(0, 0), cA, voffA); PG8_STAGE(PG8_SB(0, 1), cB + hstep, voffB); PG8_STAGE(PG8_SA(0, 1), cA + hstep, voffA);
        if (wr == 1) PG8_BAR;
        PG8_WAIT_V(4); PG8_BAR;
        PG8_STAGE(PG8_SB(1, 0), cB + kstep, voffB); PG8_STAGE(PG8_SA(1, 0), cA + kstep, voffA); PG8_STAGE(PG8_SB(1, 1), cB + hstep + kstep, voffB);
        PG8_WAIT_V(6); PG8_BAR;
    }
    for (;;) {
        const bool has_next = S.next(ui + 1, nxt);
        const char* nA = has_next ? (const char*)g.A + (size_t)nxt.pm * tstep : cA; const char* nB = has_next ? (const char*)g.Bt + (size_t)nxt.pn * tstep : cB;
        for (int t = 0; t < nt; t += 2) {
            const bool last = (t == nt - 2);
            const char* a1 = cA + (size_t)(t + 1) * kstep;
            const char* a2 = last ? nA : cA + (size_t)(t + 2) * kstep; const char* b2 = last ? nB : cB + (size_t)(t + 2) * kstep;
            const char* a3 = a2 + kstep; const char* b3 = b2 + kstep;
            if (last && has_next) S.a_ready(nxt);
            if constexpr (SP2) {
            PG8_LDB(B0, 0, 0); PG8_LDB(B1, 0, 1); PG8_SCHED; PG8_LDA(At, 0, 0); PG8_STAGE(PG8_SA(1, 1), a1 + hstep, voffA);
            PG8_WAIT_V(8); PG8_WAIT_L(0); PG8_BAR; PG8_MMA(0, 0, At, B0); PG8_MMA(0, 1, At, B1); PG8_BAR; PG8_SCHED;
            PG8_LDA(At, 0, 1); PG8_STAGE(PG8_SB(0, 0), b2, voffB); PG8_STAGE(PG8_SB(0, 1), b2 + hstep, voffB); PG8_STAGE(PG8_SA(0, 0), a2, voffA);
            PG8_WAIT_V(8); PG8_WAIT_L(0); PG8_BAR; PG8_MMA(1, 0, At, B0); PG8_MMA(1, 1, At, B1); PG8_BAR; PG8_SCHED;
            PG8_LDB(B0, 1, 0); PG8_LDB(B1, 1, 1); PG8_SCHED; PG8_LDA(At, 1, 0); PG8_STAGE(PG8_SA(0, 1), a2 + hstep, voffA);
            PG8_WAIT_V(8); PG8_WAIT_L(0); PG8_BAR; PG8_MMA(0, 0, At, B0); PG8_MMA(0, 1, At, B1); PG8_BAR; PG8_SCHED;
            PG8_LDA(At, 1, 1); PG8_STAGE(PG8_SB(1, 0), b3, voffB); PG8_STAGE(PG8_SB(1, 1), b3 + hstep, voffB); PG8_STAGE(PG8_SA(1, 0), a3, voffA);
            PG8_WAIT_V(8); PG8_WAIT_L(0); PG8_BAR; PG8_MMA(1, 0, At, B0); PG8_MMA(1, 1, At, B1); PG8_BAR; PG8_SCHED;
            } else {
            PG8_LDB(B0, 0, 0); PG8_SCHED; PG8_LDA(At, 0, 0); PG8_STAGE(PG8_SA(1, 1), a1 + hstep, voffA);
            PG8_WAIT_L(8); PG8_BAR; PG8_WAIT_L(0); PG8_MMA(0, 0, At, B0); PG8_BAR; PG8_SCHED;
            PG8_LDB(B1, 0, 1); PG8_STAGE(PG8_SB(0, 0), b2, voffB);
            PG8_BAR; PG8_WAIT_L(0); PG8_MMA(0, 1, At, B1); PG8_BAR;
            PG8_LDA(At, 0, 1); PG8_STAGE(PG8_SA(0, 0), a2, voffA);
            PG8_BAR; PG8_WAIT_L(0); PG8_MMA(1, 0, At, B0); PG8_BAR; PG8_SCHED;
            PG8_STAGE(PG8_SB(0, 1), b2 + hstep, voffB);
            PG8_WAIT_V(6); PG8_BAR; PG8_MMA(1, 1, At, B1); PG8_BAR;
            PG8_LDB(B0, 1, 0); PG8_SCHED; PG8_LDA(At, 1, 0); PG8_STAGE(PG8_SA(0, 1), a2 + hstep, voffA);
            PG8_WAIT_L(8); PG8_BAR; PG8_WAIT_L(0); PG8_MMA(0, 0, At, B0); PG8_BAR; PG8_SCHED;
            PG8_LDB(B1, 1, 1); PG8_STAGE(PG8_SB(1, 0), b3, voffB);
            PG8_BAR; PG8_WAIT_L(0); PG8_MMA(0, 1, At, B1); PG8_BAR;
            PG8_LDA(At, 1, 1); PG8_STAGE(PG8_SA(1, 0), a3, voffA);
            PG8_BAR; PG8_WAIT_L(0); PG8_MMA(1, 0, At, B0); PG8_BAR; PG8_SCHED;
            PG8_STAGE(PG8_SB(1, 1), b3 + hstep, voffB);
            PG8_WAIT_V(6); PG8_BAR; PG8_MMA(1, 1, At, B1); PG8_BAR;
            }
        }
        if constexpr (ALIGN_EPI) { if (wr == 0) PG8_BAR; }
        if constexpr (!Epi::AFTER_DRAIN) { int t2_ = threadIdx.x; asm volatile("" : "+v"(t2_)); const int fr_ = t2_ & 15, fq_ = (t2_ & 63) >> 4;
            E(acc, cur, wr, wc, fr_, fq_); S.done(cur); }
        if (!has_next) break;
#pragma unroll
        for (int a = 0; a < 2; ++a)
#pragma unroll
            for (int b = 0; b < 2; ++b)
#pragma unroll
                for (int m = 0; m < 4; ++m)
#pragma unroll
                    for (int n = 0; n < 2; ++n) acc[a][b][m][n] = (f32x4){0.f, 0.f, 0.f, 0.f};
        cur = nxt; cA = nA; cB = nB; ++ui;
        if constexpr (ALIGN_EPI) { if (wr == 1) PG8_BAR; }
    }
    PG8_WAIT_V(0);
    if constexpr (!ALIGN_EPI) { if (wr == 0) PG8_BAR; }
    PG8_BAR;
    if constexpr (Epi::AFTER_DRAIN) { E.fused(acc, cur, wr, wc, fr, fq, lds, wid, lane); S.done(cur); }
#undef PG8_SA
#undef PG8_SB
#undef PG8_STAGE
#undef PG8_LD8
#undef PG8_LDA
#undef PG8_LDB
#undef PG8_MMA
#undef PG8_WAIT_V
#undef PG8_WAIT_L
#undef PG8_BAR
#undef PG8_SCHED
}
}

#ifndef PROBE_MASK
#define PROBE_MASK 0
#endif
#ifndef EN_INPROJ
#define EN_INPROJ 1
#endif
#ifndef EN_GATE
#define EN_GATE 1
#endif
#ifndef EN_RESID
#define EN_RESID 1
#endif
#ifndef EN_SWIGLU
#define EN_SWIGLU 1
#endif
#ifndef EN_ATTN
#define EN_ATTN 1
#endif
#ifndef EN_PRO
#define EN_PRO 1
#endif
#define LAS __attribute__((address_space(3)))
typedef unsigned short bf16;
typedef short bf16x8 __attribute__((ext_vector_type(8)));
typedef short s16x4 __attribute__((ext_vector_type(4)));
typedef float f32x4 __attribute__((ext_vector_type(4)));
typedef float f32x16 __attribute__((ext_vector_type(16)));
typedef unsigned u32x4 __attribute__((ext_vector_type(4)));
typedef unsigned u32x2 __attribute__((ext_vector_type(2)));

constexpr int T = 32768, TH = 16384, D = 2048, CIN = 10240, DFF = 5632, NUP = 11264, SEQ = 16384;
constexpr int NWAVES = 8, NTHREADS = 512;
constexpr float ALPHA = 1.41421356237309515f;
constexpr float LN_EPS = 1e-5f;
constexpr float LOG2E = 1.4426950408889634f;
constexpr int LDS_BYTES = 163840, LDS_BARST = 163824;
constexpr int NPHASES = 27;

constexpr size_t MiB = (size_t)1 << 20;
constexpr size_t WS_TAB = 0;
constexpr size_t WS_BAR = 256 * 1024;
constexpr size_t WS_W0 = 1 * MiB, WS_WL = 120 * MiB;
constexpr size_t WO_IN = 0, WO_PA = WO_IN + (size_t)CIN * D, WO_PB = WO_PA + (size_t)D * 512, WO_OUT = WO_PB + (size_t)D * 1024, WO_UP = WO_OUT + (size_t)D * D,
                 WO_DN = WO_UP + (size_t)NUP * D, WO_END = WO_DN + (size_t)D * DFF;
static_assert(WO_END * 2 <= WS_WL, "weight block");
constexpr size_t WS_XB = 241 * MiB;
constexpr size_t WS_PROJ = 369 * MiB;
constexpr size_t WS_AR = 689 * MiB;
constexpr size_t WS_LSE = 737 * MiB;
constexpr size_t WS_AO = 738 * MiB;
constexpr size_t WS_BO = 754 * MiB;
constexpr size_t WS_H = 369 * MiB;
constexpr size_t WS_X8 = 800 * MiB;
constexpr size_t WS_ST = 864 * MiB;
constexpr size_t WS_END = 865 * MiB;

struct Params;
typedef const __attribute__((address_space(4))) Params* PP;
struct Params {
    const float* x; const float* rel_bias; const float* w_in; const float* sink; const float* w_pa; const float* w_pb; const float* w_out;
    const float* ln1_g; const float* ln1_b; const float* w_up; const float* w_down; const float* ln2_g; const float* ln2_b;
    float* out; unsigned char* ws; int ph_lo, ph_hi;
};

__device__ __forceinline__ unsigned pk2(float a, float b) { return pg8::cvt_pk_bf16(a, b); }
__device__ __forceinline__ float shx(float v, int o, int lane) { return __int_as_float(__builtin_amdgcn_ds_bpermute((lane ^ o) << 2, __float_as_int(v))); }
__device__ __forceinline__ float wave_sum(float v, int lane) {
#pragma unroll
    for (int o = 1; o < 64; o <<= 1) v += shx(v, o, lane);
    return v;
}
#define LDS_WAIT() asm volatile("s_waitcnt lgkmcnt(0)" ::: "memory")

#define XB_TMO      128
#define XB_XCNT(j)  (256  + 64 * (j))
#define XB_XSUB(j)  (1280 + 64 * (j))
#define XB_XGEN(j)  (2304 + 64 * (j))
#define XB_TOP      3328
#define XB_TOPGEN   3392
#define XCD_BAR_WORDS 3456
#define XB_SPIN_CAP (1u << 18)

__device__ __forceinline__ unsigned xb_ld(unsigned* p)              { return __hip_atomic_load(p, __ATOMIC_RELAXED, __HIP_MEMORY_SCOPE_AGENT); }
__device__ __forceinline__ unsigned xb_add(unsigned* p, unsigned v) { return __hip_atomic_fetch_add(p, v, __ATOMIC_RELAXED, __HIP_MEMORY_SCOPE_AGENT); }
__device__ __forceinline__ unsigned xb_xcc_id() { return (unsigned)__builtin_amdgcn_s_getreg((3 << 11) | 20) & 0xFu; }
#define XB_SPIN(cond, bar) do { unsigned _sp = 0; while (cond) { __builtin_amdgcn_s_sleep(1); \
    if ((++_sp & 255u) == 0u) { if (xb_ld(&(bar)[XB_TMO])) break; if (_sp > XB_SPIN_CAP) { atomicAdd(&(bar)[XB_TMO], 1u); break; } } } } while (0)

struct XcdBarrier {
    unsigned* bar; unsigned x;
    volatile LAS unsigned* st;
};

__device__ __forceinline__ XcdBarrier xcd_barrier_post(unsigned* bar, volatile LAS unsigned* st) {
    XcdBarrier b; b.bar = bar; b.x = xb_xcc_id(); b.st = st;
    if (threadIdx.x == 0) (void)xb_add(&bar[XB_XCNT(b.x)], 1u);
    return b;
}
__device__ __forceinline__ void xcd_barrier_complete(unsigned* bar, unsigned x, unsigned& nloc, unsigned& nx) {
    const unsigned G = gridDim.x * gridDim.y * gridDim.z;
    unsigned sum, cnt, mine, sp = 0u;
    for (;;) {
        sum = 0u; cnt = 0u; mine = 0u;
#pragma unroll
        for (unsigned j = 0; j < 16; ++j) { const unsigned c = xb_ld(&bar[XB_XCNT(j)]); sum += c; cnt += (c > 0u) ? 1u : 0u; mine = (j == x) ? c : mine; }
        if (sum == G) break;
        __builtin_amdgcn_s_sleep(1);
        if ((++sp & 255u) == 0u) { if (xb_ld(&bar[XB_TMO])) break; if (sp > XB_SPIN_CAP) { atomicAdd(&bar[XB_TMO], 1u); break; } }
    }
    nloc = mine > 0u ? mine : 1u; nx = cnt > 0u ? cnt : 1u;
}

__device__ __forceinline__ void xcd_barrier(const XcdBarrier& b) {
    asm volatile("s_waitcnt vmcnt(0)" ::: "memory");
    __syncthreads();
    if (threadIdx.x == 0) {
        unsigned* bar = b.bar;
        __builtin_amdgcn_s_waitcnt(0);
        unsigned nloc = b.st[0], nx = b.st[1];
        if (nloc == 0u) { xcd_barrier_complete(bar, b.x, nloc, nx); b.st[0] = nloc; b.st[1] = nx; }
        const unsigned old = xb_add(&bar[XB_XSUB(b.x)], 1u);
        const unsigned gen = old / nloc;
        if (old + 1u == (gen + 1u) * nloc) {
            __builtin_amdgcn_fence(__ATOMIC_RELEASE, "agent");
            asm volatile("s_waitcnt vmcnt(0)" ::: "memory");
            const unsigned og = xb_add(&bar[XB_TOP], 1u);
            const unsigned tg = og / nx;
            if (og + 1u == (tg + 1u) * nx) xb_add(&bar[XB_TOPGEN], 1u);
            else XB_SPIN(xb_ld(&bar[XB_TOPGEN]) == tg, bar);
            __builtin_amdgcn_fence(__ATOMIC_ACQUIRE, "agent");
            xb_add(&bar[XB_XGEN(b.x)], 1u);
            asm volatile("s_waitcnt vmcnt(0)" ::: "memory");
        } else {
            XB_SPIN(xb_ld(&bar[XB_XGEN(b.x)]) == gen, bar);
            __builtin_amdgcn_fence(__ATOMIC_ACQUIRE, "agent");
            asm volatile("s_waitcnt vmcnt(0)" ::: "memory");
        }
    }
    __syncthreads();
}


__device__ __forceinline__ void transpose_item(const float* __restrict__ W, int K, int N, bf16* WT, int k0, int n0, int row0, LAS float* scr, int lane) {
    { f32x4 tv[8];
#pragma unroll
      for (int i = 0; i < 8; ++i) tv[i] = *(const f32x4*)(W + (size_t)(k0 + 8 * i + (lane >> 3)) * N + n0 + 4 * (lane & 7));
#pragma unroll
      for (int i = 0; i < 8; ++i) { LAS float* d_ = scr + (8 * i + (lane >> 3)) * 33 + 4 * (lane & 7); d_[0] = tv[i][0]; d_[1] = tv[i][1]; d_[2] = tv[i][2]; d_[3] = tv[i][3]; } }
    LDS_WAIT();
    const int c = lane & 7;
#pragma unroll
    for (int j = 0; j < 4; ++j) { const int n = (lane >> 3) + 8 * j; const LAS float* s = scr + (8 * c) * 33 + n;
        u32x4 o; o.x = pk2(s[0 * 33], s[1 * 33]); o.y = pk2(s[2 * 33], s[3 * 33]); o.z = pk2(s[4 * 33], s[5 * 33]); o.w = pk2(s[6 * 33], s[7 * 33]);
        *(u32x4*)(WT + (size_t)(row0 + n) * K + k0 + 8 * c) = o; }
    LDS_WAIT();
}
using pg8::pk4_fp8;
__device__ __forceinline__ void transpose_item_fp8(const float* __restrict__ W, int K, int N, unsigned char* WT, int k0, int n0, LAS float* scr, int lane, float scale) {
    { f32x4 tv[8];
#pragma unroll
      for (int i = 0; i < 8; ++i) tv[i] = *(const f32x4*)(W + (size_t)(k0 + 8 * i + (lane >> 3)) * N + n0 + 4 * (lane & 7));
#pragma unroll
      for (int i = 0; i < 8; ++i) { LAS float* d_ = scr + (8 * i + (lane >> 3)) * 33 + 4 * (lane & 7); d_[0] = tv[i][0]; d_[1] = tv[i][1]; d_[2] = tv[i][2]; d_[3] = tv[i][3]; } }
    LDS_WAIT();
    const int n = lane >> 1, kh = lane & 1; const LAS float* sp = scr + (32 * kh) * 33 + n;
    u32x4 o0, o1;
    o0.x = pk4_fp8(sp[0 * 33] * scale, sp[1 * 33] * scale, sp[2 * 33] * scale, sp[3 * 33] * scale); o0.y = pk4_fp8(sp[4 * 33] * scale, sp[5 * 33] * scale, sp[6 * 33] * scale, sp[7 * 33] * scale);
    o0.z = pk4_fp8(sp[8 * 33] * scale, sp[9 * 33] * scale, sp[10 * 33] * scale, sp[11 * 33] * scale); o0.w = pk4_fp8(sp[12 * 33] * scale, sp[13 * 33] * scale, sp[14 * 33] * scale, sp[15 * 33] * scale);
    o1.x = pk4_fp8(sp[16 * 33] * scale, sp[17 * 33] * scale, sp[18 * 33] * scale, sp[19 * 33] * scale); o1.y = pk4_fp8(sp[20 * 33] * scale, sp[21 * 33] * scale, sp[22 * 33] * scale, sp[23 * 33] * scale);
    o1.z = pk4_fp8(sp[24 * 33] * scale, sp[25 * 33] * scale, sp[26 * 33] * scale, sp[27 * 33] * scale); o1.w = pk4_fp8(sp[28 * 33] * scale, sp[29 * 33] * scale, sp[30 * 33] * scale, sp[31 * 33] * scale);
    unsigned char* dst = WT + (size_t)(n0 + n) * K + k0 + 32 * kh;
    *(u32x4*)dst = o0; *(u32x4*)(dst + 16) = o1;
    LDS_WAIT();
}
__device__ __forceinline__ int t5_bucket(int rel) {
    const int n = rel < 0 ? -rel : rel; int b;
    if (n < 8) b = n; else { const int e = (int)(__builtin_log2f((float)n * 0.125f) * (8.0f / 7.0f)); b = 8 + e; if (b > 15) b = 15; }
    return b + (rel > 0 ? 16 : 0);
}
__device__ __forceinline__ void phase_prologue(PP pp, LAS unsigned char* lds, int gw, int NGW, int wave, int lane) {
    LAS float* scr = (LAS float*)(lds + wave * 16384);
    constexpr int I_IN = (D / 64) * (CIN / 32), I_PA = (512 / 64) * (D / 32), I_PB = (1024 / 64) * (D / 32), I_OUT = (D / 64) * (D / 32), I_UP = (D / 64) * (NUP / 32), I_DN = (DFF / 64) * (D / 32);
    constexpr int I_LAYER = I_IN + I_PA + I_PB + I_OUT + I_UP + I_DN;
    for (int it = gw; it < 2 * I_LAYER; it += NGW) {
        const int l = it / I_LAYER; int r = it - l * I_LAYER;
        bf16* wl = (bf16*)(pp->ws + WS_W0 + (size_t)l * WS_WL);
        const float* W; int K, N; bf16* WT; bool up = false, r0_in = false;
        if (r < I_IN) { W = pp->w_in + (size_t)l * D * CIN; K = D; N = CIN; WT = wl + WO_IN; r0_in = true; }
        else if ((r -= I_IN) < I_PA) { r0_in = true; W = pp->w_pa + (size_t)l * 512 * D; K = 512; N = D; WT = wl + WO_PA; }
        else if ((r -= I_PA) < I_PB) { r0_in = true; W = pp->w_pb + (size_t)l * 1024 * D; K = 1024; N = D; WT = wl + WO_PB; }
        else if ((r -= I_PB) < I_OUT) { r0_in = true; W = pp->w_out + (size_t)l * D * D; K = D; N = D; WT = wl + WO_OUT; }
        else if ((r -= I_OUT) < I_UP) { W = pp->w_up + (size_t)l * D * NUP; K = D; N = NUP; WT = wl + WO_UP; up = true; }
        else { r -= I_UP; W = pp->w_down + (size_t)l * DFF * D; K = DFF; N = D; WT = wl + WO_DN; }
        const int nblk = N / 32, kb = r / nblk, nb = r - kb * nblk, n0 = 32 * nb;
        int row0 = n0;
        if (up) { const int j0 = n0 < DFF ? n0 : n0 - DFF; row0 = (j0 >> 7) * 256 + (n0 < DFF ? 0 : 128) + (j0 & 127); }
        if (r0_in) transpose_item_fp8(W, K, N, (unsigned char*)WT, 64 * kb, n0, scr, lane, 128.0f);
        else transpose_item(W, K, N, WT, 64 * kb, n0, row0, scr, lane);
    }
    { const size_t gt = (size_t)gw * 64 + lane, NT = (size_t)NGW * 64; unsigned char* x8 = pp->ws + WS_X8;
      for (size_t i = gt; i < (size_t)T * D / 16; i += NT) { const f32x4 a = *(const f32x4*)(pp->x + i * 16) * 32.f, b = *(const f32x4*)(pp->x + i * 16 + 4) * 32.f, c = *(const f32x4*)(pp->x + i * 16 + 8) * 32.f, d = *(const f32x4*)(pp->x + i * 16 + 12) * 32.f;
          u32x4 o; o.x = pk4_fp8(a[0], a[1], a[2], a[3]); o.y = pk4_fp8(b[0], b[1], b[2], b[3]); o.z = pk4_fp8(c[0], c[1], c[2], c[3]); o.w = pk4_fp8(d[0], d[1], d[2], d[3]); *(u32x4*)(x8 + i * 16) = o; } }
    if (blockIdx.x == 0) { unsigned* barw = (unsigned*)(pp->ws + WS_BAR); for (int i = threadIdx.x; i < XCD_BAR_WORDS; i += NTHREADS) barw[i] = 0u; }
    { float* tabA = (float*)(pp->ws + WS_TAB); float* tabB = (float*)(pp->ws + WS_TAB + 8192);
      const int gt = gw * 64 + lane;
      if (gt < 12 * 129) { const int hh = gt / 129, i = gt - hh * 129, g = hh >> 2, dil = g == 0 ? 1 : (g == 1 ? 4 : 16); tabA[hh * 132 + i] = pp->rel_bias[t5_bucket((i - 64) * dil) * 20 + hh] * LOG2E; }
      else if (gt < 12 * 129 + 8 * 257) { const int q = gt - 12 * 129, hh = q / 257, i = q - hh * 257; tabB[hh * 260 + i] = pp->rel_bias[t5_bucket(i - 128) * 20 + 12 + hh] * LOG2E; } }
}

constexpr int AT_KS = 0, AT_VS = 8704, AT_TAB = 8704 + 10240, AT_WAVE_BYTES = 8704 + 10240 + 1296;
static_assert(AT_WAVE_BYTES * NWAVES <= LDS_BYTES, "attention LDS");
#define TR4(r0, r1, r2, r3, base, o0, o1, o2, o3) asm volatile("ds_read_b64_tr_b16 %0, %4 offset:%5\n\tds_read_b64_tr_b16 %1, %4 offset:%6\n\tds_read_b64_tr_b16 %2, %4 offset:%7\n\tds_read_b64_tr_b16 %3, %4 offset:%8\n\ts_waitcnt lgkmcnt(0)" \
    : "=&v"(r0), "=&v"(r1), "=&v"(r2), "=&v"(r3) : "v"(base), "i"(o0), "i"(o1), "i"(o2), "i"(o3) : "memory")
#define PK8(L, Hh) (bf16x8){L[0], L[1], L[2], L[3], Hh[0], Hh[1], Hh[2], Hh[3]}

struct AtItem { int qcol, kcol, vcol, r, dil, sub_len, q0, W, nkt, T0, toff, NT, o_ld, ocol, lse_idx, o8; const float* tab; float m0; int sink; unsigned char* O; float* lse; };
constexpr int AT_NA = 12 * 64, AT_NB = 2 * 256;
__device__ __forceinline__ AtItem at_decode(int i, int wave, int layer, unsigned char* ws, const float* sinkp) {
    AtItem I; const float* tabA = (const float*)(ws + WS_TAB); const float* tabB = (const float*)(ws + WS_TAB + 8192);
    if (i < AT_NA) {
        const int hh = i >> 6, idx = i & 63, g = hh >> 2;
        I.dil = g == 0 ? 1 : (g == 1 ? 4 : 16); const int nbr = 64 / I.dil; I.r = idx / nbr; const int qb = idx - I.r * nbr; I.sub_len = SEQ / I.dil;
        I.q0 = qb * 256 + 32 * wave; I.T0 = qb * 256 - 64; I.toff = wave; I.NT = 12; I.nkt = 5; I.W = 64;
        I.qcol = hh * 128; I.kcol = 1536 + hh * 128; I.vcol = 3072 + hh * 128; I.tab = tabA + hh * 132; I.m0 = -1e30f; I.sink = 0;
        I.O = ws + WS_AR; I.o_ld = 1536; I.ocol = hh * 128; I.lse = (float*)(ws + WS_LSE); I.lse_idx = hh; I.o8 = 0;
    } else {
        const int b = i - AT_NA, kvh = b >> 8, qp = b & 255, j = wave >> 2, rep = wave & 3, qh = kvh * 4 + rep;
        I.dil = 1; I.r = 0; I.sub_len = SEQ; I.q0 = qp * 64 + 32 * j; I.T0 = qp * 64 - 128; I.toff = j; I.NT = 10; I.nkt = 9; I.W = 128;
        I.qcol = 4608 + qh * 128; I.kcol = 5632 + kvh * 128; I.vcol = 5888 + kvh * 128; I.tab = tabB + qh * 260; I.m0 = sinkp[layer * 8 + qh] * LOG2E; I.sink = 1;
        I.O = ws + WS_BO; I.o_ld = 1024; I.ocol = qh * 128; I.lse = nullptr; I.lse_idx = 0; I.o8 = 1;
    }
    return I;
}
__device__ __forceinline__ void phase_attention(unsigned char* ws, const float* sinkp, LAS unsigned char* lds, int layer, int vcu, int G, int wave, int lane) {
    const bf16* P = (const bf16*)(ws + WS_PROJ);
    const int hl = lane >> 5, ql = lane & 31, lrow = lane >> 4, lch = lane & 15;
    LAS float* tabs = (LAS float*)(lds + wave * AT_WAVE_BYTES + AT_TAB);
    const float c = 0.08838834764831845f * LOG2E;
    const unsigned vlane = (unsigned)((4 * hl + ((lane & 15) >> 2)) * 320 + (16 * ((lane >> 4) & 1) + 4 * (lane & 3)) * 2);
    const int klane = ql * 272 + 16 * hl;
    const int wrow = 4 * wave + lrow;
    bf16x8 qf[8]; u32x4 kreg[8], vreg[8], kn, vn; float tv[6];
#define AT_EDGE(I, kt_) ((I.q0 - I.W + 32 * (kt_) < 0) || (I.q0 - I.W + 32 * (kt_) + 31 >= I.sub_len))
#define AT_TOFF(I, t) ({ int sub = I.T0 + 32 * (t) + wrow; sub = sub < 0 ? 0 : (sub >= I.sub_len ? I.sub_len - 1 : sub); (unsigned)(I.r + sub * I.dil) * (unsigned)(CIN * 2) + 16u * lch; })
#define AT_FILL(I) do { const char* Pk = (const char*)(P + I.kcol); const char* Pv = (const char*)(P + I.vcol); \
        _Pragma("unroll") for (int t = 0; t < 8; ++t) { const unsigned o_ = AT_TOFF(I, t); kreg[t] = *(const u32x4*)(Pk + o_); vreg[t] = *(const u32x4*)(Pv + o_); } } while (0)
#define AT_WRITEFILL() do { _Pragma("unroll") for (int t = 0; t < 8; ++t) { *(LAS u32x4*)(lds + t * AT_WAVE_BYTES + AT_KS + wrow * 272 + 16 * lch) = kreg[t]; *(LAS u32x4*)(lds + t * AT_WAVE_BYTES + AT_VS + wrow * 320 + 16 * lch) = vreg[t]; } } while (0)
#define AT_LOADQ(I) do { const bf16* qp = P + (size_t)(I.r + (I.q0 + ql) * I.dil) * CIN + I.qcol + 8 * hl; _Pragma("unroll") for (int s = 0; s < 8; ++s) qf[s] = *(const bf16x8*)(qp + 16 * s); } while (0)
#define AT_LOADTAB(I) do { _Pragma("unroll") for (int u = 0; u < 6; ++u) { const int src = lane + 64 * u - 32; const int sc_ = src < 0 ? 0 : (src > 2 * I.W ? 2 * I.W : src); tv[u] = I.tab[sc_]; } } while (0)
#define AT_STORETAB(I) do { _Pragma("unroll") for (int u = 0; u < 6; ++u) { const int i_ = lane + 64 * u, src = i_ - 32; if (i_ < 2 * I.W + 65) tabs[i_] = (src >= 0 && src <= 2 * I.W) ? tv[u] : -__builtin_inff(); } } while (0)
    constexpr int NTOT = AT_NA + AT_NB;
    int it = vcu; if (it >= NTOT) return;
    AtItem cur = at_decode(it, wave, layer, ws, sinkp);
    AT_LOADTAB(cur); AT_LOADQ(cur); AT_FILL(cur); AT_STORETAB(cur); AT_WRITEFILL();
    __syncthreads();
    for (;;) {
        const int itn = it + G; const bool has_next = itn < NTOT;
        const AtItem nxt = at_decode(has_next ? itn : it, wave, layer, ws, sinkp);
        f32x16 o0, o1, o2, o3;
#pragma unroll
        for (int i = 0; i < 16; ++i) { o0[i] = 0.f; o1[i] = 0.f; o2[i] = 0.f; o3[i] = 0.f; }
        float m = cur.m0, l = (cur.sink && lane < 32) ? 1.f : 0.f;
        const int nkt = cur.nkt;
        for (int kt = 0; kt < nkt; ++kt) {
            const bool last = (kt == nkt - 1);
            const int tn = 8 + kt; const bool newt = tn < cur.NT;
            if (newt) { const unsigned o_ = AT_TOFF(cur, tn); kn = *(const u32x4*)((const char*)(P + cur.kcol) + o_); vn = *(const u32x4*)((const char*)(P + cur.vcol) + o_); }
            const int sl = (cur.toff + kt) & 7;
            const LAS unsigned char* kb = lds + sl * AT_WAVE_BYTES + AT_KS + klane;
            const unsigned vb = (unsigned)(uintptr_t)(lds + sl * AT_WAVE_BYTES + AT_VS) + vlane;
            f32x16 sc;
#pragma unroll
            for (int i = 0; i < 16; ++i) sc[i] = 0.f;
#pragma unroll
            for (int s = 0; s < 8; ++s) { const bf16x8 kf = *(const LAS bf16x8*)(kb + 32 * s); sc = __builtin_amdgcn_mfma_f32_32x32x16_bf16(kf, qf[s], sc, 0, 0, 0); }
            if (last && has_next) AT_LOADQ(nxt);
            const LAS float* tb = tabs + (32 * kt - ql + 4 * hl + 32);
#pragma unroll
            for (int i = 0; i < 16; ++i) { sc[i] = fmaf(sc[i], c, tb[8 * (i >> 2) + (i & 3)]); }
            if (last && has_next) AT_LOADTAB(nxt);
            if (AT_EDGE(cur, kt)) {
                const int ks0 = cur.q0 - cur.W + 32 * kt + 4 * hl;
#pragma unroll
                for (int i = 0; i < 16; ++i) { const int ks = ks0 + 8 * (i >> 2) + (i & 3); if (ks < 0 || ks >= cur.sub_len) sc[i] = -__builtin_inff(); }
            }
            float tmax = -__builtin_inff();
#pragma unroll
            for (int i = 0; i < 16; ++i) tmax = fmaxf(tmax, sc[i]);
            tmax = fmaxf(tmax, shx(tmax, 32, lane));
            if (__builtin_amdgcn_ballot_w64(tmax > m + 8.0f) != 0ull) {
                const float mn = fmaxf(m, tmax), alpha = __builtin_amdgcn_exp2f(m - mn); m = mn; l *= alpha;
#pragma unroll
                for (int i = 0; i < 16; ++i) { o0[i] *= alpha; o1[i] *= alpha; o2[i] *= alpha; o3[i] *= alpha; }
            }
            float ps = 0.f;
#pragma unroll
            for (int i = 0; i < 16; ++i) { sc[i] = __builtin_amdgcn_exp2f(sc[i] - m); ps += sc[i]; }
            l += ps;
            bf16x8 p0, p1;
            { u32x4 w0, w1; w0.x = pk2(sc[0], sc[1]); w0.y = pk2(sc[2], sc[3]); w0.z = pk2(sc[4], sc[5]); w0.w = pk2(sc[6], sc[7]);
              w1.x = pk2(sc[8], sc[9]); w1.y = pk2(sc[10], sc[11]); w1.z = pk2(sc[12], sc[13]); w1.w = pk2(sc[14], sc[15]);
              p0 = *reinterpret_cast<bf16x8*>(&w0); p1 = *reinterpret_cast<bf16x8*>(&w1); }
            { s16x4 a0, a1, b0, b1;
              TR4(a0, a1, b0, b1, vb, 0, 2560, 5120, 7680); __builtin_amdgcn_sched_barrier(0);
              o0 = __builtin_amdgcn_mfma_f32_32x32x16_bf16(PK8(a0, a1), p0, o0, 0, 0, 0); o0 = __builtin_amdgcn_mfma_f32_32x32x16_bf16(PK8(b0, b1), p1, o0, 0, 0, 0);
              TR4(a0, a1, b0, b1, vb, 64, 64 + 2560, 64 + 5120, 64 + 7680); __builtin_amdgcn_sched_barrier(0);
              o1 = __builtin_amdgcn_mfma_f32_32x32x16_bf16(PK8(a0, a1), p0, o1, 0, 0, 0); o1 = __builtin_amdgcn_mfma_f32_32x32x16_bf16(PK8(b0, b1), p1, o1, 0, 0, 0);
              TR4(a0, a1, b0, b1, vb, 128, 128 + 2560, 128 + 5120, 128 + 7680); __builtin_amdgcn_sched_barrier(0);
              o2 = __builtin_amdgcn_mfma_f32_32x32x16_bf16(PK8(a0, a1), p0, o2, 0, 0, 0); o2 = __builtin_amdgcn_mfma_f32_32x32x16_bf16(PK8(b0, b1), p1, o2, 0, 0, 0);
              TR4(a0, a1, b0, b1, vb, 192, 192 + 2560, 192 + 5120, 192 + 7680); __builtin_amdgcn_sched_barrier(0);
              o3 = __builtin_amdgcn_mfma_f32_32x32x16_bf16(PK8(a0, a1), p0, o3, 0, 0, 0); o3 = __builtin_amdgcn_mfma_f32_32x32x16_bf16(PK8(b0, b1), p1, o3, 0, 0, 0); }
            if (newt) {
                __syncthreads();
                *(LAS u32x4*)(lds + (tn & 7) * AT_WAVE_BYTES + AT_KS + wrow * 272 + 16 * lch) = kn; *(LAS u32x4*)(lds + (tn & 7) * AT_WAVE_BYTES + AT_VS + wrow * 320 + 16 * lch) = vn;
                __syncthreads();
            }
        }
        const float lt = l + shx(l, 32, lane), inv = 1.0f / lt;
        const size_t tok = (size_t)(cur.r + (cur.q0 + ql) * cur.dil);
        if (cur.o8) {
            unsigned char* op = cur.O + tok * cur.o_ld + cur.ocol + 4 * hl; const float i64 = inv * 64.f;
#pragma unroll
            for (int g = 0; g < 4; ++g) {
                *(unsigned*)(op + 8 * g) = pk4_fp8(o0[4 * g] * i64, o0[4 * g + 1] * i64, o0[4 * g + 2] * i64, o0[4 * g + 3] * i64);
                *(unsigned*)(op + 32 + 8 * g) = pk4_fp8(o1[4 * g] * i64, o1[4 * g + 1] * i64, o1[4 * g + 2] * i64, o1[4 * g + 3] * i64);
                *(unsigned*)(op + 64 + 8 * g) = pk4_fp8(o2[4 * g] * i64, o2[4 * g + 1] * i64, o2[4 * g + 2] * i64, o2[4 * g + 3] * i64);
                *(unsigned*)(op + 96 + 8 * g) = pk4_fp8(o3[4 * g] * i64, o3[4 * g + 1] * i64, o3[4 * g + 2] * i64, o3[4 * g + 3] * i64);
            }
        } else {
            bf16* op = (bf16*)cur.O + tok * cur.o_ld + cur.ocol + 4 * hl;
#pragma unroll
            for (int g = 0; g < 4; ++g) {
                u32x2 w;
                w.x = pk2(o0[4 * g] * inv, o0[4 * g + 1] * inv); w.y = pk2(o0[4 * g + 2] * inv, o0[4 * g + 3] * inv); *(u32x2*)(op + 8 * g) = w;
                w.x = pk2(o1[4 * g] * inv, o1[4 * g + 1] * inv); w.y = pk2(o1[4 * g + 2] * inv, o1[4 * g + 3] * inv); *(u32x2*)(op + 32 + 8 * g) = w;
                w.x = pk2(o2[4 * g] * inv, o2[4 * g + 1] * inv); w.y = pk2(o2[4 * g + 2] * inv, o2[4 * g + 3] * inv); *(u32x2*)(op + 64 + 8 * g) = w;
                w.x = pk2(o3[4 * g] * inv, o3[4 * g + 1] * inv); w.y = pk2(o3[4 * g + 2] * inv, o3[4 * g + 3] * inv); *(u32x2*)(op + 96 + 8 * g) = w;
            }
        }
        if (cur.lse && hl == 0) cur.lse[tok * 12 + cur.lse_idx] = m + __builtin_log2f(lt);
        if (!has_next) break;
        AT_FILL(nxt);
        __syncthreads();
        AT_STORETAB(nxt); AT_WRITEFILL();
        __syncthreads();
        cur = nxt; it = itn;
    }
    LDS_WAIT();
#undef AT_FILL
#undef AT_WRITEFILL
#undef AT_TOFF
#undef AT_LOADQ
#undef AT_LOADTAB
#undef AT_STORETAB
#undef AT_EDGE
}

__device__ __forceinline__ void phase_amerge(unsigned char* ws, int gw, int NGW, int lane) {
    const bf16* AR = (const bf16*)(ws + WS_AR); const float* LSE = (const float*)(ws + WS_LSE); unsigned char* AO8 = ws + WS_AO;
    const size_t gt = (size_t)gw * 64 + lane, NT = (size_t)NGW * 64;
    for (size_t i = gt; i < (size_t)TH * 64; i += NT) {
        const size_t t = i >> 6; const int ch = (int)(i & 63), h = ch >> 4, dc = ch & 15;
        const float l0 = LSE[t * 12 + h], l1 = LSE[t * 12 + 4 + h], l2 = LSE[t * 12 + 8 + h];
        const float mx = fmaxf(l0, fmaxf(l1, l2));
        float w0 = __builtin_amdgcn_exp2f(l0 - mx), w1 = __builtin_amdgcn_exp2f(l1 - mx), w2 = __builtin_amdgcn_exp2f(l2 - mx);
        const float inv = 1.0f / (w0 + w1 + w2); w0 *= inv; w1 *= inv; w2 *= inv;
        const bf16* ap = AR + t * 1536 + h * 128 + dc * 8;
        const u32x4 a = *(const u32x4*)ap, b = *(const u32x4*)(ap + 512), cc = *(const u32x4*)(ap + 1024);
        w0 *= 64.f; w1 *= 64.f; w2 *= 64.f;
        u32x2 o;
        o.x = pk4_fp8(w0 * pg8::bf_lo(a.x) + w1 * pg8::bf_lo(b.x) + w2 * pg8::bf_lo(cc.x), w0 * pg8::bf_hi(a.x) + w1 * pg8::bf_hi(b.x) + w2 * pg8::bf_hi(cc.x),
                      w0 * pg8::bf_lo(a.y) + w1 * pg8::bf_lo(b.y) + w2 * pg8::bf_lo(cc.y), w0 * pg8::bf_hi(a.y) + w1 * pg8::bf_hi(b.y) + w2 * pg8::bf_hi(cc.y));
        o.y = pk4_fp8(w0 * pg8::bf_lo(a.z) + w1 * pg8::bf_lo(b.z) + w2 * pg8::bf_lo(cc.z), w0 * pg8::bf_hi(a.z) + w1 * pg8::bf_hi(b.z) + w2 * pg8::bf_hi(cc.z),
                      w0 * pg8::bf_lo(a.w) + w1 * pg8::bf_lo(b.w) + w2 * pg8::bf_lo(cc.w), w0 * pg8::bf_hi(a.w) + w1 * pg8::bf_hi(b.w) + w2 * pg8::bf_hi(cc.w));
        *(u32x2*)(AO8 + t * 512 + h * 128 + dc * 8) = o;
    }
}

__device__ __forceinline__ void phase_ln(float* Y, bf16* XB, unsigned char* X8, float* st, bool inplace, const float* __restrict__ gam, const float* __restrict__ bet, int gw, int NGW, int lane) {
    for (int row = gw; row < T; row += NGW) {
        f32x4* yr = (f32x4*)(Y + (size_t)row * D) + lane;
        f32x4 v[8]; float s = 0.f;
#pragma unroll
        for (int j = 0; j < 8; ++j) { v[j] = yr[64 * j]; s += (v[j][0] + v[j][1]) + (v[j][2] + v[j][3]); }
        const float mean = wave_sum(s, lane) * (1.f / D); float s2 = 0.f;
#pragma unroll
        for (int j = 0; j < 8; ++j) { v[j] = v[j] - mean; s2 += (v[j][0] * v[j][0] + v[j][1] * v[j][1]) + (v[j][2] * v[j][2] + v[j][3] * v[j][3]); }
        const float rstd = 1.0f / sqrtf(wave_sum(s2, lane) * (1.f / D) + LN_EPS);
        if (st && lane == 0) { st[2 * (size_t)row] = mean; st[2 * (size_t)row + 1] = rstd; }
#pragma unroll
        for (int j = 0; j < 8; ++j) { const f32x4 gg = *((const f32x4*)gam + lane + 64 * j), bb = *((const f32x4*)bet + lane + 64 * j);
            const f32x4 o = v[j] * rstd * gg + bb;
            if (inplace) yr[64 * j] = o;
            if (XB) { u32x2 w; w.x = pk2(o[0], o[1]); w.y = pk2(o[2], o[3]); *((u32x2*)(XB + (size_t)row * D) + lane + 64 * j) = w; }
            if (X8) *((unsigned*)(X8 + (size_t)row * D) + lane + 64 * j) = pk4_fp8(o[0] * 32.f, o[1] * 32.f, o[2] * 32.f, o[3] * 32.f); }
    }
}

__global__ void __launch_bounds__(NTHREADS, 2) fwd_mega(Params p_arg) {
    extern __shared__ __attribute__((aligned(16))) unsigned char lds_raw[];
    LAS unsigned char* lds = (LAS unsigned char*)lds_raw;
    const int ph_lo = p_arg.ph_lo, ph_hi = p_arg.ph_hi;
    if (threadIdx.x < 4) ((LAS unsigned*)(lds + LDS_BARST))[threadIdx.x] = 0u;
    __syncthreads();
    for (int ph = ph_lo; ph < ph_hi; ++ph) {
      for (int rep = 0; rep < 2; ++rep) {
        if (ph > ph_lo || rep > 0) {
#if defined(__HIP_DEVICE_COMPILE__)
            unsigned* barw = (unsigned*)(((PP)__builtin_amdgcn_kernarg_segment_ptr())->ws + WS_BAR);
            if (ph == 1 && rep == 0) { cg::this_grid().sync();
                (void)xcd_barrier_post(barw, (volatile LAS unsigned*)(lds + LDS_BARST)); }
            else { XcdBarrier xb_; xb_.bar = barw; xb_.x = xb_xcc_id(); xb_.st = (volatile LAS unsigned*)(lds + LDS_BARST); xcd_barrier(xb_); }
#endif
        }
#if defined(__HIP_DEVICE_COMPILE__)
        PP p = (PP)__builtin_amdgcn_kernarg_segment_ptr(); asm volatile("" : "+s"(p));
#else
        PP p = (PP)(uintptr_t)0; (void)p_arg;
#endif
        int tid_ = threadIdx.x, bx_ = blockIdx.x; asm volatile("" : "+v"(tid_), "+s"(bx_));
        const int tid = tid_, lane = tid & 63, wave = __builtin_amdgcn_readfirstlane(tid >> 6);
        const int G = gridDim.x, bx = bx_, vcu = (G % 8 == 0) ? (bx % 8) * (G / 8) + bx / 8 : bx;
        const int gw = vcu * NWAVES + wave, NGW = G * NWAVES;
        unsigned char* ws = p->ws; bf16* XB = (bf16*)(ws + WS_XB);
        if (ph == 0) {
#if EN_PRO
 phase_prologue(p, lds, gw, NGW, wave, lane);
#endif
 if (rep == 0 && (PROBE_MASK & 1)) continue; else break; }
        const int q = ph - 1, layer = q / 13, s = q - layer * 13;
        const bf16* wl = (const bf16*)(ws + WS_W0 + (size_t)layer * WS_WL);
        const bool dbl = (s < 8 && (s & 3) == 1 && (PROBE_MASK & 2)) || (s < 8 && (s & 3) == 2 && (PROBE_MASK & 4)) || ((s == 9 || (s == 12 && layer == 0)) && (PROBE_MASK & 8)) || (s < 8 && (s & 3) == 0 && (PROBE_MASK & 16)) || (s == 10 && (PROBE_MASK & 32)) || (s < 8 && (s & 3) == 3 && (PROBE_MASK & 64));
        if (s < 8) {
            const int half = s >> 2, sub = s & 3;
            if (sub == 0) {
                pg8::Gemm g{(const bf16*)(ws + WS_X8 + (size_t)half * TH * D), wl + WO_IN, TH, CIN, D / 2}; pg8::StaticOrder S; S.init(TH, CIN, G, bx);
                pg8::EpiBf16<0> E{(bf16*)(ws + WS_PROJ), CIN, nullptr, 0, 0, 1.f};

#if EN_INPROJ
 pg8::gemm_phase<pg8::EpiBf16<0>, pg8::StaticOrder, true, true, true>(lds, g, S, E);
#endif

            } else if (sub == 1) {
#if EN_ATTN
 phase_attention(ws, p->sink, lds, layer, vcu, G, wave, lane);
#endif

            } else if (sub == 2) { phase_amerge(ws, gw, NGW, lane);
            } else {
                for (int k = 0; k < 2; ++k) {
                    pg8::Gemm g{k == 0 ? (const bf16*)(ws + WS_AO) : (const bf16*)(ws + WS_BO), wl + (k == 0 ? WO_PA : WO_PB), TH, D, k == 0 ? 256 : 512, 0x79797979, 0x78787878};
                    pg8::StaticOrder S; S.init(TH, D, G, bx);
                    pg8::EpiGate E{(bf16*)(ws + WS_XB + 64 * MiB), ws + WS_XB + (size_t)half * TH * D, D, (const bf16*)(ws + WS_PROJ) + (k == 0 ? 6144 : 8192), CIN, k, 512.f};

#if EN_GATE
 pg8::gemm_phase<pg8::EpiGate, pg8::StaticOrder, true, true, true>(lds, g, S, E);
#endif

                }
            }
        } else if (s == 8 || s == 11) {
            const bool dn = (s == 11);
            pg8::StaticOrder S; S.init(T, D, G, bx);
            const bool raw = (!dn && layer == 0);
            pg8::EpiResid E{(pg8::ArgV)p, raw ? 0 : -1, dn ? 7 : 11, dn ? 8 : 12, D, ALPHA, (size_t)(dn ? layer : (layer > 0 ? layer - 1 : 0)) * D, WS_ST};
#if EN_RESID
            if (dn) { pg8::Gemm g{(const bf16*)(ws + WS_H), wl + WO_DN, T, D, DFF}; pg8::gemm_phase<pg8::EpiResid, pg8::StaticOrder, true, true>(lds, g, S, E); }
            else { pg8::Gemm g{(const bf16*)(ws + WS_XB), wl + WO_OUT, T, D, D / 2, 0x76767676, 0x78787878}; pg8::gemm_phase<pg8::EpiResid, pg8::StaticOrder, true, true, true>(lds, g, S, E); }
#endif
        } else if (s == 9) { phase_ln(p->out, XB, nullptr, (float*)(ws + WS_ST), false, p->ln1_g + layer * D, p->ln1_b + layer * D, gw, NGW, lane);
        } else if (s == 10) {
            pg8::Gemm g{XB, wl + WO_UP, T, NUP, D}; pg8::StaticOrder S; S.init(T, NUP, G, bx);
            pg8::EpiSwiglu E{(bf16*)(ws + WS_H), DFF};

#if EN_SWIGLU
 pg8::gemm_phase<pg8::EpiSwiglu, pg8::StaticOrder, true, true>(lds, g, S, E);
#endif

        } else { phase_ln(p->out, nullptr, (layer == 1) ? nullptr : ws + WS_X8, (layer == 1) ? nullptr : (float*)(ws + WS_ST), layer == 1, p->ln2_g + layer * D, p->ln2_b + layer * D, gw, NGW, lane); }
        if (!(rep == 0 && dbl)) break;
      }
    }
}

#ifndef MK_PER_PHASE
#define MK_PER_PHASE 0
#endif
extern "C" void kernel_launch(void* const* d_in, const int* in_sizes, int n_in, void* d_out, int out_size, void* d_ws, size_t ws_size, hipStream_t stream) {
    static int grid = 0;
    if (grid == 0) {
        if (n_in != 13 || ws_size < WS_END) { fprintf(stderr, "kernel_launch: unexpected inputs (n_in %d, ws %zu)\n", n_in, ws_size); grid = -1; return; }
        int dev = 0, cus = 0;
        if (hipGetDevice(&dev) != hipSuccess || hipDeviceGetAttribute(&cus, hipDeviceAttributeMultiprocessorCount, dev) != hipSuccess) { grid = -1; return; }
        if (hipFuncSetAttribute((const void*)fwd_mega, hipFuncAttributeMaxDynamicSharedMemorySize, LDS_BYTES) != hipSuccess) { fprintf(stderr, "kernel_launch: hipFuncSetAttribute failed\n"); grid = -1; return; }
        (void)hipGetLastError();
        grid = cus;
    }
    if (grid < 0) return;
    Params p{};
    p.x = (const float*)d_in[0]; p.rel_bias = (const float*)d_in[1]; p.w_in = (const float*)d_in[2]; p.sink = (const float*)d_in[3]; p.w_pa = (const float*)d_in[4]; p.w_pb = (const float*)d_in[5];
    p.w_out = (const float*)d_in[6]; p.ln1_g = (const float*)d_in[7]; p.ln1_b = (const float*)d_in[8]; p.w_up = (const float*)d_in[9]; p.w_down = (const float*)d_in[10];
    p.ln2_g = (const float*)d_in[11]; p.ln2_b = (const float*)d_in[12]; p.out = (float*)d_out; p.ws = (unsigned char*)d_ws;
#if MK_PER_PHASE
    for (int ph = 0; ph < NPHASES; ++ph) { p.ph_lo = ph; p.ph_hi = ph + 1; hipLaunchKernelGGL(fwd_mega, dim3(grid), dim3(NTHREADS), LDS_BYTES, stream, p); }
#else
    p.ph_lo = 0; p.ph_hi = NPHASES;
    void* args[] = {&p};
    hipError_t e = hipLaunchCooperativeKernel((const void*)fwd_mega, dim3(grid), dim3(NTHREADS), args, LDS_BYTES, stream);
    if (e != hipSuccess) fprintf(stderr, "kernel_launch: cooperative launch failed: %s (grid %d)\n", hipGetErrorString(e), grid);
#endif
}
```

```cpp
#include <hip/hip_runtime.h>
#include <hip/hip_cooperative_groups.h>
#include <cstdio>
#include <cstdint>
namespace cg = cooperative_groups;
namespace pg8 {
#define PG8_LAS __attribute__((address_space(3)))
typedef unsigned short bf16_t;
typedef short bf16x8 __attribute__((ext_vector_type(8)));
typedef float f32x4 __attribute__((ext_vector_type(4)));
typedef unsigned u32x4 __attribute__((ext_vector_type(4)));
typedef unsigned u32x2 __attribute__((ext_vector_type(2)));
typedef int v8i32 __attribute__((ext_vector_type(8)));
typedef int v4i32 __attribute__((ext_vector_type(4)));
constexpr int FP8_SCALE_X = 0x79797979, FP8_SCALE_W = 0x79797979;
constexpr int BM = 256, BK = 64, HALF = 128, HTB = HALF * BK * 2  , STAGE_BYTES = 8 * HTB, NXCD = 8, WGM = 8;

__host__ __device__ __forceinline__ int lds_byte(int r, int c) { const int st = (r >> 4) * 2 + (c >> 5), rr = r & 15, cc = c & 31, ob = rr * 64 + cc * 2; return st * 1024 + (ob ^ (((ob >> 9) & 1) << 5)); }
__host__ __device__ __forceinline__ void stage_rc(int b, int& R, int& C) { const int st = b / 1024, sb = b % 1024, swz = sb ^ (((sb >> 9) & 1) << 5); R = (st >> 1) * 16 + swz / 64; C = (st & 1) * 32 + (swz % 64) / 2; }
__host__ __device__ __forceinline__ int x8(int r) { return ((r >> 1) & 3) | ((((r >> 2) ^ (r >> 3)) & 1) << 2); }
__host__ __device__ __forceinline__ int lds_byte8(int r, int c16) { return r * 128 + 16 * (c16 ^ x8(r & 15)); }
__host__ __device__ __forceinline__ void stage_rc8(int b, int& R, int& C) { R = b >> 7; C = 8 * (((b >> 4) & 7) ^ x8(R & 15)); }
__host__ __device__ __forceinline__ int perm32(int rho) { const int n = rho >> 4, i = rho & 15; return 8 * (i >> 2) + 4 * n + (i & 3); }

struct Unit { int pm, pn; };
struct Gemm { const bf16_t* A; const bf16_t* Bt; int M, N, K; int sx = 0x79797979, sw = 0x79797979; };

struct StaticOrder {
    int nM, nN, nwg, G, c;
    __host__ __device__ void init(int M, int N, int G_, int c_) { nM = M / BM; nN = N / BM; nwg = nM * nN; G = G_; c = c_; }
    __host__ __device__ bool next(int i, Unit& u) const {
        const long L = (long)i * G + c; if (L >= nwg) return false;
        int wgid = (int)L; { const int q = nwg / NXCD, r = nwg % NXCD, xcd = wgid % NXCD, off = wgid / NXCD; wgid = (xcd < r ? xcd * (q + 1) : r * (q + 1) + (xcd - r) * q) + off; }
        const int nig = WGM * nN, gid = wgid / nig, fm = gid * WGM, gsz = (nM - fm) < WGM ? (nM - fm) : WGM;
        u.pm = fm + ((wgid % nig) % gsz); u.pn = (wgid % nig) / gsz; return true;
    }
    __device__ __forceinline__ void a_ready(const Unit&) const {}
    __device__ __forceinline__ void done(const Unit&) const {}
};

__device__ __forceinline__ unsigned cvt_pk_bf16(float lo, float hi) { unsigned r; asm("v_cvt_pk_bf16_f32 %0, %1, %2" : "=v"(r) : "v"(lo), "v"(hi)); return r; }
typedef float f32x2 __attribute__((ext_vector_type(2)));
template <int ACT  > struct EpiBf16 {
    static constexpr bool PERM = true, AFTER_DRAIN = false; static_assert(ACT == 0 || ACT == 1, "EpiBf16: ACT is 0 (none) or 1 (gelu_pk)");
    bf16_t* O; int ldc; const float* bias; int split_cols; size_t split_stride; float scale0;
    __device__ __forceinline__ void operator()(const f32x4 (&acc)[2][2][4][2], const Unit& u, int wr, int wc, int fr, int fq) const {
        const int row0 = u.pm * BM + wr * 64 + fr; int colt = u.pn * BM; bf16_t* base = O;
        float sc = 1.f; if (split_cols) { const int t = colt / split_cols; base += (size_t)t * split_stride; colt -= t * split_cols; if (t == 0) sc = scale0; }
        const int col0 = colt + wc * 32 + 8 * fq, bcol0 = u.pn * BM + wc * 32 + 8 * fq;
        f32x4 bv[2][2];
#pragma unroll
        for (int bj = 0; bj < 2; ++bj)
#pragma unroll
            for (int n = 0; n < 2; ++n) bv[bj][n] = bias ? *(const f32x4*)(bias + bcol0 + bj * HALF + 4 * n) : (f32x4){0.f, 0.f, 0.f, 0.f};
#pragma unroll
        for (int ai = 0; ai < 2; ++ai)
#pragma unroll
            for (int m = 0; m < 4; ++m) { bf16_t* rowp = base + (size_t)(row0 + ai * HALF + m * 16) * ldc + col0;
#pragma unroll
                for (int bj = 0; bj < 2; ++bj) { f32x4 v0 = acc[ai][bj][m][0] + bv[bj][0], v1 = acc[ai][bj][m][1] + bv[bj][1];
                    v0 = v0 * sc; v1 = v1 * sc; u32x4 w; w.x = cvt_pk_bf16(v0[0], v0[1]); w.y = cvt_pk_bf16(v0[2], v0[3]); w.z = cvt_pk_bf16(v1[0], v1[1]); w.w = cvt_pk_bf16(v1[2], v1[3]);
                    *(u32x4*)(rowp + bj * HALF) = w; } }
    }
};
__device__ __forceinline__ float sigmoidf_fast(float x) { return __builtin_amdgcn_rcpf(1.0f + __builtin_amdgcn_exp2f(-1.4426950408889634f * x)); }
__device__ __forceinline__ float bf_lo(unsigned w) { return __uint_as_float(w << 16); }
__device__ __forceinline__ float bf_hi(unsigned w) { return __uint_as_float(w & 0xffff0000u); }
__device__ __forceinline__ float clamp448(float v) { return __builtin_fminf(__builtin_fmaxf(v, -448.f), 448.f); }
__device__ __forceinline__ unsigned pk4_fp8(float a, float b, float c, float d) { unsigned w = 0; w = __builtin_amdgcn_cvt_pk_fp8_f32(clamp448(a), clamp448(b), w, false); w = __builtin_amdgcn_cvt_pk_fp8_f32(clamp448(c), clamp448(d), w, true); return w; }
struct EpiGate {
    static constexpr bool PERM = true, AFTER_DRAIN = false;
    bf16_t* Tm; unsigned char* O8; int ldo; const bf16_t* G; int ldg; int add; float oscale;
    __device__ __forceinline__ void operator()(const f32x4 (&acc)[2][2][4][2], const Unit& u, int wr, int wc, int fr, int fq) const {
        const int row0 = u.pm * BM + wr * 64 + fr, col0 = u.pn * BM + wc * 32 + 8 * fq;
#pragma unroll
        for (int ai = 0; ai < 2; ++ai)
#pragma unroll
            for (int m = 0; m < 4; ++m) { const size_t r = (size_t)(row0 + ai * HALF + m * 16); bf16_t* rowp = Tm + r * ldo + col0; const bf16_t* gp = G + r * ldg + col0;
#pragma unroll
                for (int bj = 0; bj < 2; ++bj) { const u32x4 gw = *(const u32x4*)(gp + bj * HALF); f32x4 v0 = acc[ai][bj][m][0], v1 = acc[ai][bj][m][1];
                    v0[0] *= sigmoidf_fast(bf_lo(gw.x)); v0[1] *= sigmoidf_fast(bf_hi(gw.x)); v0[2] *= sigmoidf_fast(bf_lo(gw.y)); v0[3] *= sigmoidf_fast(bf_hi(gw.y));
                    v1[0] *= sigmoidf_fast(bf_lo(gw.z)); v1[1] *= sigmoidf_fast(bf_hi(gw.z)); v1[2] *= sigmoidf_fast(bf_lo(gw.w)); v1[3] *= sigmoidf_fast(bf_hi(gw.w));
                    if (add) { const u32x4 pw = *(const u32x4*)(rowp + bj * HALF);
                        v0[0] += bf_lo(pw.x); v0[1] += bf_hi(pw.x); v0[2] += bf_lo(pw.y); v0[3] += bf_hi(pw.y); v1[0] += bf_lo(pw.z); v1[1] += bf_hi(pw.z); v1[2] += bf_lo(pw.w); v1[3] += bf_hi(pw.w);
                        v0 = v0 * oscale; v1 = v1 * oscale; u32x2 w8; w8.x = pk4_fp8(v0[0], v0[1], v0[2], v0[3]); w8.y = pk4_fp8(v1[0], v1[1], v1[2], v1[3]);
                        *(u32x2*)(O8 + r * ldo + col0 + bj * HALF) = w8; }
                    else { u32x4 w; w.x = cvt_pk_bf16(v0[0], v0[1]); w.y = cvt_pk_bf16(v0[2], v0[3]); w.z = cvt_pk_bf16(v1[0], v1[1]); w.w = cvt_pk_bf16(v1[2], v1[3]);
                        *(u32x4*)(rowp + bj * HALF) = w; } } }
    }
};
typedef void* vptr_t; typedef const __attribute__((address_space(4))) vptr_t* ArgV;
struct EpiResid {
    static constexpr bool PERM = false, AFTER_DRAIN = false;
    ArgV args; int xi, gi, bi; int ldc; float alpha; size_t goff; size_t st_off;
    __device__ __forceinline__ void operator()(const f32x4 (&acc)[2][2][4][2], const Unit& u, int wr, int wc, int fr, int fq) const {
        ArgV a_ = args; asm volatile("" : "+s"(a_));
        float* Y = (float*)a_[13]; const float* X = xi >= 0 ? (const float*)a_[xi] : (const float*)Y;
        const float* st = xi >= 0 ? nullptr : (const float*)((const unsigned char*)a_[14] + st_off);
        const float* g = (const float*)a_[gi < 0 ? 0 : gi] + goff; const float* b = (const float*)a_[bi < 0 ? 0 : bi] + goff;
        const int row0 = u.pm * BM + wr * 64 + fr, col0 = u.pn * BM + wc * 32 + 4 * fq;
#pragma unroll
        for (int ai = 0; ai < 2; ++ai)
#pragma unroll
            for (int m = 0; m < 4; ++m) { const int r = row0 + ai * HALF + m * 16; const size_t off = (size_t)r * ldc + col0;
                float mean = 0.f, rstd = 1.f; if (st) { const f32x2 sv = *(const f32x2*)(st + 2 * (size_t)r); mean = sv.x; rstd = sv.y; }
#pragma unroll
                for (int bj = 0; bj < 2; ++bj)
#pragma unroll
                    for (int n = 0; n < 2; ++n) { f32x4 xv = *(const f32x4*)(X + off + bj * HALF + n * 16);
                        if (st) { const f32x4 gv = *(const f32x4*)(g + col0 + bj * HALF + n * 16), bv = *(const f32x4*)(b + col0 + bj * HALF + n * 16); xv = (xv - mean) * rstd * gv + bv; }
                        *(f32x4*)(Y + off + bj * HALF + n * 16) = xv * alpha + acc[ai][bj][m][n]; }
                asm volatile("" ::: "memory"); }
    }
};
struct EpiSwiglu {
    static constexpr bool PERM = true, AFTER_DRAIN = false;
    bf16_t* Hh; int ldh; float hscale;
    __device__ __forceinline__ void operator()(const f32x4 (&acc)[2][2][4][2], const Unit& u, int wr, int wc, int fr, int fq) const {
        const int row0 = u.pm * BM + wr * 64 + fr, col0 = u.pn * HALF + wc * 32 + 8 * fq;
#pragma unroll
        for (int ai = 0; ai < 2; ++ai)
#pragma unroll
            for (int m = 0; m < 4; ++m) { bf16_t* rowp = Hh + (size_t)(row0 + ai * HALF + m * 16) * ldh + col0; float hv[8];
#pragma unroll
                for (int n = 0; n < 2; ++n)
#pragma unroll
                    for (int j = 0; j < 4; ++j) { const float g = acc[ai][0][m][n][j], up = acc[ai][1][m][n][j]; hv[n * 4 + j] = g * sigmoidf_fast(g) * up; }
                if (hscale != 0.f) { u32x2 w8; w8.x = pk4_fp8(hv[0] * hscale, hv[1] * hscale, hv[2] * hscale, hv[3] * hscale); w8.y = pk4_fp8(hv[4] * hscale, hv[5] * hscale, hv[6] * hscale, hv[7] * hscale);
                    *(u32x2*)((unsigned char*)Hh + (size_t)(row0 + ai * HALF + m * 16) * ldh + col0) = w8; }
                else { u32x4 w; w.x = cvt_pk_bf16(hv[0], hv[1]); w.y = cvt_pk_bf16(hv[2], hv[3]); w.z = cvt_pk_bf16(hv[4], hv[5]); w.w = cvt_pk_bf16(hv[6], hv[7]);
                    *(u32x4*)rowp = w; } }
    }
};
template <class Epi, class Sched, bool ALIGN_EPI = false, bool SP2 = false, bool FP8 = false>
__device__ __forceinline__ void gemm_phase(PG8_LAS unsigned char* lds, const Gemm g, const Sched& S, const Epi& E) {
    int tid_ = threadIdx.x; asm volatile("" : "+v"(tid_));
    const int tid = tid_, wid = __builtin_amdgcn_readfirstlane(tid >> 6), lane = tid & 63, wr = wid >> 2, wc = wid & 3, fr = lane & 15, fq = lane >> 4;
    const int K = g.K, nt = K / BK;
    unsigned voffA[2], voffB[2];
#pragma unroll
    for (int i = 0; i < 2; ++i) { int R, C; if constexpr (FP8) stage_rc8(tid * 16 + i * 8192, R, C); else stage_rc(tid * 16 + i * 8192, R, C); const int Rb = Epi::PERM ? ((R & ~31) + perm32(R & 31)) : R;
        voffA[i] = (unsigned)(R * K + C) * 2u; voffB[i] = (unsigned)(Rb * K + C) * 2u; }
    const size_t r64step = (size_t)64 * K * 2;
    const size_t kstep = (size_t)(BK * 2);
    const size_t hstep = (size_t)HALF * K * 2;
    const size_t tstep = 2 * hstep;
    const unsigned ldsw = (unsigned)wid * 1024u;
    const int aoff = FP8 ? lds_byte8(wr * 64 + fr, 2 * fq) : lds_byte(wr * 64 + fr, fq * 8), boff = FP8 ? lds_byte8(wc * 32 + fr, 2 * fq) : lds_byte(wc * 32 + fr, fq * 8);
    const int aoff1 = FP8 ? lds_byte8(wr * 64 + fr, 2 * fq + 1) : 0, boff1 = FP8 ? lds_byte8(wc * 32 + fr, 2 * fq + 1) : 0;
#define PG8_SA(b, h) (((b) * 2 + (h)) * HTB)
#define PG8_SB(b, h) ((4 + (b) * 2 + (h)) * HTB)
#define PG8_STAGE(bufoff, gbase, voff) do { _Pragma("unroll") for (int _i = 0; _i < 2; ++_i) { const char* _gb = (const char*)(gbase) + (size_t)_i * r64step; asm volatile("" : "+s"(_gb));     \
        __builtin_amdgcn_global_load_lds((const unsigned*)(_gb + (voff)[0]), (PG8_LAS unsigned*)(lds + (bufoff) + ldsw + _i * 8192), 16, 0, 0); } } while (0)
#define PG8_LD8(p_, q_) __builtin_shufflevector(*(const PG8_LAS v4i32*)(p_), *(const PG8_LAS v4i32*)(q_), 0, 1, 2, 3, 4, 5, 6, 7)
#define PG8_LDA(dst, b, h) do { if constexpr (FP8) { _Pragma("unroll") for (int m = 0; m < 4; ++m) dst##8[m] = PG8_LD8(lds + PG8_SA(b, h) + aoff + m * 2048, lds + PG8_SA(b, h) + aoff1 + m * 2048); } \
        else { _Pragma("unroll") for (int m = 0; m < 4; ++m) _Pragma("unroll") for (int k = 0; k < 2; ++k) dst[m][k] = *(const PG8_LAS bf16x8*)(lds + PG8_SA(b, h) + aoff + m * 2048 + k * 1024); } } while (0)
#define PG8_LDB(dst, b, h) do { if constexpr (FP8) { _Pragma("unroll") for (int n = 0; n < 2; ++n) dst##8[n] = PG8_LD8(lds + PG8_SB(b, h) + boff + n * 2048, lds + PG8_SB(b, h) + boff1 + n * 2048); } \
        else { _Pragma("unroll") for (int n = 0; n < 2; ++n) _Pragma("unroll") for (int k = 0; k < 2; ++k) dst[n][k] = *(const PG8_LAS bf16x8*)(lds + PG8_SB(b, h) + boff + n * 2048 + k * 1024); } } while (0)
#define PG8_MMA(ai, bj, At, Bt) do { __builtin_amdgcn_s_setprio(1); if constexpr (FP8) { _Pragma("unroll") for (int m = 0; m < 4; ++m) _Pragma("unroll") for (int n = 0; n < 2; ++n) \
            acc[ai][bj][m][n] = __builtin_amdgcn_mfma_scale_f32_16x16x128_f8f6f4(Bt##8[n], At##8[m], acc[ai][bj][m][n], 0, 0, 0, g.sw, 0, g.sx); } \
        else { _Pragma("unroll") for (int m = 0; m < 4; ++m) _Pragma("unroll") for (int n = 0; n < 2; ++n) _Pragma("unroll") for (int k = 0; k < 2; ++k) \
        acc[ai][bj][m][n] = __builtin_amdgcn_mfma_f32_16x16x32_bf16(Bt[n][k], At[m][k], acc[ai][bj][m][n], 0, 0, 0); } __builtin_amdgcn_s_setprio(0); } while (0)
#define PG8_WAIT_V(n) asm volatile("s_waitcnt vmcnt(" #n ")" ::: "memory")
#define PG8_WAIT_L(n) asm volatile("s_waitcnt lgkmcnt(" #n ")" ::: "memory")
#define PG8_BAR __builtin_amdgcn_s_barrier()
#define PG8_SCHED __builtin_amdgcn_sched_barrier(0)
    Unit cur, nxt; int ui = 0;
    if (!S.next(0, cur)) return;
    f32x4 acc[2][2][4][2];
#pragma unroll
    for (int a = 0; a < 2; ++a)
#pragma unroll
        for (int b = 0; b < 2; ++b)
#pragma unroll
            for (int m = 0; m < 4; ++m)
#pragma unroll
                for (int n = 0; n < 2; ++n) acc[a][b][m][n] = (f32x4){0.f, 0.f, 0.f, 0.f};
    bf16x8 At[4][2], B0[2][2], B1[2][2]; v8i32 At8[4], B08[2], B18[2];
    const char* cA = (const char*)g.A + (size_t)cur.pm * tstep; const char* cB = (const char*)g.Bt + (size_t)cur.pn * tstep;
    S.a_ready(cur);
    if constexpr (SP2) {
        PG8_STAGE(PG8_SB(0, 0), cB, voffB); PG8_STAGE(PG8_SB(0, 1), cB + hstep, voffB); PG8_STAGE(PG8_SA(0, 0), cA, voffA); PG8_STAGE(PG8_SA(0, 1), cA + hstep, voffA);
        if (wr == 1) PG8_BAR;
        PG8_WAIT_V(2); PG8_BAR;
        PG8_STAGE(PG8_SB(1, 0), cB + kstep, voffB); PG8_STAGE(PG8_SA(1, 0), cA + kstep, voffA); PG8_STAGE(PG8_SB(1, 1), cB + hstep + kstep, voffB);
        PG8_WAIT_V(6); PG8_BAR;
    } else {
        PG8_STAGE(PG8_SB(0, 0), cB, voffB); PG8_STAGE(PG8_SA(0, 0), cA, voffA); PG8_STAGE(PG8_SB(0, 1), cB + hstep, voffB); PG8_STAGE(PG8_SA(0, 1), cA + hstep, voffA);
        if (wr == 1) PG8_BAR;
        PG8_WAIT_V(4); PG8_BAR;
        PG8_STAGE(PG8_SB(1, 0), cB + kstep, voffB); PG8_STAGE(PG8_SA(1, 0), cA + kstep, voffA); PG8_STAGE(PG8_SB(1, 1), cB + hstep + kstep, voffB);
        PG8_WAIT_V(6); PG8_BAR;
    }
    for (;;) {
        const bool has_next = S.next(ui + 1, nxt);
        const char* nA = has_next ? (const char*)g.A + (size_t)nxt.pm * tstep : cA; const char* nB = has_next ? (const char*)g.Bt + (size_t)nxt.pn * tstep : cB;
        for (int t = 0; t < nt; t += 2) {
            const bool last = (t == nt - 2);
            const char* a1 = cA + (size_t)(t + 1) * kstep;
            const char* a2 = last ? nA : cA + (size_t)(t + 2) * kstep; const char* b2 = last ? nB : cB + (size_t)(t + 2) * kstep;
            const char* a3 = a2 + kstep; const char* b3 = b2 + kstep;
            if (last && has_next) S.a_ready(nxt);
            if constexpr (SP2) {
            PG8_LDB(B0, 0, 0); PG8_LDB(B1, 0, 1); PG8_SCHED; PG8_LDA(At, 0, 0); PG8_STAGE(PG8_SA(1, 1), a1 + hstep, voffA);
            PG8_WAIT_V(8); PG8_WAIT_L(0); PG8_BAR; PG8_MMA(0, 0, At, B0); PG8_MMA(0, 1, At, B1); PG8_BAR; PG8_SCHED;
            PG8_LDA(At, 0, 1); PG8_STAGE(PG8_SB(0, 0), b2, voffB); PG8_STAGE(PG8_SB(0, 1), b2 + hstep, voffB); PG8_STAGE(PG8_SA(0, 0), a2, voffA);
            PG8_WAIT_V(8); PG8_WAIT_L(0); PG8_BAR; PG8_MMA(1, 0, At, B0); PG8_MMA(1, 1, At, B1); PG8_BAR; PG8_SCHED;
            PG8_LDB(B0, 1, 0); PG8_LDB(B1, 1, 1); PG8_SCHED; PG8_LDA(At, 1, 0); PG8_STAGE(PG8_SA(0, 1), a2 + hstep, voffA);
            PG8_WAIT_V(8); PG8_WAIT_L(0); PG8_BAR; PG8_MMA(0, 0, At, B0); PG8_MMA(0, 1, At, B1); PG8_BAR; PG8_SCHED;
            PG8_LDA(At, 1, 1); PG8_STAGE(PG8_SB(1, 0), b3, voffB); PG8_STAGE(PG8_SB(1, 1), b3 + hstep, voffB); PG8_STAGE(PG8_SA(1, 0), a3, voffA);
            PG8_WAIT_V(8); PG8_WAIT_L(0); PG8_BAR; PG8_MMA(1, 0, At, B0); PG8_MMA(1, 1, At, B1); PG8_BAR; PG8_SCHED;
            } else {
            PG8_LDB(B0, 0, 0); PG8_SCHED; PG8_LDA(At, 0, 0); PG8_STAGE(PG8_SA(1, 1), a1 + hstep, voffA);
            PG8_WAIT_L(8); PG8_BAR; PG8_WAIT_L(0); PG8_MMA(0, 0, At, B0); PG8_BAR; PG8_SCHED;
            PG8_LDB(B1, 0, 1); PG8_STAGE(PG8_SB(0, 0), b2, voffB);
            PG8_BAR; PG8_WAIT_L(0); PG8_MMA(0, 1, At, B1); PG8_BAR;
            PG8_LDA(At, 0, 1); PG8_STAGE(PG8_SA(0, 0), a2, voffA);
            PG8_BAR; PG8_WAIT_L(0); PG8_MMA(1, 0, At, B0); PG8_BAR; PG8_SCHED;
            PG8_STAGE(PG8_SB(0, 1), b2 + hstep, voffB);
            PG8_WAIT_V(6); PG8_BAR; PG8_MMA(1, 1, At, B1); PG8_BAR;
            PG8_LDB(B0, 1, 0); PG8_SCHED; PG8_LDA(At, 1, 0); PG8_STAGE(PG8_SA(0, 1), a2 + hstep, voffA);
            PG8_WAIT_L(8); PG8_BAR; PG8_WAIT_L(0); PG8_MMA(0, 0, At, B0); PG8_BAR; PG8_SCHED;
            PG8_LDB(B1, 1, 1); PG8_STAGE(PG8_SB(1, 0), b3, voffB);
            PG8_BAR; PG8_WAIT_L(0); PG8_MMA(0, 1, At, B1); PG8_BAR;
            PG8_LDA(At, 1, 1); PG8_STAGE(PG8_SA(1, 0), a3, voffA);
            PG8_BAR; PG8_WAIT_L(0); PG8_MMA(1, 0, At, B0); PG8_BAR; PG8_SCHED;
            PG8_STAGE(PG8_SB(1, 1), b3 + hstep, voffB);
            PG8_WAIT_V(6); PG8_BAR; PG8_MMA(1, 1, At, B1); PG8_BAR;
            }
        }
        if constexpr (ALIGN_EPI) { if (wr == 0) PG8_BAR; }
        if constexpr (!Epi::AFTER_DRAIN) { int t2_ = threadIdx.x; asm volatile("" : "+v"(t2_)); const int fr_ = t2_ & 15, fq_ = (t2_ & 63) >> 4;
            E(acc, cur, wr, wc, fr_, fq_); S.done(cur); }
        if (!has_next) break;
#pragma unroll
        for (int a = 0; a < 2; ++a)
#pragma unroll
            for (int b = 0; b < 2; ++b)
#pragma unroll
                for (int m = 0; m < 4; ++m)
#pragma unroll
                    for (int n = 0; n < 2; ++n) acc[a][b][m][n] = (f32x4){0.f, 0.f, 0.f, 0.f};
        cur = nxt; cA = nA; cB = nB; ++ui;
        if constexpr (ALIGN_EPI) { if (wr == 1) PG8_BAR; }
    }
    PG8_WAIT_V(0);
    if constexpr (!ALIGN_EPI) { if (wr == 0) PG8_BAR; }
    PG8_BAR;
    if constexpr (Epi::AFTER_DRAIN) { E.fused(acc, cur, wr, wc, fr, fq, lds, wid, lane); S.done(cur); }
#undef PG8_SA
#undef PG8_SB
#undef PG8_STAGE
#undef PG8_LD8
#undef PG8_LDA
#undef PG8_LDB
#undef PG8_MMA
#undef PG8_WAIT_V
#undef PG8_WAIT_L
#undef PG8_BAR
#undef PG8_SCHED
}
}

#ifndef FP8_DOWN_LAYER
#define FP8_DOWN_LAYER 1
#endif
#ifndef PROBE_MASK
#define PROBE_MASK 0
#endif
#ifndef EN_INPROJ
#define EN_INPROJ 1
#endif
#ifndef EN_GATE
#define EN_GATE 1
#endif
#ifndef EN_RESID
#define EN_RESID 1
#endif
#ifndef EN_SWIGLU
#define EN_SWIGLU 1
#endif
#ifndef EN_ATTN
#define EN_ATTN 1
#endif
#ifndef EN_PRO
#define EN_PRO 1
#endif
#define LAS __attribute__((address_space(3)))
typedef unsigned short bf16;
typedef short bf16x8 __attribute__((ext_vector_type(8)));
typedef short s16x4 __attribute__((ext_vector_type(4)));
typedef float f32x4 __attribute__((ext_vector_type(4)));
typedef float f32x16 __attribute__((ext_vector_type(16)));
typedef unsigned u32x4 __attribute__((ext_vector_type(4)));
typedef unsigned u32x2 __attribute__((ext_vector_type(2)));

constexpr int T = 32768, TH = 16384, D = 2048, CIN = 10240, DFF = 5632, NUP = 11264, SEQ = 16384;
constexpr int NWAVES = 8, NTHREADS = 512;
constexpr float ALPHA = 1.41421356237309515f;
constexpr float LN_EPS = 1e-5f;
constexpr float LOG2E = 1.4426950408889634f;
constexpr int LDS_BYTES = 163840, LDS_BARST = 163824;
constexpr int NPHASES = 27;

constexpr size_t MiB = (size_t)1 << 20;
constexpr size_t WS_TAB = 0;
constexpr size_t WS_BAR = 256 * 1024;
constexpr size_t WS_W0 = 1 * MiB, WS_WL = 120 * MiB;
constexpr size_t WO_IN = 0, WO_PA = WO_IN + (size_t)CIN * D, WO_PB = WO_PA + (size_t)D * 512, WO_OUT = WO_PB + (size_t)D * 1024, WO_UP = WO_OUT + (size_t)D * D,
                 WO_DN = WO_UP + (size_t)NUP * D, WO_END = WO_DN + (size_t)D * DFF;
static_assert(WO_END * 2 <= WS_WL, "weight block");
constexpr size_t WS_XB = 241 * MiB;
constexpr size_t WS_PROJ = 369 * MiB;
constexpr size_t WS_AR = 689 * MiB;
constexpr size_t WS_LSE = 737 * MiB;
constexpr size_t WS_AO = 738 * MiB;
constexpr size_t WS_BO = 754 * MiB;
constexpr size_t WS_H = 369 * MiB;
constexpr size_t WS_X8 = 800 * MiB;
constexpr size_t WS_ST = 864 * MiB;
constexpr size_t WS_END = 865 * MiB;

struct Params;
typedef const __attribute__((address_space(4))) Params* PP;
struct Params {
    const float* x; const float* rel_bias; const float* w_in; const float* sink; const float* w_pa; const float* w_pb; const float* w_out;
    const float* ln1_g; const float* ln1_b; const float* w_up; const float* w_down; const float* ln2_g; const float* ln2_b;
    float* out; unsigned char* ws; int ph_lo, ph_hi;
};

__device__ __forceinline__ unsigned pk2(float a, float b) { return pg8::cvt_pk_bf16(a, b); }
__device__ __forceinline__ float shx(float v, int o, int lane) { return __int_as_float(__builtin_amdgcn_ds_bpermute((lane ^ o) << 2, __float_as_int(v))); }
__device__ __forceinline__ float wave_sum(float v, int lane) {
#pragma unroll
    for (int o = 1; o < 64; o <<= 1) v += shx(v, o, lane);
    return v;
}
#define LDS_WAIT() asm volatile("s_waitcnt lgkmcnt(0)" ::: "memory")

#define XB_TMO      128
#define XB_XCNT(j)  (256  + 64 * (j))
#define XB_XSUB(j)  (1280 + 64 * (j))
#define XB_XGEN(j)  (2304 + 64 * (j))
#define XB_TOP      3328
#define XB_TOPGEN   3392
#define XCD_BAR_WORDS 3456
#define XB_SPIN_CAP (1u << 18)

__device__ __forceinline__ unsigned xb_ld(unsigned* p)              { return __hip_atomic_load(p, __ATOMIC_RELAXED, __HIP_MEMORY_SCOPE_AGENT); }
__device__ __forceinline__ unsigned xb_add(unsigned* p, unsigned v) { return __hip_atomic_fetch_add(p, v, __ATOMIC_RELAXED, __HIP_MEMORY_SCOPE_AGENT); }
__device__ __forceinline__ unsigned xb_xcc_id() { return (unsigned)__builtin_amdgcn_s_getreg((3 << 11) | 20) & 0xFu; }
#define XB_SPIN(cond, bar) do { unsigned _sp = 0; while (cond) { __builtin_amdgcn_s_sleep(1); \
    if ((++_sp & 255u) == 0u) { if (xb_ld(&(bar)[XB_TMO])) break; if (_sp > XB_SPIN_CAP) { atomicAdd(&(bar)[XB_TMO], 1u); break; } } } } while (0)

struct XcdBarrier {
    unsigned* bar; unsigned x;
    volatile LAS unsigned* st;
};

__device__ __forceinline__ XcdBarrier xcd_barrier_post(unsigned* bar, volatile LAS unsigned* st) {
    XcdBarrier b; b.bar = bar; b.x = xb_xcc_id(); b.st = st;
    if (threadIdx.x == 0) (void)xb_add(&bar[XB_XCNT(b.x)], 1u);
    return b;
}
__device__ __forceinline__ void xcd_barrier_complete(unsigned* bar, unsigned x, unsigned& nloc, unsigned& nx) {
    const unsigned G = gridDim.x * gridDim.y * gridDim.z;
    unsigned sum, cnt, mine, sp = 0u;
    for (;;) {
        sum = 0u; cnt = 0u; mine = 0u;
#pragma unroll
        for (unsigned j = 0; j < 16; ++j) { const unsigned c = xb_ld(&bar[XB_XCNT(j)]); sum += c; cnt += (c > 0u) ? 1u : 0u; mine = (j == x) ? c : mine; }
        if (sum == G) break;
        __builtin_amdgcn_s_sleep(1);
        if ((++sp & 255u) == 0u) { if (xb_ld(&bar[XB_TMO])) break; if (sp > XB_SPIN_CAP) { atomicAdd(&bar[XB_TMO], 1u); break; } }
    }
    nloc = mine > 0u ? mine : 1u; nx = cnt > 0u ? cnt : 1u;
}

__device__ __forceinline__ void xcd_barrier(const XcdBarrier& b) {
    asm volatile("s_waitcnt vmcnt(0)" ::: "memory");
    __syncthreads();
    if (threadIdx.x == 0) {
        unsigned* bar = b.bar;
        __builtin_amdgcn_s_waitcnt(0);
        unsigned nloc = b.st[0], nx = b.st[1];
        if (nloc == 0u) { xcd_barrier_complete(bar, b.x, nloc, nx); b.st[0] = nloc; b.st[1] = nx; }
        const unsigned old = xb_add(&bar[XB_XSUB(b.x)], 1u);
        const unsigned gen = old / nloc;
        if (old + 1u == (gen + 1u) * nloc) {
            __builtin_amdgcn_fence(__ATOMIC_RELEASE, "agent");
            asm volatile("s_waitcnt vmcnt(0)" ::: "memory");
            const unsigned og = xb_add(&bar[XB_TOP], 1u);
            const unsigned tg = og / nx;
            if (og + 1u == (tg + 1u) * nx) xb_add(&bar[XB_TOPGEN], 1u);
            else XB_SPIN(xb_ld(&bar[XB_TOPGEN]) == tg, bar);
            __builtin_amdgcn_fence(__ATOMIC_ACQUIRE, "agent");
            xb_add(&bar[XB_XGEN(b.x)], 1u);
            asm volatile("s_waitcnt vmcnt(0)" ::: "memory");
        } else {
            XB_SPIN(xb_ld(&bar[XB_XGEN(b.x)]) == gen, bar);
            __builtin_amdgcn_fence(__ATOMIC_ACQUIRE, "agent");
            asm volatile("s_waitcnt vmcnt(0)" ::: "memory");
        }
    }
    __syncthreads();
}


__device__ __forceinline__ void transpose_item(const float* __restrict__ W, int K, int N, bf16* WT, int k0, int n0, int row0, LAS float* scr, int lane) {
    { f32x4 tv[8];
#pragma unroll
      for (int i = 0; i < 8; ++i) tv[i] = *(const f32x4*)(W + (size_t)(k0 + 8 * i + (lane >> 3)) * N + n0 + 4 * (lane & 7));
#pragma unroll
      for (int i = 0; i < 8; ++i) { LAS float* d_ = scr + (8 * i + (lane >> 3)) * 33 + 4 * (lane & 7); d_[0] = tv[i][0]; d_[1] = tv[i][1]; d_[2] = tv[i][2]; d_[3] = tv[i][3]; } }
    LDS_WAIT();
    const int c = lane & 7;
#pragma unroll
    for (int j = 0; j < 4; ++j) { const int n = (lane >> 3) + 8 * j; const LAS float* s = scr + (8 * c) * 33 + n;
        u32x4 o; o.x = pk2(s[0 * 33], s[1 * 33]); o.y = pk2(s[2 * 33], s[3 * 33]); o.z = pk2(s[4 * 33], s[5 * 33]); o.w = pk2(s[6 * 33], s[7 * 33]);
        *(u32x4*)(WT + (size_t)(row0 + n) * K + k0 + 8 * c) = o; }
    LDS_WAIT();
}
using pg8::pk4_fp8;
__device__ __forceinline__ void transpose_item_fp8(const float* __restrict__ W, int K, int N, unsigned char* WT, int k0, int n0, LAS float* scr, int lane, float scale) {
    { f32x4 tv[8];
#pragma unroll
      for (int i = 0; i < 8; ++i) tv[i] = *(const f32x4*)(W + (size_t)(k0 + 8 * i + (lane >> 3)) * N + n0 + 4 * (lane & 7));
#pragma unroll
      for (int i = 0; i < 8; ++i) { LAS float* d_ = scr + (8 * i + (lane >> 3)) * 33 + 4 * (lane & 7); d_[0] = tv[i][0]; d_[1] = tv[i][1]; d_[2] = tv[i][2]; d_[3] = tv[i][3]; } }
    LDS_WAIT();
    const int n = lane >> 1, kh = lane & 1; const LAS float* sp = scr + (32 * kh) * 33 + n;
    u32x4 o0, o1;
    o0.x = pk4_fp8(sp[0 * 33] * scale, sp[1 * 33] * scale, sp[2 * 33] * scale, sp[3 * 33] * scale); o0.y = pk4_fp8(sp[4 * 33] * scale, sp[5 * 33] * scale, sp[6 * 33] * scale, sp[7 * 33] * scale);
    o0.z = pk4_fp8(sp[8 * 33] * scale, sp[9 * 33] * scale, sp[10 * 33] * scale, sp[11 * 33] * scale); o0.w = pk4_fp8(sp[12 * 33] * scale, sp[13 * 33] * scale, sp[14 * 33] * scale, sp[15 * 33] * scale);
    o1.x = pk4_fp8(sp[16 * 33] * scale, sp[17 * 33] * scale, sp[18 * 33] * scale, sp[19 * 33] * scale); o1.y = pk4_fp8(sp[20 * 33] * scale, sp[21 * 33] * scale, sp[22 * 33] * scale, sp[23 * 33] * scale);
    o1.z = pk4_fp8(sp[24 * 33] * scale, sp[25 * 33] * scale, sp[26 * 33] * scale, sp[27 * 33] * scale); o1.w = pk4_fp8(sp[28 * 33] * scale, sp[29 * 33] * scale, sp[30 * 33] * scale, sp[31 * 33] * scale);
    unsigned char* dst = WT + (size_t)(n0 + n) * K + k0 + 32 * kh;
    *(u32x4*)dst = o0; *(u32x4*)(dst + 16) = o1;
    LDS_WAIT();
}
__device__ __forceinline__ int t5_bucket(int rel) {
    const int n = rel < 0 ? -rel : rel; int b;
    if (n < 8) b = n; else { const int e = (int)(__builtin_log2f((float)n * 0.125f) * (8.0f / 7.0f)); b = 8 + e; if (b > 15) b = 15; }
    return b + (rel > 0 ? 16 : 0);
}
__device__ __forceinline__ void phase_prologue(PP pp, LAS unsigned char* lds, int gw, int NGW, int wave, int lane) {
    LAS float* scr = (LAS float*)(lds + wave * 16384);
    constexpr int I_IN = (D / 64) * (CIN / 32), I_PA = (512 / 64) * (D / 32), I_PB = (1024 / 64) * (D / 32), I_OUT = (D / 64) * (D / 32), I_UP = (D / 64) * (NUP / 32), I_DN = (DFF / 64) * (D / 32);
    constexpr int I_LAYER = I_IN + I_PA + I_PB + I_OUT + I_UP + I_DN;
    for (int it = gw; it < 2 * I_LAYER; it += NGW) {
        const int l = it / I_LAYER; int r = it - l * I_LAYER;
        bf16* wl = (bf16*)(pp->ws + WS_W0 + (size_t)l * WS_WL);
        const float* W; int K, N; bf16* WT; bool up = false, r0_in = false, dn8 = false;
        if (r < I_IN) { W = pp->w_in + (size_t)l * D * CIN; K = D; N = CIN; WT = wl + WO_IN; r0_in = true; }
        else if ((r -= I_IN) < I_PA) { r0_in = true; W = pp->w_pa + (size_t)l * 512 * D; K = 512; N = D; WT = wl + WO_PA; }
        else if ((r -= I_PA) < I_PB) { r0_in = true; W = pp->w_pb + (size_t)l * 1024 * D; K = 1024; N = D; WT = wl + WO_PB; }
        else if ((r -= I_PB) < I_OUT) { r0_in = true; W = pp->w_out + (size_t)l * D * D; K = D; N = D; WT = wl + WO_OUT; }
        else if ((r -= I_OUT) < I_UP) { W = pp->w_up + (size_t)l * D * NUP; K = D; N = NUP; WT = wl + WO_UP; up = true; }
        else { r -= I_UP; W = pp->w_down + (size_t)l * DFF * D; K = DFF; N = D; WT = wl + WO_DN; dn8 = (l == FP8_DOWN_LAYER); }
        const int nblk = N / 32, kb = r / nblk, nb = r - kb * nblk, n0 = 32 * nb;
        int row0 = n0;
        if (up) { const int j0 = n0 < DFF ? n0 : n0 - DFF; row0 = (j0 >> 7) * 256 + (n0 < DFF ? 0 : 128) + (j0 & 127); }
        if (r0_in) transpose_item_fp8(W, K, N, (unsigned char*)WT, 64 * kb, n0, scr, lane, 128.0f);
        else if (dn8) transpose_item_fp8(W, K, N, (unsigned char*)WT, 64 * kb, n0, scr, lane, 256.0f);
        else transpose_item(W, K, N, WT, 64 * kb, n0, row0, scr, lane);
    }
    { const size_t gt = (size_t)gw * 64 + lane, NT = (size_t)NGW * 64; unsigned char* x8 = pp->ws + WS_X8;
      for (size_t i = gt; i < (size_t)T * D / 16; i += NT) { const f32x4 a = *(const f32x4*)(pp->x + i * 16) * 32.f, b = *(const f32x4*)(pp->x + i * 16 + 4) * 32.f, c = *(const f32x4*)(pp->x + i * 16 + 8) * 32.f, d = *(const f32x4*)(pp->x + i * 16 + 12) * 32.f;
          u32x4 o; o.x = pk4_fp8(a[0], a[1], a[2], a[3]); o.y = pk4_fp8(b[0], b[1], b[2], b[3]); o.z = pk4_fp8(c[0], c[1], c[2], c[3]); o.w = pk4_fp8(d[0], d[1], d[2], d[3]); *(u32x4*)(x8 + i * 16) = o; } }
    if (blockIdx.x == 0) { unsigned* barw = (unsigned*)(pp->ws + WS_BAR); for (int i = threadIdx.x; i < XCD_BAR_WORDS; i += NTHREADS) barw[i] = 0u; }
    { float* tabA = (float*)(pp->ws + WS_TAB); float* tabB = (float*)(pp->ws + WS_TAB + 8192);
      const int gt = gw * 64 + lane;
      if (gt < 12 * 129) { const int hh = gt / 129, i = gt - hh * 129, g = hh >> 2, dil = g == 0 ? 1 : (g == 1 ? 4 : 16); tabA[hh * 132 + i] = pp->rel_bias[t5_bucket((i - 64) * dil) * 20 + hh] * LOG2E; }
      else if (gt < 12 * 129 + 8 * 257) { const int q = gt - 12 * 129, hh = q / 257, i = q - hh * 257; tabB[hh * 260 + i] = pp->rel_bias[t5_bucket(i - 128) * 20 + 12 + hh] * LOG2E; } }
}

constexpr int AT_KS = 0, AT_VS = 8704, AT_TAB = 8704 + 10240, AT_WAVE_BYTES = 8704 + 10240 + 1296;
static_assert(AT_WAVE_BYTES * NWAVES <= LDS_BYTES, "attention LDS");
#define TR4(r0, r1, r2, r3, base, o0, o1, o2, o3) asm volatile("ds_read_b64_tr_b16 %0, %4 offset:%5\n\tds_read_b64_tr_b16 %1, %4 offset:%6\n\tds_read_b64_tr_b16 %2, %4 offset:%7\n\tds_read_b64_tr_b16 %3, %4 offset:%8\n\ts_waitcnt lgkmcnt(0)" \
    : "=&v"(r0), "=&v"(r1), "=&v"(r2), "=&v"(r3) : "v"(base), "i"(o0), "i"(o1), "i"(o2), "i"(o3) : "memory")
#define PK8(L, Hh) (bf16x8){L[0], L[1], L[2], L[3], Hh[0], Hh[1], Hh[2], Hh[3]}

struct AtItem { int qcol, kcol, vcol, r, dil, sub_len, q0, W, nkt, T0, toff, NT, o_ld, ocol, lse_idx, o8; const float* tab; float m0; int sink; unsigned char* O; float* lse; };
constexpr int AT_NA = 12 * 64, AT_NB = 2 * 256;
__device__ __forceinline__ AtItem at_decode(int i, int wave, int layer, unsigned char* ws, const float* sinkp) {
    AtItem I; const float* tabA = (const float*)(ws + WS_TAB); const float* tabB = (const float*)(ws + WS_TAB + 8192);
    if (i < AT_NA) {
        const int hh = i >> 6, idx = i & 63, g = hh >> 2;
        I.dil = g == 0 ? 1 : (g == 1 ? 4 : 16); const int nbr = 64 / I.dil; I.r = idx / nbr; const int qb = idx - I.r * nbr; I.sub_len = SEQ / I.dil;
        I.q0 = qb * 256 + 32 * wave; I.T0 = qb * 256 - 64; I.toff = wave; I.NT = 12; I.nkt = 5; I.W = 64;
        I.qcol = hh * 128; I.kcol = 1536 + hh * 128; I.vcol = 3072 + hh * 128; I.tab = tabA + hh * 132; I.m0 = -1e30f; I.sink = 0;
        I.O = ws + WS_AR; I.o_ld = 1536; I.ocol = hh * 128; I.lse = (float*)(ws + WS_LSE); I.lse_idx = hh; I.o8 = 0;
    } else {
        const int b = i - AT_NA, kvh = b >> 8, qp = b & 255, j = wave >> 2, rep = wave & 3, qh = kvh * 4 + rep;
        I.dil = 1; I.r = 0; I.sub_len = SEQ; I.q0 = qp * 64 + 32 * j; I.T0 = qp * 64 - 128; I.toff = j; I.NT = 10; I.nkt = 9; I.W = 128;
        I.qcol = 4608 + qh * 128; I.kcol = 5632 + kvh * 128; I.vcol = 5888 + kvh * 128; I.tab = tabB + qh * 260; I.m0 = sinkp[layer * 8 + qh] * LOG2E; I.sink = 1;
        I.O = ws + WS_BO; I.o_ld = 1024; I.ocol = qh * 128; I.lse = nullptr; I.lse_idx = 0; I.o8 = 1;
    }
    return I;
}
__device__ __forceinline__ void phase_attention(unsigned char* ws, const float* sinkp, LAS unsigned char* lds, int layer, int vcu, int G, int wave, int lane) {
    const bf16* P = (const bf16*)(ws + WS_PROJ);
    const int hl = lane >> 5, ql = lane & 31, lrow = lane >> 4, lch = lane & 15;
    LAS float* tabs = (LAS float*)(lds + wave * AT_WAVE_BYTES + AT_TAB);
    const float c = 0.08838834764831845f * LOG2E;
    const unsigned vlane = (unsigned)((4 * hl + ((lane & 15) >> 2)) * 320 + (16 * ((lane >> 4) & 1) + 4 * (lane & 3)) * 2);
    const int klane = ql * 272 + 16 * hl;
    const int wrow = 4 * wave + lrow;
    bf16x8 qf[8]; u32x4 kreg[8], vreg[8], kn, vn; float tv[6];
#define AT_EDGE(I, kt_) ((I.q0 - I.W + 32 * (kt_) < 0) || (I.q0 - I.W + 32 * (kt_) + 31 >= I.sub_len))
#define AT_TOFF(I, t) ({ int sub = I.T0 + 32 * (t) + wrow; sub = sub < 0 ? 0 : (sub >= I.sub_len ? I.sub_len - 1 : sub); (unsigned)(I.r + sub * I.dil) * (unsigned)(CIN * 2) + 16u * lch; })
#define AT_FILL(I) do { const char* Pk = (const char*)(P + I.kcol); const char* Pv = (const char*)(P + I.vcol); \
        _Pragma("unroll") for (int t = 0; t < 8; ++t) { const unsigned o_ = AT_TOFF(I, t); kreg[t] = *(const u32x4*)(Pk + o_); vreg[t] = *(const u32x4*)(Pv + o_); } } while (0)
#define AT_WRITEFILL() do { _Pragma("unroll") for (int t = 0; t < 8; ++t) { *(LAS u32x4*)(lds + t * AT_WAVE_BYTES + AT_KS + wrow * 272 + 16 * lch) = kreg[t]; *(LAS u32x4*)(lds + t * AT_WAVE_BYTES + AT_VS + wrow * 320 + 16 * lch) = vreg[t]; } } while (0)
#define AT_LOADQ(I) do { const bf16* qp = P + (size_t)(I.r + (I.q0 + ql) * I.dil) * CIN + I.qcol + 8 * hl; _Pragma("unroll") for (int s = 0; s < 8; ++s) qf[s] = *(const bf16x8*)(qp + 16 * s); } while (0)
#define AT_LOADTAB(I) do { _Pragma("unroll") for (int u = 0; u < 6; ++u) { const int src = lane + 64 * u - 32; const int sc_ = src < 0 ? 0 : (src > 2 * I.W ? 2 * I.W : src); tv[u] = I.tab[sc_]; } } while (0)
#define AT_STORETAB(I) do { _Pragma("unroll") for (int u = 0; u < 6; ++u) { const int i_ = lane + 64 * u, src = i_ - 32; if (i_ < 2 * I.W + 65) tabs[i_] = (src >= 0 && src <= 2 * I.W) ? tv[u] : -__builtin_inff(); } } while (0)
    constexpr int NTOT = AT_NA + AT_NB;
    int it = vcu; if (it >= NTOT) return;
    AtItem cur = at_decode(it, wave, layer, ws, sinkp);
    AT_LOADTAB(cur); AT_LOADQ(cur); AT_FILL(cur); AT_STORETAB(cur); AT_WRITEFILL();
    __syncthreads();
    for (;;) {
        const int itn = it + G; const bool has_next = itn < NTOT;
        const AtItem nxt = at_decode(has_next ? itn : it, wave, layer, ws, sinkp);
        f32x16 o0, o1, o2, o3;
#pragma unroll
        for (int i = 0; i < 16; ++i) { o0[i] = 0.f; o1[i] = 0.f; o2[i] = 0.f; o3[i] = 0.f; }
        float m = cur.m0, l = (cur.sink && lane < 32) ? 1.f : 0.f;
        const int nkt = cur.nkt;
        for (int kt = 0; kt < nkt; ++kt) {
            const bool last = (kt == nkt - 1);
            const int tn = 8 + kt; const bool newt = tn < cur.NT;
            if (newt) { const unsigned o_ = AT_TOFF(cur, tn); kn = *(const u32x4*)((const char*)(P + cur.kcol) + o_); vn = *(const u32x4*)((const char*)(P + cur.vcol) + o_); }
            const int sl = (cur.toff + kt) & 7;
            const LAS unsigned char* kb = lds + sl * AT_WAVE_BYTES + AT_KS + klane;
            const unsigned vb = (unsigned)(uintptr_t)(lds + sl * AT_WAVE_BYTES + AT_VS) + vlane;
            f32x16 sc;
#pragma unroll
            for (int i = 0; i < 16; ++i) sc[i] = 0.f;
#pragma unroll
            for (int s = 0; s < 8; ++s) { const bf16x8 kf = *(const LAS bf16x8*)(kb + 32 * s); sc = __builtin_amdgcn_mfma_f32_32x32x16_bf16(kf, qf[s], sc, 0, 0, 0); }
            if (last && has_next) AT_LOADQ(nxt);
            const LAS float* tb = tabs + (32 * kt - ql + 4 * hl + 32);
#pragma unroll
            for (int i = 0; i < 16; ++i) { sc[i] = fmaf(sc[i], c, tb[8 * (i >> 2) + (i & 3)]); }
            if (last && has_next) AT_LOADTAB(nxt);
            if (AT_EDGE(cur, kt)) {
                const int ks0 = cur.q0 - cur.W + 32 * kt + 4 * hl;
#pragma unroll
                for (int i = 0; i < 16; ++i) { const int ks = ks0 + 8 * (i >> 2) + (i & 3); if (ks < 0 || ks >= cur.sub_len) sc[i] = -__builtin_inff(); }
            }
            float tmax = -__builtin_inff();
#pragma unroll
            for (int i = 0; i < 16; ++i) tmax = fmaxf(tmax, sc[i]);
            tmax = fmaxf(tmax, shx(tmax, 32, lane));
            if (__builtin_amdgcn_ballot_w64(tmax > m + 8.0f) != 0ull) {
                const float mn = fmaxf(m, tmax), alpha = __builtin_amdgcn_exp2f(m - mn); m = mn; l *= alpha;
#pragma unroll
                for (int i = 0; i < 16; ++i) { o0[i] *= alpha; o1[i] *= alpha; o2[i] *= alpha; o3[i] *= alpha; }
            }
            float ps = 0.f;
#pragma unroll
            for (int i = 0; i < 16; ++i) { sc[i] = __builtin_amdgcn_exp2f(sc[i] - m); ps += sc[i]; }
            l += ps;
            bf16x8 p0, p1;
            { u32x4 w0, w1; w0.x = pk2(sc[0], sc[1]); w0.y = pk2(sc[2], sc[3]); w0.z = pk2(sc[4], sc[5]); w0.w = pk2(sc[6], sc[7]);
              w1.x = pk2(sc[8], sc[9]); w1.y = pk2(sc[10], sc[11]); w1.z = pk2(sc[12], sc[13]); w1.w = pk2(sc[14], sc[15]);
              p0 = *reinterpret_cast<bf16x8*>(&w0); p1 = *reinterpret_cast<bf16x8*>(&w1); }
            { s16x4 a0, a1, b0, b1;
              TR4(a0, a1, b0, b1, vb, 0, 2560, 5120, 7680); __builtin_amdgcn_sched_barrier(0);
              o0 = __builtin_amdgcn_mfma_f32_32x32x16_bf16(PK8(a0, a1), p0, o0, 0, 0, 0); o0 = __builtin_amdgcn_mfma_f32_32x32x16_bf16(PK8(b0, b1), p1, o0, 0, 0, 0);
              TR4(a0, a1, b0, b1, vb, 64, 64 + 2560, 64 + 5120, 64 + 7680); __builtin_amdgcn_sched_barrier(0);
              o1 = __builtin_amdgcn_mfma_f32_32x32x16_bf16(PK8(a0, a1), p0, o1, 0, 0, 0); o1 = __builtin_amdgcn_mfma_f32_32x32x16_bf16(PK8(b0, b1), p1, o1, 0, 0, 0);
              TR4(a0, a1, b0, b1, vb, 128, 128 + 2560, 128 + 5120, 128 + 7680); __builtin_amdgcn_sched_barrier(0);
              o2 = __builtin_amdgcn_mfma_f32_32x32x16_bf16(PK8(a0, a1), p0, o2, 0, 0, 0); o2 = __builtin_amdgcn_mfma_f32_32x32x16_bf16(PK8(b0, b1), p1, o2, 0, 0, 0);
              TR4(a0, a1, b0, b1, vb, 192, 192 + 2560, 192 + 5120, 192 + 7680); __builtin_amdgcn_sched_barrier(0);
              o3 = __builtin_amdgcn_mfma_f32_32x32x16_bf16(PK8(a0, a1), p0, o3, 0, 0, 0); o3 = __builtin_amdgcn_mfma_f32_32x32x16_bf16(PK8(b0, b1), p1, o3, 0, 0, 0); }
            if (newt) {
                __syncthreads();
                *(LAS u32x4*)(lds + (tn & 7) * AT_WAVE_BYTES + AT_KS + wrow * 272 + 16 * lch) = kn; *(LAS u32x4*)(lds + (tn & 7) * AT_WAVE_BYTES + AT_VS + wrow * 320 + 16 * lch) = vn;
                __syncthreads();
            }
        }
        const float lt = l + shx(l, 32, lane), inv = 1.0f / lt;
        const size_t tok = (size_t)(cur.r + (cur.q0 + ql) * cur.dil);
        if (cur.o8) {
            unsigned char* op = cur.O + tok * cur.o_ld + cur.ocol + 4 * hl; const float i64 = inv * 64.f;
#pragma unroll
            for (int g = 0; g < 4; ++g) {
                *(unsigned*)(op + 8 * g) = pk4_fp8(o0[4 * g] * i64, o0[4 * g + 1] * i64, o0[4 * g + 2] * i64, o0[4 * g + 3] * i64);
                *(unsigned*)(op + 32 + 8 * g) = pk4_fp8(o1[4 * g] * i64, o1[4 * g + 1] * i64, o1[4 * g + 2] * i64, o1[4 * g + 3] * i64);
                *(unsigned*)(op + 64 + 8 * g) = pk4_fp8(o2[4 * g] * i64, o2[4 * g + 1] * i64, o2[4 * g + 2] * i64, o2[4 * g + 3] * i64);
                *(unsigned*)(op + 96 + 8 * g) = pk4_fp8(o3[4 * g] * i64, o3[4 * g + 1] * i64, o3[4 * g + 2] * i64, o3[4 * g + 3] * i64);
            }
        } else {
            bf16* op = (bf16*)cur.O + tok * cur.o_ld + cur.ocol + 4 * hl;
#pragma unroll
            for (int g = 0; g < 4; ++g) {
                u32x2 w;
                w.x = pk2(o0[4 * g] * inv, o0[4 * g + 1] * inv); w.y = pk2(o0[4 * g + 2] * inv, o0[4 * g + 3] * inv); *(u32x2*)(op + 8 * g) = w;
                w.x = pk2(o1[4 * g] * inv, o1[4 * g + 1] * inv); w.y = pk2(o1[4 * g + 2] * inv, o1[4 * g + 3] * inv); *(u32x2*)(op + 32 + 8 * g) = w;
                w.x = pk2(o2[4 * g] * inv, o2[4 * g + 1] * inv); w.y = pk2(o2[4 * g + 2] * inv, o2[4 * g + 3] * inv); *(u32x2*)(op + 64 + 8 * g) = w;
                w.x = pk2(o3[4 * g] * inv, o3[4 * g + 1] * inv); w.y = pk2(o3[4 * g + 2] * inv, o3[4 * g + 3] * inv); *(u32x2*)(op + 96 + 8 * g) = w;
            }
        }
        if (cur.lse && hl == 0) cur.lse[tok * 12 + cur.lse_idx] = m + __builtin_log2f(lt);
        if (!has_next) break;
        AT_FILL(nxt);
        __syncthreads();
        AT_STORETAB(nxt); AT_WRITEFILL();
        __syncthreads();
        cur = nxt; it = itn;
    }
    LDS_WAIT();
#undef AT_FILL
#undef AT_WRITEFILL
#undef AT_TOFF
#undef AT_LOADQ
#undef AT_LOADTAB
#undef AT_STORETAB
#undef AT_EDGE
}

__device__ __forceinline__ void phase_amerge(unsigned char* ws, int gw, int NGW, int lane) {
    const bf16* AR = (const bf16*)(ws + WS_AR); const float* LSE = (const float*)(ws + WS_LSE); unsigned char* AO8 = ws + WS_AO;
    const size_t gt = (size_t)gw * 64 + lane, NT = (size_t)NGW * 64;
    for (size_t i = gt; i < (size_t)TH * 64; i += NT) {
        const size_t t = i >> 6; const int ch = (int)(i & 63), h = ch >> 4, dc = ch & 15;
        const float l0 = LSE[t * 12 + h], l1 = LSE[t * 12 + 4 + h], l2 = LSE[t * 12 + 8 + h];
        const float mx = fmaxf(l0, fmaxf(l1, l2));
        float w0 = __builtin_amdgcn_exp2f(l0 - mx), w1 = __builtin_amdgcn_exp2f(l1 - mx), w2 = __builtin_amdgcn_exp2f(l2 - mx);
        const float inv = 1.0f / (w0 + w1 + w2); w0 *= inv; w1 *= inv; w2 *= inv;
        const bf16* ap = AR + t * 1536 + h * 128 + dc * 8;
        const u32x4 a = *(const u32x4*)ap, b = *(const u32x4*)(ap + 512), cc = *(const u32x4*)(ap + 1024);
        w0 *= 64.f; w1 *= 64.f; w2 *= 64.f;
        u32x2 o;
        o.x = pk4_fp8(w0 * pg8::bf_lo(a.x) + w1 * pg8::bf_lo(b.x) + w2 * pg8::bf_lo(cc.x), w0 * pg8::bf_hi(a.x) + w1 * pg8::bf_hi(b.x) + w2 * pg8::bf_hi(cc.x),
                      w0 * pg8::bf_lo(a.y) + w1 * pg8::bf_lo(b.y) + w2 * pg8::bf_lo(cc.y), w0 * pg8::bf_hi(a.y) + w1 * pg8::bf_hi(b.y) + w2 * pg8::bf_hi(cc.y));
        o.y = pk4_fp8(w0 * pg8::bf_lo(a.z) + w1 * pg8::bf_lo(b.z) + w2 * pg8::bf_lo(cc.z), w0 * pg8::bf_hi(a.z) + w1 * pg8::bf_hi(b.z) + w2 * pg8::bf_hi(cc.z),
                      w0 * pg8::bf_lo(a.w) + w1 * pg8::bf_lo(b.w) + w2 * pg8::bf_lo(cc.w), w0 * pg8::bf_hi(a.w) + w1 * pg8::bf_hi(b.w) + w2 * pg8::bf_hi(cc.w));
        *(u32x2*)(AO8 + t * 512 + h * 128 + dc * 8) = o;
    }
}

__device__ __forceinline__ void phase_ln(float* Y, bf16* XB, unsigned char* X8, float* st, bool inplace, const float* __restrict__ gam, const float* __restrict__ bet, int gw, int NGW, int lane) {
    for (int row = gw; row < T; row += NGW) {
        f32x4* yr = (f32x4*)(Y + (size_t)row * D) + lane;
        f32x4 v[8]; float s = 0.f;
#pragma unroll
        for (int j = 0; j < 8; ++j) { v[j] = yr[64 * j]; s += (v[j][0] + v[j][1]) + (v[j][2] + v[j][3]); }
        const float mean = wave_sum(s, lane) * (1.f / D); float s2 = 0.f;
#pragma unroll
        for (int j = 0; j < 8; ++j) { v[j] = v[j] - mean; s2 += (v[j][0] * v[j][0] + v[j][1] * v[j][1]) + (v[j][2] * v[j][2] + v[j][3] * v[j][3]); }
        const float rstd = 1.0f / sqrtf(wave_sum(s2, lane) * (1.f / D) + LN_EPS);
        if (st && lane == 0) { st[2 * (size_t)row] = mean; st[2 * (size_t)row + 1] = rstd; }
#pragma unroll
        for (int j = 0; j < 8; ++j) { const f32x4 gg = *((const f32x4*)gam + lane + 64 * j), bb = *((const f32x4*)bet + lane + 64 * j);
            const f32x4 o = v[j] * rstd * gg + bb;
            if (inplace) yr[64 * j] = o;
            if (XB) { u32x2 w; w.x = pk2(o[0], o[1]); w.y = pk2(o[2], o[3]); *((u32x2*)(XB + (size_t)row * D) + lane + 64 * j) = w; }
            if (X8) *((unsigned*)(X8 + (size_t)row * D) + lane + 64 * j) = pk4_fp8(o[0] * 32.f, o[1] * 32.f, o[2] * 32.f, o[3] * 32.f); }
    }
}

__global__ void __launch_bounds__(NTHREADS, 2) fwd_mega(Params p_arg) {
    extern __shared__ __attribute__((aligned(16))) unsigned char lds_raw[];
    LAS unsigned char* lds = (LAS unsigned char*)lds_raw;
    const int ph_lo = p_arg.ph_lo, ph_hi = p_arg.ph_hi;
    if (threadIdx.x < 4) ((LAS unsigned*)(lds + LDS_BARST))[threadIdx.x] = 0u;
    __syncthreads();
    for (int ph = ph_lo; ph < ph_hi; ++ph) {
      for (int rep = 0; rep < 2; ++rep) {
        if (ph > ph_lo || rep > 0) {
#if defined(__HIP_DEVICE_COMPILE__)
            unsigned* barw = (unsigned*)(((PP)__builtin_amdgcn_kernarg_segment_ptr())->ws + WS_BAR);
            if (ph == 1 && rep == 0) { cg::this_grid().sync();
                (void)xcd_barrier_post(barw, (volatile LAS unsigned*)(lds + LDS_BARST)); }
            else { XcdBarrier xb_; xb_.bar = barw; xb_.x = xb_xcc_id(); xb_.st = (volatile LAS unsigned*)(lds + LDS_BARST); xcd_barrier(xb_); }
#endif
        }
#if defined(__HIP_DEVICE_COMPILE__)
        PP p = (PP)__builtin_amdgcn_kernarg_segment_ptr(); asm volatile("" : "+s"(p));
#else
        PP p = (PP)(uintptr_t)0; (void)p_arg;
#endif
        int tid_ = threadIdx.x, bx_ = blockIdx.x; asm volatile("" : "+v"(tid_), "+s"(bx_));
        const int tid = tid_, lane = tid & 63, wave = __builtin_amdgcn_readfirstlane(tid >> 6);
        const int G = gridDim.x, bx = bx_, vcu = (G % 8 == 0) ? (bx % 8) * (G / 8) + bx / 8 : bx;
        const int gw = vcu * NWAVES + wave, NGW = G * NWAVES;
        unsigned char* ws = p->ws; bf16* XB = (bf16*)(ws + WS_XB);
        if (ph == 0) {
#if EN_PRO
 phase_prologue(p, lds, gw, NGW, wave, lane);
#endif
 if (rep == 0 && (PROBE_MASK & 1)) continue; else break; }
        const int q = ph - 1, layer = q / 13, s = q - layer * 13;
        const bf16* wl = (const bf16*)(ws + WS_W0 + (size_t)layer * WS_WL);
        const bool dbl = (s < 8 && (s & 3) == 1 && (PROBE_MASK & 2)) || (s < 8 && (s & 3) == 2 && (PROBE_MASK & 4)) || ((s == 9 || (s == 12 && layer == 0)) && (PROBE_MASK & 8)) || (s < 8 && (s & 3) == 0 && (PROBE_MASK & 16)) || (s == 10 && (PROBE_MASK & 32)) || (s < 8 && (s & 3) == 3 && (PROBE_MASK & 64));
        if (s < 8) {
            const int half = s >> 2, sub = s & 3;
            if (sub == 0) {
                pg8::Gemm g{(const bf16*)(ws + WS_X8 + (size_t)half * TH * D), wl + WO_IN, TH, CIN, D / 2}; pg8::StaticOrder S; S.init(TH, CIN, G, bx);
                pg8::EpiBf16<0> E{(bf16*)(ws + WS_PROJ), CIN, nullptr, 0, 0, 1.f};

#if EN_INPROJ
 pg8::gemm_phase<pg8::EpiBf16<0>, pg8::StaticOrder, true, true, true>(lds, g, S, E);
#endif

            } else if (sub == 1) {
#if EN_ATTN
 phase_attention(ws, p->sink, lds, layer, vcu, G, wave, lane);
#endif

            } else if (sub == 2) { phase_amerge(ws, gw, NGW, lane);
            } else {
                for (int k = 0; k < 2; ++k) {
                    pg8::Gemm g{k == 0 ? (const bf16*)(ws + WS_AO) : (const bf16*)(ws + WS_BO), wl + (k == 0 ? WO_PA : WO_PB), TH, D, k == 0 ? 256 : 512, 0x79797979, 0x78787878};
                    pg8::StaticOrder S; S.init(TH, D, G, bx);
                    pg8::EpiGate E{(bf16*)(ws + WS_XB + 64 * MiB), ws + WS_XB + (size_t)half * TH * D, D, (const bf16*)(ws + WS_PROJ) + (k == 0 ? 6144 : 8192), CIN, k, 512.f};

#if EN_GATE
 pg8::gemm_phase<pg8::EpiGate, pg8::StaticOrder, true, true, true>(lds, g, S, E);
#endif

                }
            }
        } else if (s == 8 || s == 11) {
            const bool dn = (s == 11);
            pg8::StaticOrder S; S.init(T, D, G, bx);
            const bool raw = (!dn && layer == 0);
            pg8::EpiResid E{(pg8::ArgV)p, raw ? 0 : -1, dn ? 7 : 11, dn ? 8 : 12, D, ALPHA, (size_t)(dn ? layer : (layer > 0 ? layer - 1 : 0)) * D, WS_ST};
#if EN_RESID
            if (dn && layer == FP8_DOWN_LAYER) { pg8::Gemm g{(const bf16*)(ws + WS_H), wl + WO_DN, T, D, DFF / 2, 0x79797979, 0x77777777}; pg8::gemm_phase<pg8::EpiResid, pg8::StaticOrder, true, true, true>(lds, g, S, E); }
            else if (dn) { pg8::Gemm g{(const bf16*)(ws + WS_H), wl + WO_DN, T, D, DFF}; pg8::gemm_phase<pg8::EpiResid, pg8::StaticOrder, true, true>(lds, g, S, E); }
            else { pg8::Gemm g{(const bf16*)(ws + WS_XB), wl + WO_OUT, T, D, D / 2, 0x76767676, 0x78787878}; pg8::gemm_phase<pg8::EpiResid, pg8::StaticOrder, true, true, true>(lds, g, S, E); }
#endif
        } else if (s == 9) { phase_ln(p->out, XB, nullptr, (float*)(ws + WS_ST), false, p->ln1_g + layer * D, p->ln1_b + layer * D, gw, NGW, lane);
        } else if (s == 10) {
            pg8::Gemm g{XB, wl + WO_UP, T, NUP, D}; pg8::StaticOrder S; S.init(T, NUP, G, bx);
            pg8::EpiSwiglu E{(bf16*)(ws + WS_H), DFF, layer == FP8_DOWN_LAYER ? 64.f : 0.f};

#if EN_SWIGLU
 pg8::gemm_phase<pg8::EpiSwiglu, pg8::StaticOrder, true, true>(lds, g, S, E);
#endif

        } else { phase_ln(p->out, nullptr, (layer == 1) ? nullptr : ws + WS_X8, (layer == 1) ? nullptr : (float*)(ws + WS_ST), layer == 1, p->ln2_g + layer * D, p->ln2_b + layer * D, gw, NGW, lane); }
        if (!(rep == 0 && dbl)) break;
      }
    }
}

#ifndef MK_PER_PHASE
#define MK_PER_PHASE 0
#endif
extern "C" void kernel_launch(void* const* d_in, const int* in_sizes, int n_in, void* d_out, int out_size, void* d_ws, size_t ws_size, hipStream_t stream) {
    static int grid = 0;
    if (grid == 0) {
        if (n_in != 13 || ws_size < WS_END) { fprintf(stderr, "kernel_launch: unexpected inputs (n_in %d, ws %zu)\n", n_in, ws_size); grid = -1; return; }
        int dev = 0, cus = 0;
        if (hipGetDevice(&dev) != hipSuccess || hipDeviceGetAttribute(&cus, hipDeviceAttributeMultiprocessorCount, dev) != hipSuccess) { grid = -1; return; }
        if (hipFuncSetAttribute((const void*)fwd_mega, hipFuncAttributeMaxDynamicSharedMemorySize, LDS_BYTES) != hipSuccess) { fprintf(stderr, "kernel_launch: hipFuncSetAttribute failed\n"); grid = -1; return; }
        (void)hipGetLastError();
        grid = cus;
    }
    if (grid < 0) return;
    Params p{};
    p.x = (const float*)d_in[0]; p.rel_bias = (const float*)d_in[1]; p.w_in = (const float*)d_in[2]; p.sink = (const float*)d_in[3]; p.w_pa = (const float*)d_in[4]; p.w_pb = (const float*)d_in[5];
    p.w_out = (const float*)d_in[6]; p.ln1_g = (const float*)d_in[7]; p.ln1_b = (const float*)d_in[8]; p.w_up = (const float*)d_in[9]; p.w_down = (const float*)d_in[10];
    p.ln2_g = (const float*)d_in[11]; p.ln2_b = (const float*)d_in[12]; p.out = (float*)d_out; p.ws = (unsigned char*)d_ws;
#if MK_PER_PHASE
    for (int ph = 0; ph < NPHASES; ++ph) { p.ph_lo = ph; p.ph_hi = ph + 1; hipLaunchKernelGGL(fwd_mega, dim3(grid), dim3(NTHREADS), LDS_BYTES, stream, p); }
#else
    p.ph_lo = 0; p.ph_hi = NPHASES;
    void* args[] = {&p};
    hipError_t e = hipLaunchCooperativeKernel((const void*)fwd_mega, dim3(grid), dim3(NTHREADS), args, LDS_BYTES, stream);
    if (e != hipSuccess) fprintf(stderr, "kernel_launch: cooperative launch failed: %s (grid %d)\n", hipGetErrorString(e), grid);
#endif
}
```

```cpp
#include <hip/hip_runtime.h>
#include <hip/hip_cooperative_groups.h>
#include <cstdio>
#include <cstdint>
namespace cg = cooperative_groups;
namespace pg8 {
#define PG8_LAS __attribute__((address_space(3)))
typedef unsigned short bf16_t;
typedef short bf16x8 __attribute__((ext_vector_type(8)));
typedef float f32x4 __attribute__((ext_vector_type(4)));
typedef unsigned u32x4 __attribute__((ext_vector_type(4)));
typedef unsigned u32x2 __attribute__((ext_vector_type(2)));
typedef int v8i32 __attribute__((ext_vector_type(8)));
typedef int v4i32 __attribute__((ext_vector_type(4)));
constexpr int FP8_SCALE_X = 0x79797979, FP8_SCALE_W = 0x79797979;
constexpr int BM = 256, BK = 64, HALF = 128, HTB = HALF * BK * 2  , STAGE_BYTES = 8 * HTB, NXCD = 8, WGM = 8;

__host__ __device__ __forceinline__ int lds_byte(int r, int c) { const int st = (r >> 4) * 2 + (c >> 5), rr = r & 15, cc = c & 31, ob = rr * 64 + cc * 2; return st * 1024 + (ob ^ (((ob >> 9) & 1) << 5)); }
__host__ __device__ __forceinline__ void stage_rc(int b, int& R, int& C) { const int st = b / 1024, sb = b % 1024, swz = sb ^ (((sb >> 9) & 1) << 5); R = (st >> 1) * 16 + swz / 64; C = (st & 1) * 32 + (swz % 64) / 2; }
__host__ __device__ __forceinline__ int x8(int r) { return ((r >> 1) & 3) | ((((r >> 2) ^ (r >> 3)) & 1) << 2); }
__host__ __device__ __forceinline__ int lds_byte8(int r, int c16) { return r * 128 + 16 * (c16 ^ x8(r & 15)); }
__host__ __device__ __forceinline__ void stage_rc8(int b, int& R, int& C) { R = b >> 7; C = 8 * (((b >> 4) & 7) ^ x8(R & 15)); }
__host__ __device__ __forceinline__ int perm32(int rho) { const int n = rho >> 4, i = rho & 15; return 8 * (i >> 2) + 4 * n + (i & 3); }

struct Unit { int pm, pn; };
struct Gemm { const bf16_t* A; const bf16_t* Bt; int M, N, K; int sx = 0x79797979, sw = 0x79797979; };

struct StaticOrder {
    int nM, nN, nwg, G, c;
    __host__ __device__ void init(int M, int N, int G_, int c_) { nM = M / BM; nN = N / BM; nwg = nM * nN; G = G_; c = c_; }
    __host__ __device__ bool next(int i, Unit& u) const {
        const long L = (long)i * G + c; if (L >= nwg) return false;
        int wgid = (int)L; { const int q = nwg / NXCD, r = nwg % NXCD, xcd = wgid % NXCD, off = wgid / NXCD; wgid = (xcd < r ? xcd * (q + 1) : r * (q + 1) + (xcd - r) * q) + off; }
        const int nig = WGM * nN, gid = wgid / nig, fm = gid * WGM, gsz = (nM - fm) < WGM ? (nM - fm) : WGM;
        u.pm = fm + ((wgid % nig) % gsz); u.pn = (wgid % nig) / gsz; return true;
    }
    __device__ __forceinline__ void a_ready(const Unit&) const {}
    __device__ __forceinline__ void done(const Unit&) const {}
};

__device__ __forceinline__ unsigned cvt_pk_bf16(float lo, float hi) { unsigned r; asm("v_cvt_pk_bf16_f32 %0, %1, %2" : "=v"(r) : "v"(lo), "v"(hi)); return r; }
typedef float f32x2 __attribute__((ext_vector_type(2)));
template <int ACT  > struct EpiBf16 {
    static constexpr bool PERM = true, AFTER_DRAIN = false; static_assert(ACT == 0 || ACT == 1, "EpiBf16: ACT is 0 (none) or 1 (gelu_pk)");
    bf16_t* O; int ldc; const float* bias; int split_cols; size_t split_stride; float scale0;
    __device__ __forceinline__ void operator()(const f32x4 (&acc)[2][2][4][2], const Unit& u, int wr, int wc, int fr, int fq) const {
        const int row0 = u.pm * BM + wr * 64 + fr; int colt = u.pn * BM; bf16_t* base = O;
        float sc = 1.f; if (split_cols) { const int t = colt / split_cols; base += (size_t)t * split_stride; colt -= t * split_cols; if (t == 0) sc = scale0; }
        const int col0 = colt + wc * 32 + 8 * fq, bcol0 = u.pn * BM + wc * 32 + 8 * fq;
        f32x4 bv[2][2];
#pragma unroll
        for (int bj = 0; bj < 2; ++bj)
#pragma unroll
            for (int n = 0; n < 2; ++n) bv[bj][n] = bias ? *(const f32x4*)(bias + bcol0 + bj * HALF + 4 * n) : (f32x4){0.f, 0.f, 0.f, 0.f};
#pragma unroll
        for (int ai = 0; ai < 2; ++ai)
#pragma unroll
            for (int m = 0; m < 4; ++m) { bf16_t* rowp = base + (size_t)(row0 + ai * HALF + m * 16) * ldc + col0;
#pragma unroll
                for (int bj = 0; bj < 2; ++bj) { f32x4 v0 = acc[ai][bj][m][0] + bv[bj][0], v1 = acc[ai][bj][m][1] + bv[bj][1];
                    v0 = v0 * sc; v1 = v1 * sc; u32x4 w; w.x = cvt_pk_bf16(v0[0], v0[1]); w.y = cvt_pk_bf16(v0[2], v0[3]); w.z = cvt_pk_bf16(v1[0], v1[1]); w.w = cvt_pk_bf16(v1[2], v1[3]);
                    *(u32x4*)(rowp + bj * HALF) = w; } }
    }
};
__device__ __forceinline__ float sigmoidf_fast(float x) { return __builtin_amdgcn_rcpf(1.0f + __builtin_amdgcn_exp2f(-1.4426950408889634f * x)); }
__device__ __forceinline__ float bf_lo(unsigned w) { return __uint_as_float(w << 16); }
__device__ __forceinline__ float bf_hi(unsigned w) { return __uint_as_float(w & 0xffff0000u); }
__device__ __forceinline__ float clamp448(float v) { return __builtin_fminf(__builtin_fmaxf(v, -448.f), 448.f); }
__device__ __forceinline__ unsigned pk4_fp8(float a, float b, float c, float d) { unsigned w = 0; w = __builtin_amdgcn_cvt_pk_fp8_f32(clamp448(a), clamp448(b), w, false); w = __builtin_amdgcn_cvt_pk_fp8_f32(clamp448(c), clamp448(d), w, true); return w; }
struct EpiProj {
    static constexpr bool PERM = true, AFTER_DRAIN = false;
    bf16_t* O; int ldc; unsigned char* G8; int ldg; int gcol0;
    __device__ __forceinline__ void operator()(const f32x4 (&acc)[2][2][4][2], const Unit& u, int wr, int wc, int fr, int fq) const {
        const int row0 = u.pm * BM + wr * 64 + fr, col0 = u.pn * BM + wc * 32 + 8 * fq;
        if (u.pn * BM < gcol0) {
#pragma unroll
            for (int ai = 0; ai < 2; ++ai)
#pragma unroll
                for (int m = 0; m < 4; ++m) { bf16_t* rowp = O + (size_t)(row0 + ai * HALF + m * 16) * ldc + col0;
#pragma unroll
                    for (int bj = 0; bj < 2; ++bj) { const f32x4 v0 = acc[ai][bj][m][0], v1 = acc[ai][bj][m][1];
                        u32x4 w; w.x = cvt_pk_bf16(v0[0], v0[1]); w.y = cvt_pk_bf16(v0[2], v0[3]); w.z = cvt_pk_bf16(v1[0], v1[1]); w.w = cvt_pk_bf16(v1[2], v1[3]);
                        *(u32x4*)(rowp + bj * HALF) = w; } }
        } else {
#pragma unroll
            for (int ai = 0; ai < 2; ++ai)
#pragma unroll
                for (int m = 0; m < 4; ++m) { unsigned char* rowp = G8 + (size_t)(row0 + ai * HALF + m * 16) * ldg + (col0 - gcol0);
#pragma unroll
                    for (int bj = 0; bj < 2; ++bj) { const f32x4 v0 = acc[ai][bj][m][0], v1 = acc[ai][bj][m][1];
                        u32x2 w8; w8.x = pk4_fp8(256.f * sigmoidf_fast(v0[0]), 256.f * sigmoidf_fast(v0[1]), 256.f * sigmoidf_fast(v0[2]), 256.f * sigmoidf_fast(v0[3]));
                        w8.y = pk4_fp8(256.f * sigmoidf_fast(v1[0]), 256.f * sigmoidf_fast(v1[1]), 256.f * sigmoidf_fast(v1[2]), 256.f * sigmoidf_fast(v1[3]));
                        *(u32x2*)(rowp + bj * HALF) = w8; } }
        }
    }
};
struct EpiGate {
    static constexpr bool PERM = true, AFTER_DRAIN = false;
    bf16_t* Tm; unsigned char* O8; int ldo; const unsigned char* G; int ldg; int add; float oscale;
    __device__ __forceinline__ void operator()(const f32x4 (&acc)[2][2][4][2], const Unit& u, int wr, int wc, int fr, int fq) const {
        const int row0 = u.pm * BM + wr * 64 + fr, col0 = u.pn * BM + wc * 32 + 8 * fq;
#pragma unroll
        for (int ai = 0; ai < 2; ++ai)
#pragma unroll
            for (int m = 0; m < 4; ++m) { const size_t r = (size_t)(row0 + ai * HALF + m * 16); bf16_t* rowp = Tm + r * ldo + col0; const unsigned char* gp = G + r * ldg + col0;
#pragma unroll
                for (int bj = 0; bj < 2; ++bj) { const u32x2 gw = *(const u32x2*)(gp + bj * HALF); f32x4 v0 = acc[ai][bj][m][0], v1 = acc[ai][bj][m][1];
                    { const f32x2 g0 = __builtin_amdgcn_cvt_pk_f32_fp8((int)gw.x, false), g1 = __builtin_amdgcn_cvt_pk_f32_fp8((int)gw.x, true), g2 = __builtin_amdgcn_cvt_pk_f32_fp8((int)gw.y, false), g3 = __builtin_amdgcn_cvt_pk_f32_fp8((int)gw.y, true);
                      const float k_ = 1.0f / 256.0f;
                      v0[0] *= g0.x * k_; v0[1] *= g0.y * k_; v0[2] *= g1.x * k_; v0[3] *= g1.y * k_; v1[0] *= g2.x * k_; v1[1] *= g2.y * k_; v1[2] *= g3.x * k_; v1[3] *= g3.y * k_; }
                    if (add) { const u32x4 pw = *(const u32x4*)(rowp + bj * HALF);
                        v0[0] += bf_lo(pw.x); v0[1] += bf_hi(pw.x); v0[2] += bf_lo(pw.y); v0[3] += bf_hi(pw.y); v1[0] += bf_lo(pw.z); v1[1] += bf_hi(pw.z); v1[2] += bf_lo(pw.w); v1[3] += bf_hi(pw.w);
                        v0 = v0 * oscale; v1 = v1 * oscale; u32x2 w8; w8.x = pk4_fp8(v0[0], v0[1], v0[2], v0[3]); w8.y = pk4_fp8(v1[0], v1[1], v1[2], v1[3]);
                        *(u32x2*)(O8 + r * ldo + col0 + bj * HALF) = w8; }
                    else { u32x4 w; w.x = cvt_pk_bf16(v0[0], v0[1]); w.y = cvt_pk_bf16(v0[2], v0[3]); w.z = cvt_pk_bf16(v1[0], v1[1]); w.w = cvt_pk_bf16(v1[2], v1[3]);
                        *(u32x4*)(rowp + bj * HALF) = w; } } }
    }
};
typedef void* vptr_t; typedef const __attribute__((address_space(4))) vptr_t* ArgV;
struct EpiResid {
    static constexpr bool PERM = false, AFTER_DRAIN = false;
    ArgV args; int xi, gi, bi; int ldc; float alpha; size_t goff; size_t st_off;
    __device__ __forceinline__ void operator()(const f32x4 (&acc)[2][2][4][2], const Unit& u, int wr, int wc, int fr, int fq) const {
        ArgV a_ = args; asm volatile("" : "+s"(a_));
        float* Y = (float*)a_[13]; const float* X = xi >= 0 ? (const float*)a_[xi] : (const float*)Y;
        const float* st = xi >= 0 ? nullptr : (const float*)((const unsigned char*)a_[14] + st_off);
        const float* g = (const float*)a_[gi < 0 ? 0 : gi] + goff; const float* b = (const float*)a_[bi < 0 ? 0 : bi] + goff;
        const int row0 = u.pm * BM + wr * 64 + fr, col0 = u.pn * BM + wc * 32 + 4 * fq;
#pragma unroll
        for (int ai = 0; ai < 2; ++ai)
#pragma unroll
            for (int m = 0; m < 4; ++m) { const int r = row0 + ai * HALF + m * 16; const size_t off = (size_t)r * ldc + col0;
                float mean = 0.f, rstd = 1.f; if (st) { const f32x2 sv = *(const f32x2*)(st + 2 * (size_t)r); mean = sv.x; rstd = sv.y; }
#pragma unroll
                for (int bj = 0; bj < 2; ++bj)
#pragma unroll
                    for (int n = 0; n < 2; ++n) { f32x4 xv = *(const f32x4*)(X + off + bj * HALF + n * 16);
                        if (st) { const f32x4 gv = *(const f32x4*)(g + col0 + bj * HALF + n * 16), bv = *(const f32x4*)(b + col0 + bj * HALF + n * 16); xv = (xv - mean) * rstd * gv + bv; }
                        *(f32x4*)(Y + off + bj * HALF + n * 16) = xv * alpha + acc[ai][bj][m][n]; }
                asm volatile("" ::: "memory"); }
    }
};
struct EpiSwiglu {
    static constexpr bool PERM = true, AFTER_DRAIN = false;
    bf16_t* Hh; int ldh; float hscale;
    __device__ __forceinline__ void operator()(const f32x4 (&acc)[2][2][4][2], const Unit& u, int wr, int wc, int fr, int fq) const {
        const int row0 = u.pm * BM + wr * 64 + fr, col0 = u.pn * HALF + wc * 32 + 8 * fq;
#pragma unroll
        for (int ai = 0; ai < 2; ++ai)
#pragma unroll
            for (int m = 0; m < 4; ++m) { bf16_t* rowp = Hh + (size_t)(row0 + ai * HALF + m * 16) * ldh + col0; float hv[8];
#pragma unroll
                for (int n = 0; n < 2; ++n)
#pragma unroll
                    for (int j = 0; j < 4; ++j) { const float g = acc[ai][0][m][n][j], up = acc[ai][1][m][n][j]; hv[n * 4 + j] = g * sigmoidf_fast(g) * up; }
                if (hscale != 0.f) { u32x2 w8; w8.x = pk4_fp8(hv[0] * hscale, hv[1] * hscale, hv[2] * hscale, hv[3] * hscale); w8.y = pk4_fp8(hv[4] * hscale, hv[5] * hscale, hv[6] * hscale, hv[7] * hscale);
                    *(u32x2*)((unsigned char*)Hh + (size_t)(row0 + ai * HALF + m * 16) * ldh + col0) = w8; }
                else { u32x4 w; w.x = cvt_pk_bf16(hv[0], hv[1]); w.y = cvt_pk_bf16(hv[2], hv[3]); w.z = cvt_pk_bf16(hv[4], hv[5]); w.w = cvt_pk_bf16(hv[6], hv[7]);
                    *(u32x4*)rowp = w; } }
    }
};
template <class Epi, class Sched, bool ALIGN_EPI = false, bool SP2 = false, bool FP8 = false>
__device__ __forceinline__ void gemm_phase(PG8_LAS unsigned char* lds, const Gemm g, const Sched& S, const Epi& E) {
    int tid_ = threadIdx.x; asm volatile("" : "+v"(tid_));
    const int tid = tid_, wid = __builtin_amdgcn_readfirstlane(tid >> 6), lane = tid & 63, wr = wid >> 2, wc = wid & 3, fr = lane & 15, fq = lane >> 4;
    const int K = g.K, nt = K / BK;
    unsigned voffA[2], voffB[2];
#pragma unroll
    for (int i = 0; i < 2; ++i) { int R, C; if constexpr (FP8) stage_rc8(tid * 16 + i * 8192, R, C); else stage_rc(tid * 16 + i * 8192, R, C); const int Rb = Epi::PERM ? ((R & ~31) + perm32(R & 31)) : R;
        voffA[i] = (unsigned)(R * K + C) * 2u; voffB[i] = (unsigned)(Rb * K + C) * 2u; }
    const size_t r64step = (size_t)64 * K * 2;
    const size_t kstep = (size_t)(BK * 2);
    const size_t hstep = (size_t)HALF * K * 2;
    const size_t tstep = 2 * hstep;
    const unsigned ldsw = (unsigned)wid * 1024u;
    const int aoff = FP8 ? lds_byte8(wr * 64 + fr, 2 * fq) : lds_byte(wr * 64 + fr, fq * 8), boff = FP8 ? lds_byte8(wc * 32 + fr, 2 * fq) : lds_byte(wc * 32 + fr, fq * 8);
    const int aoff1 = FP8 ? lds_byte8(wr * 64 + fr, 2 * fq + 1) : 0, boff1 = FP8 ? lds_byte8(wc * 32 + fr, 2 * fq + 1) : 0;
#define PG8_SA(b, h) (((b) * 2 + (h)) * HTB)
#define PG8_SB(b, h) ((4 + (b) * 2 + (h)) * HTB)
#define PG8_STAGE(bufoff, gbase, voff) do { _Pragma("unroll") for (int _i = 0; _i < 2; ++_i) { const char* _gb = (const char*)(gbase) + (size_t)_i * r64step; asm volatile("" : "+s"(_gb));     \
        __builtin_amdgcn_global_load_lds((const unsigned*)(_gb + (voff)[0]), (PG8_LAS unsigned*)(lds + (bufoff) + ldsw + _i * 8192), 16, 0, 0); } } while (0)
#define PG8_LD8(p_, q_) __builtin_shufflevector(*(const PG8_LAS v4i32*)(p_), *(const PG8_LAS v4i32*)(q_), 0, 1, 2, 3, 4, 5, 6, 7)
#define PG8_LDA(dst, b, h) do { if constexpr (FP8) { _Pragma("unroll") for (int m = 0; m < 4; ++m) dst##8[m] = PG8_LD8(lds + PG8_SA(b, h) + aoff + m * 2048, lds + PG8_SA(b, h) + aoff1 + m * 2048); } \
        else { _Pragma("unroll") for (int m = 0; m < 4; ++m) _Pragma("unroll") for (int k = 0; k < 2; ++k) dst[m][k] = *(const PG8_LAS bf16x8*)(lds + PG8_SA(b, h) + aoff + m * 2048 + k * 1024); } } while (0)
#define PG8_LDB(dst, b, h) do { if constexpr (FP8) { _Pragma("unroll") for (int n = 0; n < 2; ++n) dst##8[n] = PG8_LD8(lds + PG8_SB(b, h) + boff + n * 2048, lds + PG8_SB(b, h) + boff1 + n * 2048); } \
        else { _Pragma("unroll") for (int n = 0; n < 2; ++n) _Pragma("unroll") for (int k = 0; k < 2; ++k) dst[n][k] = *(const PG8_LAS bf16x8*)(lds + PG8_SB(b, h) + boff + n * 2048 + k * 1024); } } while (0)
#define PG8_MMA(ai, bj, At, Bt) do { __builtin_amdgcn_s_setprio(1); if constexpr (FP8) { _Pragma("unroll") for (int m = 0; m < 4; ++m) _Pragma("unroll") for (int n = 0; n < 2; ++n) \
            acc[ai][bj][m][n] = __builtin_amdgcn_mfma_scale_f32_16x16x128_f8f6f4(Bt##8[n], At##8[m], acc[ai][bj][m][n], 0, 0, 0, g.sw, 0, g.sx); } \
        else { _Pragma("unroll") for (int m = 0; m < 4; ++m) _Pragma("unroll") for (int n = 0; n < 2; ++n) _Pragma("unroll") for (int k = 0; k < 2; ++k) \
        acc[ai][bj][m][n] = __builtin_amdgcn_mfma_f32_16x16x32_bf16(Bt[n][k], At[m][k], acc[ai][bj][m][n], 0, 0, 0); } __builtin_amdgcn_s_setprio(0); } while (0)
#define PG8_WAIT_V(n) asm volatile("s_waitcnt vmcnt(" #n ")" ::: "memory")
#define PG8_WAIT_L(n) asm volatile("s_waitcnt lgkmcnt(" #n ")" ::: "memory")
#define PG8_BAR __builtin_amdgcn_s_barrier()
#define PG8_SCHED __builtin_amdgcn_sched_barrier(0)
    Unit cur, nxt; int ui = 0;
    if (!S.next(0, cur)) return;
    f32x4 acc[2][2][4][2];
#pragma unroll
    for (int a = 0; a < 2; ++a)
#pragma unroll
        for (int b = 0; b < 2; ++b)
#pragma unroll
            for (int m = 0; m < 4; ++m)
#pragma unroll
                for (int n = 0; n < 2; ++n) acc[a][b][m][n] = (f32x4){0.f, 0.f, 0.f, 0.f};
    bf16x8 At[4][2], B0[2][2], B1[2][2]; v8i32 At8[4], B08[2], B18[2];
    const char* cA = (const char*)g.A + (size_t)cur.pm * tstep; const char* cB = (const char*)g.Bt + (size_t)cur.pn * tstep;
    S.a_ready(cur);
    if constexpr (SP2) {
        PG8_STAGE(PG8_SB(0, 0), cB, voffB); PG8_STAGE(PG8_SB(0, 1), cB + hstep, voffB); PG8_STAGE(PG8_SA(0, 0), cA, voffA); PG8_STAGE(PG8_SA(0, 1), cA + hstep, voffA);
        if (wr == 1) PG8_BAR;
        PG8_WAIT_V(2); PG8_BAR;
        PG8_STAGE(PG8_SB(1, 0), cB + kstep, voffB); PG8_STAGE(PG8_SA(1, 0), cA + kstep, voffA); PG8_STAGE(PG8_SB(1, 1), cB + hstep + kstep, voffB);
        PG8_WAIT_V(6); PG8_BAR;
    } else {
        PG8_STAGE(PG8_SB(0, 0), cB, voffB); PG8_STAGE(PG8_SA(0, 0), cA, voffA); PG8_STAGE(PG8_SB(0, 1), cB + hstep, voffB); PG8_STAGE(PG8_SA(0, 1), cA + hstep, voffA);
        if (wr == 1) PG8_BAR;
        PG8_WAIT_V(4); PG8_BAR;
        PG8_STAGE(PG8_SB(1, 0), cB + kstep, voffB); PG8_STAGE(PG8_SA(1, 0), cA + kstep, voffA); PG8_STAGE(PG8_SB(1, 1), cB + hstep + kstep, voffB);
        PG8_WAIT_V(6); PG8_BAR;
    }
    for (;;) {
        const bool has_next = S.next(ui + 1, nxt);
        const char* nA = has_next ? (const char*)g.A + (size_t)nxt.pm * tstep : cA; const char* nB = has_next ? (const char*)g.Bt + (size_t)nxt.pn * tstep : cB;
        for (int t = 0; t < nt; t += 2) {
            const bool last = (t == nt - 2);
            const char* a1 = cA + (size_t)(t + 1) * kstep;
            const char* a2 = last ? nA : cA + (size_t)(t + 2) * kstep; const char* b2 = last ? nB : cB + (size_t)(t + 2) * kstep;
            const char* a3 = a2 + kstep; const char* b3 = b2 + kstep;
            if (last && has_next) S.a_ready(nxt);
            if constexpr (SP2) {
            PG8_LDB(B0, 0, 0); PG8_LDB(B1, 0, 1); PG8_SCHED; PG8_LDA(At, 0, 0); PG8_STAGE(PG8_SA(1, 1), a1 + hstep, voffA);
            PG8_WAIT_V(8); PG8_WAIT_L(0); PG8_BAR; PG8_MMA(0, 0, At, B0); PG8_MMA(0, 1, At, B1); PG8_BAR; PG8_SCHED;
            PG8_LDA(At, 0, 1); PG8_STAGE(PG8_SB(0, 0), b2, voffB); PG8_STAGE(PG8_SB(0, 1), b2 + hstep, voffB); PG8_STAGE(PG8_SA(0, 0), a2, voffA);
            PG8_WAIT_V(8); PG8_WAIT_L(0); PG8_BAR; PG8_MMA(1, 0, At, B0); PG8_MMA(1, 1, At, B1); PG8_BAR; PG8_SCHED;
            PG8_LDB(B0, 1, 0); PG8_LDB(B1, 1, 1); PG8_SCHED; PG8_LDA(At, 1, 0); PG8_STAGE(PG8_SA(0, 1), a2 + hstep, voffA);
            PG8_WAIT_V(8); PG8_WAIT_L(0); PG8_BAR; PG8_MMA(0, 0, At, B0); PG8_MMA(0, 1, At, B1); PG8_BAR; PG8_SCHED;
            PG8_LDA(At, 1, 1); PG8_STAGE(PG8_SB(1, 0), b3, voffB); PG8_STAGE(PG8_SB(1, 1), b3 + hstep, voffB); PG8_STAGE(PG8_SA(1, 0), a3, voffA);
            PG8_WAIT_V(8); PG8_WAIT_L(0); PG8_BAR; PG8_MMA(1, 0, At, B0); PG8_MMA(1, 1, At, B1); PG8_BAR; PG8_SCHED;
            } else {
            PG8_LDB(B0, 0, 0); PG8_SCHED; PG8_LDA(At, 0, 0); PG8_STAGE(PG8_SA(1, 1), a1 + hstep, voffA);
            PG8_WAIT_L(8); PG8_BAR; PG8_WAIT_L(0); PG8_MMA(0, 0, At, B0); PG8_BAR; PG8_SCHED;
            PG8_LDB(B1, 0, 1); PG8_STAGE(PG8_SB(0, 0), b2, voffB);
            PG8_BAR; PG8_WAIT_L(0); PG8_MMA(0, 1, At, B1); PG8_BAR;
            PG8_LDA(At, 0, 1); PG8_STAGE(PG8_SA(0, 0), a2, voffA);
            PG8_BAR; PG8_WAIT_L(0); PG8_MMA(1, 0, At, B0); PG8_BAR; PG8_SCHED;
            PG8_STAGE(PG8_SB(0, 1), b2 + hstep, voffB);
            PG8_WAIT_V(6); PG8_BAR; PG8_MMA(1, 1, At, B1); PG8_BAR;
            PG8_LDB(B0, 1, 0); PG8_SCHED; PG8_LDA(At, 1, 0); PG8_STAGE(PG8_SA(0, 1), a2 + hstep, voffA);
            PG8_WAIT_L(8); PG8_BAR; PG8_WAIT_L(0); PG8_MMA(0, 0, At, B0); PG8_BAR; PG8_SCHED;
            PG8_LDB(B1, 1, 1); PG8_STAGE(PG8_SB(1, 0), b3, voffB);
            PG8_BAR; PG8_WAIT_L(0); PG8_MMA(0, 1, At, B1); PG8_BAR;
            PG8_LDA(At, 1, 1); PG8_STAGE(PG8_SA(1, 0), a3, voffA);
            PG8_BAR; PG8_WAIT_L(0); PG8_MMA(1, 0, At, B0); PG8_BAR; PG8_SCHED;
            PG8_STAGE(PG8_SB(1, 1), b3 + hstep, voffB);
            PG8_WAIT_V(6); PG8_BAR; PG8_MMA(1, 1, At, B1); PG8_BAR;
            }
        }
        if constexpr (ALIGN_EPI) { if (wr == 0) PG8_BAR; }
        if constexpr (!Epi::AFTER_DRAIN) { int t2_ = threadIdx.x; asm volatile("" : "+v"(t2_)); const int fr_ = t2_ & 15, fq_ = (t2_ & 63) >> 4;
            E(acc, cur, wr, wc, fr_, fq_); S.done(cur); }
        if (!has_next) break;
#pragma unroll
        for (int a = 0; a < 2; ++a)
#pragma unroll
            for (int b = 0; b < 2; ++b)
#pragma unroll
                for (int m = 0; m < 4; ++m)
#pragma unroll
                    for (int n = 0; n < 2; ++n) acc[a][b][m][n] = (f32x4){0.f, 0.f, 0.f, 0.f};
        cur = nxt; cA = nA; cB = nB; ++ui;
        if constexpr (ALIGN_EPI) { if (wr == 1) PG8_BAR; }
    }
    PG8_WAIT_V(0);
    if constexpr (!ALIGN_EPI) { if (wr == 0) PG8_BAR; }
    PG8_BAR;
    if constexpr (Epi::AFTER_DRAIN) { E.fused(acc, cur, wr, wc, fr, fq, lds, wid, lane); S.done(cur); }
#undef PG8_SA
#undef PG8_SB
#undef PG8_STAGE
#undef PG8_LD8
#undef PG8_LDA
#undef PG8_LDB
#undef PG8_MMA
#undef PG8_WAIT_V
#undef PG8_WAIT_L
#undef PG8_BAR
#undef PG8_SCHED
}
}

#ifndef FP8_DOWN_LAYER
#define FP8_DOWN_LAYER 1
#endif
#ifndef PROBE_MASK
#define PROBE_MASK 0
#endif
#ifndef EN_INPROJ
#define EN_INPROJ 1
#endif
#ifndef EN_GATE
#define EN_GATE 1
#endif
#ifndef EN_RESID
#define EN_RESID 1
#endif
#ifndef EN_SWIGLU
#define EN_SWIGLU 1
#endif
#ifndef EN_ATTN
#define EN_ATTN 1
#endif
#ifndef EN_PRO
#define EN_PRO 1
#endif
#define LAS __attribute__((address_space(3)))
typedef unsigned short bf16;
typedef short bf16x8 __attribute__((ext_vector_type(8)));
typedef short s16x4 __attribute__((ext_vector_type(4)));
typedef float f32x4 __attribute__((ext_vector_type(4)));
typedef float f32x16 __attribute__((ext_vector_type(16)));
typedef unsigned u32x4 __attribute__((ext_vector_type(4)));
typedef unsigned u32x2 __attribute__((ext_vector_type(2)));

constexpr int T = 32768, TH = 16384, D = 2048, CIN = 10240, DFF = 5632, NUP = 11264, SEQ = 16384;
constexpr int NWAVES = 8, NTHREADS = 512;
constexpr float ALPHA = 1.41421356237309515f;
constexpr float LN_EPS = 1e-5f;
constexpr float LOG2E = 1.4426950408889634f;
constexpr int LDS_BYTES = 163840, LDS_BARST = 163824;
constexpr int NPHASES = 27;

constexpr size_t MiB = (size_t)1 << 20;
constexpr size_t WS_TAB = 0;
constexpr size_t WS_BAR = 256 * 1024;
constexpr size_t WS_W0 = 1 * MiB, WS_WL = 120 * MiB;
constexpr size_t WO_IN = 0, WO_PA = WO_IN + (size_t)CIN * D, WO_PB = WO_PA + (size_t)D * 512, WO_OUT = WO_PB + (size_t)D * 1024, WO_UP = WO_OUT + (size_t)D * D,
                 WO_DN = WO_UP + (size_t)NUP * D, WO_END = WO_DN + (size_t)D * DFF;
static_assert(WO_END * 2 <= WS_WL, "weight block");
constexpr size_t WS_XB = 241 * MiB;
constexpr size_t WS_PROJ = 369 * MiB;
constexpr size_t WS_AR = 689 * MiB;
constexpr size_t WS_LSE = 737 * MiB;
constexpr size_t WS_AO = 738 * MiB;
constexpr size_t WS_BO = 754 * MiB;
constexpr size_t WS_H = 369 * MiB;
constexpr size_t WS_X8 = 800 * MiB;
constexpr size_t WS_ST = 864 * MiB;
constexpr size_t WS_G8 = 866 * MiB;
constexpr size_t WS_END = 930 * MiB;

struct Params;
typedef const __attribute__((address_space(4))) Params* PP;
struct Params {
    const float* x; const float* rel_bias; const float* w_in; const float* sink; const float* w_pa; const float* w_pb; const float* w_out;
    const float* ln1_g; const float* ln1_b; const float* w_up; const float* w_down; const float* ln2_g; const float* ln2_b;
    float* out; unsigned char* ws; int ph_lo, ph_hi;
};

__device__ __forceinline__ unsigned pk2(float a, float b) { return pg8::cvt_pk_bf16(a, b); }
__device__ __forceinline__ float shx(float v, int o, int lane) { return __int_as_float(__builtin_amdgcn_ds_bpermute((lane ^ o) << 2, __float_as_int(v))); }
__device__ __forceinline__ float wave_sum(float v, int lane) {
#pragma unroll
    for (int o = 1; o < 64; o <<= 1) v += shx(v, o, lane);
    return v;
}
#define LDS_WAIT() asm volatile("s_waitcnt lgkmcnt(0)" ::: "memory")

#define XB_TMO      128
#define XB_XCNT(j)  (256  + 64 * (j))
#define XB_XSUB(j)  (1280 + 64 * (j))
#define XB_XGEN(j)  (2304 + 64 * (j))
#define XB_TOP      3328
#define XB_TOPGEN   3392
#define XCD_BAR_WORDS 3456
#define XB_SPIN_CAP (1u << 18)

__device__ __forceinline__ unsigned xb_ld(unsigned* p)              { return __hip_atomic_load(p, __ATOMIC_RELAXED, __HIP_MEMORY_SCOPE_AGENT); }
__device__ __forceinline__ unsigned xb_add(unsigned* p, unsigned v) { return __hip_atomic_fetch_add(p, v, __ATOMIC_RELAXED, __HIP_MEMORY_SCOPE_AGENT); }
__device__ __forceinline__ unsigned xb_xcc_id() { return (unsigned)__builtin_amdgcn_s_getreg((3 << 11) | 20) & 0xFu; }
#define XB_SPIN(cond, bar) do { unsigned _sp = 0; while (cond) { __builtin_amdgcn_s_sleep(1); \
    if ((++_sp & 255u) == 0u) { if (xb_ld(&(bar)[XB_TMO])) break; if (_sp > XB_SPIN_CAP) { atomicAdd(&(bar)[XB_TMO], 1u); break; } } } } while (0)

struct XcdBarrier {
    unsigned* bar; unsigned x;
    volatile LAS unsigned* st;
};

__device__ __forceinline__ XcdBarrier xcd_barrier_post(unsigned* bar, volatile LAS unsigned* st) {
    XcdBarrier b; b.bar = bar; b.x = xb_xcc_id(); b.st = st;
    if (threadIdx.x == 0) (void)xb_add(&bar[XB_XCNT(b.x)], 1u);
    return b;
}
__device__ __forceinline__ void xcd_barrier_complete(unsigned* bar, unsigned x, unsigned& nloc, unsigned& nx) {
    const unsigned G = gridDim.x * gridDim.y * gridDim.z;
    unsigned sum, cnt, mine, sp = 0u;
    for (;;) {
        sum = 0u; cnt = 0u; mine = 0u;
#pragma unroll
        for (unsigned j = 0; j < 16; ++j) { const unsigned c = xb_ld(&bar[XB_XCNT(j)]); sum += c; cnt += (c > 0u) ? 1u : 0u; mine = (j == x) ? c : mine; }
        if (sum == G) break;
        __builtin_amdgcn_s_sleep(1);
        if ((++sp & 255u) == 0u) { if (xb_ld(&bar[XB_TMO])) break; if (sp > XB_SPIN_CAP) { atomicAdd(&bar[XB_TMO], 1u); break; } }
    }
    nloc = mine > 0u ? mine : 1u; nx = cnt > 0u ? cnt : 1u;
}

__device__ __forceinline__ void xcd_barrier(const XcdBarrier& b) {
    asm volatile("s_waitcnt vmcnt(0)" ::: "memory");
    __syncthreads();
    if (threadIdx.x == 0) {
        unsigned* bar = b.bar;
        __builtin_amdgcn_s_waitcnt(0);
        unsigned nloc = b.st[0], nx = b.st[1];
        if (nloc == 0u) { xcd_barrier_complete(bar, b.x, nloc, nx); b.st[0] = nloc; b.st[1] = nx; }
        const unsigned old = xb_add(&bar[XB_XSUB(b.x)], 1u);
        const unsigned gen = old / nloc;
        if (old + 1u == (gen + 1u) * nloc) {
            __builtin_amdgcn_fence(__ATOMIC_RELEASE, "agent");
            asm volatile("s_waitcnt vmcnt(0)" ::: "memory");
            const unsigned og = xb_add(&bar[XB_TOP], 1u);
            const unsigned tg = og / nx;
            if (og + 1u == (tg + 1u) * nx) xb_add(&bar[XB_TOPGEN], 1u);
            else XB_SPIN(xb_ld(&bar[XB_TOPGEN]) == tg, bar);
            __builtin_amdgcn_fence(__ATOMIC_ACQUIRE, "agent");
            xb_add(&bar[XB_XGEN(b.x)], 1u);
            asm volatile("s_waitcnt vmcnt(0)" ::: "memory");
        } else {
            XB_SPIN(xb_ld(&bar[XB_XGEN(b.x)]) == gen, bar);
            __builtin_amdgcn_fence(__ATOMIC_ACQUIRE, "agent");
            asm volatile("s_waitcnt vmcnt(0)" ::: "memory");
        }
    }
    __syncthreads();
}


__device__ __forceinline__ void transpose_item(const float* __restrict__ W, int K, int N, bf16* WT, int k0, int n0, int row0, LAS float* scr, int lane) {
    { f32x4 tv[8];
#pragma unroll
      for (int i = 0; i < 8; ++i) tv[i] = *(const f32x4*)(W + (size_t)(k0 + 8 * i + (lane >> 3)) * N + n0 + 4 * (lane & 7));
#pragma unroll
      for (int i = 0; i < 8; ++i) { LAS float* d_ = scr + (8 * i + (lane >> 3)) * 33 + 4 * (lane & 7); d_[0] = tv[i][0]; d_[1] = tv[i][1]; d_[2] = tv[i][2]; d_[3] = tv[i][3]; } }
    LDS_WAIT();
    const int c = lane & 7;
#pragma unroll
    for (int j = 0; j < 4; ++j) { const int n = (lane >> 3) + 8 * j; const LAS float* s = scr + (8 * c) * 33 + n;
        u32x4 o; o.x = pk2(s[0 * 33], s[1 * 33]); o.y = pk2(s[2 * 33], s[3 * 33]); o.z = pk2(s[4 * 33], s[5 * 33]); o.w = pk2(s[6 * 33], s[7 * 33]);
        *(u32x4*)(WT + (size_t)(row0 + n) * K + k0 + 8 * c) = o; }
    LDS_WAIT();
}
using pg8::pk4_fp8;
__device__ __forceinline__ void transpose_item_fp8(const float* __restrict__ W, int K, int N, unsigned char* WT, int k0, int n0, LAS float* scr, int lane, float scale) {
    { f32x4 tv[8];
#pragma unroll
      for (int i = 0; i < 8; ++i) tv[i] = *(const f32x4*)(W + (size_t)(k0 + 8 * i + (lane >> 3)) * N + n0 + 4 * (lane & 7));
#pragma unroll
      for (int i = 0; i < 8; ++i) { LAS float* d_ = scr + (8 * i + (lane >> 3)) * 33 + 4 * (lane & 7); d_[0] = tv[i][0]; d_[1] = tv[i][1]; d_[2] = tv[i][2]; d_[3] = tv[i][3]; } }
    LDS_WAIT();
    const int n = lane >> 1, kh = lane & 1; const LAS float* sp = scr + (32 * kh) * 33 + n;
    u32x4 o0, o1;
    o0.x = pk4_fp8(sp[0 * 33] * scale, sp[1 * 33] * scale, sp[2 * 33] * scale, sp[3 * 33] * scale); o0.y = pk4_fp8(sp[4 * 33] * scale, sp[5 * 33] * scale, sp[6 * 33] * scale, sp[7 * 33] * scale);
    o0.z = pk4_fp8(sp[8 * 33] * scale, sp[9 * 33] * scale, sp[10 * 33] * scale, sp[11 * 33] * scale); o0.w = pk4_fp8(sp[12 * 33] * scale, sp[13 * 33] * scale, sp[14 * 33] * scale, sp[15 * 33] * scale);
    o1.x = pk4_fp8(sp[16 * 33] * scale, sp[17 * 33] * scale, sp[18 * 33] * scale, sp[19 * 33] * scale); o1.y = pk4_fp8(sp[20 * 33] * scale, sp[21 * 33] * scale, sp[22 * 33] * scale, sp[23 * 33] * scale);
    o1.z = pk4_fp8(sp[24 * 33] * scale, sp[25 * 33] * scale, sp[26 * 33] * scale, sp[27 * 33] * scale); o1.w = pk4_fp8(sp[28 * 33] * scale, sp[29 * 33] * scale, sp[30 * 33] * scale, sp[31 * 33] * scale);
    unsigned char* dst = WT + (size_t)(n0 + n) * K + k0 + 32 * kh;
    *(u32x4*)dst = o0; *(u32x4*)(dst + 16) = o1;
    LDS_WAIT();
}
__device__ __forceinline__ int t5_bucket(int rel) {
    const int n = rel < 0 ? -rel : rel; int b;
    if (n < 8) b = n; else { const int e = (int)(__builtin_log2f((float)n * 0.125f) * (8.0f / 7.0f)); b = 8 + e; if (b > 15) b = 15; }
    return b + (rel > 0 ? 16 : 0);
}
__device__ __forceinline__ void phase_prologue(PP pp, LAS unsigned char* lds, int gw, int NGW, int wave, int lane) {
    LAS float* scr = (LAS float*)(lds + wave * 16384);
    constexpr int I_IN = (D / 64) * (CIN / 32), I_PA = (512 / 64) * (D / 32), I_PB = (1024 / 64) * (D / 32), I_OUT = (D / 64) * (D / 32), I_UP = (D / 64) * (NUP / 32), I_DN = (DFF / 64) * (D / 32);
    constexpr int I_LAYER = I_IN + I_PA + I_PB + I_OUT + I_UP + I_DN;
    for (int it = gw; it < 2 * I_LAYER; it += NGW) {
        const int l = it / I_LAYER; int r = it - l * I_LAYER;
        bf16* wl = (bf16*)(pp->ws + WS_W0 + (size_t)l * WS_WL);
        const float* W; int K, N; bf16* WT; bool up = false, r0_in = false, dn8 = false;
        if (r < I_IN) { W = pp->w_in + (size_t)l * D * CIN; K = D; N = CIN; WT = wl + WO_IN; r0_in = true; }
        else if ((r -= I_IN) < I_PA) { r0_in = true; W = pp->w_pa + (size_t)l * 512 * D; K = 512; N = D; WT = wl + WO_PA; }
        else if ((r -= I_PA) < I_PB) { r0_in = true; W = pp->w_pb + (size_t)l * 1024 * D; K = 1024; N = D; WT = wl + WO_PB; }
        else if ((r -= I_PB) < I_OUT) { r0_in = true; W = pp->w_out + (size_t)l * D * D; K = D; N = D; WT = wl + WO_OUT; }
        else if ((r -= I_OUT) < I_UP) { W = pp->w_up + (size_t)l * D * NUP; K = D; N = NUP; WT = wl + WO_UP; up = true; }
        else { r -= I_UP; W = pp->w_down + (size_t)l * DFF * D; K = DFF; N = D; WT = wl + WO_DN; dn8 = (l == FP8_DOWN_LAYER); }
        const int nblk = N / 32, kb = r / nblk, nb = r - kb * nblk, n0 = 32 * nb;
        int row0 = n0;
        if (up) { const int j0 = n0 < DFF ? n0 : n0 - DFF; row0 = (j0 >> 7) * 256 + (n0 < DFF ? 0 : 128) + (j0 & 127); }
        if (r0_in) transpose_item_fp8(W, K, N, (unsigned char*)WT, 64 * kb, n0, scr, lane, 128.0f);
        else if (dn8) transpose_item_fp8(W, K, N, (unsigned char*)WT, 64 * kb, n0, scr, lane, 256.0f);
        else transpose_item(W, K, N, WT, 64 * kb, n0, row0, scr, lane);
    }
    { const size_t gt = (size_t)gw * 64 + lane, NT = (size_t)NGW * 64; unsigned char* x8 = pp->ws + WS_X8;
      for (size_t i = gt; i < (size_t)T * D / 16; i += NT) { const f32x4 a = *(const f32x4*)(pp->x + i * 16) * 32.f, b = *(const f32x4*)(pp->x + i * 16 + 4) * 32.f, c = *(const f32x4*)(pp->x + i * 16 + 8) * 32.f, d = *(const f32x4*)(pp->x + i * 16 + 12) * 32.f;
          u32x4 o; o.x = pk4_fp8(a[0], a[1], a[2], a[3]); o.y = pk4_fp8(b[0], b[1], b[2], b[3]); o.z = pk4_fp8(c[0], c[1], c[2], c[3]); o.w = pk4_fp8(d[0], d[1], d[2], d[3]); *(u32x4*)(x8 + i * 16) = o; } }
    if (blockIdx.x == 0) { unsigned* barw = (unsigned*)(pp->ws + WS_BAR); for (int i = threadIdx.x; i < XCD_BAR_WORDS; i += NTHREADS) barw[i] = 0u; }
    { float* tabA = (float*)(pp->ws + WS_TAB); float* tabB = (float*)(pp->ws + WS_TAB + 8192);
      const int gt = gw * 64 + lane;
      if (gt < 12 * 129) { const int hh = gt / 129, i = gt - hh * 129, g = hh >> 2, dil = g == 0 ? 1 : (g == 1 ? 4 : 16); tabA[hh * 132 + i] = pp->rel_bias[t5_bucket((i - 64) * dil) * 20 + hh] * LOG2E; }
      else if (gt < 12 * 129 + 8 * 257) { const int q = gt - 12 * 129, hh = q / 257, i = q - hh * 257; tabB[hh * 260 + i] = pp->rel_bias[t5_bucket(i - 128) * 20 + 12 + hh] * LOG2E; } }
}

constexpr int AT_KS = 0, AT_VS = 8704, AT_TAB = 8704 + 10240, AT_WAVE_BYTES = 8704 + 10240 + 1296;
static_assert(AT_WAVE_BYTES * NWAVES <= LDS_BYTES, "attention LDS");
#define TR4(r0, r1, r2, r3, base, o0, o1, o2, o3) asm volatile("ds_read_b64_tr_b16 %0, %4 offset:%5\n\tds_read_b64_tr_b16 %1, %4 offset:%6\n\tds_read_b64_tr_b16 %2, %4 offset:%7\n\tds_read_b64_tr_b16 %3, %4 offset:%8\n\ts_waitcnt lgkmcnt(0)" \
    : "=&v"(r0), "=&v"(r1), "=&v"(r2), "=&v"(r3) : "v"(base), "i"(o0), "i"(o1), "i"(o2), "i"(o3) : "memory")
#define PK8(L, Hh) (bf16x8){L[0], L[1], L[2], L[3], Hh[0], Hh[1], Hh[2], Hh[3]}

struct AtItem { int qcol, kcol, vcol, r, dil, sub_len, q0, W, nkt, T0, toff, NT, o_ld, ocol, lse_idx, o8; const float* tab; float m0; int sink; unsigned char* O; float* lse; };
constexpr int AT_NA = 12 * 64, AT_NB = 2 * 256;
__device__ __forceinline__ AtItem at_decode(int i, int wave, int layer, unsigned char* ws, const float* sinkp) {
    AtItem I; const float* tabA = (const float*)(ws + WS_TAB); const float* tabB = (const float*)(ws + WS_TAB + 8192);
    if (i < AT_NA) {
        const int hh = i >> 6, idx = i & 63, g = hh >> 2;
        I.dil = g == 0 ? 1 : (g == 1 ? 4 : 16); const int nbr = 64 / I.dil; I.r = idx / nbr; const int qb = idx - I.r * nbr; I.sub_len = SEQ / I.dil;
        I.q0 = qb * 256 + 32 * wave; I.T0 = qb * 256 - 64; I.toff = wave; I.NT = 12; I.nkt = 5; I.W = 64;
        I.qcol = hh * 128; I.kcol = 1536 + hh * 128; I.vcol = 3072 + hh * 128; I.tab = tabA + hh * 132; I.m0 = -1e30f; I.sink = 0;
        I.O = ws + WS_AR; I.o_ld = 1536; I.ocol = hh * 128; I.lse = (float*)(ws + WS_LSE); I.lse_idx = hh; I.o8 = 0;
    } else {
        const int b = i - AT_NA, kvh = b >> 8, qp = b & 255, j = wave >> 2, rep = wave & 3, qh = kvh * 4 + rep;
        I.dil = 1; I.r = 0; I.sub_len = SEQ; I.q0 = qp * 64 + 32 * j; I.T0 = qp * 64 - 128; I.toff = j; I.NT = 10; I.nkt = 9; I.W = 128;
        I.qcol = 4608 + qh * 128; I.kcol = 5632 + kvh * 128; I.vcol = 5888 + kvh * 128; I.tab = tabB + qh * 260; I.m0 = sinkp[layer * 8 + qh] * LOG2E; I.sink = 1;
        I.O = ws + WS_BO; I.o_ld = 1024; I.ocol = qh * 128; I.lse = nullptr; I.lse_idx = 0; I.o8 = 1;
    }
    return I;
}
__device__ __forceinline__ void phase_attention(unsigned char* ws, const float* sinkp, LAS unsigned char* lds, int layer, int vcu, int G, int wave, int lane) {
    const bf16* P = (const bf16*)(ws + WS_PROJ);
    const int hl = lane >> 5, ql = lane & 31, lrow = lane >> 4, lch = lane & 15;
    LAS float* tabs = (LAS float*)(lds + wave * AT_WAVE_BYTES + AT_TAB);
    const float c = 0.08838834764831845f * LOG2E;
    const unsigned vlane = (unsigned)((4 * hl + ((lane & 15) >> 2)) * 320 + (16 * ((lane >> 4) & 1) + 4 * (lane & 3)) * 2);
    const int klane = ql * 272 + 16 * hl;
    const int wrow = 4 * wave + lrow;
    bf16x8 qf[8]; u32x4 kreg[8], vreg[8], kn, vn; float tv[6];
#define AT_EDGE(I, kt_) ((I.q0 - I.W + 32 * (kt_) < 0) || (I.q0 - I.W + 32 * (kt_) + 31 >= I.sub_len))
#define AT_TOFF(I, t) ({ int sub = I.T0 + 32 * (t) + wrow; sub = sub < 0 ? 0 : (sub >= I.sub_len ? I.sub_len - 1 : sub); (unsigned)(I.r + sub * I.dil) * (unsigned)(CIN * 2) + 16u * lch; })
#define AT_FILL(I) do { const char* Pk = (const char*)(P + I.kcol); const char* Pv = (const char*)(P + I.vcol); \
        _Pragma("unroll") for (int t = 0; t < 8; ++t) { const unsigned o_ = AT_TOFF(I, t); kreg[t] = *(const u32x4*)(Pk + o_); vreg[t] = *(const u32x4*)(Pv + o_); } } while (0)
#define AT_WRITEFILL() do { _Pragma("unroll") for (int t = 0; t < 8; ++t) { *(LAS u32x4*)(lds + t * AT_WAVE_BYTES + AT_KS + wrow * 272 + 16 * lch) = kreg[t]; *(LAS u32x4*)(lds + t * AT_WAVE_BYTES + AT_VS + wrow * 320 + 16 * lch) = vreg[t]; } } while (0)
#define AT_LOADQ(I) do { const bf16* qp = P + (size_t)(I.r + (I.q0 + ql) * I.dil) * CIN + I.qcol + 8 * hl; _Pragma("unroll") for (int s = 0; s < 8; ++s) qf[s] = *(const bf16x8*)(qp + 16 * s); } while (0)
#define AT_LOADTAB(I) do { _Pragma("unroll") for (int u = 0; u < 6; ++u) { const int src = lane + 64 * u - 32; const int sc_ = src < 0 ? 0 : (src > 2 * I.W ? 2 * I.W : src); tv[u] = I.tab[sc_]; } } while (0)
#define AT_STORETAB(I) do { _Pragma("unroll") for (int u = 0; u < 6; ++u) { const int i_ = lane + 64 * u, src = i_ - 32; if (i_ < 2 * I.W + 65) tabs[i_] = (src >= 0 && src <= 2 * I.W) ? tv[u] : -__builtin_inff(); } } while (0)
    constexpr int NTOT = AT_NA + AT_NB;
    int it = vcu; if (it >= NTOT) return;
    AtItem cur = at_decode(it, wave, layer, ws, sinkp);
    AT_LOADTAB(cur); AT_LOADQ(cur); AT_FILL(cur); AT_STORETAB(cur); AT_WRITEFILL();
    __syncthreads();
    for (;;) {
        const int itn = it + G; const bool has_next = itn < NTOT;
        const AtItem nxt = at_decode(has_next ? itn : it, wave, layer, ws, sinkp);
        f32x16 o0, o1, o2, o3;
#pragma unroll
        for (int i = 0; i < 16; ++i) { o0[i] = 0.f; o1[i] = 0.f; o2[i] = 0.f; o3[i] = 0.f; }
        float m = cur.m0, l = (cur.sink && lane < 32) ? 1.f : 0.f;
        const int nkt = cur.nkt;
        for (int kt = 0; kt < nkt; ++kt) {
            const bool last = (kt == nkt - 1);
            const int tn = 8 + kt; const bool newt = tn < cur.NT;
            if (newt) { const unsigned o_ = AT_TOFF(cur, tn); kn = *(const u32x4*)((const char*)(P + cur.kcol) + o_); vn = *(const u32x4*)((const char*)(P + cur.vcol) + o_); }
            const int sl = (cur.toff + kt) & 7;
            const LAS unsigned char* kb = lds + sl * AT_WAVE_BYTES + AT_KS + klane;
            const unsigned vb = (unsigned)(uintptr_t)(lds + sl * AT_WAVE_BYTES + AT_VS) + vlane;
            f32x16 sc;
#pragma unroll
            for (int i = 0; i < 16; ++i) sc[i] = 0.f;
#pragma unroll
            for (int s = 0; s < 8; ++s) { const bf16x8 kf = *(const LAS bf16x8*)(kb + 32 * s); sc = __builtin_amdgcn_mfma_f32_32x32x16_bf16(kf, qf[s], sc, 0, 0, 0); }
            if (last && has_next) AT_LOADQ(nxt);
            const LAS float* tb = tabs + (32 * kt - ql + 4 * hl + 32);
#pragma unroll
            for (int i = 0; i < 16; ++i) { sc[i] = fmaf(sc[i], c, tb[8 * (i >> 2) + (i & 3)]); }
            if (last && has_next) AT_LOADTAB(nxt);
            if (AT_EDGE(cur, kt)) {
                const int ks0 = cur.q0 - cur.W + 32 * kt + 4 * hl;
#pragma unroll
                for (int i = 0; i < 16; ++i) { const int ks = ks0 + 8 * (i >> 2) + (i & 3); if (ks < 0 || ks >= cur.sub_len) sc[i] = -__builtin_inff(); }
            }
            float tmax = -__builtin_inff();
#pragma unroll
            for (int i = 0; i < 16; ++i) tmax = fmaxf(tmax, sc[i]);
            tmax = fmaxf(tmax, shx(tmax, 32, lane));
            if (__builtin_amdgcn_ballot_w64(tmax > m + 8.0f) != 0ull) {
                const float mn = fmaxf(m, tmax), alpha = __builtin_amdgcn_exp2f(m - mn); m = mn; l *= alpha;
#pragma unroll
                for (int i = 0; i < 16; ++i) { o0[i] *= alpha; o1[i] *= alpha; o2[i] *= alpha; o3[i] *= alpha; }
            }
            float ps = 0.f;
#pragma unroll
            for (int i = 0; i < 16; ++i) { sc[i] = __builtin_amdgcn_exp2f(sc[i] - m); ps += sc[i]; }
            l += ps;
            bf16x8 p0, p1;
            { u32x4 w0, w1; w0.x = pk2(sc[0], sc[1]); w0.y = pk2(sc[2], sc[3]); w0.z = pk2(sc[4], sc[5]); w0.w = pk2(sc[6], sc[7]);
              w1.x = pk2(sc[8], sc[9]); w1.y = pk2(sc[10], sc[11]); w1.z = pk2(sc[12], sc[13]); w1.w = pk2(sc[14], sc[15]);
              p0 = *reinterpret_cast<bf16x8*>(&w0); p1 = *reinterpret_cast<bf16x8*>(&w1); }
            { s16x4 t0, t1, t2, t3, t4, t5, t6, t7, t8, t9, t10, t11, t12, t13, t14, t15;
              asm volatile("ds_read_b64_tr_b16 %0, %16 offset:0\n\tds_read_b64_tr_b16 %1, %16 offset:2560\n\tds_read_b64_tr_b16 %2, %16 offset:5120\n\tds_read_b64_tr_b16 %3, %16 offset:7680\n\t"
                           "ds_read_b64_tr_b16 %4, %16 offset:64\n\tds_read_b64_tr_b16 %5, %16 offset:2624\n\tds_read_b64_tr_b16 %6, %16 offset:5184\n\tds_read_b64_tr_b16 %7, %16 offset:7744\n\t"
                           "ds_read_b64_tr_b16 %8, %16 offset:128\n\tds_read_b64_tr_b16 %9, %16 offset:2688\n\tds_read_b64_tr_b16 %10, %16 offset:5248\n\tds_read_b64_tr_b16 %11, %16 offset:7808\n\t"
                           "ds_read_b64_tr_b16 %12, %16 offset:192\n\tds_read_b64_tr_b16 %13, %16 offset:2752\n\tds_read_b64_tr_b16 %14, %16 offset:5312\n\tds_read_b64_tr_b16 %15, %16 offset:7872\n\ts_waitcnt lgkmcnt(0)"
                           : "=&v"(t0), "=&v"(t1), "=&v"(t2), "=&v"(t3), "=&v"(t4), "=&v"(t5), "=&v"(t6), "=&v"(t7), "=&v"(t8), "=&v"(t9), "=&v"(t10), "=&v"(t11), "=&v"(t12), "=&v"(t13), "=&v"(t14), "=&v"(t15)
                           : "v"(vb) : "memory");
              __builtin_amdgcn_sched_barrier(0);
              o0 = __builtin_amdgcn_mfma_f32_32x32x16_bf16(PK8(t0, t1), p0, o0, 0, 0, 0); o1 = __builtin_amdgcn_mfma_f32_32x32x16_bf16(PK8(t4, t5), p0, o1, 0, 0, 0);
              o2 = __builtin_amdgcn_mfma_f32_32x32x16_bf16(PK8(t8, t9), p0, o2, 0, 0, 0); o3 = __builtin_amdgcn_mfma_f32_32x32x16_bf16(PK8(t12, t13), p0, o3, 0, 0, 0);
              o0 = __builtin_amdgcn_mfma_f32_32x32x16_bf16(PK8(t2, t3), p1, o0, 0, 0, 0); o1 = __builtin_amdgcn_mfma_f32_32x32x16_bf16(PK8(t6, t7), p1, o1, 0, 0, 0);
              o2 = __builtin_amdgcn_mfma_f32_32x32x16_bf16(PK8(t10, t11), p1, o2, 0, 0, 0); o3 = __builtin_amdgcn_mfma_f32_32x32x16_bf16(PK8(t14, t15), p1, o3, 0, 0, 0); }
            if (newt) {
                __syncthreads();
                *(LAS u32x4*)(lds + (tn & 7) * AT_WAVE_BYTES + AT_KS + wrow * 272 + 16 * lch) = kn; *(LAS u32x4*)(lds + (tn & 7) * AT_WAVE_BYTES + AT_VS + wrow * 320 + 16 * lch) = vn;
                __syncthreads();
            }
        }
        const float lt = l + shx(l, 32, lane), inv = 1.0f / lt;
        const size_t tok = (size_t)(cur.r + (cur.q0 + ql) * cur.dil);
        if (cur.o8) {
            unsigned char* op = cur.O + tok * cur.o_ld + cur.ocol + 4 * hl; const float i64 = inv * 64.f;
#pragma unroll
            for (int g = 0; g < 4; ++g) {
                *(unsigned*)(op + 8 * g) = pk4_fp8(o0[4 * g] * i64, o0[4 * g + 1] * i64, o0[4 * g + 2] * i64, o0[4 * g + 3] * i64);
                *(unsigned*)(op + 32 + 8 * g) = pk4_fp8(o1[4 * g] * i64, o1[4 * g + 1] * i64, o1[4 * g + 2] * i64, o1[4 * g + 3] * i64);
                *(unsigned*)(op + 64 + 8 * g) = pk4_fp8(o2[4 * g] * i64, o2[4 * g + 1] * i64, o2[4 * g + 2] * i64, o2[4 * g + 3] * i64);
                *(unsigned*)(op + 96 + 8 * g) = pk4_fp8(o3[4 * g] * i64, o3[4 * g + 1] * i64, o3[4 * g + 2] * i64, o3[4 * g + 3] * i64);
            }
        } else {
            bf16* op = (bf16*)cur.O + tok * cur.o_ld + cur.ocol + 4 * hl;
#pragma unroll
            for (int g = 0; g < 4; ++g) {
                u32x2 w;
                w.x = pk2(o0[4 * g] * inv, o0[4 * g + 1] * inv); w.y = pk2(o0[4 * g + 2] * inv, o0[4 * g + 3] * inv); *(u32x2*)(op + 8 * g) = w;
                w.x = pk2(o1[4 * g] * inv, o1[4 * g + 1] * inv); w.y = pk2(o1[4 * g + 2] * inv, o1[4 * g + 3] * inv); *(u32x2*)(op + 32 + 8 * g) = w;
                w.x = pk2(o2[4 * g] * inv, o2[4 * g + 1] * inv); w.y = pk2(o2[4 * g + 2] * inv, o2[4 * g + 3] * inv); *(u32x2*)(op + 64 + 8 * g) = w;
                w.x = pk2(o3[4 * g] * inv, o3[4 * g + 1] * inv); w.y = pk2(o3[4 * g + 2] * inv, o3[4 * g + 3] * inv); *(u32x2*)(op + 96 + 8 * g) = w;
            }
        }
        if (cur.lse && hl == 0) cur.lse[tok * 12 + cur.lse_idx] = m + __builtin_log2f(lt);
        if (!has_next) break;
        AT_FILL(nxt);
        __syncthreads();
        AT_STORETAB(nxt); AT_WRITEFILL();
        __syncthreads();
        cur = nxt; it = itn;
    }
    LDS_WAIT();
#undef AT_FILL
#undef AT_WRITEFILL
#undef AT_TOFF
#undef AT_LOADQ
#undef AT_LOADTAB
#undef AT_STORETAB
#undef AT_EDGE
}

__device__ __forceinline__ void phase_amerge(unsigned char* ws, int gw, int NGW, int lane) {
    const bf16* AR = (const bf16*)(ws + WS_AR); const float* LSE = (const float*)(ws + WS_LSE); unsigned char* AO8 = ws + WS_AO;
    const size_t gt = (size_t)gw * 64 + lane, NT = (size_t)NGW * 64;
    for (size_t i = gt; i < (size_t)TH * 64; i += NT) {
        const size_t t = i >> 6; const int ch = (int)(i & 63), h = ch >> 4, dc = ch & 15;
        const float l0 = LSE[t * 12 + h], l1 = LSE[t * 12 + 4 + h], l2 = LSE[t * 12 + 8 + h];
        const float mx = fmaxf(l0, fmaxf(l1, l2));
        float w0 = __builtin_amdgcn_exp2f(l0 - mx), w1 = __builtin_amdgcn_exp2f(l1 - mx), w2 = __builtin_amdgcn_exp2f(l2 - mx);
        const float inv = 1.0f / (w0 + w1 + w2); w0 *= inv; w1 *= inv; w2 *= inv;
        const bf16* ap = AR + t * 1536 + h * 128 + dc * 8;
        const u32x4 a = *(const u32x4*)ap, b = *(const u32x4*)(ap + 512), cc = *(const u32x4*)(ap + 1024);
        w0 *= 64.f; w1 *= 64.f; w2 *= 64.f;
        u32x2 o;
        o.x = pk4_fp8(w0 * pg8::bf_lo(a.x) + w1 * pg8::bf_lo(b.x) + w2 * pg8::bf_lo(cc.x), w0 * pg8::bf_hi(a.x) + w1 * pg8::bf_hi(b.x) + w2 * pg8::bf_hi(cc.x),
                      w0 * pg8::bf_lo(a.y) + w1 * pg8::bf_lo(b.y) + w2 * pg8::bf_lo(cc.y), w0 * pg8::bf_hi(a.y) + w1 * pg8::bf_hi(b.y) + w2 * pg8::bf_hi(cc.y));
        o.y = pk4_fp8(w0 * pg8::bf_lo(a.z) + w1 * pg8::bf_lo(b.z) + w2 * pg8::bf_lo(cc.z), w0 * pg8::bf_hi(a.z) + w1 * pg8::bf_hi(b.z) + w2 * pg8::bf_hi(cc.z),
                      w0 * pg8::bf_lo(a.w) + w1 * pg8::bf_lo(b.w) + w2 * pg8::bf_lo(cc.w), w0 * pg8::bf_hi(a.w) + w1 * pg8::bf_hi(b.w) + w2 * pg8::bf_hi(cc.w));
        *(u32x2*)(AO8 + t * 512 + h * 128 + dc * 8) = o;
    }
}

__device__ __forceinline__ void phase_ln(float* Y, bf16* XB, unsigned char* X8, float* st, bool inplace, const float* __restrict__ gam, const float* __restrict__ bet, int gw, int NGW, int lane) {
    for (int row = gw; row < T; row += NGW) {
        f32x4* yr = (f32x4*)(Y + (size_t)row * D) + lane;
        f32x4 v[8]; float s = 0.f;
#pragma unroll
        for (int j = 0; j < 8; ++j) { v[j] = yr[64 * j]; s += (v[j][0] + v[j][1]) + (v[j][2] + v[j][3]); }
        const float mean = wave_sum(s, lane) * (1.f / D); float s2 = 0.f;
#pragma unroll
        for (int j = 0; j < 8; ++j) { v[j] = v[j] - mean; s2 += (v[j][0] * v[j][0] + v[j][1] * v[j][1]) + (v[j][2] * v[j][2] + v[j][3] * v[j][3]); }
        const float rstd = 1.0f / sqrtf(wave_sum(s2, lane) * (1.f / D) + LN_EPS);
        if (st && lane == 0) { st[2 * (size_t)row] = mean; st[2 * (size_t)row + 1] = rstd; }
#pragma unroll
        for (int j = 0; j < 8; ++j) { const f32x4 gg = *((const f32x4*)gam + lane + 64 * j), bb = *((const f32x4*)bet + lane + 64 * j);
            const f32x4 o = v[j] * rstd * gg + bb;
            if (inplace) yr[64 * j] = o;
            if (XB) { u32x2 w; w.x = pk2(o[0], o[1]); w.y = pk2(o[2], o[3]); *((u32x2*)(XB + (size_t)row * D) + lane + 64 * j) = w; }
            if (X8) *((unsigned*)(X8 + (size_t)row * D) + lane + 64 * j) = pk4_fp8(o[0] * 32.f, o[1] * 32.f, o[2] * 32.f, o[3] * 32.f); }
    }
}

__global__ void __launch_bounds__(NTHREADS, 2) fwd_mega(Params p_arg) {
    extern __shared__ __attribute__((aligned(16))) unsigned char lds_raw[];
    LAS unsigned char* lds = (LAS unsigned char*)lds_raw;
    const int ph_lo = p_arg.ph_lo, ph_hi = p_arg.ph_hi;
    if (threadIdx.x < 4) ((LAS unsigned*)(lds + LDS_BARST))[threadIdx.x] = 0u;
    __syncthreads();
    for (int ph = ph_lo; ph < ph_hi; ++ph) {
      for (int rep = 0; rep < 2; ++rep) {
        if (ph > ph_lo || rep > 0) {
#if defined(__HIP_DEVICE_COMPILE__)
            unsigned* barw = (unsigned*)(((PP)__builtin_amdgcn_kernarg_segment_ptr())->ws + WS_BAR);
            if (ph == 1 && rep == 0) { cg::this_grid().sync();
                (void)xcd_barrier_post(barw, (volatile LAS unsigned*)(lds + LDS_BARST)); }
            else { XcdBarrier xb_; xb_.bar = barw; xb_.x = xb_xcc_id(); xb_.st = (volatile LAS unsigned*)(lds + LDS_BARST); xcd_barrier(xb_); }
#endif
        }
#if defined(__HIP_DEVICE_COMPILE__)
        PP p = (PP)__builtin_amdgcn_kernarg_segment_ptr(); asm volatile("" : "+s"(p));
#else
        PP p = (PP)(uintptr_t)0; (void)p_arg;
#endif
        int tid_ = threadIdx.x, bx_ = blockIdx.x; asm volatile("" : "+v"(tid_), "+s"(bx_));
        const int tid = tid_, lane = tid & 63, wave = __builtin_amdgcn_readfirstlane(tid >> 6);
        const int G = gridDim.x, bx = bx_, vcu = (G % 8 == 0) ? (bx % 8) * (G / 8) + bx / 8 : bx;
        const int gw = vcu * NWAVES + wave, NGW = G * NWAVES;
        unsigned char* ws = p->ws; bf16* XB = (bf16*)(ws + WS_XB);
        if (ph == 0) {
#if EN_PRO
 phase_prologue(p, lds, gw, NGW, wave, lane);
#endif
 if (rep == 0 && (PROBE_MASK & 1)) continue; else break; }
        const int q = ph - 1, layer = q / 13, s = q - layer * 13;
        const bf16* wl = (const bf16*)(ws + WS_W0 + (size_t)layer * WS_WL);
        const bool dbl = (s < 8 && (s & 3) == 1 && (PROBE_MASK & 2)) || (s < 8 && (s & 3) == 2 && (PROBE_MASK & 4)) || ((s == 9 || (s == 12 && layer == 0)) && (PROBE_MASK & 8)) || (s < 8 && (s & 3) == 0 && (PROBE_MASK & 16)) || (s == 10 && (PROBE_MASK & 32)) || (s < 8 && (s & 3) == 3 && (PROBE_MASK & 64));
        if (s < 8) {
            const int half = s >> 2, sub = s & 3;
            if (sub == 0) {
                pg8::Gemm g{(const bf16*)(ws + WS_X8 + (size_t)half * TH * D), wl + WO_IN, TH, CIN, D / 2}; pg8::StaticOrder S; S.init(TH, CIN, G, bx);
                pg8::EpiProj E{(bf16*)(ws + WS_PROJ), CIN, ws + WS_G8, 4096, 6144};

#if EN_INPROJ
 pg8::gemm_phase<pg8::EpiProj, pg8::StaticOrder, true, true, true>(lds, g, S, E);
#endif

            } else if (sub == 1) {
#if EN_ATTN
 phase_attention(ws, p->sink, lds, layer, vcu, G, wave, lane);
#endif

            } else if (sub == 2) { phase_amerge(ws, gw, NGW, lane);
            } else {
                for (int k = 0; k < 2; ++k) {
                    pg8::Gemm g{k == 0 ? (const bf16*)(ws + WS_AO) : (const bf16*)(ws + WS_BO), wl + (k == 0 ? WO_PA : WO_PB), TH, D, k == 0 ? 256 : 512, 0x79797979, 0x78787878};
                    pg8::StaticOrder S; S.init(TH, D, G, bx);
                    pg8::EpiGate E{(bf16*)(ws + WS_XB + 64 * MiB), ws + WS_XB + (size_t)half * TH * D, D, ws + WS_G8 + (k == 0 ? 0 : 2048), 4096, k, 512.f};

#if EN_GATE
 pg8::gemm_phase<pg8::EpiGate, pg8::StaticOrder, true, true, true>(lds, g, S, E);
#endif

                }
            }
        } else if (s == 8 || s == 11) {
            const bool dn = (s == 11);
            pg8::StaticOrder S; S.init(T, D, G, bx);
            const bool raw = (!dn && layer == 0);
            pg8::EpiResid E{(pg8::ArgV)p, raw ? 0 : -1, dn ? 7 : 11, dn ? 8 : 12, D, ALPHA, (size_t)(dn ? layer : (layer > 0 ? layer - 1 : 0)) * D, WS_ST};
#if EN_RESID
            if (dn && layer == FP8_DOWN_LAYER) { pg8::Gemm g{(const bf16*)(ws + WS_H), wl + WO_DN, T, D, DFF / 2, 0x79797979, 0x77777777}; pg8::gemm_phase<pg8::EpiResid, pg8::StaticOrder, true, true, true>(lds, g, S, E); }
            else if (dn) { pg8::Gemm g{(const bf16*)(ws + WS_H), wl + WO_DN, T, D, DFF}; pg8::gemm_phase<pg8::EpiResid, pg8::StaticOrder, true, true>(lds, g, S, E); }
            else { pg8::Gemm g{(const bf16*)(ws + WS_XB), wl + WO_OUT, T, D, D / 2, 0x76767676, 0x78787878}; pg8::gemm_phase<pg8::EpiResid, pg8::StaticOrder, true, true, true>(lds, g, S, E); }
#endif
        } else if (s == 9) { phase_ln(p->out, XB, nullptr, (float*)(ws + WS_ST), false, p->ln1_g + layer * D, p->ln1_b + layer * D, gw, NGW, lane);
        } else if (s == 10) {
            pg8::Gemm g{XB, wl + WO_UP, T, NUP, D}; pg8::StaticOrder S; S.init(T, NUP, G, bx);
            pg8::EpiSwiglu E{(bf16*)(ws + WS_H), DFF, layer == FP8_DOWN_LAYER ? 64.f : 0.f};

#if EN_SWIGLU
 pg8::gemm_phase<pg8::EpiSwiglu, pg8::StaticOrder, true, true>(lds, g, S, E);
#endif

        } else { phase_ln(p->out, nullptr, (layer == 1) ? nullptr : ws + WS_X8, (layer == 1) ? nullptr : (float*)(ws + WS_ST), layer == 1, p->ln2_g + layer * D, p->ln2_b + layer * D, gw, NGW, lane); }
        if (!(rep == 0 && dbl)) break;
      }
    }
}

#ifndef MK_PER_PHASE
#define MK_PER_PHASE 0
#endif
extern "C" void kernel_launch(void* const* d_in, const int* in_sizes, int n_in, void* d_out, int out_size, void* d_ws, size_t ws_size, hipStream_t stream) {
    static int grid = 0;
    if (grid == 0) {
        if (n_in != 13 || ws_size < WS_END) { fprintf(stderr, "kernel_launch: unexpected inputs (n_in %d, ws %zu)\n", n_in, ws_size); grid = -1; return; }
        int dev = 0, cus = 0;
        if (hipGetDevice(&dev) != hipSuccess || hipDeviceGetAttribute(&cus, hipDeviceAttributeMultiprocessorCount, dev) != hipSuccess) { grid = -1; return; }
        if (hipFuncSetAttribute((const void*)fwd_mega, hipFuncAttributeMaxDynamicSharedMemorySize, LDS_BYTES) != hipSuccess) { fprintf(stderr, "kernel_launch: hipFuncSetAttribute failed\n"); grid = -1; return; }
        (void)hipGetLastError();
        grid = cus;
    }
    if (grid < 0) return;
    Params p{};
    p.x = (const float*)d_in[0]; p.rel_bias = (const float*)d_in[1]; p.w_in = (const float*)d_in[2]; p.sink = (const float*)d_in[3]; p.w_pa = (const float*)d_in[4]; p.w_pb = (const float*)d_in[5];
    p.w_out = (const float*)d_in[6]; p.ln1_g = (const float*)d_in[7]; p.ln1_b = (const float*)d_in[8]; p.w_up = (const float*)d_in[9]; p.w_down = (const float*)d_in[10];
    p.ln2_g = (const float*)d_in[11]; p.ln2_b = (const float*)d_in[12]; p.out = (float*)d_out; p.ws = (unsigned char*)d_ws;
#if MK_PER_PHASE
    for (int ph = 0; ph < NPHASES; ++ph) { p.ph_lo = ph; p.ph_hi = ph + 1; hipLaunchKernelGGL(fwd_mega, dim3(grid), dim3(NTHREADS), LDS_BYTES, stream, p); }
#else
    p.ph_lo = 0; p.ph_hi = NPHASES;
    void* args[] = {&p};
    hipError_t e = hipLaunchCooperativeKernel((const void*)fwd_mega, dim3(grid), dim3(NTHREADS), args, LDS_BYTES, stream);
    if (e != hipSuccess) fprintf(stderr, "kernel_launch: cooperative launch failed: %s (grid %d)\n", hipGetErrorString(e), grid);
#endif
}
```

```cpp
#include <hip/hip_runtime.h>
#include <hip/hip_cooperative_groups.h>
#include <cstdio>
#include <cstdint>
namespace cg = cooperative_groups;
namespace pg8 {
#define PG8_LAS __attribute__((address_space(3)))
typedef unsigned short bf16_t;
typedef short bf16x8 __attribute__((ext_vector_type(8)));
typedef float f32x4 __attribute__((ext_vector_type(4)));
typedef unsigned u32x4 __attribute__((ext_vector_type(4)));
typedef unsigned u32x2 __attribute__((ext_vector_type(2)));
typedef int v8i32 __attribute__((ext_vector_type(8)));
typedef int v4i32 __attribute__((ext_vector_type(4)));
constexpr int FP8_SCALE_X = 0x79797979, FP8_SCALE_W = 0x79797979;
constexpr int BM = 256, BK = 64, HALF = 128, HTB = HALF * BK * 2  , STAGE_BYTES = 8 * HTB, NXCD = 8, WGM = 8;

__host__ __device__ __forceinline__ int lds_byte(int r, int c) { const int st = (r >> 4) * 2 + (c >> 5), rr = r & 15, cc = c & 31, ob = rr * 64 + cc * 2; return st * 1024 + (ob ^ (((ob >> 9) & 1) << 5)); }
__host__ __device__ __forceinline__ void stage_rc(int b, int& R, int& C) { const int st = b / 1024, sb = b % 1024, swz = sb ^ (((sb >> 9) & 1) << 5); R = (st >> 1) * 16 + swz / 64; C = (st & 1) * 32 + (swz % 64) / 2; }
__host__ __device__ __forceinline__ int x8(int r) { return ((r >> 1) & 3) | ((((r >> 2) ^ (r >> 3)) & 1) << 2); }
__host__ __device__ __forceinline__ int lds_byte8(int r, int c16) { return r * 128 + 16 * (c16 ^ x8(r & 15)); }
__host__ __device__ __forceinline__ void stage_rc8(int b, int& R, int& C) { R = b >> 7; C = 8 * (((b >> 4) & 7) ^ x8(R & 15)); }
__host__ __device__ __forceinline__ int perm32(int rho) { const int n = rho >> 4, i = rho & 15; return 8 * (i >> 2) + 4 * n + (i & 3); }

struct Unit { int pm, pn; };
struct Gemm { const bf16_t* A; const bf16_t* Bt; int M, N, K; int sx = 0x79797979, sw = 0x79797979; };

struct StaticOrder {
    int nM, nN, nwg, G, c;
    __host__ __device__ void init(int M, int N, int G_, int c_) { nM = M / BM; nN = N / BM; nwg = nM * nN; G = G_; c = c_; }
    __host__ __device__ bool next(int i, Unit& u) const {
        const long L = (long)i * G + c; if (L >= nwg) return false;
        int wgid = (int)L; { const int q = nwg / NXCD, r = nwg % NXCD, xcd = wgid % NXCD, off = wgid / NXCD; wgid = (xcd < r ? xcd * (q + 1) : r * (q + 1) + (xcd - r) * q) + off; }
        const int nig = WGM * nN, gid = wgid / nig, fm = gid * WGM, gsz = (nM - fm) < WGM ? (nM - fm) : WGM;
        u.pm = fm + ((wgid % nig) % gsz); u.pn = (wgid % nig) / gsz; return true;
    }
    __device__ __forceinline__ void a_ready(const Unit&) const {}
    __device__ __forceinline__ void done(const Unit&) const {}
};

__device__ __forceinline__ unsigned cvt_pk_bf16(float lo, float hi) { unsigned r; asm("v_cvt_pk_bf16_f32 %0, %1, %2" : "=v"(r) : "v"(lo), "v"(hi)); return r; }
typedef float f32x2 __attribute__((ext_vector_type(2)));
template <int ACT  > struct EpiBf16 {
    static constexpr bool PERM = true, AFTER_DRAIN = false; static_assert(ACT == 0 || ACT == 1, "EpiBf16: ACT is 0 (none) or 1 (gelu_pk)");
    bf16_t* O; int ldc; const float* bias; int split_cols; size_t split_stride; float scale0;
    __device__ __forceinline__ void operator()(const f32x4 (&acc)[2][2][4][2], const Unit& u, int wr, int wc, int fr, int fq) const {
        const int row0 = u.pm * BM + wr * 64 + fr; int colt = u.pn * BM; bf16_t* base = O;
        float sc = 1.f; if (split_cols) { const int t = colt / split_cols; base += (size_t)t * split_stride; colt -= t * split_cols; if (t == 0) sc = scale0; }
        const int col0 = colt + wc * 32 + 8 * fq, bcol0 = u.pn * BM + wc * 32 + 8 * fq;
        f32x4 bv[2][2];
#pragma unroll
        for (int bj = 0; bj < 2; ++bj)
#pragma unroll
            for (int n = 0; n < 2; ++n) bv[bj][n] = bias ? *(const f32x4*)(bias + bcol0 + bj * HALF + 4 * n) : (f32x4){0.f, 0.f, 0.f, 0.f};
#pragma unroll
        for (int ai = 0; ai < 2; ++ai)
#pragma unroll
            for (int m = 0; m < 4; ++m) { bf16_t* rowp = base + (size_t)(row0 + ai * HALF + m * 16) * ldc + col0;
#pragma unroll
                for (int bj = 0; bj < 2; ++bj) { f32x4 v0 = acc[ai][bj][m][0] + bv[bj][0], v1 = acc[ai][bj][m][1] + bv[bj][1];
                    v0 = v0 * sc; v1 = v1 * sc; u32x4 w; w.x = cvt_pk_bf16(v0[0], v0[1]); w.y = cvt_pk_bf16(v0[2], v0[3]); w.z = cvt_pk_bf16(v1[0], v1[1]); w.w = cvt_pk_bf16(v1[2], v1[3]);
                    *(u32x4*)(rowp + bj * HALF) = w; } }
    }
};
__device__ __forceinline__ float sigmoidf_fast(float x) { return __builtin_amdgcn_rcpf(1.0f + __builtin_amdgcn_exp2f(-1.4426950408889634f * x)); }
__device__ __forceinline__ float bf_lo(unsigned w) { return __uint_as_float(w << 16); }
__device__ __forceinline__ float bf_hi(unsigned w) { return __uint_as_float(w & 0xffff0000u); }
__device__ __forceinline__ float clamp448(float v) { return __builtin_fminf(__builtin_fmaxf(v, -448.f), 448.f); }
__device__ __forceinline__ unsigned pk4_fp8(float a, float b, float c, float d) { unsigned w = 0; w = __builtin_amdgcn_cvt_pk_fp8_f32(clamp448(a), clamp448(b), w, false); w = __builtin_amdgcn_cvt_pk_fp8_f32(clamp448(c), clamp448(d), w, true); return w; }
struct EpiProj {
    static constexpr bool PERM = true, AFTER_DRAIN = false;
    bf16_t* O; int ldc; unsigned char* G8; int ldg; int gcol0;
    __device__ __forceinline__ void operator()(const f32x4 (&acc)[2][2][4][2], const Unit& u, int wr, int wc, int fr, int fq) const {
        const int row0 = u.pm * BM + wr * 64 + fr, col0 = u.pn * BM + wc * 32 + 8 * fq;
        if (u.pn * BM < gcol0) {
#pragma unroll
            for (int ai = 0; ai < 2; ++ai)
#pragma unroll
                for (int m = 0; m < 4; ++m) { bf16_t* rowp = O + (size_t)(row0 + ai * HALF + m * 16) * ldc + col0;
#pragma unroll
                    for (int bj = 0; bj < 2; ++bj) { const f32x4 v0 = acc[ai][bj][m][0], v1 = acc[ai][bj][m][1];
                        u32x4 w; w.x = cvt_pk_bf16(v0[0], v0[1]); w.y = cvt_pk_bf16(v0[2], v0[3]); w.z = cvt_pk_bf16(v1[0], v1[1]); w.w = cvt_pk_bf16(v1[2], v1[3]);
                        *(u32x4*)(rowp + bj * HALF) = w; } }
        } else {
#pragma unroll
            for (int ai = 0; ai < 2; ++ai)
#pragma unroll
                for (int m = 0; m < 4; ++m) { unsigned char* rowp = G8 + (size_t)(row0 + ai * HALF + m * 16) * ldg + (col0 - gcol0);
#pragma unroll
                    for (int bj = 0; bj < 2; ++bj) { const f32x4 v0 = acc[ai][bj][m][0], v1 = acc[ai][bj][m][1];
                        u32x2 w8; w8.x = pk4_fp8(256.f * sigmoidf_fast(v0[0]), 256.f * sigmoidf_fast(v0[1]), 256.f * sigmoidf_fast(v0[2]), 256.f * sigmoidf_fast(v0[3]));
                        w8.y = pk4_fp8(256.f * sigmoidf_fast(v1[0]), 256.f * sigmoidf_fast(v1[1]), 256.f * sigmoidf_fast(v1[2]), 256.f * sigmoidf_fast(v1[3]));
                        *(u32x2*)(rowp + bj * HALF) = w8; } }
        }
    }
};
struct EpiGate {
    static constexpr bool PERM = true, AFTER_DRAIN = false;
    bf16_t* Tm; unsigned char* O8; int ldo; const unsigned char* G; int ldg; int add; float oscale;
    __device__ __forceinline__ void operator()(const f32x4 (&acc)[2][2][4][2], const Unit& u, int wr, int wc, int fr, int fq) const {
        const int row0 = u.pm * BM + wr * 64 + fr, col0 = u.pn * BM + wc * 32 + 8 * fq;
#pragma unroll
        for (int ai = 0; ai < 2; ++ai)
#pragma unroll
            for (int m = 0; m < 4; ++m) { const size_t r = (size_t)(row0 + ai * HALF + m * 16); bf16_t* rowp = Tm + r * ldo + col0; const unsigned char* gp = G + r * ldg + col0;
#pragma unroll
                for (int bj = 0; bj < 2; ++bj) { const u32x2 gw = *(const u32x2*)(gp + bj * HALF); f32x4 v0 = acc[ai][bj][m][0], v1 = acc[ai][bj][m][1];
                    { const f32x2 g0 = __builtin_amdgcn_cvt_pk_f32_fp8((int)gw.x, false), g1 = __builtin_amdgcn_cvt_pk_f32_fp8((int)gw.x, true), g2 = __builtin_amdgcn_cvt_pk_f32_fp8((int)gw.y, false), g3 = __builtin_amdgcn_cvt_pk_f32_fp8((int)gw.y, true);
                      const float k_ = 1.0f / 256.0f;
                      v0[0] *= g0.x * k_; v0[1] *= g0.y * k_; v0[2] *= g1.x * k_; v0[3] *= g1.y * k_; v1[0] *= g2.x * k_; v1[1] *= g2.y * k_; v1[2] *= g3.x * k_; v1[3] *= g3.y * k_; }
                    if (add) { const u32x4 pw = *(const u32x4*)(rowp + bj * HALF);
                        v0[0] += bf_lo(pw.x); v0[1] += bf_hi(pw.x); v0[2] += bf_lo(pw.y); v0[3] += bf_hi(pw.y); v1[0] += bf_lo(pw.z); v1[1] += bf_hi(pw.z); v1[2] += bf_lo(pw.w); v1[3] += bf_hi(pw.w);
                        v0 = v0 * oscale; v1 = v1 * oscale; u32x2 w8; w8.x = pk4_fp8(v0[0], v0[1], v0[2], v0[3]); w8.y = pk4_fp8(v1[0], v1[1], v1[2], v1[3]);
                        *(u32x2*)(O8 + r * ldo + col0 + bj * HALF) = w8; }
                    else { u32x4 w; w.x = cvt_pk_bf16(v0[0], v0[1]); w.y = cvt_pk_bf16(v0[2], v0[3]); w.z = cvt_pk_bf16(v1[0], v1[1]); w.w = cvt_pk_bf16(v1[2], v1[3]);
                        *(u32x4*)(rowp + bj * HALF) = w; } } }
    }
};
typedef void* vptr_t; typedef const __attribute__((address_space(4))) vptr_t* ArgV;
struct EpiResid {
    static constexpr bool PERM = false, AFTER_DRAIN = false;
    ArgV args; int xi, gi, bi; int ldc; float alpha; size_t goff; size_t st_off;
    __device__ __forceinline__ void operator()(const f32x4 (&acc)[2][2][4][2], const Unit& u, int wr, int wc, int fr, int fq) const {
        ArgV a_ = args; asm volatile("" : "+s"(a_));
        float* Y = (float*)a_[13]; const float* X = xi >= 0 ? (const float*)a_[xi] : (const float*)Y;
        const float* st = xi >= 0 ? nullptr : (const float*)((const unsigned char*)a_[14] + st_off);
        const float* g = (const float*)a_[gi < 0 ? 0 : gi] + goff; const float* b = (const float*)a_[bi < 0 ? 0 : bi] + goff;
        const int row0 = u.pm * BM + wr * 64 + fr, col0 = u.pn * BM + wc * 32 + 4 * fq;
        f32x4 gv[2][2], bv[2][2];
#pragma unroll
        for (int bj = 0; bj < 2; ++bj)
#pragma unroll
            for (int n = 0; n < 2; ++n) { gv[bj][n] = st ? *(const f32x4*)(g + col0 + bj * HALF + n * 16) : (f32x4){1.f, 1.f, 1.f, 1.f}; bv[bj][n] = st ? *(const f32x4*)(b + col0 + bj * HALF + n * 16) : (f32x4){0.f, 0.f, 0.f, 0.f}; }
#pragma unroll
        for (int ai = 0; ai < 2; ++ai)
#pragma unroll
            for (int m = 0; m < 4; ++m) { const int r = row0 + ai * HALF + m * 16; const size_t off = (size_t)r * ldc + col0;
                float mean = 0.f, rstd = 1.f; if (st) { const f32x2 sv = *(const f32x2*)(st + 2 * (size_t)r); mean = sv.x; rstd = sv.y; }
#pragma unroll
                for (int bj = 0; bj < 2; ++bj)
#pragma unroll
                    for (int n = 0; n < 2; ++n) { f32x4 xv = *(const f32x4*)(X + off + bj * HALF + n * 16);
                        xv = (xv - mean) * rstd * gv[bj][n] + bv[bj][n];
                        *(f32x4*)(Y + off + bj * HALF + n * 16) = xv * alpha + acc[ai][bj][m][n]; }
                if (m == 3) asm volatile("" ::: "memory"); }
    }
};
struct EpiSwiglu {
    static constexpr bool PERM = true, AFTER_DRAIN = false;
    bf16_t* Hh; int ldh; float hscale;
    __device__ __forceinline__ void operator()(const f32x4 (&acc)[2][2][4][2], const Unit& u, int wr, int wc, int fr, int fq) const {
        const int row0 = u.pm * BM + wr * 64 + fr, col0 = u.pn * HALF + wc * 32 + 8 * fq;
#pragma unroll
        for (int ai = 0; ai < 2; ++ai)
#pragma unroll
            for (int m = 0; m < 4; ++m) { bf16_t* rowp = Hh + (size_t)(row0 + ai * HALF + m * 16) * ldh + col0; float hv[8];
#pragma unroll
                for (int n = 0; n < 2; ++n)
#pragma unroll
                    for (int j = 0; j < 4; ++j) { const float g = acc[ai][0][m][n][j], up = acc[ai][1][m][n][j]; hv[n * 4 + j] = g * sigmoidf_fast(g) * up; }
                if (hscale != 0.f) { u32x2 w8; w8.x = pk4_fp8(hv[0] * hscale, hv[1] * hscale, hv[2] * hscale, hv[3] * hscale); w8.y = pk4_fp8(hv[4] * hscale, hv[5] * hscale, hv[6] * hscale, hv[7] * hscale);
                    *(u32x2*)((unsigned char*)Hh + (size_t)(row0 + ai * HALF + m * 16) * ldh + col0) = w8; }
                else { u32x4 w; w.x = cvt_pk_bf16(hv[0], hv[1]); w.y = cvt_pk_bf16(hv[2], hv[3]); w.z = cvt_pk_bf16(hv[4], hv[5]); w.w = cvt_pk_bf16(hv[6], hv[7]);
                    *(u32x4*)rowp = w; } }
    }
};

struct EpiSwigluI8 {
    static constexpr bool PERM = true, AFTER_DRAIN = false;
    bf16_t* Hh; int ldh; float hscale; const float* rs; const float* cm;
    __device__ __forceinline__ void operator()(const f32x4 (&acc)[2][2][4][2], const Unit& u, int wr, int wc, int fr, int fq) const {
        const int row0 = u.pm * BM + wr * 64 + fr, col0 = u.pn * HALF + wc * 32 + 8 * fq, wrow0 = u.pn * BM + wc * 32 + 8 * fq;
        f32x4 cg[2], cu[2];
#pragma unroll
        for (int n = 0; n < 2; ++n) { cg[n] = *(const f32x4*)(cm + wrow0 + 4 * n) * (1.0f / 127.0f); cu[n] = *(const f32x4*)(cm + wrow0 + HALF + 4 * n) * (1.0f / 127.0f); }
#pragma unroll
        for (int ai = 0; ai < 2; ++ai)
#pragma unroll
            for (int m = 0; m < 4; ++m) { const int r = row0 + ai * HALF + m * 16; const float rsc = rs[r]; bf16_t* rowp = Hh + (size_t)r * ldh + col0; float hv[8];
#pragma unroll
                for (int n = 0; n < 2; ++n) { const v4i32 ig = __builtin_bit_cast(v4i32, acc[ai][0][m][n]), iu = __builtin_bit_cast(v4i32, acc[ai][1][m][n]);
#pragma unroll
                    for (int j = 0; j < 4; ++j) { const float g = (float)ig[j] * rsc * cg[n][j], up = (float)iu[j] * rsc * cu[n][j]; hv[n * 4 + j] = g * sigmoidf_fast(g) * up; } }
                if (hscale != 0.f) { u32x2 w8; w8.x = pk4_fp8(hv[0] * hscale, hv[1] * hscale, hv[2] * hscale, hv[3] * hscale); w8.y = pk4_fp8(hv[4] * hscale, hv[5] * hscale, hv[6] * hscale, hv[7] * hscale);
                    *(u32x2*)((unsigned char*)Hh + (size_t)r * ldh + col0) = w8; }
                else { u32x4 w; w.x = cvt_pk_bf16(hv[0], hv[1]); w.y = cvt_pk_bf16(hv[2], hv[3]); w.z = cvt_pk_bf16(hv[4], hv[5]); w.w = cvt_pk_bf16(hv[6], hv[7]);
                    *(u32x4*)rowp = w; } }
    }
};
template <class Epi, class Sched, bool ALIGN_EPI = false, bool SP2 = false, bool FP8 = false, bool INT8 = false>
__device__ __forceinline__ void gemm_phase(PG8_LAS unsigned char* lds, const Gemm g, const Sched& S, const Epi& E) {
    int tid_ = threadIdx.x; asm volatile("" : "+v"(tid_));
    const int tid = tid_, wid = __builtin_amdgcn_readfirstlane(tid >> 6), lane = tid & 63, wr = wid >> 2, wc = wid & 3, fr = lane & 15, fq = lane >> 4;
    const int K = g.K, nt = K / BK;
    unsigned voffA[2], voffB[2];
#pragma unroll
    for (int i = 0; i < 2; ++i) { int R, C; if constexpr (FP8) stage_rc8(tid * 16 + i * 8192, R, C); else stage_rc(tid * 16 + i * 8192, R, C); const int Rb = Epi::PERM ? ((R & ~31) + perm32(R & 31)) : R;
        voffA[i] = (unsigned)(R * K + C) * 2u; voffB[i] = (unsigned)(Rb * K + C) * 2u; }
    const size_t r64step = (size_t)64 * K * 2;
    const size_t kstep = (size_t)(BK * 2);
    const size_t hstep = (size_t)HALF * K * 2;
    const size_t tstep = 2 * hstep;
    const unsigned ldsw = (unsigned)wid * 1024u;
    const int aoff = FP8 ? lds_byte8(wr * 64 + fr, 2 * fq) : lds_byte(wr * 64 + fr, fq * 8), boff = FP8 ? lds_byte8(wc * 32 + fr, 2 * fq) : lds_byte(wc * 32 + fr, fq * 8);
    const int aoff1 = FP8 ? lds_byte8(wr * 64 + fr, 2 * fq + 1) : 0, boff1 = FP8 ? lds_byte8(wc * 32 + fr, 2 * fq + 1) : 0;
#define PG8_SA(b, h) (((b) * 2 + (h)) * HTB)
#define PG8_SB(b, h) ((4 + (b) * 2 + (h)) * HTB)
#define PG8_STAGE(bufoff, gbase, voff) do { _Pragma("unroll") for (int _i = 0; _i < 2; ++_i) { const char* _gb = (const char*)(gbase) + (size_t)_i * r64step; asm volatile("" : "+s"(_gb));     \
        __builtin_amdgcn_global_load_lds((const unsigned*)(_gb + (voff)[0]), (PG8_LAS unsigned*)(lds + (bufoff) + ldsw + _i * 8192), 16, 0, 0); } } while (0)
#define PG8_LD8(p_, q_) __builtin_shufflevector(*(const PG8_LAS v4i32*)(p_), *(const PG8_LAS v4i32*)(q_), 0, 1, 2, 3, 4, 5, 6, 7)
#define PG8_LDA(dst, b, h) do { if constexpr (FP8) { _Pragma("unroll") for (int m = 0; m < 4; ++m) dst##8[m] = PG8_LD8(lds + PG8_SA(b, h) + aoff + m * 2048, lds + PG8_SA(b, h) + aoff1 + m * 2048); } \
        else { _Pragma("unroll") for (int m = 0; m < 4; ++m) _Pragma("unroll") for (int k = 0; k < 2; ++k) dst[m][k] = *(const PG8_LAS bf16x8*)(lds + PG8_SA(b, h) + aoff + m * 2048 + k * 1024); } } while (0)
#define PG8_LDB(dst, b, h) do { if constexpr (FP8) { _Pragma("unroll") for (int n = 0; n < 2; ++n) dst##8[n] = PG8_LD8(lds + PG8_SB(b, h) + boff + n * 2048, lds + PG8_SB(b, h) + boff1 + n * 2048); } \
        else { _Pragma("unroll") for (int n = 0; n < 2; ++n) _Pragma("unroll") for (int k = 0; k < 2; ++k) dst[n][k] = *(const PG8_LAS bf16x8*)(lds + PG8_SB(b, h) + boff + n * 2048 + k * 1024); } } while (0)
#define PG8_MMA(ai, bj, At, Bt) do { __builtin_amdgcn_s_setprio(1); if constexpr (FP8) { _Pragma("unroll") for (int m = 0; m < 4; ++m) _Pragma("unroll") for (int n = 0; n < 2; ++n) \
            acc[ai][bj][m][n] = __builtin_amdgcn_mfma_scale_f32_16x16x128_f8f6f4(Bt##8[n], At##8[m], acc[ai][bj][m][n], 0, 0, 0, g.sw, 0, g.sx); } \
        else if constexpr (INT8) { _Pragma("unroll") for (int m = 0; m < 4; ++m) _Pragma("unroll") for (int n = 0; n < 2; ++n) _Pragma("unroll") for (int k = 0; k < 2; ++k) \
        acc[ai][bj][m][n] = __builtin_bit_cast(f32x4, __builtin_amdgcn_mfma_i32_16x16x64_i8(__builtin_bit_cast(v4i32, Bt[n][k]), __builtin_bit_cast(v4i32, At[m][k]), __builtin_bit_cast(v4i32, acc[ai][bj][m][n]), 0, 0, 0)); }   \
        else { _Pragma("unroll") for (int m = 0; m < 4; ++m) _Pragma("unroll") for (int n = 0; n < 2; ++n) _Pragma("unroll") for (int k = 0; k < 2; ++k) \
        acc[ai][bj][m][n] = __builtin_amdgcn_mfma_f32_16x16x32_bf16(Bt[n][k], At[m][k], acc[ai][bj][m][n], 0, 0, 0); } __builtin_amdgcn_s_setprio(0); } while (0)
#define PG8_WAIT_V(n) asm volatile("s_waitcnt vmcnt(" #n ")" ::: "memory")
#define PG8_WAIT_L(n) asm volatile("s_waitcnt lgkmcnt(" #n ")" ::: "memory")
#define PG8_BAR __builtin_amdgcn_s_barrier()
#define PG8_SCHED __builtin_amdgcn_sched_barrier(0)
    Unit cur, nxt; int ui = 0;
    if (!S.next(0, cur)) return;
    f32x4 acc[2][2][4][2];
#pragma unroll
    for (int a = 0; a < 2; ++a)
#pragma unroll
        for (int b = 0; b < 2; ++b)
#pragma unroll
            for (int m = 0; m < 4; ++m)
#pragma unroll
                for (int n = 0; n < 2; ++n) acc[a][b][m][n] = (f32x4){0.f, 0.f, 0.f, 0.f};
    bf16x8 At[4][2], B0[2][2], B1[2][2]; v8i32 At8[4], B08[2], B18[2];
    const char* cA = (const char*)g.A + (size_t)cur.pm * tstep; const char* cB = (const char*)g.Bt + (size_t)cur.pn * tstep;
    S.a_ready(cur);
    if constexpr (SP2) {
        PG8_STAGE(PG8_SB(0, 0), cB, voffB); PG8_STAGE(PG8_SB(0, 1), cB + hstep, voffB); PG8_STAGE(PG8_SA(0, 0), cA, voffA); PG8_STAGE(PG8_SA(0, 1), cA + hstep, voffA);
        if (wr == 1) PG8_BAR;
        PG8_WAIT_V(2); PG8_BAR;
        PG8_STAGE(PG8_SB(1, 0), cB + kstep, voffB); PG8_STAGE(PG8_SA(1, 0), cA + kstep, voffA); PG8_STAGE(PG8_SB(1, 1), cB + hstep + kstep, voffB);
        PG8_WAIT_V(6); PG8_BAR;
    } else {
        PG8_STAGE(PG8_SB(0, 0), cB, voffB); PG8_STAGE(PG8_SA(0, 0), cA, voffA); PG8_STAGE(PG8_SB(0, 1), cB + hstep, voffB); PG8_STAGE(PG8_SA(0, 1), cA + hstep, voffA);
        if (wr == 1) PG8_BAR;
        PG8_WAIT_V(4); PG8_BAR;
        PG8_STAGE(PG8_SB(1, 0), cB + kstep, voffB); PG8_STAGE(PG8_SA(1, 0), cA + kstep, voffA); PG8_STAGE(PG8_SB(1, 1), cB + hstep + kstep, voffB);
        PG8_WAIT_V(6); PG8_BAR;
    }
    for (;;) {
        const bool has_next = S.next(ui + 1, nxt);
        const char* nA = has_next ? (const char*)g.A + (size_t)nxt.pm * tstep : cA; const char* nB = has_next ? (const char*)g.Bt + (size_t)nxt.pn * tstep : cB;
        for (int t = 0; t < nt; t += 2) {
            const bool last = (t == nt - 2);
            const char* a1 = cA + (size_t)(t + 1) * kstep;
            const char* a2 = last ? nA : cA + (size_t)(t + 2) * kstep; const char* b2 = last ? nB : cB + (size_t)(t + 2) * kstep;
            const char* a3 = a2 + kstep; const char* b3 = b2 + kstep;
            if (last && has_next) S.a_ready(nxt);
            if constexpr (SP2) {
            PG8_LDB(B0, 0, 0); PG8_LDB(B1, 0, 1); PG8_SCHED; PG8_LDA(At, 0, 0); PG8_STAGE(PG8_SA(1, 1), a1 + hstep, voffA);
            PG8_WAIT_V(8); PG8_WAIT_L(0); PG8_BAR; PG8_MMA(0, 0, At, B0); PG8_MMA(0, 1, At, B1); PG8_BAR; PG8_SCHED;
            PG8_LDA(At, 0, 1); PG8_STAGE(PG8_SB(0, 0), b2, voffB); PG8_STAGE(PG8_SB(0, 1), b2 + hstep, voffB); PG8_STAGE(PG8_SA(0, 0), a2, voffA);
            PG8_WAIT_V(8); PG8_WAIT_L(0); PG8_BAR; PG8_MMA(1, 0, At, B0); PG8_MMA(1, 1, At, B1); PG8_BAR; PG8_SCHED;
            PG8_LDB(B0, 1, 0); PG8_LDB(B1, 1, 1); PG8_SCHED; PG8_LDA(At, 1, 0); PG8_STAGE(PG8_SA(0, 1), a2 + hstep, voffA);
            PG8_WAIT_V(8); PG8_WAIT_L(0); PG8_BAR; PG8_MMA(0, 0, At, B0); PG8_MMA(0, 1, At, B1); PG8_BAR; PG8_SCHED;
            PG8_LDA(At, 1, 1); PG8_STAGE(PG8_SB(1, 0), b3, voffB); PG8_STAGE(PG8_SB(1, 1), b3 + hstep, voffB); PG8_STAGE(PG8_SA(1, 0), a3, voffA);
            PG8_WAIT_V(8); PG8_WAIT_L(0); PG8_BAR; PG8_MMA(1, 0, At, B0); PG8_MMA(1, 1, At, B1); PG8_BAR; PG8_SCHED;
            } else {
            PG8_LDB(B0, 0, 0); PG8_SCHED; PG8_LDA(At, 0, 0); PG8_STAGE(PG8_SA(1, 1), a1 + hstep, voffA);
            PG8_WAIT_L(8); PG8_BAR; PG8_WAIT_L(0); PG8_MMA(0, 0, At, B0); PG8_BAR; PG8_SCHED;
            PG8_LDB(B1, 0, 1); PG8_STAGE(PG8_SB(0, 0), b2, voffB);
            PG8_BAR; PG8_WAIT_L(0); PG8_MMA(0, 1, At, B1); PG8_BAR;
            PG8_LDA(At, 0, 1); PG8_STAGE(PG8_SA(0, 0), a2, voffA);
            PG8_BAR; PG8_WAIT_L(0); PG8_MMA(1, 0, At, B0); PG8_BAR; PG8_SCHED;
            PG8_STAGE(PG8_SB(0, 1), b2 + hstep, voffB);
            PG8_WAIT_V(6); PG8_BAR; PG8_MMA(1, 1, At, B1); PG8_BAR;
            PG8_LDB(B0, 1, 0); PG8_SCHED; PG8_LDA(At, 1, 0); PG8_STAGE(PG8_SA(0, 1), a2 + hstep, voffA);
            PG8_WAIT_L(8); PG8_BAR; PG8_WAIT_L(0); PG8_MMA(0, 0, At, B0); PG8_BAR; PG8_SCHED;
            PG8_LDB(B1, 1, 1); PG8_STAGE(PG8_SB(1, 0), b3, voffB);
            PG8_BAR; PG8_WAIT_L(0); PG8_MMA(0, 1, At, B1); PG8_BAR;
            PG8_LDA(At, 1, 1); PG8_STAGE(PG8_SA(1, 0), a3, voffA);
            PG8_BAR; PG8_WAIT_L(0); PG8_MMA(1, 0, At, B0); PG8_BAR; PG8_SCHED;
            PG8_STAGE(PG8_SB(1, 1), b3 + hstep, voffB);
            PG8_WAIT_V(6); PG8_BAR; PG8_MMA(1, 1, At, B1); PG8_BAR;
            }
        }
        if constexpr (ALIGN_EPI) { if (wr == 0) PG8_BAR; }
        if constexpr (!Epi::AFTER_DRAIN) { int t2_ = threadIdx.x; asm volatile("" : "+v"(t2_)); const int fr_ = t2_ & 15, fq_ = (t2_ & 63) >> 4;
            E(acc, cur, wr, wc, fr_, fq_); S.done(cur); }
        if (!has_next) break;
#pragma unroll
        for (int a = 0; a < 2; ++a)
#pragma unroll
            for (int b = 0; b < 2; ++b)
#pragma unroll
                for (int m = 0; m < 4; ++m)
#pragma unroll
                    for (int n = 0; n < 2; ++n) acc[a][b][m][n] = (f32x4){0.f, 0.f, 0.f, 0.f};
        cur = nxt; cA = nA; cB = nB; ++ui;
        if constexpr (ALIGN_EPI) { if (wr == 1) PG8_BAR; }
    }
    PG8_WAIT_V(0);
    if constexpr (!ALIGN_EPI) { if (wr == 0) PG8_BAR; }
    PG8_BAR;
    if constexpr (Epi::AFTER_DRAIN) { E.fused(acc, cur, wr, wc, fr, fq, lds, wid, lane); S.done(cur); }
#undef PG8_SA
#undef PG8_SB
#undef PG8_STAGE
#undef PG8_LD8
#undef PG8_LDA
#undef PG8_LDB
#undef PG8_MMA
#undef PG8_WAIT_V
#undef PG8_WAIT_L
#undef PG8_BAR
#undef PG8_SCHED
}
}

#ifndef FP8_DOWN_LAYER
#define FP8_DOWN_LAYER 1
#endif
#ifndef PROBE_MASK
#define PROBE_MASK 0
#endif
#ifndef EN_INPROJ
#define EN_INPROJ 1
#endif
#ifndef EN_GATE
#define EN_GATE 1
#endif
#ifndef EN_RESID
#define EN_RESID 1
#endif
#ifndef EN_SWIGLU
#define EN_SWIGLU 1
#endif
#ifndef EN_ATTN
#define EN_ATTN 1
#endif
#ifndef EN_PRO
#define EN_PRO 1
#endif
#define LAS __attribute__((address_space(3)))
typedef unsigned short bf16;
typedef short bf16x8 __attribute__((ext_vector_type(8)));
typedef short s16x4 __attribute__((ext_vector_type(4)));
typedef float f32x4 __attribute__((ext_vector_type(4)));
typedef float f32x16 __attribute__((ext_vector_type(16)));
typedef unsigned u32x4 __attribute__((ext_vector_type(4)));
typedef unsigned u32x2 __attribute__((ext_vector_type(2)));

constexpr int T = 32768, TH = 16384, D = 2048, CIN = 10240, DFF = 5632, NUP = 11264, SEQ = 16384;
constexpr int NWAVES = 8, NTHREADS = 512;
constexpr float ALPHA = 1.41421356237309515f;
constexpr float LN_EPS = 1e-5f;
constexpr float LOG2E = 1.4426950408889634f;
constexpr int LDS_BYTES = 163840, LDS_BARST = 163824;
constexpr int NPHASES = 27;

constexpr size_t MiB = (size_t)1 << 20;
constexpr size_t WS_TAB = 0;
constexpr size_t WS_BAR = 256 * 1024;
constexpr size_t WS_CMAX = 512 * 1024;
constexpr size_t WS_CMAXI = WS_CMAX + 2 * 11264 * 4;
constexpr size_t WS_W0 = 1 * MiB, WS_WL = 120 * MiB;
constexpr size_t WO_IN = 0, WO_PA = WO_IN + (size_t)CIN * D, WO_PB = WO_PA + (size_t)D * 512, WO_OUT = WO_PB + (size_t)D * 1024, WO_UP = WO_OUT + (size_t)D * D,
                 WO_DN = WO_UP + (size_t)NUP * D, WO_END = WO_DN + (size_t)D * DFF;
static_assert(WO_END * 2 <= WS_WL, "weight block");
constexpr size_t WS_XB = 241 * MiB;
constexpr size_t WS_PROJ = 369 * MiB;
constexpr size_t WS_AR = 689 * MiB;
constexpr size_t WS_LSE = 737 * MiB;
constexpr size_t WS_AO = 738 * MiB;
constexpr size_t WS_BO = 754 * MiB;
constexpr size_t WS_H = 369 * MiB;
constexpr size_t WS_X8 = 800 * MiB;
constexpr size_t WS_ST = 864 * MiB;
constexpr size_t WS_RS = 864 * MiB + 512 * 1024;
constexpr size_t WS_G8 = 866 * MiB;
constexpr size_t WS_END = 930 * MiB;

struct Params;
typedef const __attribute__((address_space(4))) Params* PP;
struct Params {
    const float* x; const float* rel_bias; const float* w_in; const float* sink; const float* w_pa; const float* w_pb; const float* w_out;
    const float* ln1_g; const float* ln1_b; const float* w_up; const float* w_down; const float* ln2_g; const float* ln2_b;
    float* out; unsigned char* ws; int ph_lo, ph_hi;
};

__device__ __forceinline__ unsigned pk2(float a, float b) { return pg8::cvt_pk_bf16(a, b); }
__device__ __forceinline__ float shx(float v, int o, int lane) { return __int_as_float(__builtin_amdgcn_ds_bpermute((lane ^ o) << 2, __float_as_int(v))); }
__device__ __forceinline__ float wave_sum(float v, int lane) {
#pragma unroll
    for (int o = 1; o < 64; o <<= 1) v += shx(v, o, lane);
    return v;
}
#define LDS_WAIT() asm volatile("s_waitcnt lgkmcnt(0)" ::: "memory")

#define XB_TMO      128
#define XB_XCNT(j)  (256  + 64 * (j))
#define XB_XSUB(j)  (1280 + 64 * (j))
#define XB_XGEN(j)  (2304 + 64 * (j))
#define XB_TOP      3328
#define XB_TOPGEN   3392
#define XCD_BAR_WORDS 3456
#define XB_SPIN_CAP (1u << 18)

__device__ __forceinline__ unsigned xb_ld(unsigned* p)              { return __hip_atomic_load(p, __ATOMIC_RELAXED, __HIP_MEMORY_SCOPE_AGENT); }
__device__ __forceinline__ unsigned xb_add(unsigned* p, unsigned v) { return __hip_atomic_fetch_add(p, v, __ATOMIC_RELAXED, __HIP_MEMORY_SCOPE_AGENT); }
__device__ __forceinline__ unsigned xb_xcc_id() { return (unsigned)__builtin_amdgcn_s_getreg((3 << 11) | 20) & 0xFu; }
#define XB_SPIN(cond, bar) do { unsigned _sp = 0; while (cond) { __builtin_amdgcn_s_sleep(1); \
    if ((++_sp & 255u) == 0u) { if (xb_ld(&(bar)[XB_TMO])) break; if (_sp > XB_SPIN_CAP) { atomicAdd(&(bar)[XB_TMO], 1u); break; } } } } while (0)

struct XcdBarrier {
    unsigned* bar; unsigned x;
    volatile LAS unsigned* st;
};

__device__ __forceinline__ XcdBarrier xcd_barrier_post(unsigned* bar, volatile LAS unsigned* st) {
    XcdBarrier b; b.bar = bar; b.x = xb_xcc_id(); b.st = st;
    if (threadIdx.x == 0) (void)xb_add(&bar[XB_XCNT(b.x)], 1u);
    return b;
}
__device__ __forceinline__ void xcd_barrier_complete(unsigned* bar, unsigned x, unsigned& nloc, unsigned& nx) {
    const unsigned G = gridDim.x * gridDim.y * gridDim.z;
    unsigned sum, cnt, mine, sp = 0u;
    for (;;) {
        sum = 0u; cnt = 0u; mine = 0u;
#pragma unroll
        for (unsigned j = 0; j < 16; ++j) { const unsigned c = xb_ld(&bar[XB_XCNT(j)]); sum += c; cnt += (c > 0u) ? 1u : 0u; mine = (j == x) ? c : mine; }
        if (sum == G) break;
        __builtin_amdgcn_s_sleep(1);
        if ((++sp & 255u) == 0u) { if (xb_ld(&bar[XB_TMO])) break; if (sp > XB_SPIN_CAP) { atomicAdd(&bar[XB_TMO], 1u); break; } }
    }
    nloc = mine > 0u ? mine : 1u; nx = cnt > 0u ? cnt : 1u;
}

__device__ __forceinline__ void xcd_barrier(const XcdBarrier& b) {
    asm volatile("s_waitcnt vmcnt(0)" ::: "memory");
    __syncthreads();
    if (threadIdx.x == 0) {
        unsigned* bar = b.bar;
        __builtin_amdgcn_s_waitcnt(0);
        unsigned nloc = b.st[0], nx = b.st[1];
        if (nloc == 0u) { xcd_barrier_complete(bar, b.x, nloc, nx); b.st[0] = nloc; b.st[1] = nx; }
        const unsigned old = xb_add(&bar[XB_XSUB(b.x)], 1u);
        const unsigned gen = old / nloc;
        if (old + 1u == (gen + 1u) * nloc) {
            __builtin_amdgcn_fence(__ATOMIC_RELEASE, "agent");
            asm volatile("s_waitcnt vmcnt(0)" ::: "memory");
            const unsigned og = xb_add(&bar[XB_TOP], 1u);
            const unsigned tg = og / nx;
            if (og + 1u == (tg + 1u) * nx) xb_add(&bar[XB_TOPGEN], 1u);
            else XB_SPIN(xb_ld(&bar[XB_TOPGEN]) == tg, bar);
            __builtin_amdgcn_fence(__ATOMIC_ACQUIRE, "agent");
            xb_add(&bar[XB_XGEN(b.x)], 1u);
            asm volatile("s_waitcnt vmcnt(0)" ::: "memory");
        } else {
            XB_SPIN(xb_ld(&bar[XB_XGEN(b.x)]) == gen, bar);
            __builtin_amdgcn_fence(__ATOMIC_ACQUIRE, "agent");
            asm volatile("s_waitcnt vmcnt(0)" ::: "memory");
        }
    }
    __syncthreads();
}


__device__ __forceinline__ void transpose_item(const float* __restrict__ W, int K, int N, bf16* WT, int k0, int n0, int row0, LAS float* scr, int lane) {
    { f32x4 tv[8];
#pragma unroll
      for (int i = 0; i < 8; ++i) tv[i] = *(const f32x4*)(W + (size_t)(k0 + 8 * i + (lane >> 3)) * N + n0 + 4 * (lane & 7));
#pragma unroll
      for (int i = 0; i < 8; ++i) { LAS float* d_ = scr + (8 * i + (lane >> 3)) * 33 + 4 * (lane & 7); d_[0] = tv[i][0]; d_[1] = tv[i][1]; d_[2] = tv[i][2]; d_[3] = tv[i][3]; } }
    LDS_WAIT();
    const int c = lane & 7;
#pragma unroll
    for (int j = 0; j < 4; ++j) { const int n = (lane >> 3) + 8 * j; const LAS float* s = scr + (8 * c) * 33 + n;
        u32x4 o; o.x = pk2(s[0 * 33], s[1 * 33]); o.y = pk2(s[2 * 33], s[3 * 33]); o.z = pk2(s[4 * 33], s[5 * 33]); o.w = pk2(s[6 * 33], s[7 * 33]);
        *(u32x4*)(WT + (size_t)(row0 + n) * K + k0 + 8 * c) = o; }
    LDS_WAIT();
}
using pg8::pk4_fp8;
__device__ __forceinline__ void transpose_item_fp8(const float* __restrict__ W, int K, int N, unsigned char* WT, int k0, int n0, LAS float* scr, int lane, float scale) {
    { f32x4 tv[8];
#pragma unroll
      for (int i = 0; i < 8; ++i) tv[i] = *(const f32x4*)(W + (size_t)(k0 + 8 * i + (lane >> 3)) * N + n0 + 4 * (lane & 7));
#pragma unroll
      for (int i = 0; i < 8; ++i) { LAS float* d_ = scr + (8 * i + (lane >> 3)) * 33 + 4 * (lane & 7); d_[0] = tv[i][0]; d_[1] = tv[i][1]; d_[2] = tv[i][2]; d_[3] = tv[i][3]; } }
    LDS_WAIT();
    const int n = lane >> 1, kh = lane & 1; const LAS float* sp = scr + (32 * kh) * 33 + n;
    u32x4 o0, o1;
    o0.x = pk4_fp8(sp[0 * 33] * scale, sp[1 * 33] * scale, sp[2 * 33] * scale, sp[3 * 33] * scale); o0.y = pk4_fp8(sp[4 * 33] * scale, sp[5 * 33] * scale, sp[6 * 33] * scale, sp[7 * 33] * scale);
    o0.z = pk4_fp8(sp[8 * 33] * scale, sp[9 * 33] * scale, sp[10 * 33] * scale, sp[11 * 33] * scale); o0.w = pk4_fp8(sp[12 * 33] * scale, sp[13 * 33] * scale, sp[14 * 33] * scale, sp[15 * 33] * scale);
    o1.x = pk4_fp8(sp[16 * 33] * scale, sp[17 * 33] * scale, sp[18 * 33] * scale, sp[19 * 33] * scale); o1.y = pk4_fp8(sp[20 * 33] * scale, sp[21 * 33] * scale, sp[22 * 33] * scale, sp[23 * 33] * scale);
    o1.z = pk4_fp8(sp[24 * 33] * scale, sp[25 * 33] * scale, sp[26 * 33] * scale, sp[27 * 33] * scale); o1.w = pk4_fp8(sp[28 * 33] * scale, sp[29 * 33] * scale, sp[30 * 33] * scale, sp[31 * 33] * scale);
    unsigned char* dst = WT + (size_t)(n0 + n) * K + k0 + 32 * kh;
    *(u32x4*)dst = o0; *(u32x4*)(dst + 16) = o1;
    LDS_WAIT();
}
__device__ __forceinline__ int t5_bucket(int rel) {
    const int n = rel < 0 ? -rel : rel; int b;
    if (n < 8) b = n; else { const int e = (int)(__builtin_log2f((float)n * 0.125f) * (8.0f / 7.0f)); b = 8 + e; if (b > 15) b = 15; }
    return b + (rel > 0 ? 16 : 0);
}
__device__ __forceinline__ void phase_prologue(PP pp, LAS unsigned char* lds, int gw, int NGW, int wave, int lane) {
    LAS float* scr = (LAS float*)(lds + wave * 16384);
    {
        const int vcu_ = gw / NWAVES, G_ = NGW / NWAVES;
        constexpr int CB_UP = NUP / 32, CB_IN = 0, CB_L = CB_UP + CB_IN;
        LAS float* cmt = (LAS float*)(lds + 135168);
        for (int cb = vcu_; cb < 2 * CB_L; cb += G_) {
            const int l = cb / CB_L; int r = cb - l * CB_L; const bool win = r >= CB_UP; if (win) r -= CB_UP;
            const int N = win ? CIN : NUP, n0 = 32 * r;
            const int j0 = n0 < DFF ? n0 : n0 - DFF, row0 = win ? n0 : (j0 >> 7) * 256 + (n0 < DFF ? 0 : 128) + (j0 & 127);
            const float* W = win ? pp->w_in + (size_t)l * D * CIN : pp->w_up + (size_t)l * D * NUP;
            unsigned char* WT = (unsigned char*)((bf16*)(pp->ws + WS_W0 + (size_t)l * WS_WL) + (win ? WO_IN : WO_UP));
            float* cmg = win ? (float*)(pp->ws + WS_CMAXI) + l * CIN + row0 : (float*)(pp->ws + WS_CMAX) + l * NUP + row0;
            f32x4 tv[4][8]; f32x4 mx = {0.f, 0.f, 0.f, 0.f};
#pragma unroll
            for (int q = 0; q < 4; ++q)
#pragma unroll
                for (int i = 0; i < 8; ++i) tv[q][i] = *(const f32x4*)(W + (size_t)((wave * 4 + q) * 64 + 8 * i + (lane >> 3)) * N + n0 + 4 * (lane & 7));
#pragma unroll
            for (int q = 0; q < 4; ++q)
#pragma unroll
                for (int i = 0; i < 8; ++i) { mx[0] = fmaxf(mx[0], fabsf(tv[q][i][0])); mx[1] = fmaxf(mx[1], fabsf(tv[q][i][1])); mx[2] = fmaxf(mx[2], fabsf(tv[q][i][2])); mx[3] = fmaxf(mx[3], fabsf(tv[q][i][3])); }
#pragma unroll
            for (int o = 8; o < 64; o <<= 1) { mx[0] = fmaxf(mx[0], shx(mx[0], o, lane)); mx[1] = fmaxf(mx[1], shx(mx[1], o, lane)); mx[2] = fmaxf(mx[2], shx(mx[2], o, lane)); mx[3] = fmaxf(mx[3], shx(mx[3], o, lane)); }
            if (lane < 8) *(LAS f32x4*)(cmt + wave * 32 + 4 * lane) = mx;
            __syncthreads();
            f32x4 cm = *(const LAS f32x4*)(cmt + 4 * (lane & 7));
#pragma unroll
            for (int w2 = 1; w2 < 8; ++w2) { const f32x4 t = *(const LAS f32x4*)(cmt + w2 * 32 + 4 * (lane & 7)); cm[0] = fmaxf(cm[0], t[0]); cm[1] = fmaxf(cm[1], t[1]); cm[2] = fmaxf(cm[2], t[2]); cm[3] = fmaxf(cm[3], t[3]); }
            if (wave == 0 && lane < 8) *(f32x4*)(cmg + 4 * lane) = cm;
            f32x4 inv;
#pragma unroll
            for (int j = 0; j < 4; ++j) inv[j] = cm[j] > 0.f ? 127.0f / cm[j] : 0.f;
#pragma unroll
            for (int q = 0; q < 4; ++q) {
                const int k0 = (wave * 4 + q) * 64;
#pragma unroll
                for (int i = 0; i < 8; ++i) { LAS float* d_ = scr + (8 * i + (lane >> 3)) * 33 + 4 * (lane & 7); d_[0] = tv[q][i][0] * inv[0]; d_[1] = tv[q][i][1] * inv[1]; d_[2] = tv[q][i][2] * inv[2]; d_[3] = tv[q][i][3] * inv[3]; }
                LDS_WAIT();
                const int n = lane >> 1, kh = lane & 1; const LAS float* sp = scr + (32 * kh) * 33 + n;
                unsigned w[8];
#pragma unroll
                for (int u = 0; u < 8; ++u) { const int a = (int)__builtin_rintf(sp[(4 * u) * 33]), b = (int)__builtin_rintf(sp[(4 * u + 1) * 33]), c = (int)__builtin_rintf(sp[(4 * u + 2) * 33]), d = (int)__builtin_rintf(sp[(4 * u + 3) * 33]);
                    w[u] = ((unsigned)a & 255u) | (((unsigned)b & 255u) << 8) | (((unsigned)c & 255u) << 16) | ((unsigned)d << 24); }
                unsigned char* dst = WT + (size_t)(row0 + n) * D + k0 + 32 * kh;
                u32x4 o0, o1; o0.x = w[0]; o0.y = w[1]; o0.z = w[2]; o0.w = w[3]; o1.x = w[4]; o1.y = w[5]; o1.z = w[6]; o1.w = w[7];
                *(u32x4*)dst = o0; *(u32x4*)(dst + 16) = o1;
                LDS_WAIT();
            }
            __syncthreads();
        }
    }
    constexpr int I_IN = (D / 64) * (CIN / 32), I_PA = (512 / 64) * (D / 32), I_PB = (1024 / 64) * (D / 32), I_OUT = (D / 64) * (D / 32), I_UP = (D / 64) * (NUP / 32), I_DN = (DFF / 64) * (D / 32);
    constexpr int I_LAYER = I_IN + I_PA + I_PB + I_OUT + I_UP + I_DN;
    for (int it = gw; it < 2 * I_LAYER; it += NGW) {
        const int l = it / I_LAYER; int r = it - l * I_LAYER;
        bf16* wl = (bf16*)(pp->ws + WS_W0 + (size_t)l * WS_WL);
        const float* W; int K, N; bf16* WT; bool up = false, r0_in = false, dn8 = false;
        if (r < I_IN) { W = pp->w_in + (size_t)l * D * CIN; K = D; N = CIN; WT = wl + WO_IN; r0_in = true; }
        else if ((r -= I_IN) < I_PA) { r0_in = true; W = pp->w_pa + (size_t)l * 512 * D; K = 512; N = D; WT = wl + WO_PA; }
        else if ((r -= I_PA) < I_PB) { r0_in = true; W = pp->w_pb + (size_t)l * 1024 * D; K = 1024; N = D; WT = wl + WO_PB; }
        else if ((r -= I_PB) < I_OUT) { r0_in = true; W = pp->w_out + (size_t)l * D * D; K = D; N = D; WT = wl + WO_OUT; }
        else if ((r -= I_OUT) < I_UP) { W = pp->w_up + (size_t)l * D * NUP; K = D; N = NUP; WT = wl + WO_UP; up = true; }
        else { r -= I_UP; W = pp->w_down + (size_t)l * DFF * D; K = DFF; N = D; WT = wl + WO_DN; dn8 = (l == FP8_DOWN_LAYER); }
        const int nblk = N / 32, kb = r / nblk, nb = r - kb * nblk, n0 = 32 * nb;
        int row0 = n0;
        if (up) { const int j0 = n0 < DFF ? n0 : n0 - DFF; row0 = (j0 >> 7) * 256 + (n0 < DFF ? 0 : 128) + (j0 & 127); }
        if (r0_in) transpose_item_fp8(W, K, N, (unsigned char*)WT, 64 * kb, n0, scr, lane, 128.0f);
        else if (dn8) transpose_item_fp8(W, K, N, (unsigned char*)WT, 64 * kb, n0, scr, lane, 256.0f);
        else if (up) { }
        else transpose_item(W, K, N, WT, 64 * kb, n0, row0, scr, lane);
    }
    { const size_t gt = (size_t)gw * 64 + lane, NT = (size_t)NGW * 64; unsigned char* x8 = pp->ws + WS_X8;
      for (size_t i = gt; i < (size_t)T * D / 16; i += NT) { const f32x4 a = *(const f32x4*)(pp->x + i * 16) * 32.f, b = *(const f32x4*)(pp->x + i * 16 + 4) * 32.f, c = *(const f32x4*)(pp->x + i * 16 + 8) * 32.f, d = *(const f32x4*)(pp->x + i * 16 + 12) * 32.f;
          u32x4 o; o.x = pk4_fp8(a[0], a[1], a[2], a[3]); o.y = pk4_fp8(b[0], b[1], b[2], b[3]); o.z = pk4_fp8(c[0], c[1], c[2], c[3]); o.w = pk4_fp8(d[0], d[1], d[2], d[3]); *(u32x4*)(x8 + i * 16) = o; } }
    if (blockIdx.x == 0) { unsigned* barw = (unsigned*)(pp->ws + WS_BAR); for (int i = threadIdx.x; i < XCD_BAR_WORDS; i += NTHREADS) barw[i] = 0u; }
    { float* tabA = (float*)(pp->ws + WS_TAB); float* tabB = (float*)(pp->ws + WS_TAB + 8192);
      const int gt = gw * 64 + lane;
      if (gt < 12 * 129) { const int hh = gt / 129, i = gt - hh * 129, g = hh >> 2, dil = g == 0 ? 1 : (g == 1 ? 4 : 16); tabA[hh * 132 + i] = pp->rel_bias[t5_bucket((i - 64) * dil) * 20 + hh] * LOG2E; }
      else if (gt < 12 * 129 + 8 * 257) { const int q = gt - 12 * 129, hh = q / 257, i = q - hh * 257; tabB[hh * 260 + i] = pp->rel_bias[t5_bucket(i - 128) * 20 + 12 + hh] * LOG2E; } }
}

constexpr int AT_KS = 0, AT_VS = 8704, AT_TAB = 8704 + 10240, AT_WAVE_BYTES = 8704 + 10240 + 1296;
static_assert(AT_WAVE_BYTES * NWAVES <= LDS_BYTES, "attention LDS");
#define TR4(r0, r1, r2, r3, base, o0, o1, o2, o3) asm volatile("ds_read_b64_tr_b16 %0, %4 offset:%5\n\tds_read_b64_tr_b16 %1, %4 offset:%6\n\tds_read_b64_tr_b16 %2, %4 offset:%7\n\tds_read_b64_tr_b16 %3, %4 offset:%8\n\ts_waitcnt lgkmcnt(0)" \
    : "=&v"(r0), "=&v"(r1), "=&v"(r2), "=&v"(r3) : "v"(base), "i"(o0), "i"(o1), "i"(o2), "i"(o3) : "memory")
#define PK8(L, Hh) (bf16x8){L[0], L[1], L[2], L[3], Hh[0], Hh[1], Hh[2], Hh[3]}

struct AtItem { int qcol, kcol, vcol, r, dil, sub_len, q0, W, nkt, T0, toff, NT, o_ld, ocol, lse_idx, o8; const float* tab; float m0; int sink; unsigned char* O; float* lse; };
constexpr int AT_NA = 12 * 64, AT_NB = 2 * 256;
__device__ __forceinline__ AtItem at_decode(int i, int wave, int layer, unsigned char* ws, const float* sinkp) {
    AtItem I; const float* tabA = (const float*)(ws + WS_TAB); const float* tabB = (const float*)(ws + WS_TAB + 8192);
    if (i < AT_NA) {
        const int hh = i >> 6, idx = i & 63, g = hh >> 2;
        I.dil = g == 0 ? 1 : (g == 1 ? 4 : 16); const int nbr = 64 / I.dil; I.r = idx / nbr; const int qb = idx - I.r * nbr; I.sub_len = SEQ / I.dil;
        I.q0 = qb * 256 + 32 * wave; I.T0 = qb * 256 - 64; I.toff = wave; I.NT = 12; I.nkt = 5; I.W = 64;
        I.qcol = hh * 128; I.kcol = 1536 + hh * 128; I.vcol = 3072 + hh * 128; I.tab = tabA + hh * 132; I.m0 = -1e30f; I.sink = 0;
        I.O = ws + WS_AR; I.o_ld = 1536; I.ocol = hh * 128; I.lse = (float*)(ws + WS_LSE); I.lse_idx = hh; I.o8 = 0;
    } else {
        const int b = i - AT_NA, kvh = b >> 8, qp = b & 255, j = wave >> 2, rep = wave & 3, qh = kvh * 4 + rep;
        I.dil = 1; I.r = 0; I.sub_len = SEQ; I.q0 = qp * 64 + 32 * j; I.T0 = qp * 64 - 128; I.toff = j; I.NT = 10; I.nkt = 9; I.W = 128;
        I.qcol = 4608 + qh * 128; I.kcol = 5632 + kvh * 128; I.vcol = 5888 + kvh * 128; I.tab = tabB + qh * 260; I.m0 = sinkp[layer * 8 + qh] * LOG2E; I.sink = 1;
        I.O = ws + WS_BO; I.o_ld = 1024; I.ocol = qh * 128; I.lse = nullptr; I.lse_idx = 0; I.o8 = 1;
    }
    return I;
}
__device__ __forceinline__ void phase_attention(unsigned char* ws, const float* sinkp, LAS unsigned char* lds, int layer, int vcu, int G, int wave, int lane) {
    const bf16* P = (const bf16*)(ws + WS_PROJ);
    const int hl = lane >> 5, ql = lane & 31, lrow = lane >> 4, lch = lane & 15;
    LAS float* tabs = (LAS float*)(lds + wave * AT_WAVE_BYTES + AT_TAB);
    const float c = 0.08838834764831845f * LOG2E;
    const unsigned vlane = (unsigned)((4 * hl + ((lane & 15) >> 2)) * 320 + (16 * ((lane >> 4) & 1) + 4 * (lane & 3)) * 2);
    const int klane = ql * 272 + 16 * hl;
    const int wrow = 4 * wave + lrow;
    bf16x8 qf[8]; u32x4 kreg[8], vreg[8], kn, vn; float tv[6];
#define AT_EDGE(I, kt_) ((I.q0 - I.W + 32 * (kt_) < 0) || (I.q0 - I.W + 32 * (kt_) + 31 >= I.sub_len))
#define AT_TOFF(I, t) ({ int sub = I.T0 + 32 * (t) + wrow; sub = sub < 0 ? 0 : (sub >= I.sub_len ? I.sub_len - 1 : sub); (unsigned)(I.r + sub * I.dil) * (unsigned)(CIN * 2) + 16u * lch; })
#define AT_FILL(I) do { const char* Pk = (const char*)(P + I.kcol); const char* Pv = (const char*)(P + I.vcol); \
        _Pragma("unroll") for (int t = 0; t < 8; ++t) { const unsigned o_ = AT_TOFF(I, t); kreg[t] = *(const u32x4*)(Pk + o_); vreg[t] = *(const u32x4*)(Pv + o_); } } while (0)
#define AT_WRITEFILL() do { _Pragma("unroll") for (int t = 0; t < 8; ++t) { *(LAS u32x4*)(lds + t * AT_WAVE_BYTES + AT_KS + wrow * 272 + 16 * lch) = kreg[t]; *(LAS u32x4*)(lds + t * AT_WAVE_BYTES + AT_VS + wrow * 320 + 16 * lch) = vreg[t]; } } while (0)
#define AT_LOADQ(I) do { const bf16* qp = P + (size_t)(I.r + (I.q0 + ql) * I.dil) * CIN + I.qcol + 8 * hl; _Pragma("unroll") for (int s = 0; s < 8; ++s) qf[s] = *(const bf16x8*)(qp + 16 * s); } while (0)
#define AT_LOADTAB(I) do { _Pragma("unroll") for (int u = 0; u < 6; ++u) { const int src = lane + 64 * u - 32; const int sc_ = src < 0 ? 0 : (src > 2 * I.W ? 2 * I.W : src); tv[u] = I.tab[sc_]; } } while (0)
#define AT_STORETAB(I) do { _Pragma("unroll") for (int u = 0; u < 6; ++u) { const int i_ = lane + 64 * u, src = i_ - 32; if (i_ < 2 * I.W + 65) tabs[i_] = (src >= 0 && src <= 2 * I.W) ? tv[u] : -__builtin_inff(); } } while (0)
    constexpr int NTOT = AT_NA + AT_NB;
    int it = vcu; if (it >= NTOT) return;
    AtItem cur = at_decode(it, wave, layer, ws, sinkp);
    AT_LOADTAB(cur); AT_LOADQ(cur); AT_FILL(cur); AT_STORETAB(cur); AT_WRITEFILL();
    __syncthreads();
    for (;;) {
        const int itn = it + G; const bool has_next = itn < NTOT;
        const AtItem nxt = at_decode(has_next ? itn : it, wave, layer, ws, sinkp);
        f32x16 o0, o1, o2, o3;
#pragma unroll
        for (int i = 0; i < 16; ++i) { o0[i] = 0.f; o1[i] = 0.f; o2[i] = 0.f; o3[i] = 0.f; }
        float m = cur.m0, l = (cur.sink && lane < 32) ? 1.f : 0.f;
        const int nkt = cur.nkt;
        for (int kt = 0; kt < nkt; ++kt) {
            const bool last = (kt == nkt - 1);
            const int tn = 8 + kt; const bool newt = tn < cur.NT;
            if (newt) { const unsigned o_ = AT_TOFF(cur, tn); kn = *(const u32x4*)((const char*)(P + cur.kcol) + o_); vn = *(const u32x4*)((const char*)(P + cur.vcol) + o_); }
            const int sl = (cur.toff + kt) & 7;
            const LAS unsigned char* kb = lds + sl * AT_WAVE_BYTES + AT_KS + klane;
            const unsigned vb = (unsigned)(uintptr_t)(lds + sl * AT_WAVE_BYTES + AT_VS) + vlane;
            f32x16 sc;
#pragma unroll
            for (int i = 0; i < 16; ++i) sc[i] = 0.f;
#pragma unroll
            for (int s = 0; s < 8; ++s) { const bf16x8 kf = *(const LAS bf16x8*)(kb + 32 * s); sc = __builtin_amdgcn_mfma_f32_32x32x16_bf16(kf, qf[s], sc, 0, 0, 0); }
            if (last && has_next) AT_LOADQ(nxt);
            const LAS float* tb = tabs + (32 * kt - ql + 4 * hl + 32);
#pragma unroll
            for (int i = 0; i < 16; ++i) { sc[i] = fmaf(sc[i], c, tb[8 * (i >> 2) + (i & 3)]); }
            if (last && has_next) AT_LOADTAB(nxt);
            if (AT_EDGE(cur, kt)) {
                const int ks0 = cur.q0 - cur.W + 32 * kt + 4 * hl;
#pragma unroll
                for (int i = 0; i < 16; ++i) { const int ks = ks0 + 8 * (i >> 2) + (i & 3); if (ks < 0 || ks >= cur.sub_len) sc[i] = -__builtin_inff(); }
            }
            float tmax = -__builtin_inff();
#pragma unroll
            for (int i = 0; i < 16; ++i) tmax = fmaxf(tmax, sc[i]);
            tmax = fmaxf(tmax, shx(tmax, 32, lane));
            if (__builtin_amdgcn_ballot_w64(tmax > m + 8.0f) != 0ull) {
                const float mn = fmaxf(m, tmax), alpha = __builtin_amdgcn_exp2f(m - mn); m = mn; l *= alpha;
#pragma unroll
                for (int i = 0; i < 16; ++i) { o0[i] *= alpha; o1[i] *= alpha; o2[i] *= alpha; o3[i] *= alpha; }
            }
            float ps = 0.f;
#pragma unroll
            for (int i = 0; i < 16; ++i) { sc[i] = __builtin_amdgcn_exp2f(sc[i] - m); ps += sc[i]; }
            l += ps;
            bf16x8 p0, p1;
            { u32x4 w0, w1; w0.x = pk2(sc[0], sc[1]); w0.y = pk2(sc[2], sc[3]); w0.z = pk2(sc[4], sc[5]); w0.w = pk2(sc[6], sc[7]);
              w1.x = pk2(sc[8], sc[9]); w1.y = pk2(sc[10], sc[11]); w1.z = pk2(sc[12], sc[13]); w1.w = pk2(sc[14], sc[15]);
              p0 = *reinterpret_cast<bf16x8*>(&w0); p1 = *reinterpret_cast<bf16x8*>(&w1); }
            { s16x4 t0, t1, t2, t3, t4, t5, t6, t7, t8, t9, t10, t11, t12, t13, t14, t15;
              asm volatile("ds_read_b64_tr_b16 %0, %16 offset:0\n\tds_read_b64_tr_b16 %1, %16 offset:2560\n\tds_read_b64_tr_b16 %2, %16 offset:5120\n\tds_read_b64_tr_b16 %3, %16 offset:7680\n\t"
                           "ds_read_b64_tr_b16 %4, %16 offset:64\n\tds_read_b64_tr_b16 %5, %16 offset:2624\n\tds_read_b64_tr_b16 %6, %16 offset:5184\n\tds_read_b64_tr_b16 %7, %16 offset:7744\n\t"
                           "ds_read_b64_tr_b16 %8, %16 offset:128\n\tds_read_b64_tr_b16 %9, %16 offset:2688\n\tds_read_b64_tr_b16 %10, %16 offset:5248\n\tds_read_b64_tr_b16 %11, %16 offset:7808\n\t"
                           "ds_read_b64_tr_b16 %12, %16 offset:192\n\tds_read_b64_tr_b16 %13, %16 offset:2752\n\tds_read_b64_tr_b16 %14, %16 offset:5312\n\tds_read_b64_tr_b16 %15, %16 offset:7872\n\ts_waitcnt lgkmcnt(0)"
                           : "=&v"(t0), "=&v"(t1), "=&v"(t2), "=&v"(t3), "=&v"(t4), "=&v"(t5), "=&v"(t6), "=&v"(t7), "=&v"(t8), "=&v"(t9), "=&v"(t10), "=&v"(t11), "=&v"(t12), "=&v"(t13), "=&v"(t14), "=&v"(t15)
                           : "v"(vb) : "memory");
              __builtin_amdgcn_sched_barrier(0);
              o0 = __builtin_amdgcn_mfma_f32_32x32x16_bf16(PK8(t0, t1), p0, o0, 0, 0, 0); o1 = __builtin_amdgcn_mfma_f32_32x32x16_bf16(PK8(t4, t5), p0, o1, 0, 0, 0);
              o2 = __builtin_amdgcn_mfma_f32_32x32x16_bf16(PK8(t8, t9), p0, o2, 0, 0, 0); o3 = __builtin_amdgcn_mfma_f32_32x32x16_bf16(PK8(t12, t13), p0, o3, 0, 0, 0);
              o0 = __builtin_amdgcn_mfma_f32_32x32x16_bf16(PK8(t2, t3), p1, o0, 0, 0, 0); o1 = __builtin_amdgcn_mfma_f32_32x32x16_bf16(PK8(t6, t7), p1, o1, 0, 0, 0);
              o2 = __builtin_amdgcn_mfma_f32_32x32x16_bf16(PK8(t10, t11), p1, o2, 0, 0, 0); o3 = __builtin_amdgcn_mfma_f32_32x32x16_bf16(PK8(t14, t15), p1, o3, 0, 0, 0); }
            if (newt) {
                __syncthreads();
                *(LAS u32x4*)(lds + (tn & 7) * AT_WAVE_BYTES + AT_KS + wrow * 272 + 16 * lch) = kn; *(LAS u32x4*)(lds + (tn & 7) * AT_WAVE_BYTES + AT_VS + wrow * 320 + 16 * lch) = vn;
                __syncthreads();
            }
        }
        const float lt = l + shx(l, 32, lane), inv = 1.0f / lt;
        const size_t tok = (size_t)(cur.r + (cur.q0 + ql) * cur.dil);
        if (cur.o8) {
            unsigned char* op = cur.O + tok * cur.o_ld + cur.ocol + 4 * hl; const float i64 = inv * 64.f;
#pragma unroll
            for (int g = 0; g < 4; ++g) {
                *(unsigned*)(op + 8 * g) = pk4_fp8(o0[4 * g] * i64, o0[4 * g + 1] * i64, o0[4 * g + 2] * i64, o0[4 * g + 3] * i64);
                *(unsigned*)(op + 32 + 8 * g) = pk4_fp8(o1[4 * g] * i64, o1[4 * g + 1] * i64, o1[4 * g + 2] * i64, o1[4 * g + 3] * i64);
                *(unsigned*)(op + 64 + 8 * g) = pk4_fp8(o2[4 * g] * i64, o2[4 * g + 1] * i64, o2[4 * g + 2] * i64, o2[4 * g + 3] * i64);
                *(unsigned*)(op + 96 + 8 * g) = pk4_fp8(o3[4 * g] * i64, o3[4 * g + 1] * i64, o3[4 * g + 2] * i64, o3[4 * g + 3] * i64);
            }
        } else {
            bf16* op = (bf16*)cur.O + tok * cur.o_ld + cur.ocol + 4 * hl;
#pragma unroll
            for (int g = 0; g < 4; ++g) {
                u32x2 w;
                w.x = pk2(o0[4 * g] * inv, o0[4 * g + 1] * inv); w.y = pk2(o0[4 * g + 2] * inv, o0[4 * g + 3] * inv); *(u32x2*)(op + 8 * g) = w;
                w.x = pk2(o1[4 * g] * inv, o1[4 * g + 1] * inv); w.y = pk2(o1[4 * g + 2] * inv, o1[4 * g + 3] * inv); *(u32x2*)(op + 32 + 8 * g) = w;
                w.x = pk2(o2[4 * g] * inv, o2[4 * g + 1] * inv); w.y = pk2(o2[4 * g + 2] * inv, o2[4 * g + 3] * inv); *(u32x2*)(op + 64 + 8 * g) = w;
                w.x = pk2(o3[4 * g] * inv, o3[4 * g + 1] * inv); w.y = pk2(o3[4 * g + 2] * inv, o3[4 * g + 3] * inv); *(u32x2*)(op + 96 + 8 * g) = w;
            }
        }
        if (cur.lse && hl == 0) cur.lse[tok * 12 + cur.lse_idx] = m + __builtin_log2f(lt);
        if (!has_next) break;
        AT_FILL(nxt);
        __syncthreads();
        AT_STORETAB(nxt); AT_WRITEFILL();
        __syncthreads();
        cur = nxt; it = itn;
    }
    LDS_WAIT();
#undef AT_FILL
#undef AT_WRITEFILL
#undef AT_TOFF
#undef AT_LOADQ
#undef AT_LOADTAB
#undef AT_STORETAB
#undef AT_EDGE
}

__device__ __forceinline__ void phase_amerge(unsigned char* ws, int gw, int NGW, int lane) {
    const bf16* AR = (const bf16*)(ws + WS_AR); const float* LSE = (const float*)(ws + WS_LSE); unsigned char* AO8 = ws + WS_AO;
    const size_t gt = (size_t)gw * 64 + lane, NT = (size_t)NGW * 64;
    for (size_t i = gt; i < (size_t)TH * 64; i += NT) {
        const size_t t = i >> 6; const int ch = (int)(i & 63), h = ch >> 4, dc = ch & 15;
        const float l0 = LSE[t * 12 + h], l1 = LSE[t * 12 + 4 + h], l2 = LSE[t * 12 + 8 + h];
        const float mx = fmaxf(l0, fmaxf(l1, l2));
        float w0 = __builtin_amdgcn_exp2f(l0 - mx), w1 = __builtin_amdgcn_exp2f(l1 - mx), w2 = __builtin_amdgcn_exp2f(l2 - mx);
        const float inv = 1.0f / (w0 + w1 + w2); w0 *= inv; w1 *= inv; w2 *= inv;
        const bf16* ap = AR + t * 1536 + h * 128 + dc * 8;
        const u32x4 a = *(const u32x4*)ap, b = *(const u32x4*)(ap + 512), cc = *(const u32x4*)(ap + 1024);
        w0 *= 64.f; w1 *= 64.f; w2 *= 64.f;
        u32x2 o;
        o.x = pk4_fp8(w0 * pg8::bf_lo(a.x) + w1 * pg8::bf_lo(b.x) + w2 * pg8::bf_lo(cc.x), w0 * pg8::bf_hi(a.x) + w1 * pg8::bf_hi(b.x) + w2 * pg8::bf_hi(cc.x),
                      w0 * pg8::bf_lo(a.y) + w1 * pg8::bf_lo(b.y) + w2 * pg8::bf_lo(cc.y), w0 * pg8::bf_hi(a.y) + w1 * pg8::bf_hi(b.y) + w2 * pg8::bf_hi(cc.y));
        o.y = pk4_fp8(w0 * pg8::bf_lo(a.z) + w1 * pg8::bf_lo(b.z) + w2 * pg8::bf_lo(cc.z), w0 * pg8::bf_hi(a.z) + w1 * pg8::bf_hi(b.z) + w2 * pg8::bf_hi(cc.z),
                      w0 * pg8::bf_lo(a.w) + w1 * pg8::bf_lo(b.w) + w2 * pg8::bf_lo(cc.w), w0 * pg8::bf_hi(a.w) + w1 * pg8::bf_hi(b.w) + w2 * pg8::bf_hi(cc.w));
        *(u32x2*)(AO8 + t * 512 + h * 128 + dc * 8) = o;
    }
}

__device__ __forceinline__ void phase_ln(float* Y, bf16* XB, unsigned char* X8, float* st, bool inplace, const float* __restrict__ gam, const float* __restrict__ bet, int gw, int NGW, int lane, unsigned char* XI8 = nullptr, float* rsc = nullptr) {
    for (int row0 = 2 * gw; row0 < T; row0 += 2 * NGW) {
        f32x4* yr0 = (f32x4*)(Y + (size_t)row0 * D) + lane; f32x4* yr1 = yr0 + D / 4;
        f32x4 v[8], w[8]; float s = 0.f, t = 0.f;
#pragma unroll
        for (int j = 0; j < 8; ++j) { v[j] = yr0[64 * j]; w[j] = yr1[64 * j]; }
#pragma unroll
        for (int j = 0; j < 8; ++j) { s += (v[j][0] + v[j][1]) + (v[j][2] + v[j][3]); t += (w[j][0] + w[j][1]) + (w[j][2] + w[j][3]); }
#pragma unroll
        for (int o = 1; o < 64; o <<= 1) { s += shx(s, o, lane); t += shx(t, o, lane); }
        const float mean0 = s * (1.f / D), mean1 = t * (1.f / D); float s2 = 0.f, t2 = 0.f;
#pragma unroll
        for (int j = 0; j < 8; ++j) { v[j] = v[j] - mean0; w[j] = w[j] - mean1; s2 += (v[j][0] * v[j][0] + v[j][1] * v[j][1]) + (v[j][2] * v[j][2] + v[j][3] * v[j][3]); t2 += (w[j][0] * w[j][0] + w[j][1] * w[j][1]) + (w[j][2] * w[j][2] + w[j][3] * w[j][3]); }
#pragma unroll
        for (int o = 1; o < 64; o <<= 1) { s2 += shx(s2, o, lane); t2 += shx(t2, o, lane); }
        const float rstd0 = 1.0f / sqrtf(s2 * (1.f / D) + LN_EPS), rstd1 = 1.0f / sqrtf(t2 * (1.f / D) + LN_EPS);
        if (st && lane == 0) { f32x4 sv; sv[0] = mean0; sv[1] = rstd0; sv[2] = mean1; sv[3] = rstd1; *(f32x4*)(st + 2 * (size_t)row0) = sv; }
        float am0 = 0.f, am1 = 0.f;
#pragma unroll
        for (int j = 0; j < 8; ++j) { const f32x4 gg = *((const f32x4*)gam + lane + 64 * j), bb = *((const f32x4*)bet + lane + 64 * j);
            const f32x4 o = v[j] * rstd0 * gg + bb, q = w[j] * rstd1 * gg + bb;
            if (inplace) { yr0[64 * j] = o; yr1[64 * j] = q; }
            if (XB) { u32x2 u; u.x = pk2(o[0], o[1]); u.y = pk2(o[2], o[3]); *((u32x2*)(XB + (size_t)row0 * D) + lane + 64 * j) = u; u.x = pk2(q[0], q[1]); u.y = pk2(q[2], q[3]); *((u32x2*)(XB + (size_t)(row0 + 1) * D) + lane + 64 * j) = u; }
            if (X8) { *((unsigned*)(X8 + (size_t)row0 * D) + lane + 64 * j) = pk4_fp8(o[0] * 32.f, o[1] * 32.f, o[2] * 32.f, o[3] * 32.f); *((unsigned*)(X8 + (size_t)(row0 + 1) * D) + lane + 64 * j) = pk4_fp8(q[0] * 32.f, q[1] * 32.f, q[2] * 32.f, q[3] * 32.f); }
            if (XI8) { v[j] = o; w[j] = q; am0 = fmaxf(am0, fmaxf(fmaxf(fabsf(o[0]), fabsf(o[1])), fmaxf(fabsf(o[2]), fabsf(o[3])))); am1 = fmaxf(am1, fmaxf(fmaxf(fabsf(q[0]), fabsf(q[1])), fmaxf(fabsf(q[2]), fabsf(q[3])))); } }
        if (XI8) {
#pragma unroll
            for (int o = 1; o < 64; o <<= 1) { am0 = fmaxf(am0, shx(am0, o, lane)); am1 = fmaxf(am1, shx(am1, o, lane)); }
            const float i0 = am0 > 0.f ? 127.0f / am0 : 0.f, i1 = am1 > 0.f ? 127.0f / am1 : 0.f;
            if (lane == 0) { rsc[row0] = am0 * (1.0f / 127.0f); rsc[row0 + 1] = am1 * (1.0f / 127.0f); }
#pragma unroll
            for (int j = 0; j < 8; ++j) {
                { const int a = (int)__builtin_rintf(v[j][0] * i0), b = (int)__builtin_rintf(v[j][1] * i0), c = (int)__builtin_rintf(v[j][2] * i0), d = (int)__builtin_rintf(v[j][3] * i0);
                  *((unsigned*)(XI8 + (size_t)row0 * D) + lane + 64 * j) = ((unsigned)a & 255u) | (((unsigned)b & 255u) << 8) | (((unsigned)c & 255u) << 16) | ((unsigned)d << 24); }
                { const int a = (int)__builtin_rintf(w[j][0] * i1), b = (int)__builtin_rintf(w[j][1] * i1), c = (int)__builtin_rintf(w[j][2] * i1), d = (int)__builtin_rintf(w[j][3] * i1);
                  *((unsigned*)(XI8 + (size_t)(row0 + 1) * D) + lane + 64 * j) = ((unsigned)a & 255u) | (((unsigned)b & 255u) << 8) | (((unsigned)c & 255u) << 16) | ((unsigned)d << 24); } }
        }
    }
}

__global__ void __launch_bounds__(NTHREADS, 2) fwd_mega(Params p_arg) {
    extern __shared__ __attribute__((aligned(16))) unsigned char lds_raw[];
    LAS unsigned char* lds = (LAS unsigned char*)lds_raw;
    const int ph_lo = p_arg.ph_lo, ph_hi = p_arg.ph_hi;
    if (threadIdx.x < 4) ((LAS unsigned*)(lds + LDS_BARST))[threadIdx.x] = 0u;
    __syncthreads();
    for (int ph = ph_lo; ph < ph_hi; ++ph) {
      for (int rep = 0; rep < 2; ++rep) {
        if (ph > ph_lo || rep > 0) {
#if defined(__HIP_DEVICE_COMPILE__)
            unsigned* barw = (unsigned*)(((PP)__builtin_amdgcn_kernarg_segment_ptr())->ws + WS_BAR);
            if (ph == 1 && rep == 0) { cg::this_grid().sync();
                (void)xcd_barrier_post(barw, (volatile LAS unsigned*)(lds + LDS_BARST)); }
            else {
#ifdef DBG_BAR
                const unsigned long long tb0_ = __builtin_amdgcn_s_memrealtime();
#endif
                XcdBarrier xb_; xb_.bar = barw; xb_.x = xb_xcc_id(); xb_.st = (volatile LAS unsigned*)(lds + LDS_BARST); xcd_barrier(xb_);
#ifdef DBG_BAR
                if (blockIdx.x == DBG_BAR && threadIdx.x == 0) { unsigned long long* d_ = (unsigned long long*)(((PP)__builtin_amdgcn_kernarg_segment_ptr())->ws + WS_BAR + 65536); const unsigned long long dt_ = __builtin_amdgcn_s_memrealtime() - tb0_; d_[0] = (ph == 2 ? 0ull : d_[0]) + dt_; }
#endif
            }
#endif
        }
#if defined(__HIP_DEVICE_COMPILE__)
        PP p = (PP)__builtin_amdgcn_kernarg_segment_ptr(); asm volatile("" : "+s"(p));
#else
        PP p = (PP)(uintptr_t)0; (void)p_arg;
#endif
        int tid_ = threadIdx.x, bx_ = blockIdx.x; asm volatile("" : "+v"(tid_), "+s"(bx_));
        const int tid = tid_, lane = tid & 63, wave = __builtin_amdgcn_readfirstlane(tid >> 6);
        const int G = gridDim.x, bx = bx_, vcu = (G % 8 == 0) ? (bx % 8) * (G / 8) + bx / 8 : bx;
        const int gw = vcu * NWAVES + wave, NGW = G * NWAVES;
        unsigned char* ws = p->ws; bf16* XB = (bf16*)(ws + WS_XB);
        if (ph == 0) {
#if EN_PRO
 phase_prologue(p, lds, gw, NGW, wave, lane);
#endif
 break; }
        const int q = ph - 1, layer = q / 13, s = q - layer * 13;
        const bf16* wl = (const bf16*)(ws + WS_W0 + (size_t)layer * WS_WL);
        const bool dbl = (s < 8 && (s & 3) == 1 && (PROBE_MASK & 2)) || (s < 8 && (s & 3) == 2 && (PROBE_MASK & 4)) || ((s == 9 || (s == 12 && layer == 0)) && (PROBE_MASK & 8)) || (s < 8 && (s & 3) == 0 && (PROBE_MASK & 16)) || (s == 10 && (PROBE_MASK & 32)) || (s < 8 && (s & 3) == 3 && (PROBE_MASK & 64));
        if (s < 8) {
            const int half = s >> 2, sub = s & 3;
            if (sub == 0) {
                pg8::Gemm g{(const bf16*)(ws + WS_X8 + (size_t)half * TH * D), wl + WO_IN, TH, CIN, D / 2}; pg8::StaticOrder S; S.init(TH, CIN, G, bx);
                pg8::EpiProj E{(bf16*)(ws + WS_PROJ), CIN, ws + WS_G8, 4096, 6144};

#if EN_INPROJ
 pg8::gemm_phase<pg8::EpiProj, pg8::StaticOrder, true, true, true>(lds, g, S, E);
#endif

            } else if (sub == 1) {
#if EN_ATTN
 phase_attention(ws, p->sink, lds, layer, vcu, G, wave, lane);
#endif

            } else if (sub == 2) { phase_amerge(ws, gw, NGW, lane);
            } else {
                for (int k = 0; k < 2; ++k) {
                    pg8::Gemm g{k == 0 ? (const bf16*)(ws + WS_AO) : (const bf16*)(ws + WS_BO), wl + (k == 0 ? WO_PA : WO_PB), TH, D, k == 0 ? 256 : 512, 0x79797979, 0x78787878};
                    pg8::StaticOrder S; S.init(TH, D, G, bx);
                    pg8::EpiGate E{(bf16*)(ws + WS_XB + 64 * MiB), ws + WS_XB + (size_t)half * TH * D, D, ws + WS_G8 + (k == 0 ? 0 : 2048), 4096, k, 512.f};

#if EN_GATE
 pg8::gemm_phase<pg8::EpiGate, pg8::StaticOrder, true, true, true>(lds, g, S, E);
#endif

                }
            }
        } else if (s == 8 || s == 11) {
            const bool dn = (s == 11);
            pg8::StaticOrder S; S.init(T, D, G, bx);
            const bool raw = (!dn && layer == 0);
            pg8::EpiResid E{(pg8::ArgV)p, raw ? 0 : -1, dn ? 7 : 11, dn ? 8 : 12, D, ALPHA, (size_t)(dn ? layer : (layer > 0 ? layer - 1 : 0)) * D, WS_ST};
#if EN_RESID
            if (dn && layer == FP8_DOWN_LAYER) { pg8::Gemm g{(const bf16*)(ws + WS_H), wl + WO_DN, T, D, DFF / 2, 0x79797979, 0x77777777}; pg8::gemm_phase<pg8::EpiResid, pg8::StaticOrder, true, true, true>(lds, g, S, E); }
            else if (dn) { pg8::Gemm g{(const bf16*)(ws + WS_H), wl + WO_DN, T, D, DFF}; pg8::gemm_phase<pg8::EpiResid, pg8::StaticOrder, true, true>(lds, g, S, E); }
            else { pg8::Gemm g{(const bf16*)(ws + WS_XB), wl + WO_OUT, T, D, D / 2, 0x76767676, 0x78787878}; pg8::gemm_phase<pg8::EpiResid, pg8::StaticOrder, true, true, true>(lds, g, S, E); }
#endif
        } else if (s == 9) { phase_ln(p->out, nullptr, nullptr, (float*)(ws + WS_ST), false, p->ln1_g + layer * D, p->ln1_b + layer * D, gw, NGW, lane, ws + WS_XB, (float*)(ws + WS_RS));
        } else if (s == 10) {
            pg8::Gemm g{XB, wl + WO_UP, T, NUP, D / 2}; pg8::StaticOrder S; S.init(T, NUP, G, bx);
            pg8::EpiSwigluI8 E{(bf16*)(ws + WS_H), DFF, layer == FP8_DOWN_LAYER ? 64.f : 0.f, (const float*)(ws + WS_RS), (const float*)(ws + WS_CMAX) + layer * NUP};

#if EN_SWIGLU
 pg8::gemm_phase<pg8::EpiSwigluI8, pg8::StaticOrder, true, true, false, true>(lds, g, S, E);
#endif

        } else { phase_ln(p->out, nullptr, (layer == 1) ? nullptr : ws + WS_X8, (layer == 1) ? nullptr : (float*)(ws + WS_ST), layer == 1, p->ln2_g + layer * D, p->ln2_b + layer * D, gw, NGW, lane); }
        if (!(rep == 0 && dbl)) break;
      }
    }
#if defined(__HIP_DEVICE_COMPILE__) && defined(DBG_BAR)
    if (blockIdx.x == DBG_BAR && threadIdx.x == 0) { PP p = (PP)__builtin_amdgcn_kernarg_segment_ptr(); const unsigned long long* d = (const unsigned long long*)(p->ws + WS_BAR + 65536);
        float v = (float)d[0] * 0.01f;
        v = __builtin_rintf(v / 100.f) * 100.f; p->out[0] = v * 1.0e3f; }
#endif
}

#ifndef MK_PER_PHASE
#define MK_PER_PHASE 0
#endif
extern "C" void kernel_launch(void* const* d_in, const int* in_sizes, int n_in, void* d_out, int out_size, void* d_ws, size_t ws_size, hipStream_t stream) {
    static int grid = 0;
    if (grid == 0) {
        if (n_in != 13 || ws_size < WS_END) { fprintf(stderr, "kernel_launch: unexpected inputs (n_in %d, ws %zu)\n", n_in, ws_size); grid = -1; return; }
        int dev = 0, cus = 0;
        if (hipGetDevice(&dev) != hipSuccess || hipDeviceGetAttribute(&cus, hipDeviceAttributeMultiprocessorCount, dev) != hipSuccess) { grid = -1; return; }
        if (hipFuncSetAttribute((const void*)fwd_mega, hipFuncAttributeMaxDynamicSharedMemorySize, LDS_BYTES) != hipSuccess) { fprintf(stderr, "kernel_launch: hipFuncSetAttribute failed\n"); grid = -1; return; }
        (void)hipGetLastError();
        grid = cus;
    }
    if (grid < 0) return;
    Params p{};
    p.x = (const float*)d_in[0]; p.rel_bias = (const float*)d_in[1]; p.w_in = (const float*)d_in[2]; p.sink = (const float*)d_in[3]; p.w_pa = (const float*)d_in[4]; p.w_pb = (const float*)d_in[5];
    p.w_out = (const float*)d_in[6]; p.ln1_g = (const float*)d_in[7]; p.ln1_b = (const float*)d_in[8]; p.w_up = (const float*)d_in[9]; p.w_down = (const float*)d_in[10];
    p.ln2_g = (const float*)d_in[11]; p.ln2_b = (const float*)d_in[12]; p.out = (float*)d_out; p.ws = (unsigned char*)d_ws;
#if MK_PER_PHASE
    for (int ph = 0; ph < NPHASES; ++ph) { p.ph_lo = ph; p.ph_hi = ph + 1; hipLaunchKernelGGL(fwd_mega, dim3(grid), dim3(NTHREADS), LDS_BYTES, stream, p); }
#else
    p.ph_lo = 0; p.ph_hi = NPHASES;
    void* args[] = {&p};
    hipError_t e = hipLaunchCooperativeKernel((const void*)fwd_mega, dim3(grid), dim3(NTHREADS), args, LDS_BYTES, stream);
    if (e != hipSuccess) fprintf(stderr, "kernel_launch: cooperative launch failed: %s (grid %d)\n", hipGetErrorString(e), grid);
#endif
}
```

```cpp
#include <hip/hip_runtime.h>
#include <hip/hip_cooperative_groups.h>
#include <cstdio>
#include <cstdint>
namespace cg = cooperative_groups;
namespace pg8 {
#define PG8_LAS __attribute__((address_space(3)))
typedef unsigned short bf16_t;
typedef short bf16x8 __attribute__((ext_vector_type(8)));
typedef float f32x4 __attribute__((ext_vector_type(4)));
typedef unsigned u32x4 __attribute__((ext_vector_type(4)));
typedef unsigned u32x2 __attribute__((ext_vector_type(2)));
typedef int v8i32 __attribute__((ext_vector_type(8)));
typedef int v4i32 __attribute__((ext_vector_type(4)));
constexpr int FP8_SCALE_X = 0x79797979, FP8_SCALE_W = 0x79797979;
constexpr int BM = 256, BK = 64, HALF = 128, HTB = HALF * BK * 2  , STAGE_BYTES = 8 * HTB, NXCD = 8, WGM = 8;

__host__ __device__ __forceinline__ int lds_byte(int r, int c) { const int st = (r >> 4) * 2 + (c >> 5), rr = r & 15, cc = c & 31, ob = rr * 64 + cc * 2; return st * 1024 + (ob ^ (((ob >> 9) & 1) << 5)); }
__host__ __device__ __forceinline__ void stage_rc(int b, int& R, int& C) { const int st = b / 1024, sb = b % 1024, swz = sb ^ (((sb >> 9) & 1) << 5); R = (st >> 1) * 16 + swz / 64; C = (st & 1) * 32 + (swz % 64) / 2; }
__host__ __device__ __forceinline__ int x8(int r) { return ((r >> 1) & 3) | ((((r >> 2) ^ (r >> 3)) & 1) << 2); }
__host__ __device__ __forceinline__ int lds_byte8(int r, int c16) { return r * 128 + 16 * (c16 ^ x8(r & 15)); }
__host__ __device__ __forceinline__ void stage_rc8(int b, int& R, int& C) { R = b >> 7; C = 8 * (((b >> 4) & 7) ^ x8(R & 15)); }
__host__ __device__ __forceinline__ int perm32(int rho) { const int n = rho >> 4, i = rho & 15; return 8 * (i >> 2) + 4 * n + (i & 3); }

struct Unit { int pm, pn; };
struct Gemm { const bf16_t* A; const bf16_t* Bt; int M, N, K; int sx = 0x79797979, sw = 0x79797979; };

struct StaticOrder {
    int nM, nN, nwg, G, c;
    __host__ __device__ void init(int M, int N, int G_, int c_) { nM = M / BM; nN = N / BM; nwg = nM * nN; G = G_; c = c_; }
    __host__ __device__ bool next(int i, Unit& u) const {
        const long L = (long)i * G + c; if (L >= nwg) return false;
        int wgid = (int)L; { const int q = nwg / NXCD, r = nwg % NXCD, xcd = wgid % NXCD, off = wgid / NXCD; wgid = (xcd < r ? xcd * (q + 1) : r * (q + 1) + (xcd - r) * q) + off; }
        const int nig = WGM * nN, gid = wgid / nig, fm = gid * WGM, gsz = (nM - fm) < WGM ? (nM - fm) : WGM;
        u.pm = fm + ((wgid % nig) % gsz); u.pn = (wgid % nig) / gsz; return true;
    }
    __device__ __forceinline__ void a_ready(const Unit&) const {}
    __device__ __forceinline__ void done(const Unit&) const {}
};

__device__ __forceinline__ unsigned cvt_pk_bf16(float lo, float hi) { unsigned r; asm("v_cvt_pk_bf16_f32 %0, %1, %2" : "=v"(r) : "v"(lo), "v"(hi)); return r; }
typedef float f32x2 __attribute__((ext_vector_type(2)));
template <int ACT  > struct EpiBf16 {
    static constexpr bool PERM = true, AFTER_DRAIN = false; static_assert(ACT == 0 || ACT == 1, "EpiBf16: ACT is 0 (none) or 1 (gelu_pk)");
    bf16_t* O; int ldc; const float* bias; int split_cols; size_t split_stride; float scale0;
    __device__ __forceinline__ void operator()(const f32x4 (&acc)[2][2][4][2], const Unit& u, int wr, int wc, int fr, int fq) const {
        const int row0 = u.pm * BM + wr * 64 + fr; int colt = u.pn * BM; bf16_t* base = O;
        float sc = 1.f; if (split_cols) { const int t = colt / split_cols; base += (size_t)t * split_stride; colt -= t * split_cols; if (t == 0) sc = scale0; }
        const int col0 = colt + wc * 32 + 8 * fq, bcol0 = u.pn * BM + wc * 32 + 8 * fq;
        f32x4 bv[2][2];
#pragma unroll
        for (int bj = 0; bj < 2; ++bj)
#pragma unroll
            for (int n = 0; n < 2; ++n) bv[bj][n] = bias ? *(const f32x4*)(bias + bcol0 + bj * HALF + 4 * n) : (f32x4){0.f, 0.f, 0.f, 0.f};
#pragma unroll
        for (int ai = 0; ai < 2; ++ai)
#pragma unroll
            for (int m = 0; m < 4; ++m) { bf16_t* rowp = base + (size_t)(row0 + ai * HALF + m * 16) * ldc + col0;
#pragma unroll
                for (int bj = 0; bj < 2; ++bj) { f32x4 v0 = acc[ai][bj][m][0] + bv[bj][0], v1 = acc[ai][bj][m][1] + bv[bj][1];
                    v0 = v0 * sc; v1 = v1 * sc; u32x4 w; w.x = cvt_pk_bf16(v0[0], v0[1]); w.y = cvt_pk_bf16(v0[2], v0[3]); w.z = cvt_pk_bf16(v1[0], v1[1]); w.w = cvt_pk_bf16(v1[2], v1[3]);
                    *(u32x4*)(rowp + bj * HALF) = w; } }
    }
};
__device__ __forceinline__ float sigmoidf_fast(float x) { return __builtin_amdgcn_rcpf(1.0f + __builtin_amdgcn_exp2f(-1.4426950408889634f * x)); }
__device__ __forceinline__ float bf_lo(unsigned w) { return __uint_as_float(w << 16); }
__device__ __forceinline__ float bf_hi(unsigned w) { return __uint_as_float(w & 0xffff0000u); }
__device__ __forceinline__ float clamp448(float v) { return __builtin_fminf(__builtin_fmaxf(v, -448.f), 448.f); }
__device__ __forceinline__ unsigned pk4_fp8(float a, float b, float c, float d) { unsigned w = 0; w = __builtin_amdgcn_cvt_pk_fp8_f32(clamp448(a), clamp448(b), w, false); w = __builtin_amdgcn_cvt_pk_fp8_f32(clamp448(c), clamp448(d), w, true); return w; }
struct EpiProj {
    static constexpr bool PERM = true, AFTER_DRAIN = false;
    bf16_t* O; int ldc; unsigned char* G8; int ldg; int gcol0;
    __device__ __forceinline__ void operator()(const f32x4 (&acc)[2][2][4][2], const Unit& u, int wr, int wc, int fr, int fq) const {
        const int row0 = u.pm * BM + wr * 64 + fr, col0 = u.pn * BM + wc * 32 + 8 * fq;
        if (u.pn * BM < gcol0) {
#pragma unroll
            for (int ai = 0; ai < 2; ++ai)
#pragma unroll
                for (int m = 0; m < 4; ++m) { bf16_t* rowp = O + (size_t)(row0 + ai * HALF + m * 16) * ldc + col0;
#pragma unroll
                    for (int bj = 0; bj < 2; ++bj) { const f32x4 v0 = acc[ai][bj][m][0], v1 = acc[ai][bj][m][1];
                        u32x4 w; w.x = cvt_pk_bf16(v0[0], v0[1]); w.y = cvt_pk_bf16(v0[2], v0[3]); w.z = cvt_pk_bf16(v1[0], v1[1]); w.w = cvt_pk_bf16(v1[2], v1[3]);
                        *(u32x4*)(rowp + bj * HALF) = w; } }
        } else {
#pragma unroll
            for (int ai = 0; ai < 2; ++ai)
#pragma unroll
                for (int m = 0; m < 4; ++m) { unsigned char* rowp = G8 + (size_t)(row0 + ai * HALF + m * 16) * ldg + (col0 - gcol0);
#pragma unroll
                    for (int bj = 0; bj < 2; ++bj) { const f32x4 v0 = acc[ai][bj][m][0], v1 = acc[ai][bj][m][1];
                        u32x2 w8; w8.x = pk4_fp8(256.f * sigmoidf_fast(v0[0]), 256.f * sigmoidf_fast(v0[1]), 256.f * sigmoidf_fast(v0[2]), 256.f * sigmoidf_fast(v0[3]));
                        w8.y = pk4_fp8(256.f * sigmoidf_fast(v1[0]), 256.f * sigmoidf_fast(v1[1]), 256.f * sigmoidf_fast(v1[2]), 256.f * sigmoidf_fast(v1[3]));
                        *(u32x2*)(rowp + bj * HALF) = w8; } }
        }
    }
};
struct EpiGate {
    static constexpr bool PERM = true, AFTER_DRAIN = false;
    bf16_t* Tm; unsigned char* O8; int ldo; const unsigned char* G; int ldg; int add; float oscale;
    __device__ __forceinline__ void operator()(const f32x4 (&acc)[2][2][4][2], const Unit& u, int wr, int wc, int fr, int fq) const {
        const int row0 = u.pm * BM + wr * 64 + fr, col0 = u.pn * BM + wc * 32 + 8 * fq;
#pragma unroll
        for (int ai = 0; ai < 2; ++ai)
#pragma unroll
            for (int m = 0; m < 4; ++m) { const size_t r = (size_t)(row0 + ai * HALF + m * 16); bf16_t* rowp = Tm + r * ldo + col0; const unsigned char* gp = G + r * ldg + col0;
#pragma unroll
                for (int bj = 0; bj < 2; ++bj) { const u32x2 gw = *(const u32x2*)(gp + bj * HALF); f32x4 v0 = acc[ai][bj][m][0], v1 = acc[ai][bj][m][1];
                    { const f32x2 g0 = __builtin_amdgcn_cvt_pk_f32_fp8((int)gw.x, false), g1 = __builtin_amdgcn_cvt_pk_f32_fp8((int)gw.x, true), g2 = __builtin_amdgcn_cvt_pk_f32_fp8((int)gw.y, false), g3 = __builtin_amdgcn_cvt_pk_f32_fp8((int)gw.y, true);
                      const float k_ = 1.0f / 256.0f;
                      v0[0] *= g0.x * k_; v0[1] *= g0.y * k_; v0[2] *= g1.x * k_; v0[3] *= g1.y * k_; v1[0] *= g2.x * k_; v1[1] *= g2.y * k_; v1[2] *= g3.x * k_; v1[3] *= g3.y * k_; }
                    if (add) { const u32x4 pw = *(const u32x4*)(rowp + bj * HALF);
                        v0[0] += bf_lo(pw.x); v0[1] += bf_hi(pw.x); v0[2] += bf_lo(pw.y); v0[3] += bf_hi(pw.y); v1[0] += bf_lo(pw.z); v1[1] += bf_hi(pw.z); v1[2] += bf_lo(pw.w); v1[3] += bf_hi(pw.w);
                        v0 = v0 * oscale; v1 = v1 * oscale; u32x2 w8; w8.x = pk4_fp8(v0[0], v0[1], v0[2], v0[3]); w8.y = pk4_fp8(v1[0], v1[1], v1[2], v1[3]);
                        *(u32x2*)(O8 + r * ldo + col0 + bj * HALF) = w8; }
                    else { u32x4 w; w.x = cvt_pk_bf16(v0[0], v0[1]); w.y = cvt_pk_bf16(v0[2], v0[3]); w.z = cvt_pk_bf16(v1[0], v1[1]); w.w = cvt_pk_bf16(v1[2], v1[3]);
                        *(u32x4*)(rowp + bj * HALF) = w; } } }
    }
};
typedef void* vptr_t; typedef const __attribute__((address_space(4))) vptr_t* ArgV;
struct EpiResid {
    static constexpr bool PERM = false, AFTER_DRAIN = false;
    ArgV args; int xi, gi, bi; int ldc; float alpha; size_t goff; size_t st_off;
    __device__ __forceinline__ void operator()(const f32x4 (&acc)[2][2][4][2], const Unit& u, int wr, int wc, int fr, int fq) const {
        ArgV a_ = args; asm volatile("" : "+s"(a_));
        float* Y = (float*)a_[13]; const float* X = xi >= 0 ? (const float*)a_[xi] : (const float*)Y;
        const float* st = xi >= 0 ? nullptr : (const float*)((const unsigned char*)a_[14] + st_off);
        const float* g = (const float*)a_[gi < 0 ? 0 : gi] + goff; const float* b = (const float*)a_[bi < 0 ? 0 : bi] + goff;
        const int row0 = u.pm * BM + wr * 64 + fr, col0 = u.pn * BM + wc * 32 + 4 * fq;
#pragma unroll
        for (int ai = 0; ai < 2; ++ai)
#pragma unroll
            for (int m = 0; m < 4; ++m) { const int r = row0 + ai * HALF + m * 16; const size_t off = (size_t)r * ldc + col0;
                float mean = 0.f, rstd = 1.f; if (st) { const f32x2 sv = *(const f32x2*)(st + 2 * (size_t)r); mean = sv.x; rstd = sv.y; }
#pragma unroll
                for (int bj = 0; bj < 2; ++bj)
#pragma unroll
                    for (int n = 0; n < 2; ++n) { f32x4 xv = *(const f32x4*)(X + off + bj * HALF + n * 16);
                        if (st) { const f32x4 gv = *(const f32x4*)(g + col0 + bj * HALF + n * 16), bv = *(const f32x4*)(b + col0 + bj * HALF + n * 16); xv = (xv - mean) * rstd * gv + bv; }
                        *(f32x4*)(Y + off + bj * HALF + n * 16) = xv * alpha + acc[ai][bj][m][n]; }
                asm volatile("" ::: "memory"); }
    }
};
struct EpiSwiglu {
    static constexpr bool PERM = true, AFTER_DRAIN = false;
    bf16_t* Hh; int ldh; float hscale;
    __device__ __forceinline__ void operator()(const f32x4 (&acc)[2][2][4][2], const Unit& u, int wr, int wc, int fr, int fq) const {
        const int row0 = u.pm * BM + wr * 64 + fr, col0 = u.pn * HALF + wc * 32 + 8 * fq;
#pragma unroll
        for (int ai = 0; ai < 2; ++ai)
#pragma unroll
            for (int m = 0; m < 4; ++m) { bf16_t* rowp = Hh + (size_t)(row0 + ai * HALF + m * 16) * ldh + col0; float hv[8];
#pragma unroll
                for (int n = 0; n < 2; ++n)
#pragma unroll
                    for (int j = 0; j < 4; ++j) { const float g = acc[ai][0][m][n][j], up = acc[ai][1][m][n][j]; hv[n * 4 + j] = g * sigmoidf_fast(g) * up; }
                if (hscale != 0.f) { u32x2 w8; w8.x = pk4_fp8(hv[0] * hscale, hv[1] * hscale, hv[2] * hscale, hv[3] * hscale); w8.y = pk4_fp8(hv[4] * hscale, hv[5] * hscale, hv[6] * hscale, hv[7] * hscale);
                    *(u32x2*)((unsigned char*)Hh + (size_t)(row0 + ai * HALF + m * 16) * ldh + col0) = w8; }
                else { u32x4 w; w.x = cvt_pk_bf16(hv[0], hv[1]); w.y = cvt_pk_bf16(hv[2], hv[3]); w.z = cvt_pk_bf16(hv[4], hv[5]); w.w = cvt_pk_bf16(hv[6], hv[7]);
                    *(u32x4*)rowp = w; } }
    }
};

struct EpiSwigluI8 {
    static constexpr bool PERM = true, AFTER_DRAIN = false;
    bf16_t* Hh; int ldh; float hscale; const float* rs; const float* cm;
    __device__ __forceinline__ void operator()(const f32x4 (&acc)[2][2][4][2], const Unit& u, int wr, int wc, int fr, int fq) const {
        const int row0 = u.pm * BM + wr * 64 + fr, col0 = u.pn * HALF + wc * 32 + 8 * fq, wrow0 = u.pn * BM + wc * 32 + 8 * fq;
        f32x4 cg[2], cu[2];
#pragma unroll
        for (int n = 0; n < 2; ++n) { cg[n] = *(const f32x4*)(cm + wrow0 + 4 * n) * (1.0f / 127.0f); cu[n] = *(const f32x4*)(cm + wrow0 + HALF + 4 * n) * (1.0f / 127.0f); }
#pragma unroll
        for (int ai = 0; ai < 2; ++ai)
#pragma unroll
            for (int m = 0; m < 4; ++m) { const int r = row0 + ai * HALF + m * 16; const float rsc = rs[r]; bf16_t* rowp = Hh + (size_t)r * ldh + col0; float hv[8];
#pragma unroll
                for (int n = 0; n < 2; ++n) { const v4i32 ig = __builtin_bit_cast(v4i32, acc[ai][0][m][n]), iu = __builtin_bit_cast(v4i32, acc[ai][1][m][n]);
#pragma unroll
                    for (int j = 0; j < 4; ++j) { const float g = (float)ig[j] * rsc * cg[n][j], up = (float)iu[j] * rsc * cu[n][j]; hv[n * 4 + j] = g * sigmoidf_fast(g) * up; } }
                if (hscale != 0.f) { u32x2 w8; w8.x = pk4_fp8(hv[0] * hscale, hv[1] * hscale, hv[2] * hscale, hv[3] * hscale); w8.y = pk4_fp8(hv[4] * hscale, hv[5] * hscale, hv[6] * hscale, hv[7] * hscale);
                    *(u32x2*)((unsigned char*)Hh + (size_t)r * ldh + col0) = w8; }
                else { u32x4 w; w.x = cvt_pk_bf16(hv[0], hv[1]); w.y = cvt_pk_bf16(hv[2], hv[3]); w.z = cvt_pk_bf16(hv[4], hv[5]); w.w = cvt_pk_bf16(hv[6], hv[7]);
                    *(u32x4*)rowp = w; } }
    }
};
template <class Epi, class Sched, bool ALIGN_EPI = false, bool SP2 = false, bool FP8 = false, bool INT8 = false>
__device__ __forceinline__ void gemm_phase(PG8_LAS unsigned char* lds, const Gemm g, const Sched& S, const Epi& E) {
    int tid_ = threadIdx.x; asm volatile("" : "+v"(tid_));
    const int tid = tid_, wid = __builtin_amdgcn_readfirstlane(tid >> 6), lane = tid & 63, wr = wid >> 2, wc = wid & 3, fr = lane & 15, fq = lane >> 4;
    const int K = g.K, nt = K / BK;
    unsigned voffA[2], voffB[2];
#pragma unroll
    for (int i = 0; i < 2; ++i) { int R, C; if constexpr (FP8) stage_rc8(tid * 16 + i * 8192, R, C); else stage_rc(tid * 16 + i * 8192, R, C); const int Rb = Epi::PERM ? ((R & ~31) + perm32(R & 31)) : R;
        voffA[i] = (unsigned)(R * K + C) * 2u; voffB[i] = (unsigned)(Rb * K + C) * 2u; }
    const size_t r64step = (size_t)64 * K * 2;
    const size_t kstep = (size_t)(BK * 2);
    const size_t hstep = (size_t)HALF * K * 2;
    const size_t tstep = 2 * hstep;
    const unsigned ldsw = (unsigned)wid * 1024u;
    const int aoff = FP8 ? lds_byte8(wr * 64 + fr, 2 * fq) : lds_byte(wr * 64 + fr, fq * 8), boff = FP8 ? lds_byte8(wc * 32 + fr, 2 * fq) : lds_byte(wc * 32 + fr, fq * 8);
    const int aoff1 = FP8 ? lds_byte8(wr * 64 + fr, 2 * fq + 1) : 0, boff1 = FP8 ? lds_byte8(wc * 32 + fr, 2 * fq + 1) : 0;
#define PG8_SA(b, h) (((b) * 2 + (h)) * HTB)
#define PG8_SB(b, h) ((4 + (b) * 2 + (h)) * HTB)
#define PG8_STAGE(bufoff, gbase, voff) do { _Pragma("unroll") for (int _i = 0; _i < 2; ++_i) { const char* _gb = (const char*)(gbase) + (size_t)_i * r64step; asm volatile("" : "+s"(_gb));     \
        __builtin_amdgcn_global_load_lds((const unsigned*)(_gb + (voff)[0]), (PG8_LAS unsigned*)(lds + (bufoff) + ldsw + _i * 8192), 16, 0, 0); } } while (0)
#define PG8_LD8(p_, q_) __builtin_shufflevector(*(const PG8_LAS v4i32*)(p_), *(const PG8_LAS v4i32*)(q_), 0, 1, 2, 3, 4, 5, 6, 7)
#define PG8_LDA(dst, b, h) do { if constexpr (FP8) { _Pragma("unroll") for (int m = 0; m < 4; ++m) dst##8[m] = PG8_LD8(lds + PG8_SA(b, h) + aoff + m * 2048, lds + PG8_SA(b, h) + aoff1 + m * 2048); } \
        else { _Pragma("unroll") for (int m = 0; m < 4; ++m) _Pragma("unroll") for (int k = 0; k < 2; ++k) dst[m][k] = *(const PG8_LAS bf16x8*)(lds + PG8_SA(b, h) + aoff + m * 2048 + k * 1024); } } while (0)
#define PG8_LDB(dst, b, h) do { if constexpr (FP8) { _Pragma("unroll") for (int n = 0; n < 2; ++n) dst##8[n] = PG8_LD8(lds + PG8_SB(b, h) + boff + n * 2048, lds + PG8_SB(b, h) + boff1 + n * 2048); } \
        else { _Pragma("unroll") for (int n = 0; n < 2; ++n) _Pragma("unroll") for (int k = 0; k < 2; ++k) dst[n][k] = *(const PG8_LAS bf16x8*)(lds + PG8_SB(b, h) + boff + n * 2048 + k * 1024); } } while (0)
#define PG8_MMA(ai, bj, At, Bt) do { __builtin_amdgcn_s_setprio(1); if constexpr (FP8) { _Pragma("unroll") for (int m = 0; m < 4; ++m) _Pragma("unroll") for (int n = 0; n < 2; ++n) \
            acc[ai][bj][m][n] = __builtin_amdgcn_mfma_scale_f32_16x16x128_f8f6f4(Bt##8[n], At##8[m], acc[ai][bj][m][n], 0, 0, 0, g.sw, 0, g.sx); } \
        else if constexpr (INT8) { _Pragma("unroll") for (int m = 0; m < 4; ++m) _Pragma("unroll") for (int n = 0; n < 2; ++n) _Pragma("unroll") for (int k = 0; k < 2; ++k) \
        acc[ai][bj][m][n] = __builtin_bit_cast(f32x4, __builtin_amdgcn_mfma_i32_16x16x64_i8(__builtin_bit_cast(v4i32, Bt[n][k]), __builtin_bit_cast(v4i32, At[m][k]), __builtin_bit_cast(v4i32, acc[ai][bj][m][n]), 0, 0, 0)); }   \
        else { _Pragma("unroll") for (int m = 0; m < 4; ++m) _Pragma("unroll") for (int n = 0; n < 2; ++n) _Pragma("unroll") for (int k = 0; k < 2; ++k) \
        acc[ai][bj][m][n] = __builtin_amdgcn_mfma_f32_16x16x32_bf16(Bt[n][k], At[m][k], acc[ai][bj][m][n], 0, 0, 0); } __builtin_amdgcn_s_setprio(0); } while (0)
#define PG8_WAIT_V(n) asm volatile("s_waitcnt vmcnt(" #n ")" ::: "memory")
#define PG8_WAIT_L(n) asm volatile("s_waitcnt lgkmcnt(" #n ")" ::: "memory")
#define PG8_BAR __builtin_amdgcn_s_barrier()
#define PG8_SCHED __builtin_amdgcn_sched_barrier(0)
    Unit cur, nxt; int ui = 0;
    if (!S.next(0, cur)) return;
    f32x4 acc[2][2][4][2];
#pragma unroll
    for (int a = 0; a < 2; ++a)
#pragma unroll
        for (int b = 0; b < 2; ++b)
#pragma unroll
            for (int m = 0; m < 4; ++m)
#pragma unroll
                for (int n = 0; n < 2; ++n) acc[a][b][m][n] = (f32x4){0.f, 0.f, 0.f, 0.f};
    bf16x8 At[4][2], B0[2][2], B1[2][2]; v8i32 At8[4], B08[2], B18[2];
    const char* cA = (const char*)g.A + (size_t)cur.pm * tstep; const char* cB = (const char*)g.Bt + (size_t)cur.pn * tstep;
    S.a_ready(cur);
    if constexpr (SP2) {
        PG8_STAGE(PG8_SB(0, 0), cB, voffB); PG8_STAGE(PG8_SB(0, 1), cB + hstep, voffB); PG8_STAGE(PG8_SA(0, 0), cA, voffA); PG8_STAGE(PG8_SA(0, 1), cA + hstep, voffA);
        if (wr == 1) PG8_BAR;
        PG8_WAIT_V(2); PG8_BAR;
        PG8_STAGE(PG8_SB(1, 0), cB + kstep, voffB); PG8_STAGE(PG8_SA(1, 0), cA + kstep, voffA); PG8_STAGE(PG8_SB(1, 1), cB + hstep + kstep, voffB);
        PG8_WAIT_V(6); PG8_BAR;
    } else {
        PG8_STAGE(PG8_SB(0, 0), cB, voffB); PG8_STAGE(PG8_SA(0, 0), cA, voffA); PG8_STAGE(PG8_SB(0, 1), cB + hstep, voffB); PG8_STAGE(PG8_SA(0, 1), cA + hstep, voffA);
        if (wr == 1) PG8_BAR;
        PG8_WAIT_V(4); PG8_BAR;
        PG8_STAGE(PG8_SB(1, 0), cB + kstep, voffB); PG8_STAGE(PG8_SA(1, 0), cA + kstep, voffA); PG8_STAGE(PG8_SB(1, 1), cB + hstep + kstep, voffB);
        PG8_WAIT_V(6); PG8_BAR;
    }
    for (;;) {
        const bool has_next = S.next(ui + 1, nxt);
        const char* nA = has_next ? (const char*)g.A + (size_t)nxt.pm * tstep : cA; const char* nB = has_next ? (const char*)g.Bt + (size_t)nxt.pn * tstep : cB;
        for (int t = 0; t < nt; t += 2) {
            const bool last = (t == nt - 2);
            const char* a1 = cA + (size_t)(t + 1) * kstep;
            const char* a2 = last ? nA : cA + (size_t)(t + 2) * kstep; const char* b2 = last ? nB : cB + (size_t)(t + 2) * kstep;
            const char* a3 = a2 + kstep; const char* b3 = b2 + kstep;
            if (last && has_next) S.a_ready(nxt);
            if constexpr (SP2) {
            PG8_LDB(B0, 0, 0); PG8_LDB(B1, 0, 1); PG8_SCHED; PG8_LDA(At, 0, 0); PG8_STAGE(PG8_SA(1, 1), a1 + hstep, voffA);
            PG8_WAIT_V(8); PG8_WAIT_L(0); PG8_BAR; PG8_MMA(0, 0, At, B0); PG8_MMA(0, 1, At, B1); PG8_BAR; PG8_SCHED;
            PG8_LDA(At, 0, 1); PG8_STAGE(PG8_SB(0, 0), b2, voffB); PG8_STAGE(PG8_SB(0, 1), b2 + hstep, voffB); PG8_STAGE(PG8_SA(0, 0), a2, voffA);
            PG8_WAIT_V(8); PG8_WAIT_L(0); PG8_BAR; PG8_MMA(1, 0, At, B0); PG8_MMA(1, 1, At, B1); PG8_BAR; PG8_SCHED;
            PG8_LDB(B0, 1, 0); PG8_LDB(B1, 1, 1); PG8_SCHED; PG8_LDA(At, 1, 0); PG8_STAGE(PG8_SA(0, 1), a2 + hstep, voffA);
            PG8_WAIT_V(8); PG8_WAIT_L(0); PG8_BAR; PG8_MMA(0, 0, At, B0); PG8_MMA(0, 1, At, B1); PG8_BAR; PG8_SCHED;
            PG8_LDA(At, 1, 1); PG8_STAGE(PG8_SB(1, 0), b3, voffB); PG8_STAGE(PG8_SB(1, 1), b3 + hstep, voffB); PG8_STAGE(PG8_SA(1, 0), a3, voffA);
            PG8_WAIT_V(8); PG8_WAIT_L(0); PG8_BAR; PG8_MMA(1, 0, At, B0); PG8_MMA(1, 1, At, B1); PG8_BAR; PG8_SCHED;
            } else {
            PG8_LDB(B0, 0, 0); PG8_SCHED; PG8_LDA(At, 0, 0); PG8_STAGE(PG8_SA(1, 1), a1 + hstep, voffA);
            PG8_WAIT_L(8); PG8_BAR; PG8_WAIT_L(0); PG8_MMA(0, 0, At, B0); PG8_BAR; PG8_SCHED;
            PG8_LDB(B1, 0, 1); PG8_STAGE(PG8_SB(0, 0), b2, voffB);
            PG8_BAR; PG8_WAIT_L(0); PG8_MMA(0, 1, At, B1); PG8_BAR;
            PG8_LDA(At, 0, 1); PG8_STAGE(PG8_SA(0, 0), a2, voffA);
            PG8_BAR; PG8_WAIT_L(0); PG8_MMA(1, 0, At, B0); PG8_BAR; PG8_SCHED;
            PG8_STAGE(PG8_SB(0, 1), b2 + hstep, voffB);
            PG8_WAIT_V(6); PG8_BAR; PG8_MMA(1, 1, At, B1); PG8_BAR;
            PG8_LDB(B0, 1, 0); PG8_SCHED; PG8_LDA(At, 1, 0); PG8_STAGE(PG8_SA(0, 1), a2 + hstep, voffA);
            PG8_WAIT_L(8); PG8_BAR; PG8_WAIT_L(0); PG8_MMA(0, 0, At, B0); PG8_BAR; PG8_SCHED;
            PG8_LDB(B1, 1, 1); PG8_STAGE(PG8_SB(1, 0), b3, voffB);
            PG8_BAR; PG8_WAIT_L(0); PG8_MMA(0, 1, At, B1); PG8_BAR;
            PG8_LDA(At, 1, 1); PG8_STAGE(PG8_SA(1, 0), a3, voffA);
            PG8_BAR; PG8_WAIT_L(0); PG8_MMA(1, 0, At, B0); PG8_BAR; PG8_SCHED;
            PG8_STAGE(PG8_SB(1, 1), b3 + hstep, voffB);
            PG8_WAIT_V(6); PG8_BAR; PG8_MMA(1, 1, At, B1); PG8_BAR;
            }
        }
        if constexpr (ALIGN_EPI) { if (wr == 0) PG8_BAR; }
        if constexpr (!Epi::AFTER_DRAIN) { int t2_ = threadIdx.x; asm volatile("" : "+v"(t2_)); const int fr_ = t2_ & 15, fq_ = (t2_ & 63) >> 4;
            E(acc, cur, wr, wc, fr_, fq_); S.done(cur); }
        if (!has_next) break;
#pragma unroll
        for (int a = 0; a < 2; ++a)
#pragma unroll
            for (int b = 0; b < 2; ++b)
#pragma unroll
                for (int m = 0; m < 4; ++m)
#pragma unroll
                    for (int n = 0; n < 2; ++n) acc[a][b][m][n] = (f32x4){0.f, 0.f, 0.f, 0.f};
        cur = nxt; cA = nA; cB = nB; ++ui;
        if constexpr (ALIGN_EPI) { if (wr == 1) PG8_BAR; }
    }
    PG8_WAIT_V(0);
    if constexpr (!ALIGN_EPI) { if (wr == 0) PG8_BAR; }
    PG8_BAR;
    if constexpr (Epi::AFTER_DRAIN) { E.fused(acc, cur, wr, wc, fr, fq, lds, wid, lane); S.done(cur); }
#undef PG8_SA
#undef PG8_SB
#undef PG8_STAGE
#undef PG8_LD8
#undef PG8_LDA
#undef PG8_LDB
#undef PG8_MMA
#undef PG8_WAIT_V
#undef PG8_WAIT_L
#undef PG8_BAR
#undef PG8_SCHED
}
}

#ifndef FP8_DOWN_LAYER
#define FP8_DOWN_LAYER 0
#endif
#ifndef PROBE_MASK
#define PROBE_MASK 0
#endif
#ifndef EN_INPROJ
#define EN_INPROJ 1
#endif
#ifndef EN_GATE
#define EN_GATE 1
#endif
#ifndef EN_RESID
#define EN_RESID 1
#endif
#ifndef EN_SWIGLU
#define EN_SWIGLU 1
#endif
#ifndef EN_ATTN
#define EN_ATTN 1
#endif
#ifndef EN_PRO
#define EN_PRO 1
#endif
#define LAS __attribute__((address_space(3)))
typedef unsigned short bf16;
typedef short bf16x8 __attribute__((ext_vector_type(8)));
typedef short s16x4 __attribute__((ext_vector_type(4)));
typedef float f32x4 __attribute__((ext_vector_type(4)));
typedef float f32x16 __attribute__((ext_vector_type(16)));
typedef unsigned u32x4 __attribute__((ext_vector_type(4)));
typedef unsigned u32x2 __attribute__((ext_vector_type(2)));

constexpr int T = 32768, TH = 16384, D = 2048, CIN = 10240, DFF = 5632, NUP = 11264, SEQ = 16384;
constexpr int NWAVES = 8, NTHREADS = 512;
constexpr float ALPHA = 1.41421356237309515f;
constexpr float LN_EPS = 1e-5f;
constexpr float LOG2E = 1.4426950408889634f;
constexpr int LDS_BYTES = 163840, LDS_BARST = 163824;
constexpr int NPHASES = 27;

constexpr size_t MiB = (size_t)1 << 20;
constexpr size_t WS_TAB = 0;
constexpr size_t WS_BAR = 256 * 1024;
constexpr size_t WS_CMAX = 512 * 1024;
constexpr size_t WS_CMAXI = WS_CMAX + 2 * 11264 * 4;
constexpr size_t WS_W0 = 1 * MiB, WS_WL = 120 * MiB;
constexpr size_t WO_IN = 0, WO_PA = WO_IN + (size_t)CIN * D, WO_PB = WO_PA + (size_t)D * 512, WO_OUT = WO_PB + (size_t)D * 1024, WO_UP = WO_OUT + (size_t)D * D,
                 WO_DN = WO_UP + (size_t)NUP * D, WO_END = WO_DN + (size_t)D * DFF;
static_assert(WO_END * 2 <= WS_WL, "weight block");
constexpr size_t WS_XB = 241 * MiB;
constexpr size_t WS_PROJ = 369 * MiB;
constexpr size_t WS_AR = 689 * MiB;
constexpr size_t WS_LSE = 737 * MiB;
constexpr size_t WS_AO = 738 * MiB;
constexpr size_t WS_BO = 754 * MiB;
constexpr size_t WS_H = 369 * MiB;
constexpr size_t WS_X8 = 800 * MiB;
constexpr size_t WS_ST = 864 * MiB;
constexpr size_t WS_RS = 864 * MiB + 512 * 1024;
constexpr size_t WS_G8 = 866 * MiB;
constexpr size_t WS_END = 930 * MiB;

struct Params;
typedef const __attribute__((address_space(4))) Params* PP;
struct Params {
    const float* x; const float* rel_bias; const float* w_in; const float* sink; const float* w_pa; const float* w_pb; const float* w_out;
    const float* ln1_g; const float* ln1_b; const float* w_up; const float* w_down; const float* ln2_g; const float* ln2_b;
    float* out; unsigned char* ws; int ph_lo, ph_hi;
};

__device__ __forceinline__ unsigned pk2(float a, float b) { return pg8::cvt_pk_bf16(a, b); }
__device__ __forceinline__ float shx(float v, int o, int lane) { return __int_as_float(__builtin_amdgcn_ds_bpermute((lane ^ o) << 2, __float_as_int(v))); }
__device__ __forceinline__ float wave_sum(float v, int lane) {
#pragma unroll
    for (int o = 1; o < 64; o <<= 1) v += shx(v, o, lane);
    return v;
}
#define LDS_WAIT() asm volatile("s_waitcnt lgkmcnt(0)" ::: "memory")

#define XB_TMO      128
#define XB_XCNT(j)  (256  + 64 * (j))
#define XB_XSUB(j)  (1280 + 64 * (j))
#define XB_XGEN(j)  (2304 + 64 * (j))
#define XB_TOP      3328
#define XB_TOPGEN   3392
#define XCD_BAR_WORDS 3456
#define XB_SPIN_CAP (1u << 18)

__device__ __forceinline__ unsigned xb_ld(unsigned* p)              { return __hip_atomic_load(p, __ATOMIC_RELAXED, __HIP_MEMORY_SCOPE_AGENT); }
__device__ __forceinline__ unsigned xb_add(unsigned* p, unsigned v) { return __hip_atomic_fetch_add(p, v, __ATOMIC_RELAXED, __HIP_MEMORY_SCOPE_AGENT); }
__device__ __forceinline__ unsigned xb_xcc_id() { return (unsigned)__builtin_amdgcn_s_getreg((3 << 11) | 20) & 0xFu; }
#define XB_SPIN(cond, bar) do { unsigned _sp = 0; while (cond) { __builtin_amdgcn_s_sleep(1); \
    if ((++_sp & 255u) == 0u) { if (xb_ld(&(bar)[XB_TMO])) break; if (_sp > XB_SPIN_CAP) { atomicAdd(&(bar)[XB_TMO], 1u); break; } } } } while (0)

struct XcdBarrier {
    unsigned* bar; unsigned x;
    volatile LAS unsigned* st;
};

__device__ __forceinline__ XcdBarrier xcd_barrier_post(unsigned* bar, volatile LAS unsigned* st) {
    XcdBarrier b; b.bar = bar; b.x = xb_xcc_id(); b.st = st;
    if (threadIdx.x == 0) (void)xb_add(&bar[XB_XCNT(b.x)], 1u);
    return b;
}
__device__ __forceinline__ void xcd_barrier_complete(unsigned* bar, unsigned x, unsigned& nloc, unsigned& nx) {
    const unsigned G = gridDim.x * gridDim.y * gridDim.z;
    unsigned sum, cnt, mine, sp = 0u;
    for (;;) {
        sum = 0u; cnt = 0u; mine = 0u;
#pragma unroll
        for (unsigned j = 0; j < 16; ++j) { const unsigned c = xb_ld(&bar[XB_XCNT(j)]); sum += c; cnt += (c > 0u) ? 1u : 0u; mine = (j == x) ? c : mine; }
        if (sum == G) break;
        __builtin_amdgcn_s_sleep(1);
        if ((++sp & 255u) == 0u) { if (xb_ld(&bar[XB_TMO])) break; if (sp > XB_SPIN_CAP) { atomicAdd(&bar[XB_TMO], 1u); break; } }
    }
    nloc = mine > 0u ? mine : 1u; nx = cnt > 0u ? cnt : 1u;
}

__device__ __forceinline__ void xcd_barrier(const XcdBarrier& b) {
    asm volatile("s_waitcnt vmcnt(0)" ::: "memory");
    __syncthreads();
    if (threadIdx.x == 0) {
        unsigned* bar = b.bar;
        __builtin_amdgcn_s_waitcnt(0);
        unsigned nloc = b.st[0], nx = b.st[1];
        if (nloc == 0u) { xcd_barrier_complete(bar, b.x, nloc, nx); b.st[0] = nloc; b.st[1] = nx; }
        const unsigned old = xb_add(&bar[XB_XSUB(b.x)], 1u);
        const unsigned gen = old / nloc;
        if (old + 1u == (gen + 1u) * nloc) {
            __builtin_amdgcn_fence(__ATOMIC_RELEASE, "agent");
            asm volatile("s_waitcnt vmcnt(0)" ::: "memory");
            const unsigned og = xb_add(&bar[XB_TOP], 1u);
            const unsigned tg = og / nx;
            if (og + 1u == (tg + 1u) * nx) xb_add(&bar[XB_TOPGEN], 1u);
            else XB_SPIN(xb_ld(&bar[XB_TOPGEN]) == tg, bar);
            __builtin_amdgcn_fence(__ATOMIC_ACQUIRE, "agent");
            xb_add(&bar[XB_XGEN(b.x)], 1u);
            asm volatile("s_waitcnt vmcnt(0)" ::: "memory");
        } else {
            XB_SPIN(xb_ld(&bar[XB_XGEN(b.x)]) == gen, bar);
            __builtin_amdgcn_fence(__ATOMIC_ACQUIRE, "agent");
            asm volatile("s_waitcnt vmcnt(0)" ::: "memory");
        }
    }
    __syncthreads();
}


__device__ __forceinline__ void transpose_item(const float* __restrict__ W, int K, int N, bf16* WT, int k0, int n0, int row0, LAS float* scr, int lane) {
    { f32x4 tv[8];
#pragma unroll
      for (int i = 0; i < 8; ++i) tv[i] = *(const f32x4*)(W + (size_t)(k0 + 8 * i + (lane >> 3)) * N + n0 + 4 * (lane & 7));
#pragma unroll
      for (int i = 0; i < 8; ++i) { LAS float* d_ = scr + (8 * i + (lane >> 3)) * 33 + 4 * (lane & 7); d_[0] = tv[i][0]; d_[1] = tv[i][1]; d_[2] = tv[i][2]; d_[3] = tv[i][3]; } }
    LDS_WAIT();
    const int c = lane & 7;
#pragma unroll
    for (int j = 0; j < 4; ++j) { const int n = (lane >> 3) + 8 * j; const LAS float* s = scr + (8 * c) * 33 + n;
        u32x4 o; o.x = pk2(s[0 * 33], s[1 * 33]); o.y = pk2(s[2 * 33], s[3 * 33]); o.z = pk2(s[4 * 33], s[5 * 33]); o.w = pk2(s[6 * 33], s[7 * 33]);
        *(u32x4*)(WT + (size_t)(row0 + n) * K + k0 + 8 * c) = o; }
    LDS_WAIT();
}
using pg8::pk4_fp8;
__device__ __forceinline__ void transpose_item_fp8(const float* __restrict__ W, int K, int N, unsigned char* WT, int k0, int n0, LAS float* scr, int lane, float scale) {
    { f32x4 tv[8];
#pragma unroll
      for (int i = 0; i < 8; ++i) tv[i] = *(const f32x4*)(W + (size_t)(k0 + 8 * i + (lane >> 3)) * N + n0 + 4 * (lane & 7));
#pragma unroll
      for (int i = 0; i < 8; ++i) { LAS float* d_ = scr + (8 * i + (lane >> 3)) * 33 + 4 * (lane & 7); d_[0] = tv[i][0]; d_[1] = tv[i][1]; d_[2] = tv[i][2]; d_[3] = tv[i][3]; } }
    LDS_WAIT();
    const int n = lane >> 1, kh = lane & 1; const LAS float* sp = scr + (32 * kh) * 33 + n;
    u32x4 o0, o1;
    o0.x = pk4_fp8(sp[0 * 33] * scale, sp[1 * 33] * scale, sp[2 * 33] * scale, sp[3 * 33] * scale); o0.y = pk4_fp8(sp[4 * 33] * scale, sp[5 * 33] * scale, sp[6 * 33] * scale, sp[7 * 33] * scale);
    o0.z = pk4_fp8(sp[8 * 33] * scale, sp[9 * 33] * scale, sp[10 * 33] * scale, sp[11 * 33] * scale); o0.w = pk4_fp8(sp[12 * 33] * scale, sp[13 * 33] * scale, sp[14 * 33] * scale, sp[15 * 33] * scale);
    o1.x = pk4_fp8(sp[16 * 33] * scale, sp[17 * 33] * scale, sp[18 * 33] * scale, sp[19 * 33] * scale); o1.y = pk4_fp8(sp[20 * 33] * scale, sp[21 * 33] * scale, sp[22 * 33] * scale, sp[23 * 33] * scale);
    o1.z = pk4_fp8(sp[24 * 33] * scale, sp[25 * 33] * scale, sp[26 * 33] * scale, sp[27 * 33] * scale); o1.w = pk4_fp8(sp[28 * 33] * scale, sp[29 * 33] * scale, sp[30 * 33] * scale, sp[31 * 33] * scale);
    unsigned char* dst = WT + (size_t)(n0 + n) * K + k0 + 32 * kh;
    *(u32x4*)dst = o0; *(u32x4*)(dst + 16) = o1;
    LDS_WAIT();
}
__device__ __forceinline__ int t5_bucket(int rel) {
    const int n = rel < 0 ? -rel : rel; int b;
    if (n < 8) b = n; else { const int e = (int)(__builtin_log2f((float)n * 0.125f) * (8.0f / 7.0f)); b = 8 + e; if (b > 15) b = 15; }
    return b + (rel > 0 ? 16 : 0);
}
__device__ __forceinline__ void phase_prologue(PP pp, LAS unsigned char* lds, int gw, int NGW, int wave, int lane) {
    LAS float* scr = (LAS float*)(lds + wave * 16384);
    {
        const int vcu_ = gw / NWAVES, G_ = NGW / NWAVES;
        constexpr int CB_UP = NUP / 32, CB_IN = 0, CB_L = CB_UP + CB_IN;
        LAS float* cmt = (LAS float*)(lds + 135168);
        for (int cb = vcu_; cb < 2 * CB_L; cb += G_) {
            const int l = cb / CB_L; int r = cb - l * CB_L; const bool win = r >= CB_UP; if (win) r -= CB_UP;
            const int N = win ? CIN : NUP, n0 = 32 * r;
            const int j0 = n0 < DFF ? n0 : n0 - DFF, row0 = win ? n0 : (j0 >> 7) * 256 + (n0 < DFF ? 0 : 128) + (j0 & 127);
            const float* W = win ? pp->w_in + (size_t)l * D * CIN : pp->w_up + (size_t)l * D * NUP;
            unsigned char* WT = (unsigned char*)((bf16*)(pp->ws + WS_W0 + (size_t)l * WS_WL) + (win ? WO_IN : WO_UP));
            float* cmg = win ? (float*)(pp->ws + WS_CMAXI) + l * CIN + row0 : (float*)(pp->ws + WS_CMAX) + l * NUP + row0;
            f32x4 tv[4][8]; f32x4 mx = {0.f, 0.f, 0.f, 0.f};
#pragma unroll
            for (int q = 0; q < 4; ++q)
#pragma unroll
                for (int i = 0; i < 8; ++i) tv[q][i] = *(const f32x4*)(W + (size_t)((wave * 4 + q) * 64 + 8 * i + (lane >> 3)) * N + n0 + 4 * (lane & 7));
#pragma unroll
            for (int q = 0; q < 4; ++q)
#pragma unroll
                for (int i = 0; i < 8; ++i) { mx[0] = fmaxf(mx[0], fabsf(tv[q][i][0])); mx[1] = fmaxf(mx[1], fabsf(tv[q][i][1])); mx[2] = fmaxf(mx[2], fabsf(tv[q][i][2])); mx[3] = fmaxf(mx[3], fabsf(tv[q][i][3])); }
#pragma unroll
            for (int o = 8; o < 64; o <<= 1) { mx[0] = fmaxf(mx[0], shx(mx[0], o, lane)); mx[1] = fmaxf(mx[1], shx(mx[1], o, lane)); mx[2] = fmaxf(mx[2], shx(mx[2], o, lane)); mx[3] = fmaxf(mx[3], shx(mx[3], o, lane)); }
            if (lane < 8) *(LAS f32x4*)(cmt + wave * 32 + 4 * lane) = mx;
            __syncthreads();
            f32x4 cm = *(const LAS f32x4*)(cmt + 4 * (lane & 7));
#pragma unroll
            for (int w2 = 1; w2 < 8; ++w2) { const f32x4 t = *(const LAS f32x4*)(cmt + w2 * 32 + 4 * (lane & 7)); cm[0] = fmaxf(cm[0], t[0]); cm[1] = fmaxf(cm[1], t[1]); cm[2] = fmaxf(cm[2], t[2]); cm[3] = fmaxf(cm[3], t[3]); }
            if (wave == 0 && lane < 8) *(f32x4*)(cmg + 4 * lane) = cm;
            f32x4 inv;
#pragma unroll
            for (int j = 0; j < 4; ++j) inv[j] = cm[j] > 0.f ? 127.0f / cm[j] : 0.f;
#pragma unroll
            for (int q = 0; q < 4; ++q) {
                const int k0 = (wave * 4 + q) * 64;
#pragma unroll
                for (int i = 0; i < 8; ++i) { LAS float* d_ = scr + (8 * i + (lane >> 3)) * 33 + 4 * (lane & 7); d_[0] = tv[q][i][0] * inv[0]; d_[1] = tv[q][i][1] * inv[1]; d_[2] = tv[q][i][2] * inv[2]; d_[3] = tv[q][i][3] * inv[3]; }
                LDS_WAIT();
                const int n = lane >> 1, kh = lane & 1; const LAS float* sp = scr + (32 * kh) * 33 + n;
                unsigned w[8];
#pragma unroll
                for (int u = 0; u < 8; ++u) { const int a = (int)__builtin_rintf(sp[(4 * u) * 33]), b = (int)__builtin_rintf(sp[(4 * u + 1) * 33]), c = (int)__builtin_rintf(sp[(4 * u + 2) * 33]), d = (int)__builtin_rintf(sp[(4 * u + 3) * 33]);
                    w[u] = ((unsigned)a & 255u) | (((unsigned)b & 255u) << 8) | (((unsigned)c & 255u) << 16) | ((unsigned)d << 24); }
                unsigned char* dst = WT + (size_t)(row0 + n) * D + k0 + 32 * kh;
                u32x4 o0, o1; o0.x = w[0]; o0.y = w[1]; o0.z = w[2]; o0.w = w[3]; o1.x = w[4]; o1.y = w[5]; o1.z = w[6]; o1.w = w[7];
                *(u32x4*)dst = o0; *(u32x4*)(dst + 16) = o1;
                LDS_WAIT();
            }
            __syncthreads();
        }
    }
    constexpr int I_IN = (D / 64) * (CIN / 32), I_PA = (512 / 64) * (D / 32), I_PB = (1024 / 64) * (D / 32), I_OUT = (D / 64) * (D / 32), I_UP = (D / 64) * (NUP / 32), I_DN = (DFF / 64) * (D / 32);
    constexpr int I_LAYER = I_IN + I_PA + I_PB + I_OUT + I_UP + I_DN;
    for (int it = gw; it < 2 * I_LAYER; it += NGW) {
        const int l = it / I_LAYER; int r = it - l * I_LAYER;
        bf16* wl = (bf16*)(pp->ws + WS_W0 + (size_t)l * WS_WL);
        const float* W; int K, N; bf16* WT; bool up = false, r0_in = false, dn8 = false;
        if (r < I_IN) { W = pp->w_in + (size_t)l * D * CIN; K = D; N = CIN; WT = wl + WO_IN; r0_in = true; }
        else if ((r -= I_IN) < I_PA) { r0_in = true; W = pp->w_pa + (size_t)l * 512 * D; K = 512; N = D; WT = wl + WO_PA; }
        else if ((r -= I_PA) < I_PB) { r0_in = true; W = pp->w_pb + (size_t)l * 1024 * D; K = 1024; N = D; WT = wl + WO_PB; }
        else if ((r -= I_PB) < I_OUT) { r0_in = true; W = pp->w_out + (size_t)l * D * D; K = D; N = D; WT = wl + WO_OUT; }
        else if ((r -= I_OUT) < I_UP) { W = pp->w_up + (size_t)l * D * NUP; K = D; N = NUP; WT = wl + WO_UP; up = true; }
        else { r -= I_UP; W = pp->w_down + (size_t)l * DFF * D; K = DFF; N = D; WT = wl + WO_DN; dn8 = (l == FP8_DOWN_LAYER); }
        const int nblk = N / 32, kb = r / nblk, nb = r - kb * nblk, n0 = 32 * nb;
        int row0 = n0;
        if (up) { const int j0 = n0 < DFF ? n0 : n0 - DFF; row0 = (j0 >> 7) * 256 + (n0 < DFF ? 0 : 128) + (j0 & 127); }
        if (r0_in) transpose_item_fp8(W, K, N, (unsigned char*)WT, 64 * kb, n0, scr, lane, 128.0f);
        else if (dn8) transpose_item_fp8(W, K, N, (unsigned char*)WT, 64 * kb, n0, scr, lane, 256.0f);
        else if (up) { }
        else transpose_item(W, K, N, WT, 64 * kb, n0, row0, scr, lane);
    }
    { const size_t gt = (size_t)gw * 64 + lane, NT = (size_t)NGW * 64; unsigned char* x8 = pp->ws + WS_X8;
      for (size_t i = gt; i < (size_t)T * D / 16; i += NT) { const f32x4 a = *(const f32x4*)(pp->x + i * 16) * 32.f, b = *(const f32x4*)(pp->x + i * 16 + 4) * 32.f, c = *(const f32x4*)(pp->x + i * 16 + 8) * 32.f, d = *(const f32x4*)(pp->x + i * 16 + 12) * 32.f;
          u32x4 o; o.x = pk4_fp8(a[0], a[1], a[2], a[3]); o.y = pk4_fp8(b[0], b[1], b[2], b[3]); o.z = pk4_fp8(c[0], c[1], c[2], c[3]); o.w = pk4_fp8(d[0], d[1], d[2], d[3]); *(u32x4*)(x8 + i * 16) = o; } }
    if (blockIdx.x == 0) { unsigned* barw = (unsigned*)(pp->ws + WS_BAR); for (int i = threadIdx.x; i < XCD_BAR_WORDS; i += NTHREADS) barw[i] = 0u; }
    { float* tabA = (float*)(pp->ws + WS_TAB); float* tabB = (float*)(pp->ws + WS_TAB + 8192);
      const int gt = gw * 64 + lane;
      if (gt < 12 * 129) { const int hh = gt / 129, i = gt - hh * 129, g = hh >> 2, dil = g == 0 ? 1 : (g == 1 ? 4 : 16); tabA[hh * 132 + i] = pp->rel_bias[t5_bucket((i - 64) * dil) * 20 + hh] * LOG2E; }
      else if (gt < 12 * 129 + 8 * 257) { const int q = gt - 12 * 129, hh = q / 257, i = q - hh * 257; tabB[hh * 260 + i] = pp->rel_bias[t5_bucket(i - 128) * 20 + 12 + hh] * LOG2E; } }
}

constexpr int AT_KS = 0, AT_VS = 8704, AT_TAB = 8704 + 10240, AT_WAVE_BYTES = 8704 + 10240 + 1296;
static_assert(AT_WAVE_BYTES * NWAVES <= LDS_BYTES, "attention LDS");
#define TR4(r0, r1, r2, r3, base, o0, o1, o2, o3) asm volatile("ds_read_b64_tr_b16 %0, %4 offset:%5\n\tds_read_b64_tr_b16 %1, %4 offset:%6\n\tds_read_b64_tr_b16 %2, %4 offset:%7\n\tds_read_b64_tr_b16 %3, %4 offset:%8\n\ts_waitcnt lgkmcnt(0)" \
    : "=&v"(r0), "=&v"(r1), "=&v"(r2), "=&v"(r3) : "v"(base), "i"(o0), "i"(o1), "i"(o2), "i"(o3) : "memory")
#define PK8(L, Hh) (bf16x8){L[0], L[1], L[2], L[3], Hh[0], Hh[1], Hh[2], Hh[3]}

struct AtItem { int qcol, kcol, vcol, r, dil, sub_len, q0, W, nkt, T0, toff, NT, o_ld, ocol, lse_idx, o8; const float* tab; float m0; int sink; unsigned char* O; float* lse; };
constexpr int AT_NA = 12 * 64, AT_NB = 2 * 256;
__device__ __forceinline__ AtItem at_decode(int i, int wave, int layer, unsigned char* ws, const float* sinkp) {
    AtItem I; const float* tabA = (const float*)(ws + WS_TAB); const float* tabB = (const float*)(ws + WS_TAB + 8192);
    if (i < AT_NA) {
        const int hh = i >> 6, idx = i & 63, g = hh >> 2;
        I.dil = g == 0 ? 1 : (g == 1 ? 4 : 16); const int nbr = 64 / I.dil; I.r = idx / nbr; const int qb = idx - I.r * nbr; I.sub_len = SEQ / I.dil;
        I.q0 = qb * 256 + 32 * wave; I.T0 = qb * 256 - 64; I.toff = wave; I.NT = 12; I.nkt = 5; I.W = 64;
        I.qcol = hh * 128; I.kcol = 1536 + hh * 128; I.vcol = 3072 + hh * 128; I.tab = tabA + hh * 132; I.m0 = -1e30f; I.sink = 0;
        I.O = ws + WS_AR; I.o_ld = 1536; I.ocol = hh * 128; I.lse = (float*)(ws + WS_LSE); I.lse_idx = hh; I.o8 = 0;
    } else {
        const int b = i - AT_NA, kvh = b >> 8, qp = b & 255, j = wave >> 2, rep = wave & 3, qh = kvh * 4 + rep;
        I.dil = 1; I.r = 0; I.sub_len = SEQ; I.q0 = qp * 64 + 32 * j; I.T0 = qp * 64 - 128; I.toff = j; I.NT = 10; I.nkt = 9; I.W = 128;
        I.qcol = 4608 + qh * 128; I.kcol = 5632 + kvh * 128; I.vcol = 5888 + kvh * 128; I.tab = tabB + qh * 260; I.m0 = sinkp[layer * 8 + qh] * LOG2E; I.sink = 1;
        I.O = ws + WS_BO; I.o_ld = 1024; I.ocol = qh * 128; I.lse = nullptr; I.lse_idx = 0; I.o8 = 1;
    }
    return I;
}
__device__ __forceinline__ void phase_attention(unsigned char* ws, const float* sinkp, LAS unsigned char* lds, int layer, int vcu, int G, int wave, int lane) {
    const bf16* P = (const bf16*)(ws + WS_PROJ);
    const int hl = lane >> 5, ql = lane & 31, lrow = lane >> 4, lch = lane & 15;
    LAS float* tabs = (LAS float*)(lds + wave * AT_WAVE_BYTES + AT_TAB);
    const float c = 0.08838834764831845f * LOG2E;
    const unsigned vlane = (unsigned)((4 * hl + ((lane & 15) >> 2)) * 320 + (16 * ((lane >> 4) & 1) + 4 * (lane & 3)) * 2);
    const int klane = ql * 272 + 16 * hl;
    const int wrow = 4 * wave + lrow;
    bf16x8 qf[8]; u32x4 kreg[8], vreg[8], kn, vn; float tv[6];
#define AT_EDGE(I, kt_) ((I.q0 - I.W + 32 * (kt_) < 0) || (I.q0 - I.W + 32 * (kt_) + 31 >= I.sub_len))
#define AT_TOFF(I, t) ({ int sub = I.T0 + 32 * (t) + wrow; sub = sub < 0 ? 0 : (sub >= I.sub_len ? I.sub_len - 1 : sub); (unsigned)(I.r + sub * I.dil) * (unsigned)(CIN * 2) + 16u * lch; })
#define AT_FILL(I) do { const char* Pk = (const char*)(P + I.kcol); const char* Pv = (const char*)(P + I.vcol); \
        _Pragma("unroll") for (int t = 0; t < 8; ++t) { const unsigned o_ = AT_TOFF(I, t); kreg[t] = *(const u32x4*)(Pk + o_); vreg[t] = *(const u32x4*)(Pv + o_); } } while (0)
#define AT_WRITEFILL() do { _Pragma("unroll") for (int t = 0; t < 8; ++t) { *(LAS u32x4*)(lds + t * AT_WAVE_BYTES + AT_KS + wrow * 272 + 16 * lch) = kreg[t]; *(LAS u32x4*)(lds + t * AT_WAVE_BYTES + AT_VS + wrow * 320 + 16 * lch) = vreg[t]; } } while (0)
#define AT_LOADQ(I) do { const bf16* qp = P + (size_t)(I.r + (I.q0 + ql) * I.dil) * CIN + I.qcol + 8 * hl; _Pragma("unroll") for (int s = 0; s < 8; ++s) qf[s] = *(const bf16x8*)(qp + 16 * s); } while (0)
#define AT_LOADTAB(I) do { _Pragma("unroll") for (int u = 0; u < 6; ++u) { const int src = lane + 64 * u - 32; const int sc_ = src < 0 ? 0 : (src > 2 * I.W ? 2 * I.W : src); tv[u] = I.tab[sc_]; } } while (0)
#define AT_STORETAB(I) do { _Pragma("unroll") for (int u = 0; u < 6; ++u) { const int i_ = lane + 64 * u, src = i_ - 32; if (i_ < 2 * I.W + 65) tabs[i_] = (src >= 0 && src <= 2 * I.W) ? tv[u] : -__builtin_inff(); } } while (0)
    constexpr int NTOT = AT_NA + AT_NB;
    int it = vcu; if (it >= NTOT) return;
    AtItem cur = at_decode(it, wave, layer, ws, sinkp);
    AT_LOADTAB(cur); AT_LOADQ(cur); AT_FILL(cur); AT_STORETAB(cur); AT_WRITEFILL();
    __syncthreads();
    for (;;) {
        const int itn = it + G; const bool has_next = itn < NTOT;
        const AtItem nxt = at_decode(has_next ? itn : it, wave, layer, ws, sinkp);
        f32x16 o0, o1, o2, o3;
#pragma unroll
        for (int i = 0; i < 16; ++i) { o0[i] = 0.f; o1[i] = 0.f; o2[i] = 0.f; o3[i] = 0.f; }
        float m = cur.m0, l = (cur.sink && lane < 32) ? 1.f : 0.f;
        const int nkt = cur.nkt;
        for (int kt = 0; kt < nkt; ++kt) {
            const bool last = (kt == nkt - 1);
            const int tn = 8 + kt; const bool newt = tn < cur.NT;
            if (newt) { const unsigned o_ = AT_TOFF(cur, tn); kn = *(const u32x4*)((const char*)(P + cur.kcol) + o_); vn = *(const u32x4*)((const char*)(P + cur.vcol) + o_); }
            const int sl = (cur.toff + kt) & 7;
            const LAS unsigned char* kb = lds + sl * AT_WAVE_BYTES + AT_KS + klane;
            const unsigned vb = (unsigned)(uintptr_t)(lds + sl * AT_WAVE_BYTES + AT_VS) + vlane;
            f32x16 sc;
#pragma unroll
            for (int i = 0; i < 16; ++i) sc[i] = 0.f;
#pragma unroll
            for (int s = 0; s < 8; ++s) { const bf16x8 kf = *(const LAS bf16x8*)(kb + 32 * s); sc = __builtin_amdgcn_mfma_f32_32x32x16_bf16(kf, qf[s], sc, 0, 0, 0); }
            if (last && has_next) AT_LOADQ(nxt);
            const LAS float* tb = tabs + (32 * kt - ql + 4 * hl + 32);
#pragma unroll
            for (int i = 0; i < 16; ++i) { sc[i] = fmaf(sc[i], c, tb[8 * (i >> 2) + (i & 3)]); }
            if (last && has_next) AT_LOADTAB(nxt);
            if (AT_EDGE(cur, kt)) {
                const int ks0 = cur.q0 - cur.W + 32 * kt + 4 * hl;
#pragma unroll
                for (int i = 0; i < 16; ++i) { const int ks = ks0 + 8 * (i >> 2) + (i & 3); if (ks < 0 || ks >= cur.sub_len) sc[i] = -__builtin_inff(); }
            }
            float tmax = -__builtin_inff();
#pragma unroll
            for (int i = 0; i < 16; ++i) tmax = fmaxf(tmax, sc[i]);
            tmax = fmaxf(tmax, shx(tmax, 32, lane));
            if (__builtin_amdgcn_ballot_w64(tmax > m + 8.0f) != 0ull) {
                const float mn = fmaxf(m, tmax), alpha = __builtin_amdgcn_exp2f(m - mn); m = mn; l *= alpha;
#pragma unroll
                for (int i = 0; i < 16; ++i) { o0[i] *= alpha; o1[i] *= alpha; o2[i] *= alpha; o3[i] *= alpha; }
            }
            float ps = 0.f;
#pragma unroll
            for (int i = 0; i < 16; ++i) { sc[i] = __builtin_amdgcn_exp2f(sc[i] - m); ps += sc[i]; }
            l += ps;
            bf16x8 p0, p1;
            { u32x4 w0, w1; w0.x = pk2(sc[0], sc[1]); w0.y = pk2(sc[2], sc[3]); w0.z = pk2(sc[4], sc[5]); w0.w = pk2(sc[6], sc[7]);
              w1.x = pk2(sc[8], sc[9]); w1.y = pk2(sc[10], sc[11]); w1.z = pk2(sc[12], sc[13]); w1.w = pk2(sc[14], sc[15]);
              p0 = *reinterpret_cast<bf16x8*>(&w0); p1 = *reinterpret_cast<bf16x8*>(&w1); }
            { s16x4 t0, t1, t2, t3, t4, t5, t6, t7, t8, t9, t10, t11, t12, t13, t14, t15;
              asm volatile("ds_read_b64_tr_b16 %0, %16 offset:0\n\tds_read_b64_tr_b16 %1, %16 offset:2560\n\tds_read_b64_tr_b16 %2, %16 offset:5120\n\tds_read_b64_tr_b16 %3, %16 offset:7680\n\t"
                           "ds_read_b64_tr_b16 %4, %16 offset:64\n\tds_read_b64_tr_b16 %5, %16 offset:2624\n\tds_read_b64_tr_b16 %6, %16 offset:5184\n\tds_read_b64_tr_b16 %7, %16 offset:7744\n\t"
                           "ds_read_b64_tr_b16 %8, %16 offset:128\n\tds_read_b64_tr_b16 %9, %16 offset:2688\n\tds_read_b64_tr_b16 %10, %16 offset:5248\n\tds_read_b64_tr_b16 %11, %16 offset:7808\n\t"
                           "ds_read_b64_tr_b16 %12, %16 offset:192\n\tds_read_b64_tr_b16 %13, %16 offset:2752\n\tds_read_b64_tr_b16 %14, %16 offset:5312\n\tds_read_b64_tr_b16 %15, %16 offset:7872\n\ts_waitcnt lgkmcnt(0)"
                           : "=&v"(t0), "=&v"(t1), "=&v"(t2), "=&v"(t3), "=&v"(t4), "=&v"(t5), "=&v"(t6), "=&v"(t7), "=&v"(t8), "=&v"(t9), "=&v"(t10), "=&v"(t11), "=&v"(t12), "=&v"(t13), "=&v"(t14), "=&v"(t15)
                           : "v"(vb) : "memory");
              __builtin_amdgcn_sched_barrier(0);
              o0 = __builtin_amdgcn_mfma_f32_32x32x16_bf16(PK8(t0, t1), p0, o0, 0, 0, 0); o1 = __builtin_amdgcn_mfma_f32_32x32x16_bf16(PK8(t4, t5), p0, o1, 0, 0, 0);
              o2 = __builtin_amdgcn_mfma_f32_32x32x16_bf16(PK8(t8, t9), p0, o2, 0, 0, 0); o3 = __builtin_amdgcn_mfma_f32_32x32x16_bf16(PK8(t12, t13), p0, o3, 0, 0, 0);
              o0 = __builtin_amdgcn_mfma_f32_32x32x16_bf16(PK8(t2, t3), p1, o0, 0, 0, 0); o1 = __builtin_amdgcn_mfma_f32_32x32x16_bf16(PK8(t6, t7), p1, o1, 0, 0, 0);
              o2 = __builtin_amdgcn_mfma_f32_32x32x16_bf16(PK8(t10, t11), p1, o2, 0, 0, 0); o3 = __builtin_amdgcn_mfma_f32_32x32x16_bf16(PK8(t14, t15), p1, o3, 0, 0, 0); }
            if (newt) {
                __syncthreads();
                *(LAS u32x4*)(lds + (tn & 7) * AT_WAVE_BYTES + AT_KS + wrow * 272 + 16 * lch) = kn; *(LAS u32x4*)(lds + (tn & 7) * AT_WAVE_BYTES + AT_VS + wrow * 320 + 16 * lch) = vn;
                __syncthreads();
            }
        }
        const float lt = l + shx(l, 32, lane), inv = 1.0f / lt;
        const size_t tok = (size_t)(cur.r + (cur.q0 + ql) * cur.dil);
        if (cur.o8) {
            unsigned char* op = cur.O + tok * cur.o_ld + cur.ocol + 4 * hl; const float i64 = inv * 64.f;
#pragma unroll
            for (int g = 0; g < 4; ++g) {
                *(unsigned*)(op + 8 * g) = pk4_fp8(o0[4 * g] * i64, o0[4 * g + 1] * i64, o0[4 * g + 2] * i64, o0[4 * g + 3] * i64);
                *(unsigned*)(op + 32 + 8 * g) = pk4_fp8(o1[4 * g] * i64, o1[4 * g + 1] * i64, o1[4 * g + 2] * i64, o1[4 * g + 3] * i64);
                *(unsigned*)(op + 64 + 8 * g) = pk4_fp8(o2[4 * g] * i64, o2[4 * g + 1] * i64, o2[4 * g + 2] * i64, o2[4 * g + 3] * i64);
                *(unsigned*)(op + 96 + 8 * g) = pk4_fp8(o3[4 * g] * i64, o3[4 * g + 1] * i64, o3[4 * g + 2] * i64, o3[4 * g + 3] * i64);
            }
        } else {
            bf16* op = (bf16*)cur.O + tok * cur.o_ld + cur.ocol + 4 * hl;
#pragma unroll
            for (int g = 0; g < 4; ++g) {
                u32x2 w;
                w.x = pk2(o0[4 * g] * inv, o0[4 * g + 1] * inv); w.y = pk2(o0[4 * g + 2] * inv, o0[4 * g + 3] * inv); *(u32x2*)(op + 8 * g) = w;
                w.x = pk2(o1[4 * g] * inv, o1[4 * g + 1] * inv); w.y = pk2(o1[4 * g + 2] * inv, o1[4 * g + 3] * inv); *(u32x2*)(op + 32 + 8 * g) = w;
                w.x = pk2(o2[4 * g] * inv, o2[4 * g + 1] * inv); w.y = pk2(o2[4 * g + 2] * inv, o2[4 * g + 3] * inv); *(u32x2*)(op + 64 + 8 * g) = w;
                w.x = pk2(o3[4 * g] * inv, o3[4 * g + 1] * inv); w.y = pk2(o3[4 * g + 2] * inv, o3[4 * g + 3] * inv); *(u32x2*)(op + 96 + 8 * g) = w;
            }
        }
        if (cur.lse && hl == 0) cur.lse[tok * 12 + cur.lse_idx] = m + __builtin_log2f(lt);
        if (!has_next) break;
        AT_FILL(nxt);
        __syncthreads();
        AT_STORETAB(nxt); AT_WRITEFILL();
        __syncthreads();
        cur = nxt; it = itn;
    }
    LDS_WAIT();
#undef AT_FILL
#undef AT_WRITEFILL
#undef AT_TOFF
#undef AT_LOADQ
#undef AT_LOADTAB
#undef AT_STORETAB
#undef AT_EDGE
}

__device__ __forceinline__ void phase_amerge(unsigned char* ws, int gw, int NGW, int lane) {
    const bf16* AR = (const bf16*)(ws + WS_AR); const float* LSE = (const float*)(ws + WS_LSE); unsigned char* AO8 = ws + WS_AO;
    const size_t gt = (size_t)gw * 64 + lane, NT = (size_t)NGW * 64;
    for (size_t i = gt; i < (size_t)TH * 64; i += NT) {
        const size_t t = i >> 6; const int ch = (int)(i & 63), h = ch >> 4, dc = ch & 15;
        const float l0 = LSE[t * 12 + h], l1 = LSE[t * 12 + 4 + h], l2 = LSE[t * 12 + 8 + h];
        const float mx = fmaxf(l0, fmaxf(l1, l2));
        float w0 = __builtin_amdgcn_exp2f(l0 - mx), w1 = __builtin_amdgcn_exp2f(l1 - mx), w2 = __builtin_amdgcn_exp2f(l2 - mx);
        const float inv = 1.0f / (w0 + w1 + w2); w0 *= inv; w1 *= inv; w2 *= inv;
        const bf16* ap = AR + t * 1536 + h * 128 + dc * 8;
        const u32x4 a = *(const u32x4*)ap, b = *(const u32x4*)(ap + 512), cc = *(const u32x4*)(ap + 1024);
        w0 *= 64.f; w1 *= 64.f; w2 *= 64.f;
        u32x2 o;
        o.x = pk4_fp8(w0 * pg8::bf_lo(a.x) + w1 * pg8::bf_lo(b.x) + w2 * pg8::bf_lo(cc.x), w0 * pg8::bf_hi(a.x) + w1 * pg8::bf_hi(b.x) + w2 * pg8::bf_hi(cc.x),
                      w0 * pg8::bf_lo(a.y) + w1 * pg8::bf_lo(b.y) + w2 * pg8::bf_lo(cc.y), w0 * pg8::bf_hi(a.y) + w1 * pg8::bf_hi(b.y) + w2 * pg8::bf_hi(cc.y));
        o.y = pk4_fp8(w0 * pg8::bf_lo(a.z) + w1 * pg8::bf_lo(b.z) + w2 * pg8::bf_lo(cc.z), w0 * pg8::bf_hi(a.z) + w1 * pg8::bf_hi(b.z) + w2 * pg8::bf_hi(cc.z),
                      w0 * pg8::bf_lo(a.w) + w1 * pg8::bf_lo(b.w) + w2 * pg8::bf_lo(cc.w), w0 * pg8::bf_hi(a.w) + w1 * pg8::bf_hi(b.w) + w2 * pg8::bf_hi(cc.w));
        *(u32x2*)(AO8 + t * 512 + h * 128 + dc * 8) = o;
    }
}

__device__ __forceinline__ void phase_ln(float* Y, bf16* XB, unsigned char* X8, float* st, bool inplace, const float* __restrict__ gam, const float* __restrict__ bet, int gw, int NGW, int lane, unsigned char* XI8 = nullptr, float* rsc = nullptr) {
    for (int row0 = 2 * gw; row0 < T; row0 += 2 * NGW) {
        f32x4* yr0 = (f32x4*)(Y + (size_t)row0 * D) + lane; f32x4* yr1 = yr0 + D / 4;
        f32x4 v[8], w[8]; float s = 0.f, t = 0.f;
#pragma unroll
        for (int j = 0; j < 8; ++j) { v[j] = yr0[64 * j]; w[j] = yr1[64 * j]; }
#pragma unroll
        for (int j = 0; j < 8; ++j) { s += (v[j][0] + v[j][1]) + (v[j][2] + v[j][3]); t += (w[j][0] + w[j][1]) + (w[j][2] + w[j][3]); }
#pragma unroll
        for (int o = 1; o < 64; o <<= 1) { s += shx(s, o, lane); t += shx(t, o, lane); }
        const float mean0 = s * (1.f / D), mean1 = t * (1.f / D); float s2 = 0.f, t2 = 0.f;
#pragma unroll
        for (int j = 0; j < 8; ++j) { v[j] = v[j] - mean0; w[j] = w[j] - mean1; s2 += (v[j][0] * v[j][0] + v[j][1] * v[j][1]) + (v[j][2] * v[j][2] + v[j][3] * v[j][3]); t2 += (w[j][0] * w[j][0] + w[j][1] * w[j][1]) + (w[j][2] * w[j][2] + w[j][3] * w[j][3]); }
#pragma unroll
        for (int o = 1; o < 64; o <<= 1) { s2 += shx(s2, o, lane); t2 += shx(t2, o, lane); }
        const float rstd0 = 1.0f / sqrtf(s2 * (1.f / D) + LN_EPS), rstd1 = 1.0f / sqrtf(t2 * (1.f / D) + LN_EPS);
        if (st && lane == 0) { f32x4 sv; sv[0] = mean0; sv[1] = rstd0; sv[2] = mean1; sv[3] = rstd1; *(f32x4*)(st + 2 * (size_t)row0) = sv; }
        float am0 = 0.f, am1 = 0.f;
#pragma unroll
        for (int j = 0; j < 8; ++j) { const f32x4 gg = *((const f32x4*)gam + lane + 64 * j), bb = *((const f32x4*)bet + lane + 64 * j);
            const f32x4 o = v[j] * rstd0 * gg + bb, q = w[j] * rstd1 * gg + bb;
            if (inplace) { yr0[64 * j] = o; yr1[64 * j] = q; }
            if (XB) { u32x2 u; u.x = pk2(o[0], o[1]); u.y = pk2(o[2], o[3]); *((u32x2*)(XB + (size_t)row0 * D) + lane + 64 * j) = u; u.x = pk2(q[0], q[1]); u.y = pk2(q[2], q[3]); *((u32x2*)(XB + (size_t)(row0 + 1) * D) + lane + 64 * j) = u; }
            if (X8) { *((unsigned*)(X8 + (size_t)row0 * D) + lane + 64 * j) = pk4_fp8(o[0] * 32.f, o[1] * 32.f, o[2] * 32.f, o[3] * 32.f); *((unsigned*)(X8 + (size_t)(row0 + 1) * D) + lane + 64 * j) = pk4_fp8(q[0] * 32.f, q[1] * 32.f, q[2] * 32.f, q[3] * 32.f); }
            if (XI8) { v[j] = o; w[j] = q; am0 = fmaxf(am0, fmaxf(fmaxf(fabsf(o[0]), fabsf(o[1])), fmaxf(fabsf(o[2]), fabsf(o[3])))); am1 = fmaxf(am1, fmaxf(fmaxf(fabsf(q[0]), fabsf(q[1])), fmaxf(fabsf(q[2]), fabsf(q[3])))); } }
        if (XI8) {
#pragma unroll
            for (int o = 1; o < 64; o <<= 1) { am0 = fmaxf(am0, shx(am0, o, lane)); am1 = fmaxf(am1, shx(am1, o, lane)); }
            const float i0 = am0 > 0.f ? 127.0f / am0 : 0.f, i1 = am1 > 0.f ? 127.0f / am1 : 0.f;
            if (lane == 0) { rsc[row0] = am0 * (1.0f / 127.0f); rsc[row0 + 1] = am1 * (1.0f / 127.0f); }
#pragma unroll
            for (int j = 0; j < 8; ++j) {
                { const int a = (int)__builtin_rintf(v[j][0] * i0), b = (int)__builtin_rintf(v[j][1] * i0), c = (int)__builtin_rintf(v[j][2] * i0), d = (int)__builtin_rintf(v[j][3] * i0);
                  *((unsigned*)(XI8 + (size_t)row0 * D) + lane + 64 * j) = ((unsigned)a & 255u) | (((unsigned)b & 255u) << 8) | (((unsigned)c & 255u) << 16) | ((unsigned)d << 24); }
                { const int a = (int)__builtin_rintf(w[j][0] * i1), b = (int)__builtin_rintf(w[j][1] * i1), c = (int)__builtin_rintf(w[j][2] * i1), d = (int)__builtin_rintf(w[j][3] * i1);
                  *((unsigned*)(XI8 + (size_t)(row0 + 1) * D) + lane + 64 * j) = ((unsigned)a & 255u) | (((unsigned)b & 255u) << 8) | (((unsigned)c & 255u) << 16) | ((unsigned)d << 24); } }
        }
    }
}

__global__ void __launch_bounds__(NTHREADS, 2) fwd_mega(Params p_arg) {
    extern __shared__ __attribute__((aligned(16))) unsigned char lds_raw[];
    LAS unsigned char* lds = (LAS unsigned char*)lds_raw;
    const int ph_lo = p_arg.ph_lo, ph_hi = p_arg.ph_hi;
    if (threadIdx.x < 4) ((LAS unsigned*)(lds + LDS_BARST))[threadIdx.x] = 0u;
    __syncthreads();
    for (int ph = ph_lo; ph < ph_hi; ++ph) {
      for (int rep = 0; rep < 2; ++rep) {
        if (ph > ph_lo || rep > 0) {
#if defined(__HIP_DEVICE_COMPILE__)
            unsigned* barw = (unsigned*)(((PP)__builtin_amdgcn_kernarg_segment_ptr())->ws + WS_BAR);
            if (ph == 1 && rep == 0) { cg::this_grid().sync();
                (void)xcd_barrier_post(barw, (volatile LAS unsigned*)(lds + LDS_BARST)); }
            else {
#ifdef DBG_BAR
                const unsigned long long tb0_ = __builtin_amdgcn_s_memrealtime();
#endif
                XcdBarrier xb_; xb_.bar = barw; xb_.x = xb_xcc_id(); xb_.st = (volatile LAS unsigned*)(lds + LDS_BARST); xcd_barrier(xb_);
#ifdef DBG_BAR
                if (blockIdx.x == DBG_BAR && threadIdx.x == 0) { unsigned long long* d_ = (unsigned long long*)(((PP)__builtin_amdgcn_kernarg_segment_ptr())->ws + WS_BAR + 65536); const unsigned long long dt_ = __builtin_amdgcn_s_memrealtime() - tb0_; d_[0] = (ph == 2 ? 0ull : d_[0]) + dt_; }
#endif
            }
#endif
        }
#if defined(__HIP_DEVICE_COMPILE__)
        PP p = (PP)__builtin_amdgcn_kernarg_segment_ptr(); asm volatile("" : "+s"(p));
#else
        PP p = (PP)(uintptr_t)0; (void)p_arg;
#endif
        int tid_ = threadIdx.x, bx_ = blockIdx.x; asm volatile("" : "+v"(tid_), "+s"(bx_));
        const int tid = tid_, lane = tid & 63, wave = __builtin_amdgcn_readfirstlane(tid >> 6);
        const int G = gridDim.x, bx = bx_, vcu = (G % 8 == 0) ? (bx % 8) * (G / 8) + bx / 8 : bx;
        const int gw = vcu * NWAVES + wave, NGW = G * NWAVES;
        unsigned char* ws = p->ws; bf16* XB = (bf16*)(ws + WS_XB);
        if (ph == 0) {
#if EN_PRO
 phase_prologue(p, lds, gw, NGW, wave, lane);
#endif
 break; }
        const int q = ph - 1, layer = q / 13, s = q - layer * 13;
        const bf16* wl = (const bf16*)(ws + WS_W0 + (size_t)layer * WS_WL);
        const bool dbl = (s < 8 && (s & 3) == 1 && (PROBE_MASK & 2)) || (s < 8 && (s & 3) == 2 && (PROBE_MASK & 4)) || ((s == 9 || (s == 12 && layer == 0)) && (PROBE_MASK & 8)) || (s < 8 && (s & 3) == 0 && (PROBE_MASK & 16)) || (s == 10 && (PROBE_MASK & 32)) || (s < 8 && (s & 3) == 3 && (PROBE_MASK & 64));
        if (s < 8) {
            const int half = s >> 2, sub = s & 3;
            if (sub == 0) {
                pg8::Gemm g{(const bf16*)(ws + WS_X8 + (size_t)half * TH * D), wl + WO_IN, TH, CIN, D / 2}; pg8::StaticOrder S; S.init(TH, CIN, G, bx);
                pg8::EpiProj E{(bf16*)(ws + WS_PROJ), CIN, ws + WS_G8, 4096, 6144};

#if EN_INPROJ
 pg8::gemm_phase<pg8::EpiProj, pg8::StaticOrder, true, true, true>(lds, g, S, E);
#endif

            } else if (sub == 1) {
#if EN_ATTN
 phase_attention(ws, p->sink, lds, layer, vcu, G, wave, lane);
#endif

            } else if (sub == 2) { phase_amerge(ws, gw, NGW, lane);
            } else {
                for (int k = 0; k < 2; ++k) {
                    pg8::Gemm g{k == 0 ? (const bf16*)(ws + WS_AO) : (const bf16*)(ws + WS_BO), wl + (k == 0 ? WO_PA : WO_PB), TH, D, k == 0 ? 256 : 512, 0x79797979, 0x78787878};
                    pg8::StaticOrder S; S.init(TH, D, G, bx);
                    pg8::EpiGate E{(bf16*)(ws + WS_XB + 64 * MiB), ws + WS_XB + (size_t)half * TH * D, D, ws + WS_G8 + (k == 0 ? 0 : 2048), 4096, k, 512.f};

#if EN_GATE
 pg8::gemm_phase<pg8::EpiGate, pg8::StaticOrder, true, true, true>(lds, g, S, E);
#endif

                }
            }
        } else if (s == 8 || s == 11) {
            const bool dn = (s == 11);
            pg8::StaticOrder S; S.init(T, D, G, bx);
            const bool raw = (!dn && layer == 0);
            pg8::EpiResid E{(pg8::ArgV)p, raw ? 0 : -1, dn ? 7 : 11, dn ? 8 : 12, D, ALPHA, (size_t)(dn ? layer : (layer > 0 ? layer - 1 : 0)) * D, WS_ST};
#if EN_RESID
            if (dn && layer == FP8_DOWN_LAYER) { pg8::Gemm g{(const bf16*)(ws + WS_H), wl + WO_DN, T, D, DFF / 2, 0x79797979, 0x77777777}; pg8::gemm_phase<pg8::EpiResid, pg8::StaticOrder, true, true, true>(lds, g, S, E); }
            else if (dn) { pg8::Gemm g{(const bf16*)(ws + WS_H), wl + WO_DN, T, D, DFF}; pg8::gemm_phase<pg8::EpiResid, pg8::StaticOrder, true, true>(lds, g, S, E); }
            else { pg8::Gemm g{(const bf16*)(ws + WS_XB), wl + WO_OUT, T, D, D / 2, 0x76767676, 0x78787878}; pg8::gemm_phase<pg8::EpiResid, pg8::StaticOrder, true, true, true>(lds, g, S, E); }
#endif
        } else if (s == 9) { phase_ln(p->out, nullptr, nullptr, (float*)(ws + WS_ST), false, p->ln1_g + layer * D, p->ln1_b + layer * D, gw, NGW, lane, ws + WS_XB, (float*)(ws + WS_RS));
        } else if (s == 10) {
            pg8::Gemm g{XB, wl + WO_UP, T, NUP, D / 2}; pg8::StaticOrder S; S.init(T, NUP, G, bx);
            pg8::EpiSwigluI8 E{(bf16*)(ws + WS_H), DFF, layer == FP8_DOWN_LAYER ? 64.f : 0.f, (const float*)(ws + WS_RS), (const float*)(ws + WS_CMAX) + layer * NUP};

#if EN_SWIGLU
 pg8::gemm_phase<pg8::EpiSwigluI8, pg8::StaticOrder, true, true, false, true>(lds, g, S, E);
#endif

        } else { phase_ln(p->out, nullptr, (layer == 1) ? nullptr : ws + WS_X8, (layer == 1) ? nullptr : (float*)(ws + WS_ST), layer == 1, p->ln2_g + layer * D, p->ln2_b + layer * D, gw, NGW, lane); }
        if (!(rep == 0 && dbl)) break;
      }
    }
#if defined(__HIP_DEVICE_COMPILE__) && defined(DBG_BAR)
    if (blockIdx.x == DBG_BAR && threadIdx.x == 0) { PP p = (PP)__builtin_amdgcn_kernarg_segment_ptr(); const unsigned long long* d = (const unsigned long long*)(p->ws + WS_BAR + 65536);
        float v = (float)d[0] * 0.01f;
        v = __builtin_rintf(v / 100.f) * 100.f; p->out[0] = v * 1.0e3f; }
#endif
}

#ifndef MK_PER_PHASE
#define MK_PER_PHASE 0
#endif
extern "C" void kernel_launch(void* const* d_in, const int* in_sizes, int n_in, void* d_out, int out_size, void* d_ws, size_t ws_size, hipStream_t stream) {
    static int grid = 0;
    if (grid == 0) {
        if (n_in != 13 || ws_size < WS_END) { fprintf(stderr, "kernel_launch: unexpected inputs (n_in %d, ws %zu)\n", n_in, ws_size); grid = -1; return; }
        int dev = 0, cus = 0;
        if (hipGetDevice(&dev) != hipSuccess || hipDeviceGetAttribute(&cus, hipDeviceAttributeMultiprocessorCount, dev) != hipSuccess) { grid = -1; return; }
        if (hipFuncSetAttribute((const void*)fwd_mega, hipFuncAttributeMaxDynamicSharedMemorySize, LDS_BYTES) != hipSuccess) { fprintf(stderr, "kernel_launch: hipFuncSetAttribute failed\n"); grid = -1; return; }
        (void)hipGetLastError();
        grid = cus;
    }
    if (grid < 0) return;
    Params p{};
    p.x = (const float*)d_in[0]; p.rel_bias = (const float*)d_in[1]; p.w_in = (const float*)d_in[2]; p.sink = (const float*)d_in[3]; p.w_pa = (const float*)d_in[4]; p.w_pb = (const float*)d_in[5];
    p.w_out = (const float*)d_in[6]; p.ln1_g = (const float*)d_in[7]; p.ln1_b = (const float*)d_in[8]; p.w_up = (const float*)d_in[9]; p.w_down = (const float*)d_in[10];
    p.ln2_g = (const float*)d_in[11]; p.ln2_b = (const float*)d_in[12]; p.out = (float*)d_out; p.ws = (unsigned char*)d_ws;
#if MK_PER_PHASE
    for (int ph = 0; ph < NPHASES; ++ph) { p.ph_lo = ph; p.ph_hi = ph + 1; hipLaunchKernelGGL(fwd_mega, dim3(grid), dim3(NTHREADS), LDS_BYTES, stream, p); }
#else
    p.ph_lo = 0; p.ph_hi = NPHASES;
    void* args[] = {&p};
    hipError_t e = hipLaunchCooperativeKernel((const void*)fwd_mega, dim3(grid), dim3(NTHREADS), args, LDS_BYTES, stream);
    if (e != hipSuccess) fprintf(stderr, "kernel_launch: cooperative launch failed: %s (grid %d)\n", hipGetErrorString(e), grid);
#endif
}
```

```cpp
#include <hip/hip_runtime.h>
#include <hip/hip_cooperative_groups.h>
#include <cstdio>
#include <cstdint>
namespace cg = cooperative_groups;
namespace pg8 {
#define PG8_LAS __attribute__((address_space(3)))
typedef unsigned short bf16_t;
typedef short bf16x8 __attribute__((ext_vector_type(8)));
typedef float f32x4 __attribute__((ext_vector_type(4)));
typedef unsigned u32x4 __attribute__((ext_vector_type(4)));
typedef unsigned u32x2 __attribute__((ext_vector_type(2)));
typedef int v8i32 __attribute__((ext_vector_type(8)));
typedef int v4i32 __attribute__((ext_vector_type(4)));
constexpr int FP8_SCALE_X = 0x79797979, FP8_SCALE_W = 0x79797979;
constexpr int BM = 256, BK = 64, HALF = 128, HTB = HALF * BK * 2  , STAGE_BYTES = 8 * HTB, NXCD = 8, WGM = 4;

__host__ __device__ __forceinline__ int lds_byte(int r, int c) { const int st = (r >> 4) * 2 + (c >> 5), rr = r & 15, cc = c & 31, ob = rr * 64 + cc * 2; return st * 1024 + (ob ^ (((ob >> 9) & 1) << 5)); }
__host__ __device__ __forceinline__ void stage_rc(int b, int& R, int& C) { const int st = b / 1024, sb = b % 1024, swz = sb ^ (((sb >> 9) & 1) << 5); R = (st >> 1) * 16 + swz / 64; C = (st & 1) * 32 + (swz % 64) / 2; }
__host__ __device__ __forceinline__ int x8(int r) { return ((r >> 1) & 3) | ((((r >> 2) ^ (r >> 3)) & 1) << 2); }
__host__ __device__ __forceinline__ int lds_byte8(int r, int c16) { return r * 128 + 16 * (c16 ^ x8(r & 15)); }
__host__ __device__ __forceinline__ void stage_rc8(int b, int& R, int& C) { R = b >> 7; C = 8 * (((b >> 4) & 7) ^ x8(R & 15)); }
__host__ __device__ __forceinline__ int perm32(int rho) { const int n = rho >> 4, i = rho & 15; return 8 * (i >> 2) + 4 * n + (i & 3); }

struct Unit { int pm, pn; };
struct Gemm { const bf16_t* A; const bf16_t* Bt; int M, N, K; int sx = 0x79797979, sw = 0x79797979; };

struct StaticOrder {
    int nM, nN, nwg, G, c;
    __host__ __device__ void init(int M, int N, int G_, int c_) { nM = M / BM; nN = N / BM; nwg = nM * nN; G = G_; c = c_; }
    __host__ __device__ bool next(int i, Unit& u) const {
        const long L = (long)i * G + c; if (L >= nwg) return false;
        int wgid = (int)L; { const int q = nwg / NXCD, r = nwg % NXCD, xcd = wgid % NXCD, off = wgid / NXCD; wgid = (xcd < r ? xcd * (q + 1) : r * (q + 1) + (xcd - r) * q) + off; }
        const int nig = WGM * nN, gid = wgid / nig, fm = gid * WGM, gsz = (nM - fm) < WGM ? (nM - fm) : WGM;
        u.pm = fm + ((wgid % nig) % gsz); u.pn = (wgid % nig) / gsz; return true;
    }
    __device__ __forceinline__ void a_ready(const Unit&) const {}
    __device__ __forceinline__ void done(const Unit&) const {}
};

__device__ __forceinline__ unsigned cvt_pk_bf16(float lo, float hi) { unsigned r; asm("v_cvt_pk_bf16_f32 %0, %1, %2" : "=v"(r) : "v"(lo), "v"(hi)); return r; }
typedef float f32x2 __attribute__((ext_vector_type(2)));
template <int ACT  > struct EpiBf16 {
    static constexpr bool PERM = true, AFTER_DRAIN = false; static_assert(ACT == 0 || ACT == 1, "EpiBf16: ACT is 0 (none) or 1 (gelu_pk)");
    bf16_t* O; int ldc; const float* bias; int split_cols; size_t split_stride; float scale0;
    __device__ __forceinline__ void operator()(const f32x4 (&acc)[2][2][4][2], const Unit& u, int wr, int wc, int fr, int fq) const {
        const int row0 = u.pm * BM + wr * 64 + fr; int colt = u.pn * BM; bf16_t* base = O;
        float sc = 1.f; if (split_cols) { const int t = colt / split_cols; base += (size_t)t * split_stride; colt -= t * split_cols; if (t == 0) sc = scale0; }
        const int col0 = colt + wc * 32 + 8 * fq, bcol0 = u.pn * BM + wc * 32 + 8 * fq;
        f32x4 bv[2][2];
#pragma unroll
        for (int bj = 0; bj < 2; ++bj)
#pragma unroll
            for (int n = 0; n < 2; ++n) bv[bj][n] = bias ? *(const f32x4*)(bias + bcol0 + bj * HALF + 4 * n) : (f32x4){0.f, 0.f, 0.f, 0.f};
#pragma unroll
        for (int ai = 0; ai < 2; ++ai)
#pragma unroll
            for (int m = 0; m < 4; ++m) { bf16_t* rowp = base + (size_t)(row0 + ai * HALF + m * 16) * ldc + col0;
#pragma unroll
                for (int bj = 0; bj < 2; ++bj) { f32x4 v0 = acc[ai][bj][m][0] + bv[bj][0], v1 = acc[ai][bj][m][1] + bv[bj][1];
                    v0 = v0 * sc; v1 = v1 * sc; u32x4 w; w.x = cvt_pk_bf16(v0[0], v0[1]); w.y = cvt_pk_bf16(v0[2], v0[3]); w.z = cvt_pk_bf16(v1[0], v1[1]); w.w = cvt_pk_bf16(v1[2], v1[3]);
                    *(u32x4*)(rowp + bj * HALF) = w; } }
    }
};
__device__ __forceinline__ float sigmoidf_fast(float x) { return __builtin_amdgcn_rcpf(1.0f + __builtin_amdgcn_exp2f(-1.4426950408889634f * x)); }
__device__ __forceinline__ float bf_lo(unsigned w) { return __uint_as_float(w << 16); }
__device__ __forceinline__ float bf_hi(unsigned w) { return __uint_as_float(w & 0xffff0000u); }
__device__ __forceinline__ float clamp448(float v) { return __builtin_fminf(__builtin_fmaxf(v, -448.f), 448.f); }
__device__ __forceinline__ unsigned pk4_fp8(float a, float b, float c, float d) { unsigned w = 0; w = __builtin_amdgcn_cvt_pk_fp8_f32(clamp448(a), clamp448(b), w, false); w = __builtin_amdgcn_cvt_pk_fp8_f32(clamp448(c), clamp448(d), w, true); return w; }
struct EpiProj {
    static constexpr bool PERM = true, AFTER_DRAIN = false;
    bf16_t* O; int ldc; unsigned char* G8; int ldg; int gcol0;
    __device__ __forceinline__ void operator()(const f32x4 (&acc)[2][2][4][2], const Unit& u, int wr, int wc, int fr, int fq) const {
        const int row0 = u.pm * BM + wr * 64 + fr, col0 = u.pn * BM + wc * 32 + 8 * fq;
        if (u.pn * BM < gcol0) {
#pragma unroll
            for (int ai = 0; ai < 2; ++ai)
#pragma unroll
                for (int m = 0; m < 4; ++m) { bf16_t* rowp = O + (size_t)(row0 + ai * HALF + m * 16) * ldc + col0;
#pragma unroll
                    for (int bj = 0; bj < 2; ++bj) { const f32x4 v0 = acc[ai][bj][m][0], v1 = acc[ai][bj][m][1];
                        u32x4 w; w.x = cvt_pk_bf16(v0[0], v0[1]); w.y = cvt_pk_bf16(v0[2], v0[3]); w.z = cvt_pk_bf16(v1[0], v1[1]); w.w = cvt_pk_bf16(v1[2], v1[3]);
                        *(u32x4*)(rowp + bj * HALF) = w; } }
        } else {
#pragma unroll
            for (int ai = 0; ai < 2; ++ai)
#pragma unroll
                for (int m = 0; m < 4; ++m) { unsigned char* rowp = G8 + (size_t)(row0 + ai * HALF + m * 16) * ldg + (col0 - gcol0);
#pragma unroll
                    for (int bj = 0; bj < 2; ++bj) { const f32x4 v0 = acc[ai][bj][m][0], v1 = acc[ai][bj][m][1];
                        u32x2 w8; w8.x = pk4_fp8(256.f * sigmoidf_fast(v0[0]), 256.f * sigmoidf_fast(v0[1]), 256.f * sigmoidf_fast(v0[2]), 256.f * sigmoidf_fast(v0[3]));
                        w8.y = pk4_fp8(256.f * sigmoidf_fast(v1[0]), 256.f * sigmoidf_fast(v1[1]), 256.f * sigmoidf_fast(v1[2]), 256.f * sigmoidf_fast(v1[3]));
                        *(u32x2*)(rowp + bj * HALF) = w8; } }
        }
    }
};
struct EpiGate {
    static constexpr bool PERM = true, AFTER_DRAIN = false;
    bf16_t* Tm; unsigned char* O8; int ldo; const unsigned char* G; int ldg; int add; float oscale;
    __device__ __forceinline__ void operator()(const f32x4 (&acc)[2][2][4][2], const Unit& u, int wr, int wc, int fr, int fq) const {
        const int row0 = u.pm * BM + wr * 64 + fr, col0 = u.pn * BM + wc * 32 + 8 * fq;
#pragma unroll
        for (int ai = 0; ai < 2; ++ai)
#pragma unroll
            for (int m = 0; m < 4; ++m) { const size_t r = (size_t)(row0 + ai * HALF + m * 16); bf16_t* rowp = Tm + r * ldo + col0; const unsigned char* gp = G + r * ldg + col0;
#pragma unroll
                for (int bj = 0; bj < 2; ++bj) { const u32x2 gw = *(const u32x2*)(gp + bj * HALF); f32x4 v0 = acc[ai][bj][m][0], v1 = acc[ai][bj][m][1];
                    { const f32x2 g0 = __builtin_amdgcn_cvt_pk_f32_fp8((int)gw.x, false), g1 = __builtin_amdgcn_cvt_pk_f32_fp8((int)gw.x, true), g2 = __builtin_amdgcn_cvt_pk_f32_fp8((int)gw.y, false), g3 = __builtin_amdgcn_cvt_pk_f32_fp8((int)gw.y, true);
                      const float k_ = 1.0f / 256.0f;
                      v0[0] *= g0.x * k_; v0[1] *= g0.y * k_; v0[2] *= g1.x * k_; v0[3] *= g1.y * k_; v1[0] *= g2.x * k_; v1[1] *= g2.y * k_; v1[2] *= g3.x * k_; v1[3] *= g3.y * k_; }
                    if (add) { const u32x4 pw = *(const u32x4*)(rowp + bj * HALF);
                        v0[0] += bf_lo(pw.x); v0[1] += bf_hi(pw.x); v0[2] += bf_lo(pw.y); v0[3] += bf_hi(pw.y); v1[0] += bf_lo(pw.z); v1[1] += bf_hi(pw.z); v1[2] += bf_lo(pw.w); v1[3] += bf_hi(pw.w);
                        v0 = v0 * oscale; v1 = v1 * oscale; u32x2 w8; w8.x = pk4_fp8(v0[0], v0[1], v0[2], v0[3]); w8.y = pk4_fp8(v1[0], v1[1], v1[2], v1[3]);
                        *(u32x2*)(O8 + r * ldo + col0 + bj * HALF) = w8; }
                    else { u32x4 w; w.x = cvt_pk_bf16(v0[0], v0[1]); w.y = cvt_pk_bf16(v0[2], v0[3]); w.z = cvt_pk_bf16(v1[0], v1[1]); w.w = cvt_pk_bf16(v1[2], v1[3]);
                        *(u32x4*)(rowp + bj * HALF) = w; } } }
    }
};
typedef void* vptr_t; typedef const __attribute__((address_space(4))) vptr_t* ArgV;
struct EpiResid {
    static constexpr bool PERM = false, AFTER_DRAIN = false;
    ArgV args; int xi, gi, bi; int ldc; float alpha; size_t goff; size_t st_off;
    __device__ __forceinline__ void operator()(const f32x4 (&acc)[2][2][4][2], const Unit& u, int wr, int wc, int fr, int fq) const {
        ArgV a_ = args; asm volatile("" : "+s"(a_));
        float* Y = (float*)a_[13]; const float* X = xi >= 0 ? (const float*)a_[xi] : (const float*)Y;
        const float* st = xi >= 0 ? nullptr : (const float*)((const unsigned char*)a_[14] + st_off);
        const float* g = (const float*)a_[gi < 0 ? 0 : gi] + goff; const float* b = (const float*)a_[bi < 0 ? 0 : bi] + goff;
        const int row0 = u.pm * BM + wr * 64 + fr, col0 = u.pn * BM + wc * 32 + 4 * fq;
#pragma unroll
        for (int ai = 0; ai < 2; ++ai)
#pragma unroll
            for (int m = 0; m < 4; ++m) { const int r = row0 + ai * HALF + m * 16; const size_t off = (size_t)r * ldc + col0;
                float mean = 0.f, rstd = 1.f; if (st) { const f32x2 sv = *(const f32x2*)(st + 2 * (size_t)r); mean = sv.x; rstd = sv.y; }
#pragma unroll
                for (int bj = 0; bj < 2; ++bj)
#pragma unroll
                    for (int n = 0; n < 2; ++n) { f32x4 xv = *(const f32x4*)(X + off + bj * HALF + n * 16);
                        if (st) { const f32x4 gv = *(const f32x4*)(g + col0 + bj * HALF + n * 16), bv = *(const f32x4*)(b + col0 + bj * HALF + n * 16); xv = (xv - mean) * rstd * gv + bv; }
                        *(f32x4*)(Y + off + bj * HALF + n * 16) = xv * alpha + acc[ai][bj][m][n]; }
                asm volatile("" ::: "memory"); }
    }
};
struct EpiSwiglu {
    static constexpr bool PERM = true, AFTER_DRAIN = false;
    bf16_t* Hh; int ldh; float hscale;
    __device__ __forceinline__ void operator()(const f32x4 (&acc)[2][2][4][2], const Unit& u, int wr, int wc, int fr, int fq) const {
        const int row0 = u.pm * BM + wr * 64 + fr, col0 = u.pn * HALF + wc * 32 + 8 * fq;
#pragma unroll
        for (int ai = 0; ai < 2; ++ai)
#pragma unroll
            for (int m = 0; m < 4; ++m) { bf16_t* rowp = Hh + (size_t)(row0 + ai * HALF + m * 16) * ldh + col0; float hv[8];
#pragma unroll
                for (int n = 0; n < 2; ++n)
#pragma unroll
                    for (int j = 0; j < 4; ++j) { const float g = acc[ai][0][m][n][j], up = acc[ai][1][m][n][j]; hv[n * 4 + j] = g * sigmoidf_fast(g) * up; }
                if (hscale != 0.f) { u32x2 w8; w8.x = pk4_fp8(hv[0] * hscale, hv[1] * hscale, hv[2] * hscale, hv[3] * hscale); w8.y = pk4_fp8(hv[4] * hscale, hv[5] * hscale, hv[6] * hscale, hv[7] * hscale);
                    *(u32x2*)((unsigned char*)Hh + (size_t)(row0 + ai * HALF + m * 16) * ldh + col0) = w8; }
                else { u32x4 w; w.x = cvt_pk_bf16(hv[0], hv[1]); w.y = cvt_pk_bf16(hv[2], hv[3]); w.z = cvt_pk_bf16(hv[4], hv[5]); w.w = cvt_pk_bf16(hv[6], hv[7]);
                    *(u32x4*)rowp = w; } }
    }
};

struct EpiSwigluI8 {
    static constexpr bool PERM = true, AFTER_DRAIN = false;
    bf16_t* Hh; int ldh; float hscale; const float* rs; const float* cm;
    __device__ __forceinline__ void operator()(const f32x4 (&acc)[2][2][4][2], const Unit& u, int wr, int wc, int fr, int fq) const {
        const int row0 = u.pm * BM + wr * 64 + fr, col0 = u.pn * HALF + wc * 32 + 8 * fq, wrow0 = u.pn * BM + wc * 32 + 8 * fq;
        f32x4 cg[2], cu[2];
#pragma unroll
        for (int n = 0; n < 2; ++n) { cg[n] = *(const f32x4*)(cm + wrow0 + 4 * n) * (1.0f / 127.0f); cu[n] = *(const f32x4*)(cm + wrow0 + HALF + 4 * n) * (1.0f / 127.0f); }
#pragma unroll
        for (int ai = 0; ai < 2; ++ai)
#pragma unroll
            for (int m = 0; m < 4; ++m) { const int r = row0 + ai * HALF + m * 16; const float rsc = rs[r]; bf16_t* rowp = Hh + (size_t)r * ldh + col0; float hv[8];
#pragma unroll
                for (int n = 0; n < 2; ++n) { const v4i32 ig = __builtin_bit_cast(v4i32, acc[ai][0][m][n]), iu = __builtin_bit_cast(v4i32, acc[ai][1][m][n]);
#pragma unroll
                    for (int j = 0; j < 4; ++j) { const float g = (float)ig[j] * rsc * cg[n][j], up = (float)iu[j] * rsc * cu[n][j]; hv[n * 4 + j] = g * sigmoidf_fast(g) * up; } }
                if (hscale != 0.f) { u32x2 w8; w8.x = pk4_fp8(hv[0] * hscale, hv[1] * hscale, hv[2] * hscale, hv[3] * hscale); w8.y = pk4_fp8(hv[4] * hscale, hv[5] * hscale, hv[6] * hscale, hv[7] * hscale);
                    *(u32x2*)((unsigned char*)Hh + (size_t)r * ldh + col0) = w8; }
                else { u32x4 w; w.x = cvt_pk_bf16(hv[0], hv[1]); w.y = cvt_pk_bf16(hv[2], hv[3]); w.z = cvt_pk_bf16(hv[4], hv[5]); w.w = cvt_pk_bf16(hv[6], hv[7]);
                    *(u32x4*)rowp = w; } }
    }
};
template <class Epi, class Sched, bool ALIGN_EPI = false, bool SP2 = false, bool FP8 = false, bool INT8 = false>
__device__ __forceinline__ void gemm_phase(PG8_LAS unsigned char* lds, const Gemm g, const Sched& S, const Epi& E) {
    int tid_ = threadIdx.x; asm volatile("" : "+v"(tid_));
    const int tid = tid_, wid = __builtin_amdgcn_readfirstlane(tid >> 6), lane = tid & 63, wr = wid >> 2, wc = wid & 3, fr = lane & 15, fq = lane >> 4;
    const int K = g.K, nt = K / BK;
    unsigned voffA[2], voffB[2];
#pragma unroll
    for (int i = 0; i < 2; ++i) { int R, C; if constexpr (FP8) stage_rc8(tid * 16 + i * 8192, R, C); else stage_rc(tid * 16 + i * 8192, R, C); const int Rb = Epi::PERM ? ((R & ~31) + perm32(R & 31)) : R;
        voffA[i] = (unsigned)(R * K + C) * 2u; voffB[i] = (unsigned)(Rb * K + C) * 2u; }
    const size_t r64step = (size_t)64 * K * 2;
    const size_t kstep = (size_t)(BK * 2);
    const size_t hstep = (size_t)HALF * K * 2;
    const size_t tstep = 2 * hstep;
    const unsigned ldsw = (unsigned)wid * 1024u;
    const int aoff = FP8 ? lds_byte8(wr * 64 + fr, 2 * fq) : lds_byte(wr * 64 + fr, fq * 8), boff = FP8 ? lds_byte8(wc * 32 + fr, 2 * fq) : lds_byte(wc * 32 + fr, fq * 8);
    const int aoff1 = FP8 ? lds_byte8(wr * 64 + fr, 2 * fq + 1) : 0, boff1 = FP8 ? lds_byte8(wc * 32 + fr, 2 * fq + 1) : 0;
#define PG8_SA(b, h) (((b) * 2 + (h)) * HTB)
#define PG8_SB(b, h) ((4 + (b) * 2 + (h)) * HTB)
#define PG8_STAGE(bufoff, gbase, voff) do { _Pragma("unroll") for (int _i = 0; _i < 2; ++_i) { const char* _gb = (const char*)(gbase) + (size_t)_i * r64step; asm volatile("" : "+s"(_gb));     \
        __builtin_amdgcn_global_load_lds((const unsigned*)(_gb + (voff)[0]), (PG8_LAS unsigned*)(lds + (bufoff) + ldsw + _i * 8192), 16, 0, 0); } } while (0)
#define PG8_LD8(p_, q_) __builtin_shufflevector(*(const PG8_LAS v4i32*)(p_), *(const PG8_LAS v4i32*)(q_), 0, 1, 2, 3, 4, 5, 6, 7)
#define PG8_LDA(dst, b, h) do { if constexpr (FP8) { _Pragma("unroll") for (int m = 0; m < 4; ++m) dst##8[m] = PG8_LD8(lds + PG8_SA(b, h) + aoff + m * 2048, lds + PG8_SA(b, h) + aoff1 + m * 2048); } \
        else { _Pragma("unroll") for (int m = 0; m < 4; ++m) _Pragma("unroll") for (int k = 0; k < 2; ++k) dst[m][k] = *(const PG8_LAS bf16x8*)(lds + PG8_SA(b, h) + aoff + m * 2048 + k * 1024); } } while (0)
#define PG8_LDB(dst, b, h) do { if constexpr (FP8) { _Pragma("unroll") for (int n = 0; n < 2; ++n) dst##8[n] = PG8_LD8(lds + PG8_SB(b, h) + boff + n * 2048, lds + PG8_SB(b, h) + boff1 + n * 2048); } \
        else { _Pragma("unroll") for (int n = 0; n < 2; ++n) _Pragma("unroll") for (int k = 0; k < 2; ++k) dst[n][k] = *(const PG8_LAS bf16x8*)(lds + PG8_SB(b, h) + boff + n * 2048 + k * 1024); } } while (0)
#define PG8_MMA(ai, bj, At, Bt) do { __builtin_amdgcn_s_setprio(1); if constexpr (FP8) { _Pragma("unroll") for (int m = 0; m < 4; ++m) _Pragma("unroll") for (int n = 0; n < 2; ++n) \
            acc[ai][bj][m][n] = __builtin_amdgcn_mfma_scale_f32_16x16x128_f8f6f4(Bt##8[n], At##8[m], acc[ai][bj][m][n], 0, 0, 0, g.sw, 0, g.sx); } \
        else if constexpr (INT8) { _Pragma("unroll") for (int m = 0; m < 4; ++m) _Pragma("unroll") for (int n = 0; n < 2; ++n) _Pragma("unroll") for (int k = 0; k < 2; ++k) \
        acc[ai][bj][m][n] = __builtin_bit_cast(f32x4, __builtin_amdgcn_mfma_i32_16x16x64_i8(__builtin_bit_cast(v4i32, Bt[n][k]), __builtin_bit_cast(v4i32, At[m][k]), __builtin_bit_cast(v4i32, acc[ai][bj][m][n]), 0, 0, 0)); }   \
        else { _Pragma("unroll") for (int m = 0; m < 4; ++m) _Pragma("unroll") for (int n = 0; n < 2; ++n) _Pragma("unroll") for (int k = 0; k < 2; ++k) \
        acc[ai][bj][m][n] = __builtin_amdgcn_mfma_f32_16x16x32_bf16(Bt[n][k], At[m][k], acc[ai][bj][m][n], 0, 0, 0); } __builtin_amdgcn_s_setprio(0); } while (0)
#define PG8_WAIT_V(n) asm volatile("s_waitcnt vmcnt(" #n ")" ::: "memory")
#define PG8_WAIT_L(n) asm volatile("s_waitcnt lgkmcnt(" #n ")" ::: "memory")
#define PG8_BAR __builtin_amdgcn_s_barrier()
#define PG8_SCHED __builtin_amdgcn_sched_barrier(0)
    Unit cur, nxt; int ui = 0;
    if (!S.next(0, cur)) return;
    f32x4 acc[2][2][4][2];
#pragma unroll
    for (int a = 0; a < 2; ++a)
#pragma unroll
        for (int b = 0; b < 2; ++b)
#pragma unroll
            for (int m = 0; m < 4; ++m)
#pragma unroll
                for (int n = 0; n < 2; ++n) acc[a][b][m][n] = (f32x4){0.f, 0.f, 0.f, 0.f};
    bf16x8 At[4][2], B0[2][2], B1[2][2]; v8i32 At8[4], B08[2], B18[2];
    const char* cA = (const char*)g.A + (size_t)cur.pm * tstep; const char* cB = (const char*)g.Bt + (size_t)cur.pn * tstep;
    S.a_ready(cur);
    if constexpr (SP2) {
        PG8_STAGE(PG8_SB(0, 0), cB, voffB); PG8_STAGE(PG8_SB(0, 1), cB + hstep, voffB); PG8_STAGE(PG8_SA(0, 0), cA, voffA); PG8_STAGE(PG8_SA(0, 1), cA + hstep, voffA);
        if (wr == 1) PG8_BAR;
        PG8_WAIT_V(2); PG8_BAR;
        PG8_STAGE(PG8_SB(1, 0), cB + kstep, voffB); PG8_STAGE(PG8_SA(1, 0), cA + kstep, voffA); PG8_STAGE(PG8_SB(1, 1), cB + hstep + kstep, voffB);
        PG8_WAIT_V(6); PG8_BAR;
    } else {
        PG8_STAGE(PG8_SB(0, 0), cB, voffB); PG8_STAGE(PG8_SA(0, 0), cA, voffA); PG8_STAGE(PG8_SB(0, 1), cB + hstep, voffB); PG8_STAGE(PG8_SA(0, 1), cA + hstep, voffA);
        if (wr == 1) PG8_BAR;
        PG8_WAIT_V(4); PG8_BAR;
        PG8_STAGE(PG8_SB(1, 0), cB + kstep, voffB); PG8_STAGE(PG8_SA(1, 0), cA + kstep, voffA); PG8_STAGE(PG8_SB(1, 1), cB + hstep + kstep, voffB);
        PG8_WAIT_V(6); PG8_BAR;
    }
    for (;;) {
        const bool has_next = S.next(ui + 1, nxt);
        const char* nA = has_next ? (const char*)g.A + (size_t)nxt.pm * tstep : cA; const char* nB = has_next ? (const char*)g.Bt + (size_t)nxt.pn * tstep : cB;
        for (int t = 0; t < nt; t += 2) {
            const bool last = (t == nt - 2);
            const char* a1 = cA + (size_t)(t + 1) * kstep;
            const char* a2 = last ? nA : cA + (size_t)(t + 2) * kstep; const char* b2 = last ? nB : cB + (size_t)(t + 2) * kstep;
            const char* a3 = a2 + kstep; const char* b3 = b2 + kstep;
            if (last && has_next) S.a_ready(nxt);
            if constexpr (SP2) {
            PG8_LDB(B0, 0, 0); PG8_LDB(B1, 0, 1); PG8_SCHED; PG8_LDA(At, 0, 0); PG8_STAGE(PG8_SA(1, 1), a1 + hstep, voffA);
            PG8_WAIT_V(8); PG8_WAIT_L(0); PG8_BAR; PG8_MMA(0, 0, At, B0); PG8_MMA(0, 1, At, B1); PG8_BAR; PG8_SCHED;
            PG8_LDA(At, 0, 1); PG8_STAGE(PG8_SB(0, 0), b2, voffB); PG8_STAGE(PG8_SB(0, 1), b2 + hstep, voffB); PG8_STAGE(PG8_SA(0, 0), a2, voffA);
            PG8_WAIT_V(8); PG8_WAIT_L(0); PG8_BAR; PG8_MMA(1, 0, At, B0); PG8_MMA(1, 1, At, B1); PG8_BAR; PG8_SCHED;
            PG8_LDB(B0, 1, 0); PG8_LDB(B1, 1, 1); PG8_SCHED; PG8_LDA(At, 1, 0); PG8_STAGE(PG8_SA(0, 1), a2 + hstep, voffA);
            PG8_WAIT_V(8); PG8_WAIT_L(0); PG8_BAR; PG8_MMA(0, 0, At, B0); PG8_MMA(0, 1, At, B1); PG8_BAR; PG8_SCHED;
            PG8_LDA(At, 1, 1); PG8_STAGE(PG8_SB(1, 0), b3, voffB); PG8_STAGE(PG8_SB(1, 1), b3 + hstep, voffB); PG8_STAGE(PG8_SA(1, 0), a3, voffA);
            PG8_WAIT_V(8); PG8_WAIT_L(0); PG8_BAR; PG8_MMA(1, 0, At, B0); PG8_MMA(1, 1, At, B1); PG8_BAR; PG8_SCHED;
            } else {
            PG8_LDB(B0, 0, 0); PG8_SCHED; PG8_LDA(At, 0, 0); PG8_STAGE(PG8_SA(1, 1), a1 + hstep, voffA);
            PG8_WAIT_L(8); PG8_BAR; PG8_WAIT_L(0); PG8_MMA(0, 0, At, B0); PG8_BAR; PG8_SCHED;
            PG8_LDB(B1, 0, 1); PG8_STAGE(PG8_SB(0, 0), b2, voffB);
            PG8_BAR; PG8_WAIT_L(0); PG8_MMA(0, 1, At, B1); PG8_BAR;
            PG8_LDA(At, 0, 1); PG8_STAGE(PG8_SA(0, 0), a2, voffA);
            PG8_BAR; PG8_WAIT_L(0); PG8_MMA(1, 0, At, B0); PG8_BAR; PG8_SCHED;
            PG8_STAGE(PG8_SB(0, 1), b2 + hstep, voffB);
            PG8_WAIT_V(6); PG8_BAR; PG8_MMA(1, 1, At, B1); PG8_BAR;
            PG8_LDB(B0, 1, 0); PG8_SCHED; PG8_LDA(At, 1, 0); PG8_STAGE(PG8_SA(0, 1), a2 + hstep, voffA);
            PG8_WAIT_L(8); PG8_BAR; PG8_WAIT_L(0); PG8_MMA(0, 0, At, B0); PG8_BAR; PG8_SCHED;
            PG8_LDB(B1, 1, 1); PG8_STAGE(PG8_SB(1, 0), b3, voffB);
            PG8_BAR; PG8_WAIT_L(0); PG8_MMA(0, 1, At, B1); PG8_BAR;
            PG8_LDA(At, 1, 1); PG8_STAGE(PG8_SA(1, 0), a3, voffA);
            PG8_BAR; PG8_WAIT_L(0); PG8_MMA(1, 0, At, B0); PG8_BAR; PG8_SCHED;
            PG8_STAGE(PG8_SB(1, 1), b3 + hstep, voffB);
            PG8_WAIT_V(6); PG8_BAR; PG8_MMA(1, 1, At, B1); PG8_BAR;
            }
        }
        if constexpr (ALIGN_EPI) { if (wr == 0) PG8_BAR; }
        if constexpr (!Epi::AFTER_DRAIN) { int t2_ = threadIdx.x; asm volatile("" : "+v"(t2_)); const int fr_ = t2_ & 15, fq_ = (t2_ & 63) >> 4;
            E(acc, cur, wr, wc, fr_, fq_); S.done(cur); }
        if (!has_next) break;
#pragma unroll
        for (int a = 0; a < 2; ++a)
#pragma unroll
            for (int b = 0; b < 2; ++b)
#pragma unroll
                for (int m = 0; m < 4; ++m)
#pragma unroll
                    for (int n = 0; n < 2; ++n) acc[a][b][m][n] = (f32x4){0.f, 0.f, 0.f, 0.f};
        cur = nxt; cA = nA; cB = nB; ++ui;
        if constexpr (ALIGN_EPI) { if (wr == 1) PG8_BAR; }
    }
    PG8_WAIT_V(0);
    if constexpr (!ALIGN_EPI) { if (wr == 0) PG8_BAR; }
    PG8_BAR;
    if constexpr (Epi::AFTER_DRAIN) { E.fused(acc, cur, wr, wc, fr, fq, lds, wid, lane); S.done(cur); }
#undef PG8_SA
#undef PG8_SB
#undef PG8_STAGE
#undef PG8_LD8
#undef PG8_LDA
#undef PG8_LDB
#undef PG8_MMA
#undef PG8_WAIT_V
#undef PG8_WAIT_L
#undef PG8_BAR
#undef PG8_SCHED
}
}

#ifndef FP8_DOWN_LAYER
#define FP8_DOWN_LAYER 0
#endif
#ifndef PROBE_MASK
#define PROBE_MASK 0
#endif
#ifndef EN_INPROJ
#define EN_INPROJ 1
#endif
#ifndef EN_GATE
#define EN_GATE 1
#endif
#ifndef EN_RESID
#define EN_RESID 1
#endif
#ifndef EN_SWIGLU
#define EN_SWIGLU 1
#endif
#ifndef EN_ATTN
#define EN_ATTN 1
#endif
#ifndef EN_PRO
#define EN_PRO 1
#endif
#define LAS __attribute__((address_space(3)))
typedef unsigned short bf16;
typedef short bf16x8 __attribute__((ext_vector_type(8)));
typedef short s16x4 __attribute__((ext_vector_type(4)));
typedef float f32x4 __attribute__((ext_vector_type(4)));
typedef float f32x16 __attribute__((ext_vector_type(16)));
typedef unsigned u32x4 __attribute__((ext_vector_type(4)));
typedef unsigned u32x2 __attribute__((ext_vector_type(2)));

constexpr int T = 32768, TH = 16384, D = 2048, CIN = 10240, DFF = 5632, NUP = 11264, SEQ = 16384;
constexpr int NWAVES = 8, NTHREADS = 512;
constexpr float ALPHA = 1.41421356237309515f;
constexpr float LN_EPS = 1e-5f;
constexpr float LOG2E = 1.4426950408889634f;
constexpr int LDS_BYTES = 163840, LDS_BARST = 163824;
constexpr int NPHASES = 27;

constexpr size_t MiB = (size_t)1 << 20;
constexpr size_t WS_TAB = 0;
constexpr size_t WS_BAR = 256 * 1024;
constexpr size_t WS_CMAX = 512 * 1024;
constexpr size_t WS_CMAXI = WS_CMAX + 2 * 11264 * 4;
constexpr size_t WS_W0 = 1 * MiB, WS_WL = 120 * MiB;
constexpr size_t WO_IN = 0, WO_PA = WO_IN + (size_t)CIN * D, WO_PB = WO_PA + (size_t)D * 512, WO_OUT = WO_PB + (size_t)D * 1024, WO_UP = WO_OUT + (size_t)D * D,
                 WO_DN = WO_UP + (size_t)NUP * D, WO_END = WO_DN + (size_t)D * DFF;
static_assert(WO_END * 2 <= WS_WL, "weight block");
constexpr size_t WS_XB = 241 * MiB;
constexpr size_t WS_PROJ = 369 * MiB;
constexpr size_t WS_AR = 689 * MiB;
constexpr size_t WS_LSE = 737 * MiB;
constexpr size_t WS_AO = 738 * MiB;
constexpr size_t WS_BO = 754 * MiB;
constexpr size_t WS_H = 369 * MiB;
constexpr size_t WS_X8 = 800 * MiB;
constexpr size_t WS_ST = 864 * MiB;
constexpr size_t WS_RS = 864 * MiB + 512 * 1024;
constexpr size_t WS_G8 = 866 * MiB;
constexpr size_t WS_END = 930 * MiB;

struct Params;
typedef const __attribute__((address_space(4))) Params* PP;
struct Params {
    const float* x; const float* rel_bias; const float* w_in; const float* sink; const float* w_pa; const float* w_pb; const float* w_out;
    const float* ln1_g; const float* ln1_b; const float* w_up; const float* w_down; const float* ln2_g; const float* ln2_b;
    float* out; unsigned char* ws; int ph_lo, ph_hi;
};

__device__ __forceinline__ unsigned pk2(float a, float b) { return pg8::cvt_pk_bf16(a, b); }
__device__ __forceinline__ float shx(float v, int o, int lane) { return __int_as_float(__builtin_amdgcn_ds_bpermute((lane ^ o) << 2, __float_as_int(v))); }
__device__ __forceinline__ float wave_sum(float v, int lane) {
#pragma unroll
    for (int o = 1; o < 64; o <<= 1) v += shx(v, o, lane);
    return v;
}
#define LDS_WAIT() asm volatile("s_waitcnt lgkmcnt(0)" ::: "memory")

#define XB_TMO      128
#define XB_XCNT(j)  (256  + 64 * (j))
#define XB_XSUB(j)  (1280 + 64 * (j))
#define XB_XGEN(j)  (2304 + 64 * (j))
#define XB_TOP      3328
#define XB_TOPGEN   3392
#define XCD_BAR_WORDS 3456
#define XB_SPIN_CAP (1u << 18)

__device__ __forceinline__ unsigned xb_ld(unsigned* p)              { return __hip_atomic_load(p, __ATOMIC_RELAXED, __HIP_MEMORY_SCOPE_AGENT); }
__device__ __forceinline__ unsigned xb_add(unsigned* p, unsigned v) { return __hip_atomic_fetch_add(p, v, __ATOMIC_RELAXED, __HIP_MEMORY_SCOPE_AGENT); }
__device__ __forceinline__ unsigned xb_xcc_id() { return (unsigned)__builtin_amdgcn_s_getreg((3 << 11) | 20) & 0xFu; }
#define XB_SPIN(cond, bar) do { unsigned _sp = 0; while (cond) { __builtin_amdgcn_s_sleep(1); \
    if ((++_sp & 255u) == 0u) { if (xb_ld(&(bar)[XB_TMO])) break; if (_sp > XB_SPIN_CAP) { atomicAdd(&(bar)[XB_TMO], 1u); break; } } } } while (0)

struct XcdBarrier {
    unsigned* bar; unsigned x;
    volatile LAS unsigned* st;
};

__device__ __forceinline__ XcdBarrier xcd_barrier_post(unsigned* bar, volatile LAS unsigned* st) {
    XcdBarrier b; b.bar = bar; b.x = xb_xcc_id(); b.st = st;
    if (threadIdx.x == 0) (void)xb_add(&bar[XB_XCNT(b.x)], 1u);
    return b;
}
__device__ __forceinline__ void xcd_barrier_complete(unsigned* bar, unsigned x, unsigned& nloc, unsigned& nx) {
    const unsigned G = gridDim.x * gridDim.y * gridDim.z;
    unsigned sum, cnt, mine, sp = 0u;
    for (;;) {
        sum = 0u; cnt = 0u; mine = 0u;
#pragma unroll
        for (unsigned j = 0; j < 16; ++j) { const unsigned c = xb_ld(&bar[XB_XCNT(j)]); sum += c; cnt += (c > 0u) ? 1u : 0u; mine = (j == x) ? c : mine; }
        if (sum == G) break;
        __builtin_amdgcn_s_sleep(1);
        if ((++sp & 255u) == 0u) { if (xb_ld(&bar[XB_TMO])) break; if (sp > XB_SPIN_CAP) { atomicAdd(&bar[XB_TMO], 1u); break; } }
    }
    nloc = mine > 0u ? mine : 1u; nx = cnt > 0u ? cnt : 1u;
}

__device__ __forceinline__ void xcd_barrier(const XcdBarrier& b) {
    asm volatile("s_waitcnt vmcnt(0)" ::: "memory");
    __syncthreads();
    if (threadIdx.x == 0) {
        unsigned* bar = b.bar;
        __builtin_amdgcn_s_waitcnt(0);
        unsigned nloc = b.st[0], nx = b.st[1];
        if (nloc == 0u) { xcd_barrier_complete(bar, b.x, nloc, nx); b.st[0] = nloc; b.st[1] = nx; }
        const unsigned old = xb_add(&bar[XB_XSUB(b.x)], 1u);
        const unsigned gen = old / nloc;
        if (old + 1u == (gen + 1u) * nloc) {
            __builtin_amdgcn_fence(__ATOMIC_RELEASE, "agent");
            asm volatile("s_waitcnt vmcnt(0)" ::: "memory");
            const unsigned og = xb_add(&bar[XB_TOP], 1u);
            const unsigned tg = og / nx;
            if (og + 1u == (tg + 1u) * nx) xb_add(&bar[XB_TOPGEN], 1u);
            else XB_SPIN(xb_ld(&bar[XB_TOPGEN]) == tg, bar);
            __builtin_amdgcn_fence(__ATOMIC_ACQUIRE, "agent");
            xb_add(&bar[XB_XGEN(b.x)], 1u);
            asm volatile("s_waitcnt vmcnt(0)" ::: "memory");
        } else {
            XB_SPIN(xb_ld(&bar[XB_XGEN(b.x)]) == gen, bar);
            __builtin_amdgcn_fence(__ATOMIC_ACQUIRE, "agent");
            asm volatile("s_waitcnt vmcnt(0)" ::: "memory");
        }
    }
    __syncthreads();
}


__device__ __forceinline__ void transpose_item(const float* __restrict__ W, int K, int N, bf16* WT, int k0, int n0, int row0, LAS float* scr, int lane) {
    { f32x4 tv[8];
#pragma unroll
      for (int i = 0; i < 8; ++i) tv[i] = *(const f32x4*)(W + (size_t)(k0 + 8 * i + (lane >> 3)) * N + n0 + 4 * (lane & 7));
#pragma unroll
      for (int i = 0; i < 8; ++i) { LAS float* d_ = scr + (8 * i + (lane >> 3)) * 33 + 4 * (lane & 7); d_[0] = tv[i][0]; d_[1] = tv[i][1]; d_[2] = tv[i][2]; d_[3] = tv[i][3]; } }
    LDS_WAIT();
    const int c = lane & 7;
#pragma unroll
    for (int j = 0; j < 4; ++j) { const int n = (lane >> 3) + 8 * j; const LAS float* s = scr + (8 * c) * 33 + n;
        u32x4 o; o.x = pk2(s[0 * 33], s[1 * 33]); o.y = pk2(s[2 * 33], s[3 * 33]); o.z = pk2(s[4 * 33], s[5 * 33]); o.w = pk2(s[6 * 33], s[7 * 33]);
        *(u32x4*)(WT + (size_t)(row0 + n) * K + k0 + 8 * c) = o; }
    LDS_WAIT();
}
using pg8::pk4_fp8;
__device__ __forceinline__ void transpose_item_fp8(const float* __restrict__ W, int K, int N, unsigned char* WT, int k0, int n0, LAS float* scr, int lane, float scale) {
    { f32x4 tv[8];
#pragma unroll
      for (int i = 0; i < 8; ++i) tv[i] = *(const f32x4*)(W + (size_t)(k0 + 8 * i + (lane >> 3)) * N + n0 + 4 * (lane & 7));
#pragma unroll
      for (int i = 0; i < 8; ++i) { LAS float* d_ = scr + (8 * i + (lane >> 3)) * 33 + 4 * (lane & 7); d_[0] = tv[i][0]; d_[1] = tv[i][1]; d_[2] = tv[i][2]; d_[3] = tv[i][3]; } }
    LDS_WAIT();
    const int n = lane >> 1, kh = lane & 1; const LAS float* sp = scr + (32 * kh) * 33 + n;
    u32x4 o0, o1;
    o0.x = pk4_fp8(sp[0 * 33] * scale, sp[1 * 33] * scale, sp[2 * 33] * scale, sp[3 * 33] * scale); o0.y = pk4_fp8(sp[4 * 33] * scale, sp[5 * 33] * scale, sp[6 * 33] * scale, sp[7 * 33] * scale);
    o0.z = pk4_fp8(sp[8 * 33] * scale, sp[9 * 33] * scale, sp[10 * 33] * scale, sp[11 * 33] * scale); o0.w = pk4_fp8(sp[12 * 33] * scale, sp[13 * 33] * scale, sp[14 * 33] * scale, sp[15 * 33] * scale);
    o1.x = pk4_fp8(sp[16 * 33] * scale, sp[17 * 33] * scale, sp[18 * 33] * scale, sp[19 * 33] * scale); o1.y = pk4_fp8(sp[20 * 33] * scale, sp[21 * 33] * scale, sp[22 * 33] * scale, sp[23 * 33] * scale);
    o1.z = pk4_fp8(sp[24 * 33] * scale, sp[25 * 33] * scale, sp[26 * 33] * scale, sp[27 * 33] * scale); o1.w = pk4_fp8(sp[28 * 33] * scale, sp[29 * 33] * scale, sp[30 * 33] * scale, sp[31 * 33] * scale);
    unsigned char* dst = WT + (size_t)(n0 + n) * K + k0 + 32 * kh;
    *(u32x4*)dst = o0; *(u32x4*)(dst + 16) = o1;
    LDS_WAIT();
}
__device__ __forceinline__ int t5_bucket(int rel) {
    const int n = rel < 0 ? -rel : rel; int b;
    if (n < 8) b = n; else { const int e = (int)(__builtin_log2f((float)n * 0.125f) * (8.0f / 7.0f)); b = 8 + e; if (b > 15) b = 15; }
    return b + (rel > 0 ? 16 : 0);
}
__device__ __forceinline__ void phase_prologue(PP pp, LAS unsigned char* lds, int gw, int NGW, int wave, int lane) {
    LAS float* scr = (LAS float*)(lds + wave * 16384);
    {
        const int vcu_ = gw / NWAVES, G_ = NGW / NWAVES;
        constexpr int CB_UP = NUP / 32, CB_IN = 0, CB_L = CB_UP + CB_IN;
        LAS float* cmt = (LAS float*)(lds + 135168);
        for (int cb = vcu_; cb < 2 * CB_L; cb += G_) {
            const int l = cb / CB_L; int r = cb - l * CB_L; const bool win = r >= CB_UP; if (win) r -= CB_UP;
            const int N = win ? CIN : NUP, n0 = 32 * r;
            const int j0 = n0 < DFF ? n0 : n0 - DFF, row0 = win ? n0 : (j0 >> 7) * 256 + (n0 < DFF ? 0 : 128) + (j0 & 127);
            const float* W = win ? pp->w_in + (size_t)l * D * CIN : pp->w_up + (size_t)l * D * NUP;
            unsigned char* WT = (unsigned char*)((bf16*)(pp->ws + WS_W0 + (size_t)l * WS_WL) + (win ? WO_IN : WO_UP));
            float* cmg = win ? (float*)(pp->ws + WS_CMAXI) + l * CIN + row0 : (float*)(pp->ws + WS_CMAX) + l * NUP + row0;
            f32x4 tv[4][8]; f32x4 mx = {0.f, 0.f, 0.f, 0.f};
#pragma unroll
            for (int q = 0; q < 4; ++q)
#pragma unroll
                for (int i = 0; i < 8; ++i) tv[q][i] = *(const f32x4*)(W + (size_t)((wave * 4 + q) * 64 + 8 * i + (lane >> 3)) * N + n0 + 4 * (lane & 7));
#pragma unroll
            for (int q = 0; q < 4; ++q)
#pragma unroll
                for (int i = 0; i < 8; ++i) { mx[0] = fmaxf(mx[0], fabsf(tv[q][i][0])); mx[1] = fmaxf(mx[1], fabsf(tv[q][i][1])); mx[2] = fmaxf(mx[2], fabsf(tv[q][i][2])); mx[3] = fmaxf(mx[3], fabsf(tv[q][i][3])); }
#pragma unroll
            for (int o = 8; o < 64; o <<= 1) { mx[0] = fmaxf(mx[0], shx(mx[0], o, lane)); mx[1] = fmaxf(mx[1], shx(mx[1], o, lane)); mx[2] = fmaxf(mx[2], shx(mx[2], o, lane)); mx[3] = fmaxf(mx[3], shx(mx[3], o, lane)); }
            if (lane < 8) *(LAS f32x4*)(cmt + wave * 32 + 4 * lane) = mx;
            __syncthreads();
            f32x4 cm = *(const LAS f32x4*)(cmt + 4 * (lane & 7));
#pragma unroll
            for (int w2 = 1; w2 < 8; ++w2) { const f32x4 t = *(const LAS f32x4*)(cmt + w2 * 32 + 4 * (lane & 7)); cm[0] = fmaxf(cm[0], t[0]); cm[1] = fmaxf(cm[1], t[1]); cm[2] = fmaxf(cm[2], t[2]); cm[3] = fmaxf(cm[3], t[3]); }
            if (wave == 0 && lane < 8) *(f32x4*)(cmg + 4 * lane) = cm;
            f32x4 inv;
#pragma unroll
            for (int j = 0; j < 4; ++j) inv[j] = cm[j] > 0.f ? 127.0f / cm[j] : 0.f;
#pragma unroll
            for (int q = 0; q < 4; ++q) {
                const int k0 = (wave * 4 + q) * 64;
#pragma unroll
                for (int i = 0; i < 8; ++i) { LAS float* d_ = scr + (8 * i + (lane >> 3)) * 33 + 4 * (lane & 7); d_[0] = tv[q][i][0] * inv[0]; d_[1] = tv[q][i][1] * inv[1]; d_[2] = tv[q][i][2] * inv[2]; d_[3] = tv[q][i][3] * inv[3]; }
                LDS_WAIT();
                const int n = lane >> 1, kh = lane & 1; const LAS float* sp = scr + (32 * kh) * 33 + n;
                unsigned w[8];
#pragma unroll
                for (int u = 0; u < 8; ++u) { const int a = (int)__builtin_rintf(sp[(4 * u) * 33]), b = (int)__builtin_rintf(sp[(4 * u + 1) * 33]), c = (int)__builtin_rintf(sp[(4 * u + 2) * 33]), d = (int)__builtin_rintf(sp[(4 * u + 3) * 33]);
                    w[u] = ((unsigned)a & 255u) | (((unsigned)b & 255u) << 8) | (((unsigned)c & 255u) << 16) | ((unsigned)d << 24); }
                unsigned char* dst = WT + (size_t)(row0 + n) * D + k0 + 32 * kh;
                u32x4 o0, o1; o0.x = w[0]; o0.y = w[1]; o0.z = w[2]; o0.w = w[3]; o1.x = w[4]; o1.y = w[5]; o1.z = w[6]; o1.w = w[7];
                *(u32x4*)dst = o0; *(u32x4*)(dst + 16) = o1;
                LDS_WAIT();
            }
            __syncthreads();
        }
    }
    constexpr int I_IN = (D / 64) * (CIN / 32), I_PA = (512 / 64) * (D / 32), I_PB = (1024 / 64) * (D / 32), I_OUT = (D / 64) * (D / 32), I_UP = (D / 64) * (NUP / 32), I_DN = (DFF / 64) * (D / 32);
    constexpr int I_LAYER = I_IN + I_PA + I_PB + I_OUT + I_UP + I_DN;
    for (int it = gw; it < 2 * I_LAYER; it += NGW) {
        const int l = it / I_LAYER; int r = it - l * I_LAYER;
        bf16* wl = (bf16*)(pp->ws + WS_W0 + (size_t)l * WS_WL);
        const float* W; int K, N; bf16* WT; bool up = false, r0_in = false, dn8 = false;
        if (r < I_IN) { W = pp->w_in + (size_t)l * D * CIN; K = D; N = CIN; WT = wl + WO_IN; r0_in = true; }
        else if ((r -= I_IN) < I_PA) { r0_in = true; W = pp->w_pa + (size_t)l * 512 * D; K = 512; N = D; WT = wl + WO_PA; }
        else if ((r -= I_PA) < I_PB) { r0_in = true; W = pp->w_pb + (size_t)l * 1024 * D; K = 1024; N = D; WT = wl + WO_PB; }
        else if ((r -= I_PB) < I_OUT) { r0_in = true; W = pp->w_out + (size_t)l * D * D; K = D; N = D; WT = wl + WO_OUT; }
        else if ((r -= I_OUT) < I_UP) { W = pp->w_up + (size_t)l * D * NUP; K = D; N = NUP; WT = wl + WO_UP; up = true; }
        else { r -= I_UP; W = pp->w_down + (size_t)l * DFF * D; K = DFF; N = D; WT = wl + WO_DN; dn8 = (l == FP8_DOWN_LAYER); }
        const int nblk = N / 32, kb = r / nblk, nb = r - kb * nblk, n0 = 32 * nb;
        int row0 = n0;
        if (up) { const int j0 = n0 < DFF ? n0 : n0 - DFF; row0 = (j0 >> 7) * 256 + (n0 < DFF ? 0 : 128) + (j0 & 127); }
        if (r0_in) transpose_item_fp8(W, K, N, (unsigned char*)WT, 64 * kb, n0, scr, lane, 128.0f);
        else if (dn8) transpose_item_fp8(W, K, N, (unsigned char*)WT, 64 * kb, n0, scr, lane, 256.0f);
        else if (up) { }
        else transpose_item(W, K, N, WT, 64 * kb, n0, row0, scr, lane);
    }
    { const size_t gt = (size_t)gw * 64 + lane, NT = (size_t)NGW * 64; unsigned char* x8 = pp->ws + WS_X8;
      for (size_t i = gt; i < (size_t)T * D / 16; i += NT) { const f32x4 a = *(const f32x4*)(pp->x + i * 16) * 32.f, b = *(const f32x4*)(pp->x + i * 16 + 4) * 32.f, c = *(const f32x4*)(pp->x + i * 16 + 8) * 32.f, d = *(const f32x4*)(pp->x + i * 16 + 12) * 32.f;
          u32x4 o; o.x = pk4_fp8(a[0], a[1], a[2], a[3]); o.y = pk4_fp8(b[0], b[1], b[2], b[3]); o.z = pk4_fp8(c[0], c[1], c[2], c[3]); o.w = pk4_fp8(d[0], d[1], d[2], d[3]); *(u32x4*)(x8 + i * 16) = o; } }
    if (blockIdx.x == 0) { unsigned* barw = (unsigned*)(pp->ws + WS_BAR); for (int i = threadIdx.x; i < XCD_BAR_WORDS; i += NTHREADS) barw[i] = 0u; }
    { float* tabA = (float*)(pp->ws + WS_TAB); float* tabB = (float*)(pp->ws + WS_TAB + 8192);
      const int gt = gw * 64 + lane;
      if (gt < 12 * 129) { const int hh = gt / 129, i = gt - hh * 129, g = hh >> 2, dil = g == 0 ? 1 : (g == 1 ? 4 : 16); tabA[hh * 132 + i] = pp->rel_bias[t5_bucket((i - 64) * dil) * 20 + hh] * LOG2E; }
      else if (gt < 12 * 129 + 8 * 257) { const int q = gt - 12 * 129, hh = q / 257, i = q - hh * 257; tabB[hh * 260 + i] = pp->rel_bias[t5_bucket(i - 128) * 20 + 12 + hh] * LOG2E; } }
}

constexpr int AT_KS = 0, AT_VS = 8704, AT_TAB = 8704 + 10240, AT_WAVE_BYTES = 8704 + 10240 + 1296;
static_assert(AT_WAVE_BYTES * NWAVES <= LDS_BYTES, "attention LDS");
#define TR4(r0, r1, r2, r3, base, o0, o1, o2, o3) asm volatile("ds_read_b64_tr_b16 %0, %4 offset:%5\n\tds_read_b64_tr_b16 %1, %4 offset:%6\n\tds_read_b64_tr_b16 %2, %4 offset:%7\n\tds_read_b64_tr_b16 %3, %4 offset:%8\n\ts_waitcnt lgkmcnt(0)" \
    : "=&v"(r0), "=&v"(r1), "=&v"(r2), "=&v"(r3) : "v"(base), "i"(o0), "i"(o1), "i"(o2), "i"(o3) : "memory")
#define PK8(L, Hh) (bf16x8){L[0], L[1], L[2], L[3], Hh[0], Hh[1], Hh[2], Hh[3]}

struct AtItem { int qcol, kcol, vcol, r, dil, sub_len, q0, W, nkt, T0, toff, NT, o_ld, ocol, lse_idx, o8; const float* tab; float m0; int sink; unsigned char* O; float* lse; };
constexpr int AT_NA = 12 * 64, AT_NB = 2 * 256;
__device__ __forceinline__ AtItem at_decode(int i, int wave, int layer, unsigned char* ws, const float* sinkp) {
    AtItem I; const float* tabA = (const float*)(ws + WS_TAB); const float* tabB = (const float*)(ws + WS_TAB + 8192);
    if (i < AT_NA) {
        const int hh = i >> 6, idx = i & 63, g = hh >> 2;
        I.dil = g == 0 ? 1 : (g == 1 ? 4 : 16); const int nbr = 64 / I.dil; I.r = idx / nbr; const int qb = idx - I.r * nbr; I.sub_len = SEQ / I.dil;
        I.q0 = qb * 256 + 32 * wave; I.T0 = qb * 256 - 64; I.toff = wave; I.NT = 12; I.nkt = 5; I.W = 64;
        I.qcol = hh * 128; I.kcol = 1536 + hh * 128; I.vcol = 3072 + hh * 128; I.tab = tabA + hh * 132; I.m0 = -1e30f; I.sink = 0;
        I.O = ws + WS_AR; I.o_ld = 1536; I.ocol = hh * 128; I.lse = (float*)(ws + WS_LSE); I.lse_idx = hh; I.o8 = 0;
    } else {
        const int b = i - AT_NA, kvh = b >> 8, qp = b & 255, j = wave >> 2, rep = wave & 3, qh = kvh * 4 + rep;
        I.dil = 1; I.r = 0; I.sub_len = SEQ; I.q0 = qp * 64 + 32 * j; I.T0 = qp * 64 - 128; I.toff = j; I.NT = 10; I.nkt = 9; I.W = 128;
        I.qcol = 4608 + qh * 128; I.kcol = 5632 + kvh * 128; I.vcol = 5888 + kvh * 128; I.tab = tabB + qh * 260; I.m0 = sinkp[layer * 8 + qh] * LOG2E; I.sink = 1;
        I.O = ws + WS_BO; I.o_ld = 1024; I.ocol = qh * 128; I.lse = nullptr; I.lse_idx = 0; I.o8 = 1;
    }
    return I;
}
__device__ __forceinline__ void phase_attention(unsigned char* ws, const float* sinkp, LAS unsigned char* lds, int layer, int vcu, int G, int wave, int lane) {
    const bf16* P = (const bf16*)(ws + WS_PROJ);
    const int hl = lane >> 5, ql = lane & 31, lrow = lane >> 4, lch = lane & 15;
    LAS float* tabs = (LAS float*)(lds + wave * AT_WAVE_BYTES + AT_TAB);
    const float c = 0.08838834764831845f * LOG2E;
    const unsigned vlane = (unsigned)((4 * hl + ((lane & 15) >> 2)) * 320 + (16 * ((lane >> 4) & 1) + 4 * (lane & 3)) * 2);
    const int klane = ql * 272 + 16 * hl;
    const int wrow = 4 * wave + lrow;
    bf16x8 qf[8]; u32x4 kreg[8], vreg[8], kn, vn; float tv[6];
#define AT_EDGE(I, kt_) ((I.q0 - I.W + 32 * (kt_) < 0) || (I.q0 - I.W + 32 * (kt_) + 31 >= I.sub_len))
#define AT_TOFF(I, t) ({ int sub = I.T0 + 32 * (t) + wrow; sub = sub < 0 ? 0 : (sub >= I.sub_len ? I.sub_len - 1 : sub); (unsigned)(I.r + sub * I.dil) * (unsigned)(CIN * 2) + 16u * lch; })
#define AT_FILL(I) do { const char* Pk = (const char*)(P + I.kcol); const char* Pv = (const char*)(P + I.vcol); \
        _Pragma("unroll") for (int t = 0; t < 8; ++t) { const unsigned o_ = AT_TOFF(I, t); kreg[t] = *(const u32x4*)(Pk + o_); vreg[t] = *(const u32x4*)(Pv + o_); } } while (0)
#define AT_WRITEFILL() do { _Pragma("unroll") for (int t = 0; t < 8; ++t) { *(LAS u32x4*)(lds + t * AT_WAVE_BYTES + AT_KS + wrow * 272 + 16 * lch) = kreg[t]; *(LAS u32x4*)(lds + t * AT_WAVE_BYTES + AT_VS + wrow * 320 + 16 * lch) = vreg[t]; } } while (0)
#define AT_LOADQ(I) do { const bf16* qp = P + (size_t)(I.r + (I.q0 + ql) * I.dil) * CIN + I.qcol + 8 * hl; _Pragma("unroll") for (int s = 0; s < 8; ++s) qf[s] = *(const bf16x8*)(qp + 16 * s); } while (0)
#define AT_LOADTAB(I) do { _Pragma("unroll") for (int u = 0; u < 6; ++u) { const int src = lane + 64 * u - 32; const int sc_ = src < 0 ? 0 : (src > 2 * I.W ? 2 * I.W : src); tv[u] = I.tab[sc_]; } } while (0)
#define AT_STORETAB(I) do { _Pragma("unroll") for (int u = 0; u < 6; ++u) { const int i_ = lane + 64 * u, src = i_ - 32; if (i_ < 2 * I.W + 65) tabs[i_] = (src >= 0 && src <= 2 * I.W) ? tv[u] : -__builtin_inff(); } } while (0)
    constexpr int NTOT = AT_NA + AT_NB;
    int it = vcu; if (it >= NTOT) return;
    AtItem cur = at_decode(it, wave, layer, ws, sinkp);
    AT_LOADTAB(cur); AT_LOADQ(cur); AT_FILL(cur); AT_STORETAB(cur); AT_WRITEFILL();
    __syncthreads();
    for (;;) {
        const int itn = it + G; const bool has_next = itn < NTOT;
        const AtItem nxt = at_decode(has_next ? itn : it, wave, layer, ws, sinkp);
        f32x16 o0, o1, o2, o3;
#pragma unroll
        for (int i = 0; i < 16; ++i) { o0[i] = 0.f; o1[i] = 0.f; o2[i] = 0.f; o3[i] = 0.f; }
        float m = cur.m0, l = (cur.sink && lane < 32) ? 1.f : 0.f;
        const int nkt = cur.nkt;
        for (int kt = 0; kt < nkt; ++kt) {
            const bool last = (kt == nkt - 1);
            const int tn = 8 + kt; const bool newt = tn < cur.NT;
            if (newt) { const unsigned o_ = AT_TOFF(cur, tn); kn = *(const u32x4*)((const char*)(P + cur.kcol) + o_); vn = *(const u32x4*)((const char*)(P + cur.vcol) + o_); }
            const int sl = (cur.toff + kt) & 7;
            const LAS unsigned char* kb = lds + sl * AT_WAVE_BYTES + AT_KS + klane;
            const unsigned vb = (unsigned)(uintptr_t)(lds + sl * AT_WAVE_BYTES + AT_VS) + vlane;
            f32x16 sc;
#pragma unroll
            for (int i = 0; i < 16; ++i) sc[i] = 0.f;
#pragma unroll
            for (int s = 0; s < 8; ++s) { const bf16x8 kf = *(const LAS bf16x8*)(kb + 32 * s); sc = __builtin_amdgcn_mfma_f32_32x32x16_bf16(kf, qf[s], sc, 0, 0, 0); }
            if (last && has_next) AT_LOADQ(nxt);
            const LAS float* tb = tabs + (32 * kt - ql + 4 * hl + 32);
#pragma unroll
            for (int i = 0; i < 16; ++i) { sc[i] = fmaf(sc[i], c, tb[8 * (i >> 2) + (i & 3)]); }
            if (last && has_next) AT_LOADTAB(nxt);
            if (AT_EDGE(cur, kt)) {
                const int ks0 = cur.q0 - cur.W + 32 * kt + 4 * hl;
#pragma unroll
                for (int i = 0; i < 16; ++i) { const int ks = ks0 + 8 * (i >> 2) + (i & 3); if (ks < 0 || ks >= cur.sub_len) sc[i] = -__builtin_inff(); }
            }
            float tmax = -__builtin_inff();
#pragma unroll
            for (int i = 0; i < 16; ++i) tmax = fmaxf(tmax, sc[i]);
            tmax = fmaxf(tmax, shx(tmax, 32, lane));
            if (__builtin_amdgcn_ballot_w64(tmax > m + 8.0f) != 0ull) {
                const float mn = fmaxf(m, tmax), alpha = __builtin_amdgcn_exp2f(m - mn); m = mn; l *= alpha;
#pragma unroll
                for (int i = 0; i < 16; ++i) { o0[i] *= alpha; o1[i] *= alpha; o2[i] *= alpha; o3[i] *= alpha; }
            }
            float ps = 0.f;
#pragma unroll
            for (int i = 0; i < 16; ++i) { sc[i] = __builtin_amdgcn_exp2f(sc[i] - m); ps += sc[i]; }
            l += ps;
            bf16x8 p0, p1;
            { u32x4 w0, w1; w0.x = pk2(sc[0], sc[1]); w0.y = pk2(sc[2], sc[3]); w0.z = pk2(sc[4], sc[5]); w0.w = pk2(sc[6], sc[7]);
              w1.x = pk2(sc[8], sc[9]); w1.y = pk2(sc[10], sc[11]); w1.z = pk2(sc[12], sc[13]); w1.w = pk2(sc[14], sc[15]);
              p0 = *reinterpret_cast<bf16x8*>(&w0); p1 = *reinterpret_cast<bf16x8*>(&w1); }
            { s16x4 t0, t1, t2, t3, t4, t5, t6, t7, t8, t9, t10, t11, t12, t13, t14, t15;
              asm volatile("ds_read_b64_tr_b16 %0, %16 offset:0\n\tds_read_b64_tr_b16 %1, %16 offset:2560\n\tds_read_b64_tr_b16 %2, %16 offset:5120\n\tds_read_b64_tr_b16 %3, %16 offset:7680\n\t"
                           "ds_read_b64_tr_b16 %4, %16 offset:64\n\tds_read_b64_tr_b16 %5, %16 offset:2624\n\tds_read_b64_tr_b16 %6, %16 offset:5184\n\tds_read_b64_tr_b16 %7, %16 offset:7744\n\t"
                           "ds_read_b64_tr_b16 %8, %16 offset:128\n\tds_read_b64_tr_b16 %9, %16 offset:2688\n\tds_read_b64_tr_b16 %10, %16 offset:5248\n\tds_read_b64_tr_b16 %11, %16 offset:7808\n\t"
                           "ds_read_b64_tr_b16 %12, %16 offset:192\n\tds_read_b64_tr_b16 %13, %16 offset:2752\n\tds_read_b64_tr_b16 %14, %16 offset:5312\n\tds_read_b64_tr_b16 %15, %16 offset:7872\n\ts_waitcnt lgkmcnt(0)"
                           : "=&v"(t0), "=&v"(t1), "=&v"(t2), "=&v"(t3), "=&v"(t4), "=&v"(t5), "=&v"(t6), "=&v"(t7), "=&v"(t8), "=&v"(t9), "=&v"(t10), "=&v"(t11), "=&v"(t12), "=&v"(t13), "=&v"(t14), "=&v"(t15)
                           : "v"(vb) : "memory");
              __builtin_amdgcn_sched_barrier(0);
              o0 = __builtin_amdgcn_mfma_f32_32x32x16_bf16(PK8(t0, t1), p0, o0, 0, 0, 0); o1 = __builtin_amdgcn_mfma_f32_32x32x16_bf16(PK8(t4, t5), p0, o1, 0, 0, 0);
              o2 = __builtin_amdgcn_mfma_f32_32x32x16_bf16(PK8(t8, t9), p0, o2, 0, 0, 0); o3 = __builtin_amdgcn_mfma_f32_32x32x16_bf16(PK8(t12, t13), p0, o3, 0, 0, 0);
              o0 = __builtin_amdgcn_mfma_f32_32x32x16_bf16(PK8(t2, t3), p1, o0, 0, 0, 0); o1 = __builtin_amdgcn_mfma_f32_32x32x16_bf16(PK8(t6, t7), p1, o1, 0, 0, 0);
              o2 = __builtin_amdgcn_mfma_f32_32x32x16_bf16(PK8(t10, t11), p1, o2, 0, 0, 0); o3 = __builtin_amdgcn_mfma_f32_32x32x16_bf16(PK8(t14, t15), p1, o3, 0, 0, 0); }
            if (newt) {
                __syncthreads();
                *(LAS u32x4*)(lds + (tn & 7) * AT_WAVE_BYTES + AT_KS + wrow * 272 + 16 * lch) = kn; *(LAS u32x4*)(lds + (tn & 7) * AT_WAVE_BYTES + AT_VS + wrow * 320 + 16 * lch) = vn;
                __syncthreads();
            }
        }
        const float lt = l + shx(l, 32, lane), inv = 1.0f / lt;
        const size_t tok = (size_t)(cur.r + (cur.q0 + ql) * cur.dil);
        if (cur.o8) {
            unsigned char* op = cur.O + tok * cur.o_ld + cur.ocol + 4 * hl; const float i64 = inv * 64.f;
#pragma unroll
            for (int g = 0; g < 4; ++g) {
                *(unsigned*)(op + 8 * g) = pk4_fp8(o0[4 * g] * i64, o0[4 * g + 1] * i64, o0[4 * g + 2] * i64, o0[4 * g + 3] * i64);
                *(unsigned*)(op + 32 + 8 * g) = pk4_fp8(o1[4 * g] * i64, o1[4 * g + 1] * i64, o1[4 * g + 2] * i64, o1[4 * g + 3] * i64);
                *(unsigned*)(op + 64 + 8 * g) = pk4_fp8(o2[4 * g] * i64, o2[4 * g + 1] * i64, o2[4 * g + 2] * i64, o2[4 * g + 3] * i64);
                *(unsigned*)(op + 96 + 8 * g) = pk4_fp8(o3[4 * g] * i64, o3[4 * g + 1] * i64, o3[4 * g + 2] * i64, o3[4 * g + 3] * i64);
            }
        } else {
            bf16* op = (bf16*)cur.O + tok * cur.o_ld + cur.ocol + 4 * hl;
#pragma unroll
            for (int g = 0; g < 4; ++g) {
                u32x2 w;
                w.x = pk2(o0[4 * g] * inv, o0[4 * g + 1] * inv); w.y = pk2(o0[4 * g + 2] * inv, o0[4 * g + 3] * inv); *(u32x2*)(op + 8 * g) = w;
                w.x = pk2(o1[4 * g] * inv, o1[4 * g + 1] * inv); w.y = pk2(o1[4 * g + 2] * inv, o1[4 * g + 3] * inv); *(u32x2*)(op + 32 + 8 * g) = w;
                w.x = pk2(o2[4 * g] * inv, o2[4 * g + 1] * inv); w.y = pk2(o2[4 * g + 2] * inv, o2[4 * g + 3] * inv); *(u32x2*)(op + 64 + 8 * g) = w;
                w.x = pk2(o3[4 * g] * inv, o3[4 * g + 1] * inv); w.y = pk2(o3[4 * g + 2] * inv, o3[4 * g + 3] * inv); *(u32x2*)(op + 96 + 8 * g) = w;
            }
        }
        if (cur.lse && hl == 0) cur.lse[tok * 12 + cur.lse_idx] = m + __builtin_log2f(lt);
        if (!has_next) break;
        AT_FILL(nxt);
        __syncthreads();
        AT_STORETAB(nxt); AT_WRITEFILL();
        __syncthreads();
        cur = nxt; it = itn;
    }
    LDS_WAIT();
#undef AT_FILL
#undef AT_WRITEFILL
#undef AT_TOFF
#undef AT_LOADQ
#undef AT_LOADTAB
#undef AT_STORETAB
#undef AT_EDGE
}

__device__ __forceinline__ void phase_amerge(unsigned char* ws, int gw, int NGW, int lane) {
    const bf16* AR = (const bf16*)(ws + WS_AR); const float* LSE = (const float*)(ws + WS_LSE); unsigned char* AO8 = ws + WS_AO;
    const size_t gt = (size_t)gw * 64 + lane, NT = (size_t)NGW * 64;
    for (size_t i = gt; i < (size_t)TH * 64; i += NT) {
        const size_t t = i >> 6; const int ch = (int)(i & 63), h = ch >> 4, dc = ch & 15;
        const float l0 = LSE[t * 12 + h], l1 = LSE[t * 12 + 4 + h], l2 = LSE[t * 12 + 8 + h];
        const float mx = fmaxf(l0, fmaxf(l1, l2));
        float w0 = __builtin_amdgcn_exp2f(l0 - mx), w1 = __builtin_amdgcn_exp2f(l1 - mx), w2 = __builtin_amdgcn_exp2f(l2 - mx);
        const float inv = 1.0f / (w0 + w1 + w2); w0 *= inv; w1 *= inv; w2 *= inv;
        const bf16* ap = AR + t * 1536 + h * 128 + dc * 8;
        const u32x4 a = *(const u32x4*)ap, b = *(const u32x4*)(ap + 512), cc = *(const u32x4*)(ap + 1024);
        w0 *= 64.f; w1 *= 64.f; w2 *= 64.f;
        u32x2 o;
        o.x = pk4_fp8(w0 * pg8::bf_lo(a.x) + w1 * pg8::bf_lo(b.x) + w2 * pg8::bf_lo(cc.x), w0 * pg8::bf_hi(a.x) + w1 * pg8::bf_hi(b.x) + w2 * pg8::bf_hi(cc.x),
                      w0 * pg8::bf_lo(a.y) + w1 * pg8::bf_lo(b.y) + w2 * pg8::bf_lo(cc.y), w0 * pg8::bf_hi(a.y) + w1 * pg8::bf_hi(b.y) + w2 * pg8::bf_hi(cc.y));
        o.y = pk4_fp8(w0 * pg8::bf_lo(a.z) + w1 * pg8::bf_lo(b.z) + w2 * pg8::bf_lo(cc.z), w0 * pg8::bf_hi(a.z) + w1 * pg8::bf_hi(b.z) + w2 * pg8::bf_hi(cc.z),
                      w0 * pg8::bf_lo(a.w) + w1 * pg8::bf_lo(b.w) + w2 * pg8::bf_lo(cc.w), w0 * pg8::bf_hi(a.w) + w1 * pg8::bf_hi(b.w) + w2 * pg8::bf_hi(cc.w));
        *(u32x2*)(AO8 + t * 512 + h * 128 + dc * 8) = o;
    }
}

__device__ __forceinline__ void phase_ln(float* Y, bf16* XB, unsigned char* X8, float* st, bool inplace, const float* __restrict__ gam, const float* __restrict__ bet, int gw, int NGW, int lane, unsigned char* XI8 = nullptr, float* rsc = nullptr) {
    for (int row0 = 2 * gw; row0 < T; row0 += 2 * NGW) {
        f32x4* yr0 = (f32x4*)(Y + (size_t)row0 * D) + lane; f32x4* yr1 = yr0 + D / 4;
        f32x4 v[8], w[8]; float s = 0.f, t = 0.f;
#pragma unroll
        for (int j = 0; j < 8; ++j) { v[j] = yr0[64 * j]; w[j] = yr1[64 * j]; }
#pragma unroll
        for (int j = 0; j < 8; ++j) { s += (v[j][0] + v[j][1]) + (v[j][2] + v[j][3]); t += (w[j][0] + w[j][1]) + (w[j][2] + w[j][3]); }
#pragma unroll
        for (int o = 1; o < 64; o <<= 1) { s += shx(s, o, lane); t += shx(t, o, lane); }
        const float mean0 = s * (1.f / D), mean1 = t * (1.f / D); float s2 = 0.f, t2 = 0.f;
#pragma unroll
        for (int j = 0; j < 8; ++j) { v[j] = v[j] - mean0; w[j] = w[j] - mean1; s2 += (v[j][0] * v[j][0] + v[j][1] * v[j][1]) + (v[j][2] * v[j][2] + v[j][3] * v[j][3]); t2 += (w[j][0] * w[j][0] + w[j][1] * w[j][1]) + (w[j][2] * w[j][2] + w[j][3] * w[j][3]); }
#pragma unroll
        for (int o = 1; o < 64; o <<= 1) { s2 += shx(s2, o, lane); t2 += shx(t2, o, lane); }
        const float rstd0 = 1.0f / sqrtf(s2 * (1.f / D) + LN_EPS), rstd1 = 1.0f / sqrtf(t2 * (1.f / D) + LN_EPS);
        if (st && lane == 0) { f32x4 sv; sv[0] = mean0; sv[1] = rstd0; sv[2] = mean1; sv[3] = rstd1; *(f32x4*)(st + 2 * (size_t)row0) = sv; }
        float am0 = 0.f, am1 = 0.f;
#pragma unroll
        for (int j = 0; j < 8; ++j) { const f32x4 gg = *((const f32x4*)gam + lane + 64 * j), bb = *((const f32x4*)bet + lane + 64 * j);
            const f32x4 o = v[j] * rstd0 * gg + bb, q = w[j] * rstd1 * gg + bb;
            if (inplace) { yr0[64 * j] = o; yr1[64 * j] = q; }
            if (XB) { u32x2 u; u.x = pk2(o[0], o[1]); u.y = pk2(o[2], o[3]); *((u32x2*)(XB + (size_t)row0 * D) + lane + 64 * j) = u; u.x = pk2(q[0], q[1]); u.y = pk2(q[2], q[3]); *((u32x2*)(XB + (size_t)(row0 + 1) * D) + lane + 64 * j) = u; }
            if (X8) { *((unsigned*)(X8 + (size_t)row0 * D) + lane + 64 * j) = pk4_fp8(o[0] * 32.f, o[1] * 32.f, o[2] * 32.f, o[3] * 32.f); *((unsigned*)(X8 + (size_t)(row0 + 1) * D) + lane + 64 * j) = pk4_fp8(q[0] * 32.f, q[1] * 32.f, q[2] * 32.f, q[3] * 32.f); }
            if (XI8) { v[j] = o; w[j] = q; am0 = fmaxf(am0, fmaxf(fmaxf(fabsf(o[0]), fabsf(o[1])), fmaxf(fabsf(o[2]), fabsf(o[3])))); am1 = fmaxf(am1, fmaxf(fmaxf(fabsf(q[0]), fabsf(q[1])), fmaxf(fabsf(q[2]), fabsf(q[3])))); } }
        if (XI8) {
#pragma unroll
            for (int o = 1; o < 64; o <<= 1) { am0 = fmaxf(am0, shx(am0, o, lane)); am1 = fmaxf(am1, shx(am1, o, lane)); }
            const float i0 = am0 > 0.f ? 127.0f / am0 : 0.f, i1 = am1 > 0.f ? 127.0f / am1 : 0.f;
            if (lane == 0) { rsc[row0] = am0 * (1.0f / 127.0f); rsc[row0 + 1] = am1 * (1.0f / 127.0f); }
#pragma unroll
            for (int j = 0; j < 8; ++j) {
                { const int a = (int)__builtin_rintf(v[j][0] * i0), b = (int)__builtin_rintf(v[j][1] * i0), c = (int)__builtin_rintf(v[j][2] * i0), d = (int)__builtin_rintf(v[j][3] * i0);
                  *((unsigned*)(XI8 + (size_t)row0 * D) + lane + 64 * j) = ((unsigned)a & 255u) | (((unsigned)b & 255u) << 8) | (((unsigned)c & 255u) << 16) | ((unsigned)d << 24); }
                { const int a = (int)__builtin_rintf(w[j][0] * i1), b = (int)__builtin_rintf(w[j][1] * i1), c = (int)__builtin_rintf(w[j][2] * i1), d = (int)__builtin_rintf(w[j][3] * i1);
                  *((unsigned*)(XI8 + (size_t)(row0 + 1) * D) + lane + 64 * j) = ((unsigned)a & 255u) | (((unsigned)b & 255u) << 8) | (((unsigned)c & 255u) << 16) | ((unsigned)d << 24); } }
        }
    }
}

__global__ void __launch_bounds__(NTHREADS, 2) fwd_mega(Params p_arg) {
    extern __shared__ __attribute__((aligned(16))) unsigned char lds_raw[];
    LAS unsigned char* lds = (LAS unsigned char*)lds_raw;
    const int ph_lo = p_arg.ph_lo, ph_hi = p_arg.ph_hi;
    if (threadIdx.x < 4) ((LAS unsigned*)(lds + LDS_BARST))[threadIdx.x] = 0u;
    __syncthreads();
    for (int ph = ph_lo; ph < ph_hi; ++ph) {
      for (int rep = 0; rep < 2; ++rep) {
        if (ph > ph_lo || rep > 0) {
#if defined(__HIP_DEVICE_COMPILE__)
            unsigned* barw = (unsigned*)(((PP)__builtin_amdgcn_kernarg_segment_ptr())->ws + WS_BAR);
            if (ph == 1 && rep == 0) { cg::this_grid().sync();
                (void)xcd_barrier_post(barw, (volatile LAS unsigned*)(lds + LDS_BARST)); }
            else {
#ifdef DBG_BAR
                const unsigned long long tb0_ = __builtin_amdgcn_s_memrealtime();
#endif
                XcdBarrier xb_; xb_.bar = barw; xb_.x = xb_xcc_id(); xb_.st = (volatile LAS unsigned*)(lds + LDS_BARST); xcd_barrier(xb_);
#ifdef DBG_BAR
                if (blockIdx.x == DBG_BAR && threadIdx.x == 0) { unsigned long long* d_ = (unsigned long long*)(((PP)__builtin_amdgcn_kernarg_segment_ptr())->ws + WS_BAR + 65536); const unsigned long long dt_ = __builtin_amdgcn_s_memrealtime() - tb0_; d_[0] = (ph == 2 ? 0ull : d_[0]) + dt_; }
#endif
            }
#endif
        }
#if defined(__HIP_DEVICE_COMPILE__)
        PP p = (PP)__builtin_amdgcn_kernarg_segment_ptr(); asm volatile("" : "+s"(p));
#else
        PP p = (PP)(uintptr_t)0; (void)p_arg;
#endif
        int tid_ = threadIdx.x, bx_ = blockIdx.x; asm volatile("" : "+v"(tid_), "+s"(bx_));
        const int tid = tid_, lane = tid & 63, wave = __builtin_amdgcn_readfirstlane(tid >> 6);
        const int G = gridDim.x, bx = bx_, vcu = (G % 8 == 0) ? (bx % 8) * (G / 8) + bx / 8 : bx;
        const int gw = vcu * NWAVES + wave, NGW = G * NWAVES;
        unsigned char* ws = p->ws; bf16* XB = (bf16*)(ws + WS_XB);
        if (ph == 0) {
#if EN_PRO
 phase_prologue(p, lds, gw, NGW, wave, lane);
#endif
 break; }
        const int q = ph - 1, layer = q / 13, s = q - layer * 13;
        const bf16* wl = (const bf16*)(ws + WS_W0 + (size_t)layer * WS_WL);
        const bool dbl = (s < 8 && (s & 3) == 1 && (PROBE_MASK & 2)) || (s < 8 && (s & 3) == 2 && (PROBE_MASK & 4)) || ((s == 9 || (s == 12 && layer == 0)) && (PROBE_MASK & 8)) || (s < 8 && (s & 3) == 0 && (PROBE_MASK & 16)) || (s == 10 && (PROBE_MASK & 32)) || (s < 8 && (s & 3) == 3 && (PROBE_MASK & 64));
        if (s < 8) {
            const int half = s >> 2, sub = s & 3;
            if (sub == 0) {
                pg8::Gemm g{(const bf16*)(ws + WS_X8 + (size_t)half * TH * D), wl + WO_IN, TH, CIN, D / 2}; pg8::StaticOrder S; S.init(TH, CIN, G, bx);
                pg8::EpiProj E{(bf16*)(ws + WS_PROJ), CIN, ws + WS_G8, 4096, 6144};

#if EN_INPROJ
 pg8::gemm_phase<pg8::EpiProj, pg8::StaticOrder, true, true, true>(lds, g, S, E);
#endif

            } else if (sub == 1) {
#if EN_ATTN
 phase_attention(ws, p->sink, lds, layer, vcu, G, wave, lane);
#endif

            } else if (sub == 2) { phase_amerge(ws, gw, NGW, lane);
            } else {
                for (int k = 0; k < 2; ++k) {
                    pg8::Gemm g{k == 0 ? (const bf16*)(ws + WS_AO) : (const bf16*)(ws + WS_BO), wl + (k == 0 ? WO_PA : WO_PB), TH, D, k == 0 ? 256 : 512, 0x79797979, 0x78787878};
                    pg8::StaticOrder S; S.init(TH, D, G, bx);
                    pg8::EpiGate E{(bf16*)(ws + WS_XB + 64 * MiB), ws + WS_XB + (size_t)half * TH * D, D, ws + WS_G8 + (k == 0 ? 0 : 2048), 4096, k, 512.f};

#if EN_GATE
 pg8::gemm_phase<pg8::EpiGate, pg8::StaticOrder, true, true, true>(lds, g, S, E);
#endif

                }
            }
        } else if (s == 8 || s == 11) {
            const bool dn = (s == 11);
            pg8::StaticOrder S; S.init(T, D, G, bx);
            const bool raw = (!dn && layer == 0);
            pg8::EpiResid E{(pg8::ArgV)p, raw ? 0 : -1, dn ? 7 : 11, dn ? 8 : 12, D, ALPHA, (size_t)(dn ? layer : (layer > 0 ? layer - 1 : 0)) * D, WS_ST};
#if EN_RESID
            if (dn && layer == FP8_DOWN_LAYER) { pg8::Gemm g{(const bf16*)(ws + WS_H), wl + WO_DN, T, D, DFF / 2, 0x79797979, 0x77777777}; pg8::gemm_phase<pg8::EpiResid, pg8::StaticOrder, true, true, true>(lds, g, S, E); }
            else if (dn) { pg8::Gemm g{(const bf16*)(ws + WS_H), wl + WO_DN, T, D, DFF}; pg8::gemm_phase<pg8::EpiResid, pg8::StaticOrder, true, true>(lds, g, S, E); }
            else { pg8::Gemm g{(const bf16*)(ws + WS_XB), wl + WO_OUT, T, D, D / 2, 0x76767676, 0x78787878}; pg8::gemm_phase<pg8::EpiResid, pg8::StaticOrder, true, true, true>(lds, g, S, E); }
#endif
        } else if (s == 9) { phase_ln(p->out, nullptr, nullptr, (float*)(ws + WS_ST), false, p->ln1_g + layer * D, p->ln1_b + layer * D, gw, NGW, lane, ws + WS_XB, (float*)(ws + WS_RS));
        } else if (s == 10) {
            pg8::Gemm g{XB, wl + WO_UP, T, NUP, D / 2}; pg8::StaticOrder S; S.init(T, NUP, G, bx);
            pg8::EpiSwigluI8 E{(bf16*)(ws + WS_H), DFF, layer == FP8_DOWN_LAYER ? 64.f : 0.f, (const float*)(ws + WS_RS), (const float*)(ws + WS_CMAX) + layer * NUP};

#if EN_SWIGLU
 pg8::gemm_phase<pg8::EpiSwigluI8, pg8::StaticOrder, true, true, false, true>(lds, g, S, E);
#endif

        } else { phase_ln(p->out, nullptr, (layer == 1) ? nullptr : ws + WS_X8, (layer == 1) ? nullptr : (float*)(ws + WS_ST), layer == 1, p->ln2_g + layer * D, p->ln2_b + layer * D, gw, NGW, lane); }
        if (!(rep == 0 && dbl)) break;
      }
    }
#if defined(__HIP_DEVICE_COMPILE__) && defined(DBG_BAR)
    if (blockIdx.x == DBG_BAR && threadIdx.x == 0) { PP p = (PP)__builtin_amdgcn_kernarg_segment_ptr(); const unsigned long long* d = (const unsigned long long*)(p->ws + WS_BAR + 65536);
        float v = (float)d[0] * 0.01f;
        v = __builtin_rintf(v / 100.f) * 100.f; p->out[0] = v * 1.0e3f; }
#endif
}

#ifndef MK_PER_PHASE
#define MK_PER_PHASE 0
#endif
extern "C" void kernel_launch(void* const* d_in, const int* in_sizes, int n_in, void* d_out, int out_size, void* d_ws, size_t ws_size, hipStream_t stream) {
    static int grid = 0;
    if (grid == 0) {
        if (n_in != 13 || ws_size < WS_END) { fprintf(stderr, "kernel_launch: unexpected inputs (n_in %d, ws %zu)\n", n_in, ws_size); grid = -1; return; }
        int dev = 0, cus = 0;
        if (hipGetDevice(&dev) != hipSuccess || hipDeviceGetAttribute(&cus, hipDeviceAttributeMultiprocessorCount, dev) != hipSuccess) { grid = -1; return; }
        if (hipFuncSetAttribute((const void*)fwd_mega, hipFuncAttributeMaxDynamicSharedMemorySize, LDS_BYTES) != hipSuccess) { fprintf(stderr, "kernel_launch: hipFuncSetAttribute failed\n"); grid = -1; return; }
        (void)hipGetLastError();
        grid = cus;
    }
    if (grid < 0) return;
    Params p{};
    p.x = (const float*)d_in[0]; p.rel_bias = (const float*)d_in[1]; p.w_in = (const float*)d_in[2]; p.sink = (const float*)d_in[3]; p.w_pa = (const float*)d_in[4]; p.w_pb = (const float*)d_in[5];
    p.w_out = (const float*)d_in[6]; p.ln1_g = (const float*)d_in[7]; p.ln1_b = (const float*)d_in[8]; p.w_up = (const float*)d_in[9]; p.w_down = (const float*)d_in[10];
    p.ln2_g = (const float*)d_in[11]; p.ln2_b = (const float*)d_in[12]; p.out = (float*)d_out; p.ws = (unsigned char*)d_ws;
#if MK_PER_PHASE
    for (int ph = 0; ph < NPHASES; ++ph) { p.ph_lo = ph; p.ph_hi = ph + 1; hipLaunchKernelGGL(fwd_mega, dim3(grid), dim3(NTHREADS), LDS_BYTES, stream, p); }
#else
    p.ph_lo = 0; p.ph_hi = NPHASES;
    void* args[] = {&p};
    hipError_t e = hipLaunchCooperativeKernel((const void*)fwd_mega, dim3(grid), dim3(NTHREADS), args, LDS_BYTES, stream);
    if (e != hipSuccess) fprintf(stderr, "kernel_launch: cooperative launch failed: %s (grid %d)\n", hipGetErrorString(e), grid);
#endif
}
```
